# Optimizing an MI355X kernel written in HIP

```python
import math
import numpy as np
import jax
import jax.numpy as jnp
from jax import lax

D_MODEL = 1024
BATCH = 16
SEQ = 2048
DEPTH = 4

N_MIXERS = 3
HEAD_DIM = 64
N_HEADS = D_MODEL // HEAD_DIM
D_FF = 4 * D_MODEL
ROPE_THETA = 10000.0
NORM_EPS = 1e-6
NEG_INF = -1e30
NSA_KV_GROUPS = 4
NSA_CMP_LEN = 32
NSA_CMP_STRIDE = 16
NSA_CMP_HIDDEN = 4 * HEAD_DIM
NSA_SEL_LEN = 64
NSA_TOP_N = 16
NSA_WINDOW = 512
NSA_SEL_QBLOCK = 32
NSA_FORCE_BONUS = 1000.0
FOX_QBLOCK = 128
SWA_KV_HEADS = 2
SWA_WINDOW = 128
BAND_QBLOCK = 128
N_LAYERS_A = len(range(0, DEPTH, N_MIXERS))
N_LAYERS_B = len(range(1, DEPTH, N_MIXERS))
N_LAYERS_C = len(range(2, DEPTH, N_MIXERS))

kernel_name = 'hybrid_nsa_fox_swa_sink_decoder'


def rms_norm(x, g):
    xf = x.astype(jnp.float32)
    y = xf * lax.rsqrt(jnp.mean(xf * xf, axis=-1, keepdims=True) + NORM_EPS)
    return (y * g.astype(jnp.float32)).astype(x.dtype)


def rope_tables(seq):
    inv = ROPE_THETA ** (-jnp.arange(0, HEAD_DIM, 2, dtype=jnp.float32) / HEAD_DIM)
    ang = jnp.arange(seq, dtype=jnp.float32)[:, None] * inv[None, :]
    return jnp.cos(ang), jnp.sin(ang)


def apply_rope(x, cos, sin):
    xf = x.astype(jnp.float32)
    x1, x2 = jnp.split(xf, 2, axis=-1)
    c = cos[None, :, None, :]
    s = sin[None, :, None, :]
    return jnp.concatenate([x1 * c - x2 * s, x2 * c + x1 * s], axis=-1).astype(x.dtype)


def banded_attention(q, k, v, window, sinks=None):
    B, T, H, dh = q.shape
    G = k.shape[2]
    rep = H // G
    blk = BAND_QBLOCK
    nb = T // blk
    span = blk + window
    scale = dh ** -0.5
    kp = jnp.pad(k, ((0, 0), (window, 0), (0, 0), (0, 0)))
    vp = jnp.pad(v, ((0, 0), (window, 0), (0, 0), (0, 0)))
    qc = q.reshape(B, nb, blk, G, rep, dh).transpose(1, 0, 2, 3, 4, 5)
    offs_q = jnp.arange(blk)
    offs_k = jnp.arange(span) - window

    def one(args):
        i, qi = args
        start = i * blk
        kc = lax.dynamic_slice_in_dim(kp, start, span, axis=1)
        vc = lax.dynamic_slice_in_dim(vp, start, span, axis=1)
        qpos = start + offs_q
        kpos = start + offs_k
        dist = qpos[:, None] - kpos[None, :]
        valid = (kpos[None, :] >= 0) & (dist >= 0) & (dist < window)
        s = jnp.einsum('bqgrd,bkgd->bgrqk', qi, kc).astype(jnp.float32) * scale
        s = jnp.where(valid, s, NEG_INF)
        if sinks is None:
            p = jax.nn.softmax(s, axis=-1)
        else:
            sink = jnp.broadcast_to(sinks.astype(jnp.float32).reshape(G, rep)[None, :, :, None, None],
                                    (B, G, rep, blk, 1))
            p = jax.nn.softmax(jnp.concatenate([s, sink], axis=-1), axis=-1)[..., :-1]
        return jnp.einsum('bgrqk,bkgd->bqgrd', p.astype(vc.dtype), vc)

    out = lax.map(one, (jnp.arange(nb), qc))
    return out.transpose(1, 0, 2, 3, 4, 5).reshape(B, T, H, dh)


def nsa_compress(tok, pos, w1, w2):
    B, T, G, dh = tok.shape
    nc = (T - NSA_CMP_LEN) // NSA_CMP_STRIDE + 1
    idx = np.arange(nc)[:, None] * NSA_CMP_STRIDE + np.arange(NSA_CMP_LEN)[None, :]
    win = tok[:, idx] + pos[:, None, :].astype(tok.dtype)
    win = win.transpose(0, 1, 3, 2, 4).reshape(B, nc, G, NSA_CMP_LEN * dh)
    return jax.nn.silu(win @ w1) @ w2


def nsa_selected_attention(qg, k, v, sel):
    B, T, G, rep, dh = qg.shape
    ns = T // NSA_SEL_LEN
    n = sel.shape[-1]
    qb = NSA_SEL_QBLOCK
    nq = T // qb
    scale = dh ** -0.5
    kb = k.reshape(B, ns, NSA_SEL_LEN, G, dh).transpose(0, 3, 1, 2, 4)
    vb = v.reshape(B, ns, NSA_SEL_LEN, G, dh).transpose(0, 3, 1, 2, 4)
    qc = qg.reshape(B, nq, qb, G, rep, dh).transpose(1, 0, 2, 3, 4, 5)
    sc = sel.reshape(B, G, nq, qb, n).transpose(2, 0, 1, 3, 4)
    gather = jax.vmap(jax.vmap(lambda tab, ix: tab[ix]))
    offs = jnp.arange(NSA_SEL_LEN)

    def one(args):
        i, qi, si = args
        gk = gather(kb, si).reshape(B, G, qb, n * NSA_SEL_LEN, dh)
        gv = gather(vb, si).reshape(B, G, qb, n * NSA_SEL_LEN, dh)
        kpos = (si[..., None] * NSA_SEL_LEN + offs).reshape(B, G, qb, n * NSA_SEL_LEN)
        qpos = i * qb + jnp.arange(qb)
        valid = kpos <= qpos[None, None, :, None]
        s = jnp.einsum('bqgrd,bgqkd->bgrqk', qi, gk).astype(jnp.float32) * scale
        s = jnp.where(valid[:, :, None], s, NEG_INF)
        p = jax.nn.softmax(s, axis=-1)
        return jnp.einsum('bgrqk,bgqkd->bqgrd', p.astype(gv.dtype), gv)

    out = lax.map(one, (jnp.arange(nq), qc, sc))
    return out.transpose(1, 0, 2, 3, 4, 5).reshape(B, T, G * rep, dh)


def nsa_mixer(h, w_in, cmp_pos, cmp_w1, cmp_w2, w_out, cos, sin):
    B, T, _ = h.shape
    H, G, dh = N_HEADS, NSA_KV_GROUPS, HEAD_DIM
    rep = H // G
    kvw = G * dh
    scale = dh ** -0.5
    proj = h @ w_in
    sizes = [H * dh, kvw, kvw, kvw, kvw, kvw, kvw, 3 * H]
    cuts = np.cumsum(sizes)[:-1].tolist()
    q, kc_t, vc_t, ks, vs, kw, vw, gate = jnp.split(proj, cuts, axis=-1)
    q = apply_rope(q.reshape(B, T, H, dh), cos, sin)
    kc_t = apply_rope(kc_t.reshape(B, T, G, dh), cos, sin)
    ks = apply_rope(ks.reshape(B, T, G, dh), cos, sin)
    kw = apply_rope(kw.reshape(B, T, G, dh), cos, sin)
    vc_t = vc_t.reshape(B, T, G, dh)
    vs = vs.reshape(B, T, G, dh)
    vw = vw.reshape(B, T, G, dh)
    qg = q.reshape(B, T, G, rep, dh)
    tpos = jnp.arange(T)

    kcmp = nsa_compress(kc_t, cmp_pos[0], cmp_w1[0], cmp_w2[0])
    vcmp = nsa_compress(vc_t, cmp_pos[1], cmp_w1[1], cmp_w2[1])
    nc = kcmp.shape[1]
    s = jnp.einsum('btgrd,bcgd->bgrtc', qg, kcmp).astype(jnp.float32) * scale
    cend = jnp.arange(nc) * NSA_CMP_STRIDE + NSA_CMP_LEN - 1
    cvalid = cend[None, :] <= tpos[:, None]
    p_cmp = jax.nn.softmax(jnp.where(cvalid, s, NEG_INF), axis=-1)
    p_cmp = jnp.where((tpos >= NSA_CMP_LEN - 1)[:, None], p_cmp, 0.0)
    o_cmp = jnp.einsum('bgrtc,bcgd->btgrd', p_cmp.astype(vcmp.dtype), vcmp).reshape(B, T, H, dh)

    ns = T // NSA_SEL_LEN
    c_lo = np.arange(nc)[:, None] * NSA_CMP_STRIDE
    s_lo = np.arange(ns)[None, :] * NSA_SEL_LEN
    ov = np.clip(np.minimum(c_lo + NSA_CMP_LEN, s_lo + NSA_SEL_LEN) - np.maximum(c_lo, s_lo), 0, None)
    overlap = jnp.asarray(ov.astype(np.float32) / NSA_CMP_LEN)
    imp = jnp.einsum('bgrtc,cn->bgtn', p_cmp, overlap)
    tblk = tpos // NSA_SEL_LEN
    j = jnp.arange(ns)
    forced = (j[None, :] == 0) | (j[None, :] == tblk[:, None]) | (j[None, :] == tblk[:, None] - 1)
    bvalid = j[None, :] <= tblk[:, None]
    score = jnp.where(bvalid, imp + jnp.where(forced, NSA_FORCE_BONUS, 0.0), -1.0)
    n_top = min(NSA_TOP_N, ns)
    _, sel = lax.top_k(score, n_top)

    o_slc = nsa_selected_attention(qg, ks, vs, sel)
    o_win = banded_attention(q, kw, vw, NSA_WINDOW)

    g = jax.nn.sigmoid(gate.astype(jnp.float32)).reshape(B, T, H, 3)
    o = g[..., 0:1] * o_cmp + g[..., 1:2] * o_slc + g[..., 2:3] * o_win
    return o.astype(h.dtype).reshape(B, T, H * dh) @ w_out


def fox_attention(q, k, v, logf):
    B, T, H, dh = q.shape
    blk = FOX_QBLOCK
    nb = T // blk
    scale = dh ** -0.5
    c = jnp.cumsum(logf, axis=1).transpose(0, 2, 1)
    outs = []
    for i in range(nb):
        lo, hi = i * blk, (i + 1) * blk
        s = jnp.einsum('bqhd,bkhd->bhqk', q[:, lo:hi], k[:, :hi]).astype(jnp.float32) * scale
        s = s + c[:, :, lo:hi, None] - c[:, :, None, :hi]
        causal = jnp.arange(lo, hi)[:, None] >= jnp.arange(hi)[None, :]
        p = jax.nn.softmax(jnp.where(causal, s, NEG_INF), axis=-1)
        outs.append(jnp.einsum('bhqk,bkhd->bqhd', p.astype(v.dtype), v[:, :hi]))
    return jnp.concatenate(outs, axis=1)


def fox_mixer(h, w_in, b_f, w_out):
    B, T, _ = h.shape
    H, dh = N_HEADS, HEAD_DIM
    proj = h @ w_in
    q, k, v, fl = jnp.split(proj, [H * dh, 2 * H * dh, 3 * H * dh], axis=-1)
    logf = jax.nn.log_sigmoid(fl.astype(jnp.float32) + b_f.astype(jnp.float32))
    o = fox_attention(q.reshape(B, T, H, dh), k.reshape(B, T, H, dh), v.reshape(B, T, H, dh), logf)
    return o.reshape(B, T, H * dh) @ w_out


def swa_mixer(h, w_in, b_in, sinks, w_out, b_out, cos, sin):
    B, T, _ = h.shape
    H, G, dh = N_HEADS, SWA_KV_HEADS, HEAD_DIM
    proj = h @ w_in + b_in
    q, k, v = jnp.split(proj, [H * dh, H * dh + G * dh], axis=-1)
    q = apply_rope(q.reshape(B, T, H, dh), cos, sin)
    k = apply_rope(k.reshape(B, T, G, dh), cos, sin)
    o = banded_attention(q, k, v.reshape(B, T, G, dh), SWA_WINDOW, sinks)
    return o.reshape(B, T, H * dh) @ w_out + b_out


def squared_relu_mlp(h, w_up, w_down):
    return jnp.square(jax.nn.relu(h @ w_up)) @ w_down


def setup_inputs(seed: int = 0) -> dict:
    key = jax.random.key(seed)
    ks = jax.random.split(key, 20)
    D, H, dh = D_MODEL, N_HEADS, HEAD_DIM
    f32 = jnp.float32
    nsa_in_w = H * dh + 6 * NSA_KV_GROUPS * dh + 3 * H
    fox_in_w = 3 * H * dh + H
    swa_in_w = H * dh + 2 * SWA_KV_HEADS * dh
    cmp_in = NSA_CMP_LEN * dh
    nrm = lambda k, shape, fan: jax.random.normal(k, shape, f32) * (fan ** -0.5)
    return {
        'x': jax.random.normal(ks[0], (BATCH, SEQ, D), f32),
        'norm_g': 1.0 + 0.02 * jax.random.normal(ks[1], (DEPTH, 4, D), f32),
        'mlp_w_up': nrm(ks[2], (DEPTH, D, D_FF), D),
        'mlp_w_down': nrm(ks[3], (DEPTH, D_FF, D), D_FF),
        'nsa_w_in': nrm(ks[4], (N_LAYERS_A, D, nsa_in_w), D),
        'nsa_cmp_pos': 0.2 * jax.random.normal(ks[5], (N_LAYERS_A, 2, NSA_CMP_LEN, dh), f32),
        'nsa_cmp_w1': nrm(ks[6], (N_LAYERS_A, 2, cmp_in, NSA_CMP_HIDDEN), cmp_in),
        'nsa_cmp_w2': nrm(ks[7], (N_LAYERS_A, 2, NSA_CMP_HIDDEN, dh), NSA_CMP_HIDDEN),
        'nsa_w_out': nrm(ks[8], (N_LAYERS_A, H * dh, D), H * dh),
        'fox_w_in': nrm(ks[9], (N_LAYERS_B, D, fox_in_w), D),
        'fox_b_f': jax.random.uniform(ks[10], (N_LAYERS_B, H), f32, 1.0, 5.0),
        'fox_w_out': nrm(ks[11], (N_LAYERS_B, H * dh, D), H * dh),
        'swa_w_in': nrm(ks[12], (N_LAYERS_C, D, swa_in_w), D),
        'swa_b_in': 0.02 * jax.random.normal(ks[13], (N_LAYERS_C, swa_in_w), f32),
        'swa_sinks': jax.random.normal(ks[14], (N_LAYERS_C, H), f32),
        'swa_w_out': nrm(ks[15], (N_LAYERS_C, H * dh, D), H * dh),
        'swa_b_out': 0.02 * jax.random.normal(ks[16], (N_LAYERS_C, D), f32),
    }


def reference(x, norm_g, mlp_w_up, mlp_w_down, nsa_w_in, nsa_cmp_pos, nsa_cmp_w1, nsa_cmp_w2, nsa_w_out,
              fox_w_in, fox_b_f, fox_w_out, swa_w_in, swa_b_in, swa_sinks, swa_w_out, swa_b_out):
    T = x.shape[1]
    cos, sin = rope_tables(T)
    for i in range(DEPTH):
        kind = i % N_MIXERS
        slot = i // N_MIXERS
        h = rms_norm(x, norm_g[i, 0])
        if kind == 0:
            m = nsa_mixer(h, nsa_w_in[slot], nsa_cmp_pos[slot], nsa_cmp_w1[slot], nsa_cmp_w2[slot],
                          nsa_w_out[slot], cos, sin)
        elif kind == 1:
            m = fox_mixer(h, fox_w_in[slot], fox_b_f[slot], fox_w_out[slot])
        else:
            m = swa_mixer(h, swa_w_in[slot], swa_b_in[slot], swa_sinks[slot], swa_w_out[slot],
                          swa_b_out[slot], cos, sin)
        x = x + rms_norm(m, norm_g[i, 1])
        h = rms_norm(x, norm_g[i, 2])
        x = x + rms_norm(squared_relu_mlp(h, mlp_w_up[i], mlp_w_down[i]), norm_g[i, 3])
    return x
```

```cpp
#include <hip/hip_runtime.h>
#include <cstdio>
#include <cstdint>

#define LAS __attribute__((address_space(3)))
#define GAS __attribute__((address_space(1)))
typedef unsigned short bf16_t;
typedef short bf16x8 __attribute__((ext_vector_type(8)));
typedef short s16x4 __attribute__((ext_vector_type(4)));
typedef float f32x2 __attribute__((ext_vector_type(2)));
typedef float f32x4 __attribute__((ext_vector_type(4)));
typedef float f32x16 __attribute__((ext_vector_type(16)));
typedef unsigned u32x2 __attribute__((ext_vector_type(2)));
typedef unsigned u32x4 __attribute__((ext_vector_type(4)));

constexpr int BATCH = 16, T = 2048, D = 1024, NH = 16, HD = 64, FF = 4096, DEPTH = 4;
constexpr int M = BATCH * T;
constexpr int NSA_N = 2608, NSA_NP = 2816, NSA_LDP = 2560;
constexpr int FOX_N = 3088, FOX_NP = 3328, FOX_LDP = 3072;
constexpr int SWA_N = 1280, SWA_NP = 1280, SWA_LDP = 1280;
constexpr int CMP_LDP = NSA_LDP;
constexpr int NC = 127, NCP = 128;
constexpr int CMP_ROWS = BATCH * NCP * 4;
constexpr float LOG2E = 1.4426950408889634f;
constexpr float C2 = 0.125f * LOG2E;
constexpr float NORM_EPS = 1e-6f;

__device__ __forceinline__ unsigned cvt_pk_bf16(float lo, float hi) { unsigned r; asm volatile("v_cvt_pk_bf16_f32 %0, %1, %2" : "=v"(r) : "v"(lo), "v"(hi)); return r; }
__device__ __forceinline__ void store8(bf16_t* p, f32x4 a, f32x4 b) { u32x4 w; w.x = cvt_pk_bf16(a[0], a[1]); w.y = cvt_pk_bf16(a[2], a[3]); w.z = cvt_pk_bf16(b[0], b[1]); w.w = cvt_pk_bf16(b[2], b[3]); *(u32x4*)p = w; }

__device__ __forceinline__ int lane_id_volatile() { int x; asm volatile("v_mbcnt_lo_u32_b32 %0, -1, 0\n\tv_mbcnt_hi_u32_b32 %0, -1, %0" : "=v"(x)); return x; }

namespace pg8 {
#define PG8_LAS __attribute__((address_space(3)))
constexpr int BM = 256, BK = 64, HALF = 128, HTB = HALF * BK * 2  , STAGE_BYTES = 8 * HTB, NXCD = 8, WGM = 8;

__host__ __device__ __forceinline__ int lds_byte(int r, int c) { const int st = (r >> 4) * 2 + (c >> 5), rr = r & 15, cc = c & 31, ob = rr * 64 + cc * 2; return st * 1024 + (ob ^ (((ob >> 9) & 1) << 5)); }
__host__ __device__ __forceinline__ void stage_rc(int b, int& R, int& C) { const int st = b / 1024, sb = b % 1024, swz = sb ^ (((sb >> 9) & 1) << 5); R = (st >> 1) * 16 + swz / 64; C = (st & 1) * 32 + (swz % 64) / 2; }
__host__ __device__ __forceinline__ int perm32(int rho) { const int n = rho >> 4, i = rho & 15; return 8 * (i >> 2) + 4 * n + (i & 3); }

struct Unit { int pm, pn; };
struct Gemm { const bf16_t* A; const bf16_t* Bt; int M, N, K; };

struct StaticOrder {
    int nM, nN, nwg, G, c;
    __host__ __device__ void init(int M_, int N_, int G_, int c_) { nM = M_ / BM; nN = N_ / BM; nwg = nM * nN; G = G_; c = c_; }
    __host__ __device__ bool next(int i, Unit& u) const {
        const long L = (long)i * G + c; if (L >= nwg) return false;
        int wgid = (int)L; { const int q = nwg / NXCD, r = nwg % NXCD, xcd = wgid % NXCD, off = wgid / NXCD; wgid = (xcd < r ? xcd * (q + 1) : r * (q + 1) + (xcd - r) * q) + off; }
        const int nig = WGM * nN, gid = wgid / nig, fm = gid * WGM, gsz = (nM - fm) < WGM ? (nM - fm) : WGM;
        u.pm = fm + ((wgid % nig) % gsz); u.pn = (wgid % nig) / gsz; return true;
    }
    __device__ __forceinline__ void a_ready(const Unit&) const {}
    __device__ __forceinline__ void done(const Unit&) const {}
};

enum EpiMode { EM_PLAIN = 0, EM_RELU2 = 1, EM_NSA = 2, EM_FOX = 3, EM_SWA = 4, EM_CMP = 5 };

__device__ __forceinline__ void rope4(f32x4& v, float c0, float s0, float c1, float s1) {
    const float a0 = v[0], b0 = v[1], a1 = v[2], b1 = v[3];
    v[0] = a0 * c0 - b0 * s0; v[1] = b0 * c0 + a0 * s0; v[2] = a1 * c1 - b1 * s1; v[3] = b1 * c1 + a1 * s1;
}
__device__ __forceinline__ float sigmoidf_(float x) { return 1.0f / (1.0f + __expf(-x)); }
__device__ __forceinline__ float logsigmoidf_(float x) { return fminf(x, 0.f) - log1pf(expf(-fabsf(x))); }

template <int MODE> struct Epi {
    static constexpr bool PERM = true, AFTER_DRAIN = false;
    bf16_t* O; int ldc; const float* bias; const float* rc; const float* rs; float* aux; const float* auxb;
    __device__ __forceinline__ void operator()(const f32x4 (&acc)[2][2][4][2], const Unit& u, int wr, int wc, int fr, int fq) const {
        const int row0 = u.pm * BM + wr * 64 + fr;
        const int cw = wc * 32 + 8 * fq;
        const int colt = u.pn * BM;
        if (MODE == EM_NSA && u.pn == 10) {
            if (cw < 48) {
#pragma unroll
                for (int ai = 0; ai < 2; ++ai)
#pragma unroll
                    for (int m = 0; m < 4; ++m) { const size_t row = (size_t)(row0 + ai * HALF + m * 16); f32x4 v0 = acc[ai][0][m][0], v1 = acc[ai][0][m][1];
#pragma unroll
                        for (int j = 0; j < 4; ++j) { v0[j] = sigmoidf_(v0[j]); v1[j] = sigmoidf_(v1[j]); }
                        *(f32x4*)(aux + row * 48 + cw) = v0; *(f32x4*)(aux + row * 48 + cw + 4) = v1; }
            }
            return;
        }
        if (MODE == EM_FOX && u.pn == 12) {
            if (cw < 16) {
                const f32x4 b0 = *(const f32x4*)(auxb + cw), b1 = *(const f32x4*)(auxb + cw + 4);
#pragma unroll
                for (int ai = 0; ai < 2; ++ai)
#pragma unroll
                    for (int m = 0; m < 4; ++m) { const size_t row = (size_t)(row0 + ai * HALF + m * 16); f32x4 v0 = acc[ai][0][m][0] + b0, v1 = acc[ai][0][m][1] + b1;
#pragma unroll
                        for (int j = 0; j < 4; ++j) { v0[j] = logsigmoidf_(v0[j]); v1[j] = logsigmoidf_(v1[j]); }
                        *(f32x4*)(aux + row * 16 + cw) = v0; *(f32x4*)(aux + row * 16 + cw + 4) = v1; }
            }
            return;
        }
        bool rope0 = false, rope1 = false; float sc = 1.f;
        if (MODE == EM_NSA) { if (u.pn < 4) { rope0 = rope1 = true; sc = C2; } else if (!(u.pn & 1)) { rope0 = rope1 = true; } }
        if (MODE == EM_FOX) { if (u.pn < 4) sc = C2; }
        if (MODE == EM_SWA) { if (u.pn < 4) { rope0 = rope1 = true; sc = C2; } else { rope0 = true; } }
        f32x4 bv[2][2];
#pragma unroll
        for (int bj = 0; bj < 2; ++bj)
#pragma unroll
            for (int n = 0; n < 2; ++n) bv[bj][n] = bias ? *(const f32x4*)(bias + colt + bj * HALF + cw + 4 * n) : (f32x4){0.f, 0.f, 0.f, 0.f};
        const int ib = 16 * (wc & 1) + 4 * fq;
        bf16_t* base = O; int colo = colt; size_t rowo = 0;
        if (MODE == EM_CMP) { colo = 0; rowo = (size_t)u.pn * CMP_ROWS; }
#pragma unroll
        for (int ai = 0; ai < 2; ++ai)
#pragma unroll
            for (int m = 0; m < 4; ++m) {
                const int row = row0 + ai * HALF + m * 16;
                f32x4 cc = {1.f, 1.f, 1.f, 1.f}, ss = {0.f, 0.f, 0.f, 0.f};
                if (MODE == EM_NSA || MODE == EM_SWA) { if (rope0) { const int t = row & (T - 1); cc = *(const f32x4*)(rc + t * 32 + ib); ss = *(const f32x4*)(rs + t * 32 + ib); } }
                bf16_t* rowp = base + (rowo + (size_t)row) * ldc + colo + cw;
#pragma unroll
                for (int bj = 0; bj < 2; ++bj) {
                    f32x4 v0 = acc[ai][bj][m][0] + bv[bj][0], v1 = acc[ai][bj][m][1] + bv[bj][1];
                    if (MODE == EM_NSA || MODE == EM_SWA) { if (bj == 0 ? rope0 : rope1) { rope4(v0, cc[0], ss[0], cc[1], ss[1]); rope4(v1, cc[2], ss[2], cc[3], ss[3]); } }
                    if (MODE == EM_RELU2) {
#pragma unroll
                        for (int j = 0; j < 4; ++j) { const float a = fmaxf(v0[j], 0.f), b = fmaxf(v1[j], 0.f); v0[j] = a * a; v1[j] = b * b; } }
                    if (MODE == EM_CMP) {
#pragma unroll
                        for (int j = 0; j < 4; ++j) { v0[j] = v0[j] * sigmoidf_(v0[j]); v1[j] = v1[j] * sigmoidf_(v1[j]); } }
                    if (MODE == EM_NSA || MODE == EM_FOX || MODE == EM_SWA) { v0 = v0 * sc; v1 = v1 * sc; }
                    store8(rowp + bj * HALF, v0, v1);
                }
            }
    }
};

template <class Epi, class Sched, int AMODE, bool ALIGN_EPI = false, bool SP2 = false>
__device__ __forceinline__ void gemm_phase(PG8_LAS unsigned char* lds, const Gemm g, const Sched& S, const Epi& E, int wave_id) {
    int tid_; { int x_; asm volatile("v_mbcnt_lo_u32_b32 %0, -1, 0\n\tv_mbcnt_hi_u32_b32 %0, -1, %0" : "=v"(x_)); tid_ = wave_id * 64 + x_; }
    const int tid = tid_, wid = __builtin_amdgcn_readfirstlane(tid >> 6), lane = tid & 63, wr = wid >> 2, wc = wid & 3, fr = lane & 15, fq = lane >> 4;
    const int K = g.K, nt = K / BK;
    unsigned voffA[2], voffB[2];
#pragma unroll
    for (int i = 0; i < 2; ++i) { int R, C; stage_rc(tid * 16 + i * 8192, R, C); const int Rb = Epi::PERM ? ((R & ~31) + perm32(R & 31)) : R;
        voffA[i] = (AMODE == 1) ? (unsigned)((16 * (R >> 2)) * CMP_LDP + (R & 3) * 64 + C) * 2u : (unsigned)(R * K + C) * 2u; voffB[i] = (unsigned)(Rb * K + C) * 2u; }
    const size_t kstepB = (size_t)(BK * 2);
    const size_t hstepB = (size_t)HALF * K * 2;
    const size_t tstepB = 2 * hstepB;
    const size_t kstepA = (AMODE == 1) ? (size_t)CMP_LDP * 2 : kstepB;
    const size_t hstepA = (AMODE == 1) ? (size_t)512 * CMP_LDP * 2 : hstepB;
    const size_t tstepA = 2 * hstepA;
    const size_t pnstepA = (AMODE == 1) ? (size_t)512 : (size_t)0;
    const unsigned ldsw = (unsigned)wid * 1024u;
    const int aoff = lds_byte(wr * 64 + fr, fq * 8), boff = lds_byte(wc * 32 + fr, fq * 8);
#define PG8_SA(b, h) (((b) * 2 + (h)) * HTB)
#define PG8_SB(b, h) ((4 + (b) * 2 + (h)) * HTB)
#define PG8_STAGE(bufoff, gbase, voff) do { _Pragma("unroll") for (int _i = 0; _i < 2; ++_i) \
        __builtin_amdgcn_global_load_lds((const unsigned*)((const char*)(gbase) + (voff)[_i]), (PG8_LAS unsigned*)(lds + (bufoff) + ldsw + _i * 8192), 16, 0, 0); } while (0)
#define PG8_LDA(dst, b, h) do { _Pragma("unroll") for (int m = 0; m < 4; ++m) _Pragma("unroll") for (int k = 0; k < 2; ++k) dst[m][k] = *(const PG8_LAS bf16x8*)(lds + PG8_SA(b, h) + aoff + m * 2048 + k * 1024); } while (0)
#define PG8_LDB(dst, b, h) do { _Pragma("unroll") for (int n = 0; n < 2; ++n) _Pragma("unroll") for (int k = 0; k < 2; ++k) dst[n][k] = *(const PG8_LAS bf16x8*)(lds + PG8_SB(b, h) + boff + n * 2048 + k * 1024); } while (0)
#define PG8_MMA(ai, bj, At, Bt) do { __builtin_amdgcn_s_setprio(1); _Pragma("unroll") for (int m = 0; m < 4; ++m) _Pragma("unroll") for (int n = 0; n < 2; ++n) _Pragma("unroll") for (int k = 0; k < 2; ++k) \
        acc[ai][bj][m][n] = __builtin_amdgcn_mfma_f32_16x16x32_bf16(Bt[n][k], At[m][k], acc[ai][bj][m][n], 0, 0, 0); __builtin_amdgcn_s_setprio(0); } while (0)
#define PG8_WAIT_V(n) asm volatile("s_waitcnt vmcnt(" #n ")" ::: "memory")
#define PG8_WAIT_L(n) asm volatile("s_waitcnt lgkmcnt(" #n ")" ::: "memory")
#define PG8_BAR __builtin_amdgcn_s_barrier()
#define PG8_SCHED __builtin_amdgcn_sched_barrier(0)
    Unit cur, nxt; int ui = 0;
    if (!S.next(0, cur)) return;
    f32x4 acc[2][2][4][2];
#pragma unroll
    for (int a = 0; a < 2; ++a)
#pragma unroll
        for (int b = 0; b < 2; ++b)
#pragma unroll
            for (int m = 0; m < 4; ++m)
#pragma unroll
                for (int n = 0; n < 2; ++n) acc[a][b][m][n] = (f32x4){0.f, 0.f, 0.f, 0.f};
    bf16x8 At[4][2], B0[2][2], B1[2][2];
    const char* cA = (const char*)g.A + (size_t)cur.pm * tstepA + (size_t)cur.pn * pnstepA; const char* cB = (const char*)g.Bt + (size_t)cur.pn * tstepB;
    S.a_ready(cur);
    if constexpr (SP2) {
        PG8_STAGE(PG8_SB(0, 0), cB, voffB); PG8_STAGE(PG8_SB(0, 1), cB + hstepB, voffB); PG8_STAGE(PG8_SA(0, 0), cA, voffA); PG8_STAGE(PG8_SA(0, 1), cA + hstepA, voffA);
        if (wr == 1) PG8_BAR;
        PG8_WAIT_V(2); PG8_BAR;
        PG8_STAGE(PG8_SB(1, 0), cB + kstepB, voffB); PG8_STAGE(PG8_SA(1, 0), cA + kstepA, voffA); PG8_STAGE(PG8_SB(1, 1), cB + hstepB + kstepB, voffB);
        PG8_WAIT_V(6); PG8_BAR;
    } else {
        PG8_STAGE(PG8_SB(0, 0), cB, voffB); PG8_STAGE(PG8_SA(0, 0), cA, voffA); PG8_STAGE(PG8_SB(0, 1), cB + hstepB, voffB); PG8_STAGE(PG8_SA(0, 1), cA + hstepA, voffA);
        if (wr == 1) PG8_BAR;
        PG8_WAIT_V(4); PG8_BAR;
        PG8_STAGE(PG8_SB(1, 0), cB + kstepB, voffB); PG8_STAGE(PG8_SA(1, 0), cA + kstepA, voffA); PG8_STAGE(PG8_SB(1, 1), cB + hstepB + kstepB, voffB);
        PG8_WAIT_V(6); PG8_BAR;
    }
    for (;;) {
        const bool has_next = S.next(ui + 1, nxt);
        const char* nA = has_next ? (const char*)g.A + (size_t)nxt.pm * tstepA + (size_t)nxt.pn * pnstepA : cA; const char* nB = has_next ? (const char*)g.Bt + (size_t)nxt.pn * tstepB : cB;
        for (int t = 0; t < nt; t += 2) {
            const bool last = (t == nt - 2);
            const char* a1 = cA + (size_t)(t + 1) * kstepA;
            const char* a2 = last ? nA : cA + (size_t)(t + 2) * kstepA; const char* b2 = last ? nB : cB + (size_t)(t + 2) * kstepB;
            const char* a3 = a2 + kstepA; const char* b3 = b2 + kstepB;
            if (last && has_next) S.a_ready(nxt);
            if constexpr (SP2) {
            PG8_LDB(B0, 0, 0); PG8_LDB(B1, 0, 1); PG8_SCHED; PG8_LDA(At, 0, 0); PG8_STAGE(PG8_SA(1, 1), a1 + hstepA, voffA);
            PG8_WAIT_V(8); PG8_WAIT_L(0); PG8_BAR; PG8_MMA(0, 0, At, B0); PG8_MMA(0, 1, At, B1); PG8_BAR; PG8_SCHED;
            PG8_LDA(At, 0, 1); PG8_STAGE(PG8_SB(0, 0), b2, voffB); PG8_STAGE(PG8_SB(0, 1), b2 + hstepB, voffB); PG8_STAGE(PG8_SA(0, 0), a2, voffA);
            PG8_WAIT_V(8); PG8_WAIT_L(0); PG8_BAR; PG8_MMA(1, 0, At, B0); PG8_MMA(1, 1, At, B1); PG8_BAR; PG8_SCHED;
            PG8_LDB(B0, 1, 0); PG8_LDB(B1, 1, 1); PG8_SCHED; PG8_LDA(At, 1, 0); PG8_STAGE(PG8_SA(0, 1), a2 + hstepA, voffA);
            PG8_WAIT_V(8); PG8_WAIT_L(0); PG8_BAR; PG8_MMA(0, 0, At, B0); PG8_MMA(0, 1, At, B1); PG8_BAR; PG8_SCHED;
            PG8_LDA(At, 1, 1); PG8_STAGE(PG8_SB(1, 0), b3, voffB); PG8_STAGE(PG8_SB(1, 1), b3 + hstepB, voffB); PG8_STAGE(PG8_SA(1, 0), a3, voffA);
            PG8_WAIT_V(8); PG8_WAIT_L(0); PG8_BAR; PG8_MMA(1, 0, At, B0); PG8_MMA(1, 1, At, B1); PG8_BAR; PG8_SCHED;
            } else {
            PG8_LDB(B0, 0, 0); PG8_SCHED; PG8_LDA(At, 0, 0); PG8_STAGE(PG8_SA(1, 1), a1 + hstepA, voffA);
            PG8_WAIT_L(8); PG8_BAR; PG8_WAIT_L(0); PG8_MMA(0, 0, At, B0); PG8_BAR; PG8_SCHED;
            PG8_LDB(B1, 0, 1); PG8_STAGE(PG8_SB(0, 0), b2, voffB);
            PG8_BAR; PG8_WAIT_L(0); PG8_MMA(0, 1, At, B1); PG8_BAR;
            PG8_LDA(At, 0, 1); PG8_STAGE(PG8_SA(0, 0), a2, voffA);
            PG8_BAR; PG8_WAIT_L(0); PG8_MMA(1, 0, At, B0); PG8_BAR; PG8_SCHED;
            PG8_STAGE(PG8_SB(0, 1), b2 + hstepB, voffB);
            PG8_WAIT_V(6); PG8_BAR; PG8_MMA(1, 1, At, B1); PG8_BAR;
            PG8_LDB(B0, 1, 0); PG8_SCHED; PG8_LDA(At, 1, 0); PG8_STAGE(PG8_SA(0, 1), a2 + hstepA, voffA);
            PG8_WAIT_L(8); PG8_BAR; PG8_WAIT_L(0); PG8_MMA(0, 0, At, B0); PG8_BAR; PG8_SCHED;
            PG8_LDB(B1, 1, 1); PG8_STAGE(PG8_SB(1, 0), b3, voffB);
            PG8_BAR; PG8_WAIT_L(0); PG8_MMA(0, 1, At, B1); PG8_BAR;
            PG8_LDA(At, 1, 1); PG8_STAGE(PG8_SA(1, 0), a3, voffA);
            PG8_BAR; PG8_WAIT_L(0); PG8_MMA(1, 0, At, B0); PG8_BAR; PG8_SCHED;
            PG8_STAGE(PG8_SB(1, 1), b3 + hstepB, voffB);
            PG8_WAIT_V(6); PG8_BAR; PG8_MMA(1, 1, At, B1); PG8_BAR;
            }
        }
        if constexpr (ALIGN_EPI) { if (wr == 0) PG8_BAR; }
        if constexpr (!Epi::AFTER_DRAIN) { E(acc, cur, wr, wc, fr, fq); S.done(cur); }
        if (!has_next) break;
#pragma unroll
        for (int a = 0; a < 2; ++a)
#pragma unroll
            for (int b = 0; b < 2; ++b)
#pragma unroll
                for (int m = 0; m < 4; ++m)
#pragma unroll
                    for (int n = 0; n < 2; ++n) acc[a][b][m][n] = (f32x4){0.f, 0.f, 0.f, 0.f};
        cur = nxt; cA = nA; cB = nB; ++ui;
        if constexpr (ALIGN_EPI) { if (wr == 1) PG8_BAR; }
    }
    PG8_WAIT_V(0);
    if constexpr (!ALIGN_EPI) { if (wr == 0) PG8_BAR; }
    PG8_BAR;
    if constexpr (Epi::AFTER_DRAIN) { E.fused(acc, cur, wr, wc, fr, fq, lds, wid, lane); S.done(cur); }
#undef PG8_SA
#undef PG8_SB
#undef PG8_STAGE
#undef PG8_LDA
#undef PG8_LDB
#undef PG8_MMA
#undef PG8_WAIT_V
#undef PG8_WAIT_L
#undef PG8_BAR
#undef PG8_SCHED
}
}

namespace att {
constexpr int SLOTB = 8192;
constexpr int NSLOT = 4;
constexpr int L_K = 0, L_V = 32768, L_WS = 65536, L_OST = 67584, L_PSUM = L_OST, L_IMP = 133120, L_KB = L_IMP, L_SEL = 141312, L_END = 141568;
constexpr float PFIX = 268435456.0f;
constexpr float THR = 8.0f;

__device__ __forceinline__ int crow(int r, int hh) { return (r & 3) + 8 * (r >> 2) + 4 * hh; }
typedef float f32x2_t __attribute__((ext_vector_type(2))); typedef __bf16 bf16x2_t __attribute__((ext_vector_type(2)));
__device__ __forceinline__ unsigned cvtpk_s(float lo, float hi) { f32x2_t v = {lo, hi}; bf16x2_t b = __builtin_convertvector(v, bf16x2_t); return __builtin_bit_cast(unsigned, b); }
typedef short v4i16_t __attribute__((ext_vector_type(4)));
__device__ __forceinline__ s16x4 vtr(const LAS unsigned char* p) { return __builtin_bit_cast(s16x4, __builtin_amdgcn_ds_read_tr16_b64_v4i16((LAS v4i16_t*)p)); }
__device__ __forceinline__ float swap_sum(float v) { auto rr = __builtin_amdgcn_permlane32_swap(__float_as_uint(v), __float_as_uint(v), false, false); return __uint_as_float(rr[0]) + __uint_as_float(rr[1]); }
__device__ __forceinline__ float swap_max(float v) { auto rr = __builtin_amdgcn_permlane32_swap(__float_as_uint(v), __float_as_uint(v), false, false); return fmaxf(__uint_as_float(rr[0]), __uint_as_float(rr[1])); }
__device__ __forceinline__ bool trailing_half(int wid) { asm volatile("" : "+s"(wid)); return (wid >> 2) != 0; }
#define ATT_BAR() do { __builtin_amdgcn_s_barrier(); asm volatile("" ::: "memory"); } while (0)

__device__ __forceinline__ void dma_tile(const bf16_t* Kb, const bf16_t* Vb, int pitch, int tile, LAS unsigned char* shm, int slot, int wid, int lane) {
    const bf16_t* ks = Kb + (size_t)(tile * 64 + lane) * pitch + wid * 8;
    const bf16_t* vs = Vb + (size_t)(tile * 64 + 16 * (wid & 3) + (lane >> 2)) * pitch + (wid >> 2) * 32 + (lane & 3) * 8;
    __builtin_amdgcn_global_load_lds((const unsigned*)ks, (LAS unsigned*)(shm + L_K + slot * SLOTB + wid * 1024), 16, 0, 0);
    __builtin_amdgcn_global_load_lds((const unsigned*)vs, (LAS unsigned*)(shm + L_V + slot * SLOTB + wid * 1024), 16, 0, 0);
#ifdef PROBE_DMA2
    __builtin_amdgcn_global_load_lds((const unsigned*)ks, (LAS unsigned*)(shm + L_K + slot * SLOTB + wid * 1024), 16, 0, 0);
    __builtin_amdgcn_global_load_lds((const unsigned*)vs, (LAS unsigned*)(shm + L_V + slot * SLOTB + wid * 1024), 16, 0, 0);
#endif
}
#ifdef PROBE_DMA2
#define VMW2 "4"
#define VMW4 "8"
#else
#define VMW2 "2"
#define VMW4 "4"
#endif
__device__ __forceinline__ void qkt(f32x16& p0, f32x16& p1, const LAS unsigned char* shm, int slot, const bf16x8 (&qr)[4], const f32x16& cinit, int r32, int hh) {
    const LAS unsigned char* kb = shm + L_K + slot * SLOTB + hh * 1024 + r32 * 16;
#pragma unroll
    for (int d0 = 0; d0 < 4; ++d0) {
        const bf16x8 b0 = *(const LAS bf16x8*)(kb + d0 * 2048), b1 = *(const LAS bf16x8*)(kb + d0 * 2048 + 512);
        if (d0 == 0) { p0 = __builtin_amdgcn_mfma_f32_32x32x16_bf16(b0, qr[0], cinit, 0, 0, 0); p1 = __builtin_amdgcn_mfma_f32_32x32x16_bf16(b1, qr[0], cinit, 0, 0, 0); }
        else { p0 = __builtin_amdgcn_mfma_f32_32x32x16_bf16(b0, qr[d0], p0, 0, 0, 0); p1 = __builtin_amdgcn_mfma_f32_32x32x16_bf16(b1, qr[d0], p1, 0, 0, 0); }
        if (d0 == 1) asm volatile("" ::: "memory");
    }
}
__device__ __forceinline__ void load_k(bf16x8 (&kf)[8], const LAS unsigned char* shm, int slot, int r32, int hh) {
    const LAS unsigned char* kb = shm + L_K + slot * SLOTB + hh * 1024 + r32 * 16;
#pragma unroll
    for (int d0 = 0; d0 < 4; ++d0) { kf[2 * d0] = *(const LAS bf16x8*)(kb + d0 * 2048); kf[2 * d0 + 1] = *(const LAS bf16x8*)(kb + d0 * 2048 + 512); }
}
__device__ __forceinline__ void mma_qk(f32x16& p0, f32x16& p1, const bf16x8 (&kf)[8], const bf16x8 (&qr)[4], const f32x16& cinit) {
    p0 = __builtin_amdgcn_mfma_f32_32x32x16_bf16(kf[0], qr[0], cinit, 0, 0, 0); p1 = __builtin_amdgcn_mfma_f32_32x32x16_bf16(kf[1], qr[0], cinit, 0, 0, 0);
#pragma unroll
    for (int d0 = 1; d0 < 4; ++d0) { p0 = __builtin_amdgcn_mfma_f32_32x32x16_bf16(kf[2 * d0], qr[d0], p0, 0, 0, 0); p1 = __builtin_amdgcn_mfma_f32_32x32x16_bf16(kf[2 * d0 + 1], qr[d0], p1, 0, 0, 0); }
}
__device__ __forceinline__ void load_v(bf16x8 (&vf)[8], const LAS unsigned char* shm, int slot, int lane, int hh) {
    const LAS unsigned char* vb = shm + L_V + slot * SLOTB + ((lane >> 4) & 1) * 32 + (lane & 3) * 8 + (4 * hh + ((lane & 15) >> 2)) * 64;
#pragma unroll
    for (int ks = 0; ks < 4; ++ks)
#pragma unroll
        for (int d0 = 0; d0 < 2; ++d0) {
            const s16x4 vl = vtr(vb + d0 * 4096 + ks * 1024), vh = vtr(vb + d0 * 4096 + ks * 1024 + 512);
            vf[2 * ks + d0] = (bf16x8){vl[0], vl[1], vl[2], vl[3], vh[0], vh[1], vh[2], vh[3]};
        }
}
__device__ __forceinline__ void mma_pv(f32x16 (&o)[2], const u32x4 (&pw)[4], const bf16x8 (&vf)[8]) {
#pragma unroll
    for (int ks = 0; ks < 4; ++ks)
#pragma unroll
        for (int d0 = 0; d0 < 2; ++d0) o[d0] = __builtin_amdgcn_mfma_f32_32x32x16_bf16(__builtin_bit_cast(bf16x8, pw[ks]), vf[2 * ks + d0], o[d0], 0, 0, 0);
}
__device__ __forceinline__ void pv_seq(f32x16 (&o)[2], const u32x4 (&pw)[4], const LAS unsigned char* shm, int slot, int lane, int hh) {
    const LAS unsigned char* vb = shm + L_V + slot * SLOTB + ((lane >> 4) & 1) * 32 + (lane & 3) * 8 + (4 * hh + ((lane & 15) >> 2)) * 64;
#pragma unroll
    for (int ks = 0; ks < 4; ++ks) {
#pragma unroll
        for (int d0 = 0; d0 < 2; ++d0) {
            const s16x4 vl = vtr(vb + d0 * 4096 + ks * 1024), vh = vtr(vb + d0 * 4096 + ks * 1024 + 512);
            const bf16x8 vf = {vl[0], vl[1], vl[2], vl[3], vh[0], vh[1], vh[2], vh[3]};
            o[d0] = __builtin_amdgcn_mfma_f32_32x32x16_bf16(__builtin_bit_cast(bf16x8, pw[ks]), vf, o[d0], 0, 0, 0);
        }
        if (ks == 1) asm volatile("" ::: "memory");
    }
}
__device__ __forceinline__ void range_mask(f32x16& p0, f32x16& p1, int kb, int lo, int hi) {
#pragma unroll
    for (int r = 0; r < 16; ++r) { const int k = kb + (r & 3) + 8 * (r >> 2); if (k < lo || k > hi) p0[r] = -INFINITY; if (k + 32 < lo || k + 32 > hi) p1[r] = -INFINITY; }
}
__device__ __forceinline__ void rescale_o(f32x16 (&o)[2], const LAS float* wsf, int hh) {
#pragma unroll
    for (int g = 0; g < 4; ++g) { const f32x4 a4 = *(const LAS f32x4*)(wsf + 8 * g + 4 * hh);
#pragma unroll
        for (int j = 0; j < 4; ++j) { o[0][4 * g + j] *= a4[j]; o[1][4 * g + j] *= a4[j]; } }
}

template <int MODE, bool NEGM = true, bool LEAN = false>
__device__ __forceinline__ void sweep(f32x16 (&o)[2], float& mhat, float& l, const bf16x8 (&qr)[4], const bf16_t* Kb, const bf16_t* Vb, int pitch, int t0, int NT, int lo, int hi,
                                      unsigned rowsel, LAS unsigned char* shm, int& ring, int wid, int lane) {
    asm volatile("" : "+v"(lane));
    const int r32 = lane & 31, hh = lane >> 5;
    LAS float* wsf = (LAS float*)(shm + L_WS + wid * 256);
    const int lo_max = __builtin_amdgcn_readlane(lo, 31), hi_min = __builtin_amdgcn_readfirstlane(hi);
#define RING_NEXT(x) (((x) + 1) & (NSLOT - 1))
    int s_pv = ring, s_qk = ring, s_dma = ring;
    dma_tile(Kb, Vb, pitch, t0, shm, s_dma, wid, lane); s_dma = RING_NEXT(s_dma);
    if (NT > 1) { dma_tile(Kb, Vb, pitch, t0 + 1, shm, s_dma, wid, lane); s_dma = RING_NEXT(s_dma); }
    if (NT > 2) { dma_tile(Kb, Vb, pitch, t0 + 2, shm, s_dma, wid, lane); s_dma = RING_NEXT(s_dma); }
    if (NT > 2) asm volatile("s_waitcnt vmcnt(" VMW4 ")" ::: "memory"); else if (NT > 1) asm volatile("s_waitcnt vmcnt(" VMW2 ")" ::: "memory"); else asm volatile("s_waitcnt vmcnt(0)" ::: "memory");
    ATT_BAR();
    if (trailing_half(wid)) ATT_BAR();
    f32x16 s0, s1, negm; u32x4 pw[4]; bool resc = false;
#pragma unroll
    for (int r = 0; r < 16; ++r) negm[r] = 0.f;
    bf16x8 kf[8], vf[8];
    if (LEAN) qkt(s0, s1, shm, s_qk, qr, negm, r32, hh);
    else {
        load_k(kf, shm, s_qk, r32, hh);
        mma_qk(s0, s1, kf, qr, negm);
        load_v(vf, shm, s_qk, lane, hh);
    }
    s_qk = RING_NEXT(s_qk);
    for (int j = 0;; ++j) {
        asm volatile("s_waitcnt lgkmcnt(0)" ::: "memory");
        if (trailing_half(wid)) { if (j + 2 < NT) asm volatile("s_waitcnt vmcnt(" VMW2 ")" ::: "memory"); else asm volatile("s_waitcnt vmcnt(0)" ::: "memory"); }
        ATT_BAR();
        if (trailing_half(wid) && j + 3 < NT) { dma_tile(Kb, Vb, pitch, t0 + j + 3, shm, s_dma, wid, lane); }
        {
            const int tile = t0 + j;
            if (MODE == 1) { const LAS float* kb = (const LAS float*)(shm + L_KB) + tile * 64 + 4 * hh;
#pragma unroll
                for (int k = 0; k < 4; ++k) { const f32x4 b0 = *(const LAS f32x4*)(kb + 8 * k), b1 = *(const LAS f32x4*)(kb + 32 + 8 * k);
#pragma unroll
                    for (int e = 0; e < 4; ++e) { s0[4 * k + e] += b0[e]; s1[4 * k + e] += b1[e]; } } }
            if (tile * 64 < lo_max || tile * 64 + 63 > hi_min) range_mask(s0, s1, tile * 64 + 4 * hh, lo, hi);
            if (MODE == 2) { if (!((rowsel >> tile) & 1u)) {
#pragma unroll
                for (int r = 0; r < 16; ++r) { s0[r] = -INFINITY; s1[r] = -INFINITY; } } }
            float rm = fmaxf(s0[0], s1[0]);
#pragma unroll
            for (int r = 1; r < 16; ++r) rm = fmaxf(rm, fmaxf(s0[r], s1[r]));
            rm = swap_max(rm);
            if (!NEGM) {
                rm -= mhat;
#pragma unroll
                for (int r = 0; r < 16; ++r) { s0[r] -= mhat; s1[r] -= mhat; } }
            const bool first = (j == 0);
            if (first || __any(rm > THR)) {
                float dl = first ? rm : fmaxf(rm, 0.f); if (dl == -INFINITY) dl = 0.f;
                mhat += dl;
#pragma unroll
                for (int r = 0; r < 16; ++r) { s0[r] -= dl; s1[r] -= dl; if (NEGM) negm[r] = -mhat; }
                if (!first) { const float al = __builtin_amdgcn_exp2f(-dl); l *= al; if (hh == 0) wsf[r32] = al; resc = true; }
            }
            float ls = 0.f;
#pragma unroll
            for (int r = 0; r < 16; ++r) { s0[r] = __builtin_amdgcn_exp2f(s0[r]); s1[r] = __builtin_amdgcn_exp2f(s1[r]); ls += s0[r] + s1[r]; }
            l += ls;
#pragma unroll
            for (int e = 0; e < 4; ++e) { pw[0][e] = cvtpk_s(s0[2 * e], s0[2 * e + 1]); pw[1][e] = cvtpk_s(s0[8 + 2 * e], s0[9 + 2 * e]); pw[2][e] = cvtpk_s(s1[2 * e], s1[2 * e + 1]); pw[3][e] = cvtpk_s(s1[8 + 2 * e], s1[9 + 2 * e]); }
        }
        if (!trailing_half(wid)) { if (j + 2 < NT) asm volatile("s_waitcnt vmcnt(" VMW2 ")" ::: "memory"); else asm volatile("s_waitcnt vmcnt(0)" ::: "memory"); }
        ATT_BAR();
        if (j + 1 >= NT) break;
        if (!trailing_half(wid) && j + 3 < NT) { dma_tile(Kb, Vb, pitch, t0 + j + 3, shm, s_dma, wid, lane); }
        s_dma = RING_NEXT(s_dma);
        if (LEAN) {
            if (resc) { rescale_o(o, wsf, hh); resc = false; }
            pv_seq(o, pw, shm, s_pv, lane, hh);
            qkt(s0, s1, shm, s_qk, qr, negm, r32, hh);
        } else {
            load_k(kf, shm, s_qk, r32, hh);
            __builtin_amdgcn_sched_barrier(0);
            if (resc) { rescale_o(o, wsf, hh); resc = false; }
            mma_pv(o, pw, vf);
            __builtin_amdgcn_sched_barrier(0);
            mma_qk(s0, s1, kf, qr, negm);
            __builtin_amdgcn_sched_barrier(0);
            load_v(vf, shm, s_qk, lane, hh);
        }
        s_pv = RING_NEXT(s_pv); s_qk = RING_NEXT(s_qk);
    }
    if (resc) { rescale_o(o, wsf, hh); resc = false; }
    if (LEAN) pv_seq(o, pw, shm, s_pv, lane, hh); else mma_pv(o, pw, vf);
    if (!trailing_half(wid)) ATT_BAR();
    ring = s_qk;
#undef RING_NEXT
}
template <bool FIRST>
__device__ __forceinline__ void merge(const f32x16 (&o)[2], float scale, LAS unsigned char* shm, int wid, int r32, int hh) {
    LAS float* wsf = (LAS float*)(shm + L_WS + wid * 256);
    LAS float* stg = (LAS float*)(shm + L_OST + wid * 8192) + r32;
    if (hh == 0) wsf[r32] = scale;
#pragma unroll
    for (int g = 0; g < 4; ++g) { const f32x4 s4 = *(const LAS f32x4*)(wsf + 8 * g + 4 * hh);
#pragma unroll
        for (int j = 0; j < 4; ++j) { LAS float* p = stg + (8 * g + 4 * hh + j) * 64;
            if (FIRST) { p[0] = o[0][4 * g + j] * s4[j]; p[32] = o[1][4 * g + j] * s4[j]; }
            else { p[0] += o[0][4 * g + j] * s4[j]; p[32] += o[1][4 * g + j] * s4[j]; } } }
}
__device__ __forceinline__ void store_o(bf16_t* Ow, LAS unsigned char* shm, int wid, int lane) {
    const LAS float* stg = (const LAS float*)(shm + L_OST + wid * 8192);
#pragma unroll
    for (int i = 0; i < 4; ++i) { const int rowl = i * 8 + (lane >> 3), ch = lane & 7; const f32x4 a = *(const LAS f32x4*)(stg + rowl * 64 + ch * 8), c = *(const LAS f32x4*)(stg + rowl * 64 + ch * 8 + 4);
        u32x4 v; v.x = cvtpk_s(a[0], a[1]); v.y = cvtpk_s(a[2], a[3]); v.z = cvtpk_s(c[0], c[1]); v.w = cvtpk_s(c[2], c[3]); *(GAS u32x4*)(Ow + (size_t)rowl * D + ch * 8) = v; }
}
__device__ __forceinline__ void zero_o(f32x16 (&o)[2]) { o[0] = (f32x16){0.f, 0.f, 0.f, 0.f, 0.f, 0.f, 0.f, 0.f, 0.f, 0.f, 0.f, 0.f, 0.f, 0.f, 0.f, 0.f}; o[1] = o[0]; }
#define ATT_LOADQ(Qrow_) bf16x8 qr[4]; _Pragma("unroll") for (int d0 = 0; d0 < 4; ++d0) qr[d0] = *(const GAS bf16x8*)((Qrow_) + d0 * 16 + hh * 8)

__device__ __forceinline__ void fox_unit(LAS unsigned char* shm, int b, int h, int qb, unsigned char* ws_, size_t off_p, size_t off_cb, size_t off_o, int wid, int& ring) {
    const int lane = lane_id_volatile();
    unsigned char* ws = ws_; asm volatile("" : "+s"(ws)); const bf16_t* P = (const bf16_t*)(ws + off_p); const float* CB = (const float*)(ws + off_cb); bf16_t* O = (bf16_t*)(ws + off_o);
    const int r32 = lane & 31, hh = lane >> 5;
    const int pos = 256 * qb + 32 * wid + r32;
    const size_t row = (size_t)b * T + pos;
    ATT_LOADQ(P + row * FOX_LDP + h * 64);
    const bf16_t* Kb = P + (size_t)b * T * FOX_LDP + 1024 + h * 64; const bf16_t* Vb = Kb + 1024;
    f32x16 o[2]; zero_o(o); float m = 0.f, l = 0.f;
    { const float* cb = CB + (size_t)(b * NH + h) * T; LAS float* kbl = (LAS float*)(shm + L_KB);
      for (int i = wid * 64 + lane; i < 64 * (4 * qb + 4); i += 512) kbl[i] = cb[i]; }
    sweep<1>(o, m, l, qr, Kb, Vb, FOX_LDP, 0, 4 * qb + 4, 0, pos, 0u, shm, ring, wid, lane);
    const float lt = swap_sum(l); const float inv = lt > 0.f ? 1.0f / lt : 0.f;
    merge<true>(o, inv, shm, wid, r32, hh);
    store_o(O + ((size_t)b * T + 256 * qb + 32 * wid) * D + h * 64, shm, wid, lane);
}
__device__ __forceinline__ void swa_unit(LAS unsigned char* shm, int b, int g, int qt, unsigned char* ws_, size_t off_p, size_t off_o, const float* sinks, int wid, int& ring) {
    const int lane = lane_id_volatile();
    unsigned char* ws = ws_; asm volatile("" : "+s"(ws)); const bf16_t* P = (const bf16_t*)(ws + off_p); bf16_t* O = (bf16_t*)(ws + off_o);
    const int r32 = lane & 31, hh = lane >> 5;
    const int q0 = 32 * qt, pos = q0 + r32, head = 8 * g + wid;
    const size_t row = (size_t)b * T + pos;
    ATT_LOADQ(P + row * SWA_LDP + head * 64);
    const bf16_t* Kb = P + (size_t)b * T * SWA_LDP + 1024 + g * 64; const bf16_t* Vb = Kb + 128;
    f32x16 o[2]; zero_o(o); float m = 0.f, l = 0.f;
    const int tlo = (q0 - 127) > 0 ? ((q0 - 127) >> 6) : 0, thi = (q0 + 31) >> 6;
    sweep<0, false, true>(o, m, l, qr, Kb, Vb, SWA_LDP, tlo, thi - tlo + 1, pos - 127, pos, 0u, shm, ring, wid, lane);
    const float lt = swap_sum(l) + __builtin_amdgcn_exp2f(sinks[head] * LOG2E - m);
    const float inv = 1.0f / lt;
    merge<true>(o, inv, shm, wid, r32, hh);
    store_o(O + ((size_t)b * T + q0) * D + head * 64, shm, wid, lane);
}
__device__ __forceinline__ void nsa_unit(LAS unsigned char* shm, int b, int g, int qt, unsigned char* ws_, size_t off_p, size_t off_g, size_t off_kc, size_t off_vc, size_t off_o, int wid, int& ring) {
#define NSA_WS() unsigned char* ws = ws_; asm volatile("" : "+s"(ws)); const bf16_t* P = (const bf16_t*)(ws + off_p); const float* G = (const float*)(ws + off_g); const bf16_t* Pb = P + (size_t)b * T * NSA_LDP; (void)G; (void)Pb
    const int hq = 4 * g + (wid >> 1), ph = wid & 1, q0 = 64 * qt;
    LAS unsigned* PSUM = (LAS unsigned*)(shm + L_PSUM); LAS float* IMP = (LAS float*)(shm + L_IMP); LAS unsigned* SEL = (LAS unsigned*)(shm + L_SEL);
#define NSA_LANE() const int lane = lane_id_volatile(); const int r32 = lane & 31, hh = lane >> 5; const int pos = q0 + 32 * ph + r32; const size_t row = (size_t)b * T + pos; (void)hh; (void)row
#define NSA_QROW (P + row * NSA_LDP + hq * 64)
    asm volatile("s_waitcnt lgkmcnt(0)" ::: "memory"); ATT_BAR();
    { const int tid = wid * 64 + lane_id_volatile(); for (int i = tid; i < 8192; i += 512) PSUM[i] = 0u; }
    f32x16 ocmp[2]; float inv_cmp;
    {
        NSA_LANE(); NSA_WS();
        const bf16_t* Kb = (const bf16_t*)(ws + off_kc) + (size_t)(b * 4 + g) * NCP * 64; const bf16_t* Vb = (const bf16_t*)(ws + off_vc) + (size_t)(b * 4 + g) * NCP * 64;
        const int cm = (pos < 31) ? -1 : (((pos - 31) >> 4) < 126 ? ((pos - 31) >> 4) : 126);
        const int ntile = qt >= 16 ? 2 : 1;
        ATT_LOADQ(NSA_QROW);
        f32x16 o[2]; zero_o(o); float m = 0.f, l = 0.f;
        const int ring0 = ring;
        sweep<0>(o, m, l, qr, Kb, Vb, 64, 0, ntile, 0, cm, 0u, shm, ring, wid, lane);
        const float lt = swap_sum(l); const float inv = lt > 0.f ? 1.0f / lt : 0.f;
        f32x16 negm;
#pragma unroll
        for (int r = 0; r < 16; ++r) negm[r] = -m;
        for (int tile = 0; tile < ntile; ++tile) {
            const int sl = (ring0 + tile) & (NSLOT - 1);
            f32x16 p0, p1; qkt(p0, p1, shm, sl, qr, negm, r32, hh);
            range_mask(p0, p1, tile * 64 + 4 * hh, 0, cm);
            LAS unsigned* pb = PSUM + (tile * 64 + 4 * hh) * 64 + 32 * ph + r32;
            asm volatile("" : "+v"(pb));
#pragma unroll
            for (int r = 0; r < 16; ++r) {
                const float a = __builtin_amdgcn_exp2f(p0[r]) * inv, c = __builtin_amdgcn_exp2f(p1[r]) * inv;
                __hip_atomic_fetch_add(pb + ((r & 3) + 8 * (r >> 2)) * 64, (unsigned)(a * PFIX + 0.5f), __ATOMIC_RELAXED, __HIP_MEMORY_SCOPE_WORKGROUP);
                __hip_atomic_fetch_add(pb + ((r & 3) + 8 * (r >> 2) + 32) * 64, (unsigned)(c * PFIX + 0.5f), __ATOMIC_RELAXED, __HIP_MEMORY_SCOPE_WORKGROUP);
            }
        }
        ocmp[0] = o[0]; ocmp[1] = o[1]; inv_cmp = inv;
    }
    asm volatile("s_waitcnt lgkmcnt(0)" ::: "memory"); ATT_BAR();
    {
        const int tid = wid * 64 + lane_id_volatile();
        const int rw = tid & 63, ng = tid >> 6;
        LAS unsigned* pb = PSUM + (16 * ng - 1) * 64 + rw;
        LAS float* ib = IMP + (4 * ng) * 64 + rw;
        asm volatile("" : "+v"(pb), "+v"(ib));
        float pc[17];
#pragma unroll
        for (int e = 0; e < 17; ++e) pc[e] = (float)pb[e * 64] * (1.0f / PFIX);
        if (ng == 0) pc[0] = 0.f;
#pragma unroll
        for (int k = 0; k < 4; ++k) ib[k * 64] = pc[4 * k + 1] + pc[4 * k + 2] + pc[4 * k + 3] + 0.5f * (pc[4 * k + 4] + pc[4 * k]);
        const unsigned init = qt < 16 ? ((2u << qt) - 1u) : (1u | (1u << qt) | (1u << (qt - 1)));
        if (tid < 64) SEL[tid] = init;
    }
    asm volatile("s_waitcnt lgkmcnt(0)" ::: "memory"); ATT_BAR();
    if (qt >= 16) {
        const int tid = wid * 64 + lane_id_volatile();
        const int rw = tid & 63, ng = tid >> 6; unsigned bits = 0u;
        LAS float* ib = IMP + rw; asm volatile("" : "+v"(ib));
        float v[4]; int cnt[4] = {0, 0, 0, 0};
#pragma unroll
        for (int k = 0; k < 4; ++k) v[k] = ib[(4 * ng + k) * 64];
        for (int n2 = 1; n2 <= qt - 2; ++n2) { const float v2 = ib[n2 * 64];
#pragma unroll
            for (int k = 0; k < 4; ++k) cnt[k] += (v2 > v[k] || (v2 == v[k] && n2 < 4 * ng + k)) ? 1 : 0; }
#pragma unroll
        for (int k = 0; k < 4; ++k) { const int n = 4 * ng + k; if (n >= 1 && n <= qt - 2 && cnt[k] < 13) bits |= 1u << n; }
        if (bits) __hip_atomic_fetch_or(SEL + rw, bits, __ATOMIC_RELAXED, __HIP_MEMORY_SCOPE_WORKGROUP);
    }
    asm volatile("s_waitcnt lgkmcnt(0)" ::: "memory"); ATT_BAR();
    { NSA_LANE(); NSA_WS(); merge<true>(ocmp, G[row * 48 + hq * 3 + 0] * inv_cmp, shm, wid, r32, hh); }
    {
        NSA_LANE(); NSA_WS();
        const unsigned rowsel = SEL[32 * ph + r32];
        ATT_LOADQ(NSA_QROW);
        f32x16 o[2]; zero_o(o); float m = 0.f, l = 0.f;
        sweep<2>(o, m, l, qr, Pb + 1536 + g * 64, Pb + 1792 + g * 64, NSA_LDP, 0, qt + 1, 0, pos, rowsel, shm, ring, wid, lane);
        const float lt = swap_sum(l); const float inv = lt > 0.f ? 1.0f / lt : 0.f;
        merge<false>(o, G[row * 48 + hq * 3 + 1] * inv, shm, wid, r32, hh);
    }
    {
        NSA_LANE(); NSA_WS();
        ATT_LOADQ(NSA_QROW);
        f32x16 o[2]; zero_o(o); float m = 0.f, l = 0.f;
        const int tlo = qt > 8 ? qt - 8 : 0;
        sweep<0>(o, m, l, qr, Pb + 2048 + g * 64, Pb + 2304 + g * 64, NSA_LDP, tlo, qt - tlo + 1, pos - 511, pos, 0u, shm, ring, wid, lane);
        const float lt = swap_sum(l); const float inv = lt > 0.f ? 1.0f / lt : 0.f;
        merge<false>(o, G[row * 48 + hq * 3 + 2] * inv, shm, wid, r32, hh);
    }
    { unsigned char* ws = ws_; asm volatile("" : "+s"(ws)); store_o((bf16_t*)(ws + off_o) + ((size_t)b * T + q0 + 32 * ph) * D + hq * 64, shm, wid, lane_id_volatile()); }
#undef NSA_WS
#undef NSA_LANE
#undef NSA_QROW
}
#undef ATT_LOADQ
#undef ATT_BAR
}

constexpr size_t MiB = 1u << 20;
constexpr size_t WS_CTL = 0, CTL_ZERO_BYTES = 1 * MiB;
constexpr size_t WS_WUP = 1 * MiB, WS_WDN = 33 * MiB;
constexpr size_t WS_WNSA = 65 * MiB, WNSA_STRIDE = (size_t)NSA_NP * D * 2;
constexpr size_t WS_WOUT = 76 * MiB;
constexpr size_t WS_WFOX = 84 * MiB;
constexpr size_t WS_WSWA = 84 * MiB + 6656 * 1024;
constexpr size_t WS_WCMP = 93 * MiB;
constexpr size_t WS_ROPEC = 97 * MiB, WS_ROPES = WS_ROPEC + 256 * 1024;
constexpr size_t WS_CMPB = WS_ROPES + 256 * 1024;
constexpr size_t WS_SWAB = WS_CMPB + 64 * 1024;
constexpr size_t WS_XN = 100 * MiB;
constexpr size_t WS_BIG = 164 * MiB;
constexpr size_t WS_O = WS_BIG + 192 * MiB;
constexpr size_t WS_G = 420 * MiB, WS_LF = 426 * MiB, WS_CB = 428 * MiB, WS_KC = 430 * MiB, WS_VC = 431 * MiB, WS_HID = 432 * MiB, WS_END = 440 * MiB;
static_assert(WS_WSWA + (size_t)SWA_NP * D * 2 <= WS_WCMP && WS_WFOX + (size_t)FOX_NP * D * 2 <= WS_WSWA && WS_WNSA + 2 * WNSA_STRIDE <= WS_WOUT && WS_SWAB + 8192 <= WS_XN, "d_ws map");
static_assert((size_t)M * FF * 2 == 256 * MiB && WS_O + (size_t)M * D * 2 == WS_G && (size_t)M * FOX_LDP * 2 == 192 * MiB, "d_ws map");
constexpr int CW_TMO = 0, CW_BAR = 4096;

constexpr int RING_OFF = 0, RING_BYTES = 142336;
constexpr int LDSCTL_OFF = RING_BYTES, MISC_OFF = LDSCTL_OFF + 320;
constexpr int LDS_BYTES = 147456;
static_assert(att::L_END <= RING_BYTES && MISC_OFF + 128 <= LDS_BYTES, "LDS map");
constexpr int NWAVES = 8;
#ifndef L_LO
#define L_LO 0
#endif
#ifndef L_HI
#define L_HI DEPTH
#endif

typedef GAS unsigned gu32;
typedef GAS unsigned long long gu64;
#define RLX_AGENT __ATOMIC_RELAXED, __HIP_MEMORY_SCOPE_AGENT
#define LDS_WAIT() asm volatile("s_waitcnt lgkmcnt(0)" ::: "memory")
#define VM_WAIT() asm volatile("s_waitcnt vmcnt(0)" ::: "memory")
__device__ __forceinline__ unsigned long long rt() { return __builtin_amdgcn_s_memrealtime(); }
__device__ __forceinline__ unsigned f2bf(float f) { unsigned u = __builtin_bit_cast(unsigned, f); return (u + 0x7fffu + ((u >> 16) & 1u)) >> 16; }
__device__ __forceinline__ unsigned pk2(float lo, float hi) { return f2bf(lo) | (f2bf(hi) << 16); }

#define XB_TMO      128
#define XB_XCNT(j)  (256  + 64 * (j))
#define XB_XSUB(j)  (1280 + 64 * (j))
#define XB_XGEN(j)  (2304 + 64 * (j))
#define XB_TOP      3328
#define XB_TOPGEN   3392
#define XCD_BAR_WORDS 3456
#define XB_SPIN_CAP (1u << 18)

__device__ __forceinline__ unsigned xb_ld(unsigned* p)              { return __hip_atomic_load(p, __ATOMIC_RELAXED, __HIP_MEMORY_SCOPE_AGENT); }
__device__ __forceinline__ unsigned xb_add(unsigned* p, unsigned v) { return __hip_atomic_fetch_add(p, v, __ATOMIC_RELAXED, __HIP_MEMORY_SCOPE_AGENT); }
__device__ __forceinline__ unsigned xb_xcc_id() { return (unsigned)__builtin_amdgcn_s_getreg((3 << 11) | 20) & 0xFu; }
#define XB_SPIN(cond, bar) do { unsigned _sp = 0; while (cond) { __builtin_amdgcn_s_sleep(1); \
    if ((++_sp & 255u) == 0u) { if (xb_ld(&(bar)[XB_TMO])) break; if (_sp > XB_SPIN_CAP) { atomicAdd(&(bar)[XB_TMO], 1u); break; } } } } while (0)

struct XcdBarrier {
    unsigned* bar; unsigned x;
    volatile LAS unsigned* st;
};

__device__ __forceinline__ XcdBarrier xcd_barrier_post(unsigned* bar, volatile LAS unsigned* st) {
    XcdBarrier b; b.bar = bar; b.x = xb_xcc_id(); b.st = st;
    if (threadIdx.x == 0) (void)xb_add(&bar[XB_XCNT(b.x)], 1u);
    return b;
}
__device__ __forceinline__ void xcd_barrier_complete(unsigned* bar, unsigned x, unsigned& nloc, unsigned& nx) {
    const unsigned G = gridDim.x * gridDim.y * gridDim.z;
    unsigned sum, cnt, mine, sp = 0u;
    for (;;) {
        sum = 0u; cnt = 0u; mine = 0u;
#pragma unroll
        for (unsigned j = 0; j < 16; ++j) { const unsigned c = xb_ld(&bar[XB_XCNT(j)]); sum += c; cnt += (c > 0u) ? 1u : 0u; mine = (j == x) ? c : mine; }
        if (sum == G) break;
        __builtin_amdgcn_s_sleep(1);
        if ((++sp & 255u) == 0u) { if (xb_ld(&bar[XB_TMO])) break; if (sp > XB_SPIN_CAP) { atomicAdd(&bar[XB_TMO], 1u); break; } }
    }
    nloc = mine > 0u ? mine : 1u; nx = cnt > 0u ? cnt : 1u;
}

__device__ __forceinline__ void xcd_barrier(const XcdBarrier& b) {
    asm volatile("s_waitcnt vmcnt(0)" ::: "memory");
    __syncthreads();
    if (threadIdx.x == 0) {
        unsigned* bar = b.bar;
        __builtin_amdgcn_s_waitcnt(0);
        unsigned nloc = b.st[0], nx = b.st[1];
        if (nloc == 0u) { xcd_barrier_complete(bar, b.x, nloc, nx); b.st[0] = nloc; b.st[1] = nx; }
        const unsigned old = xb_add(&bar[XB_XSUB(b.x)], 1u);
        const unsigned gen = old / nloc;
        if (old + 1u == (gen + 1u) * nloc) {
            __builtin_amdgcn_fence(__ATOMIC_RELEASE, "agent");
            asm volatile("s_waitcnt vmcnt(0)" ::: "memory");
            const unsigned og = xb_add(&bar[XB_TOP], 1u);
            const unsigned tg = og / nx;
            if (og + 1u == (tg + 1u) * nx) xb_add(&bar[XB_TOPGEN], 1u);
            else XB_SPIN(xb_ld(&bar[XB_TOPGEN]) == tg, bar);
            __builtin_amdgcn_fence(__ATOMIC_ACQUIRE, "agent");
            xb_add(&bar[XB_XGEN(b.x)], 1u);
            asm volatile("s_waitcnt vmcnt(0)" ::: "memory");
        } else {
            XB_SPIN(xb_ld(&bar[XB_XGEN(b.x)]) == gen, bar);
            __builtin_amdgcn_fence(__ATOMIC_ACQUIRE, "agent");
            asm volatile("s_waitcnt vmcnt(0)" ::: "memory");
        }
    }
    __syncthreads();
}

__device__ __forceinline__ float wave_sum(float v) {
    v += __builtin_bit_cast(float, __builtin_amdgcn_update_dpp(0, __builtin_bit_cast(int, v), 0xB1, 0xF, 0xF, true));
    v += __builtin_bit_cast(float, __builtin_amdgcn_update_dpp(0, __builtin_bit_cast(int, v), 0x4E, 0xF, 0xF, true));
    v += __builtin_bit_cast(float, __builtin_amdgcn_update_dpp(0, __builtin_bit_cast(int, v), 0x141, 0xF, 0xF, true));
    v += __builtin_bit_cast(float, __builtin_amdgcn_update_dpp(0, __builtin_bit_cast(int, v), 0x140, 0xF, 0xF, true));
    v += __builtin_bit_cast(float, __builtin_amdgcn_ds_swizzle(__builtin_bit_cast(int, v), 0x401F));
    { auto rr = __builtin_amdgcn_permlane32_swap(__float_as_uint(v), __float_as_uint(v), false, false); v = __uint_as_float(rr[0]) + __uint_as_float(rr[1]); }
    return v;
}

__device__ __forceinline__ int il64(int c) { return (c >> 1) + 32 * (c & 1); }
__device__ __forceinline__ int src_n(int mode, int n) {
    if (mode == 1) { if (n >= NSA_N) return -1; const int reg = n >> 8; const bool rope = reg < 4 || reg == 4 || reg == 6 || reg == 8; return rope ? (n & ~63) + il64(n & 63) : n; }
    if (mode == 2) return n < FOX_N ? n : -1;
    if (mode == 3) return n < 1152 ? (n & ~63) + il64(n & 63) : n;
    return n;
}
__device__ __forceinline__ void conv_item(const float* W, int K, int N, bf16_t* WT, int NP, int mode, int item, LAS float* scr, int lane) {
    const int nblk = NP / 32, kb = item / nblk, nb = item % nblk, k0 = 64 * kb, n0 = 32 * nb;
    const int sn = src_n(mode, n0 + (lane & 31));
#pragma unroll 8
    for (int i = 0; i < 32; ++i) { const int kk = 2 * i + (lane >> 5); const int sk = (mode == 4) ? il64(kk) : kk;
        scr[kk * 33 + (lane & 31)] = sn >= 0 ? W[(size_t)(k0 + sk) * N + sn] : 0.f; }
    LDS_WAIT(); asm volatile("" ::: "memory");
    const int c = lane & 7;
#pragma unroll
    for (int j = 0; j < 4; ++j) { const int n = (lane >> 3) + 8 * j; const LAS float* s = scr + (8 * c) * 33 + n;
        u32x4 o; o.x = pk2(s[0 * 33], s[1 * 33]); o.y = pk2(s[2 * 33], s[3 * 33]); o.z = pk2(s[4 * 33], s[5 * 33]); o.w = pk2(s[6 * 33], s[7 * 33]);
        *(GAS u32x4*)(WT + (size_t)(n0 + n) * K + k0 + 8 * c) = o; }
    LDS_WAIT(); asm volatile("" ::: "memory");
}
__device__ __forceinline__ void norm_row(const float* xrow, const float* g, bf16_t* orow, int lane) {
    f32x4 v[4]; float s = 0.f;
#pragma unroll
    for (int j = 0; j < 4; ++j) { v[j] = ((const f32x4*)xrow)[lane + 64 * j]; s += (v[j][0] * v[j][0] + v[j][1] * v[j][1]) + (v[j][2] * v[j][2] + v[j][3] * v[j][3]); }
    const float rstd = 1.0f / sqrtf(wave_sum(s) * (1.0f / D) + NORM_EPS);
#pragma unroll
    for (int j = 0; j < 4; ++j) { const f32x4 gg = ((const f32x4*)g)[lane + 64 * j]; u32x2 w; w.x = pk2(v[j][0] * rstd * gg[0], v[j][1] * rstd * gg[1]); w.y = pk2(v[j][2] * rstd * gg[2], v[j][3] * rstd * gg[3]);
        ((u32x2*)orow)[lane + 64 * j] = w; }
}
__device__ __forceinline__ void resnorm_row(const float* xin, const bf16_t* mrow, const float* gpost, float* xout, const float* gnext, bf16_t* xn, int lane) {
    f32x4 xv[4], mv[4]; float s = 0.f;
#pragma unroll
    for (int j = 0; j < 4; ++j) { xv[j] = ((const f32x4*)xin)[lane + 64 * j]; const u32x2 w = ((const u32x2*)mrow)[lane + 64 * j];
        mv[j][0] = __uint_as_float(w.x << 16); mv[j][1] = __uint_as_float(w.x & 0xffff0000u); mv[j][2] = __uint_as_float(w.y << 16); mv[j][3] = __uint_as_float(w.y & 0xffff0000u);
        s += (mv[j][0] * mv[j][0] + mv[j][1] * mv[j][1]) + (mv[j][2] * mv[j][2] + mv[j][3] * mv[j][3]); }
    const float rstd = 1.0f / sqrtf(wave_sum(s) * (1.0f / D) + NORM_EPS);
    float s2 = 0.f;
#pragma unroll
    for (int j = 0; j < 4; ++j) { const f32x4 gg = ((const f32x4*)gpost)[lane + 64 * j];
#pragma unroll
        for (int e = 0; e < 4; ++e) { xv[j][e] += mv[j][e] * rstd * gg[e]; s2 += xv[j][e] * xv[j][e]; }
        ((f32x4*)xout)[lane + 64 * j] = xv[j]; }
    if (gnext) {
        const float rstd2 = 1.0f / sqrtf(wave_sum(s2) * (1.0f / D) + NORM_EPS);
#pragma unroll
        for (int j = 0; j < 4; ++j) { const f32x4 gg = ((const f32x4*)gnext)[lane + 64 * j]; u32x2 w; w.x = pk2(xv[j][0] * rstd2 * gg[0], xv[j][1] * rstd2 * gg[1]); w.y = pk2(xv[j][2] * rstd2 * gg[2], xv[j][3] * rstd2 * gg[3]);
            ((u32x2*)xn)[lane + 64 * j] = w; }
    }
}

struct Args { const float* in[17]; float* out; unsigned char* ws; };
constexpr int PT_OFF = LDSCTL_OFF;
__device__ __forceinline__ unsigned char* ldptr(LAS unsigned char* lds, int idx) {
    const volatile LAS unsigned* p = (const volatile LAS unsigned*)(lds + PT_OFF + idx * 8);
    const unsigned lo = (unsigned)__builtin_amdgcn_readfirstlane((int)p[0]), hi = (unsigned)__builtin_amdgcn_readfirstlane((int)p[1]);
    return (unsigned char*)(((unsigned long long)hi << 32) | lo);
}
#define INP(i) ((const float*)ldptr(lds, (i)))
#define OUTP ((float*)ldptr(lds, 17))
#define WSP (ldptr(lds, 18))
#define IDS int tid_ = wave_s * 64 + lane_id_volatile(); const int tid = tid_, lane = tid & 63, wave = wave_s; const int G = gridDim.x, bx = blockIdx.x; \
    const int vcu = (G % 8 == 0) ? (bx % 8) * (G / 8) + bx / 8 : bx; const int gw = vcu * NWAVES + wave, NGW = G * NWAVES; (void)lane; (void)gw; (void)NGW; (void)vcu; (void)bx; (void)tid; (void)wave
template <int MODE, int AMODE>
__device__ __forceinline__ void run_gemm(LAS unsigned char* lds, const bf16_t* A, const bf16_t* Bt, int Mr, int N, int K, const pg8::Epi<MODE>& E, int wave_s) {
    pg8::Gemm g{A, Bt, Mr, N, K}; pg8::StaticOrder S; S.init(Mr, N, (int)gridDim.x, (int)blockIdx.x);
#ifndef NO_GEMM
#ifdef ONLY_MODE
    if (MODE == ONLY_MODE)
#endif
    pg8::gemm_phase<pg8::Epi<MODE>, pg8::StaticOrder, AMODE, true, true>(lds, g, S, E, wave_s);
#endif
}

#ifndef REP_GIN
#define REP_GIN 1
#endif
#ifndef REP_CMP
#define REP_CMP 1
#endif
#ifndef REP_SCAN
#define REP_SCAN 1
#endif
#ifndef REP_ATT_NSA
#define REP_ATT_NSA 1
#endif
#ifndef REP_ATT_FOX
#define REP_ATT_FOX 1
#endif
#ifndef REP_ATT_SWA
#define REP_ATT_SWA 1
#endif
#ifndef REP_GOUT
#define REP_GOUT 1
#endif
#ifndef REP_MLP
#define REP_MLP 1
#endif
#ifndef REP_PRO
#define REP_PRO 1
#endif
template <int L>
__device__ __forceinline__ void layer_body(LAS unsigned char* lds, const XcdBarrier& bar, int& aslot, const int wave_s) {
#define GRID_BAR() xcd_barrier(bar)
    constexpr int kind = L % 3, sl = L / 3;
    if (kind == 0) {
        { unsigned char* ws = WSP;
          pg8::Epi<pg8::EM_NSA> E{(bf16_t*)(ws + WS_BIG), NSA_LDP, nullptr, (const float*)(ws + WS_ROPEC), (const float*)(ws + WS_ROPES), (float*)(ws + WS_G), nullptr};
          run_gemm<pg8::EM_NSA, 0>(lds + RING_OFF, (const bf16_t*)(ws + WS_XN), (const bf16_t*)(ws + WS_WNSA) + (size_t)sl * NSA_NP * D, M, NSA_NP, D, E, wave_s); }
        GRID_BAR();
#if REP_GIN >= 2
        { unsigned char* ws = WSP;
          pg8::Epi<pg8::EM_NSA> E{(bf16_t*)(ws + WS_BIG), NSA_LDP, nullptr, (const float*)(ws + WS_ROPEC), (const float*)(ws + WS_ROPES), (float*)(ws + WS_G), nullptr};
          run_gemm<pg8::EM_NSA, 0>(lds + RING_OFF, (const bf16_t*)(ws + WS_XN), (const bf16_t*)(ws + WS_WNSA) + (size_t)sl * NSA_NP * D, M, NSA_NP, D, E, wave_s); }
        GRID_BAR();
#endif
        { unsigned char* ws = WSP;
          pg8::Epi<pg8::EM_CMP> E{(bf16_t*)(ws + WS_HID), 256, (const float*)(ws + WS_CMPB) + sl * 512, nullptr, nullptr, nullptr, nullptr};
          run_gemm<pg8::EM_CMP, 1>(lds + RING_OFF, (const bf16_t*)(ws + WS_BIG) + 1024, (const bf16_t*)(ws + WS_WCMP) + (size_t)sl * 2 * 256 * 2048, CMP_ROWS, 512, 2048, E, wave_s); }
        GRID_BAR();
#if REP_CMP >= 2
        { unsigned char* ws = WSP;
          pg8::Epi<pg8::EM_CMP> E{(bf16_t*)(ws + WS_HID), 256, (const float*)(ws + WS_CMPB) + sl * 512, nullptr, nullptr, nullptr, nullptr};
          run_gemm<pg8::EM_CMP, 1>(lds + RING_OFF, (const bf16_t*)(ws + WS_BIG) + 1024, (const bf16_t*)(ws + WS_WCMP) + (size_t)sl * 2 * 256 * 2048, CMP_ROWS, 512, 2048, E, wave_s); }
        GRID_BAR();
#endif
        { IDS; unsigned char* ws = WSP; const bf16_t* HID = (const bf16_t*)(ws + WS_HID); bf16_t* KC = (bf16_t*)(ws + WS_KC); bf16_t* VC = (bf16_t*)(ws + WS_VC); const float* nsa_w2 = INP(7);
          for (int task = gw; task < 2 * CMP_ROWS; task += NGW) {
            const int which = task >= CMP_ROWS ? 1 : 0, r = task - which * CMP_ROWS;
            const bf16_t* hrow = HID + (size_t)task * 256;
            const u32x2 hw = *(const u32x2*)(hrow + 4 * lane);
            float f[4] = {__uint_as_float(hw.x << 16), __uint_as_float(hw.x & 0xffff0000u), __uint_as_float(hw.y << 16), __uint_as_float(hw.y & 0xffff0000u)};
            const int dsrc = which ? lane : il64(lane);
            const float* w2 = nsa_w2 + (size_t)(sl * 2 + which) * 256 * 64 + dsrc;
            float acc = 0.f;
            for (int jj = 0; jj < 64; ++jj) {
#pragma unroll
                for (int s = 0; s < 4; ++s) acc += __builtin_bit_cast(float, __builtin_amdgcn_readlane(__builtin_bit_cast(int, f[s]), jj)) * w2[(size_t)(4 * jj + s) * 64];
            }
            const int gg = r & 3, c = (r >> 2) & 127, b = r >> 9;
            bf16_t* dst = (which ? VC : KC) + ((size_t)((b * 4 + gg) * NCP + c) * 64 + lane);
            *dst = (bf16_t)f2bf(c == NC ? 0.f : acc);
          } }
        GRID_BAR();
#if REP_CMP >= 2
        { IDS; unsigned char* ws = WSP; const bf16_t* HID = (const bf16_t*)(ws + WS_HID); bf16_t* KC = (bf16_t*)(ws + WS_KC); bf16_t* VC = (bf16_t*)(ws + WS_VC); const float* nsa_w2 = INP(7);
          for (int task = gw; task < 2 * CMP_ROWS; task += NGW) {
            const int which = task >= CMP_ROWS ? 1 : 0, r = task - which * CMP_ROWS;
            const bf16_t* hrow = HID + (size_t)task * 256;
            const u32x2 hw = *(const u32x2*)(hrow + 4 * lane);
            float f[4] = {__uint_as_float(hw.x << 16), __uint_as_float(hw.x & 0xffff0000u), __uint_as_float(hw.y << 16), __uint_as_float(hw.y & 0xffff0000u)};
            const int dsrc = which ? lane : il64(lane);
            const float* w2 = nsa_w2 + (size_t)(sl * 2 + which) * 256 * 64 + dsrc;
            float acc = 0.f;
            for (int jj = 0; jj < 64; ++jj) {
#pragma unroll
                for (int s = 0; s < 4; ++s) acc += __builtin_bit_cast(float, __builtin_amdgcn_readlane(__builtin_bit_cast(int, f[s]), jj)) * w2[(size_t)(4 * jj + s) * 64];
            }
            const int gg = r & 3, c = (r >> 2) & 127, b = r >> 9;
            bf16_t* dst = (which ? VC : KC) + ((size_t)((b * 4 + gg) * NCP + c) * 64 + lane);
            *dst = (bf16_t)f2bf(c == NC ? 0.f : acc);
          } }
        GRID_BAR();
#endif
        { IDS; unsigned char* ws = WSP;
          const int bg = vcu >> 2, sub = vcu & 3, b = bg >> 2, g = bg & 3;
          for (int i = 0; i < 8; ++i) { const int qt = (i & 1) ? (8 * (i >> 1) + 7 - sub) : (8 * (i >> 1) + sub);
#ifndef NO_NSA
              att::nsa_unit(lds + RING_OFF, b, g, qt, ws, WS_BIG, WS_G, WS_KC, WS_VC, WS_O, wave, aslot);
#endif
          } }
#if REP_ATT_NSA >= 2
        GRID_BAR();
        { IDS; unsigned char* ws = WSP;
          const int bg = vcu >> 2, sub = vcu & 3, b = bg >> 2, g = bg & 3;
          for (int i = 0; i < 8; ++i) { const int qt = (i & 1) ? (8 * (i >> 1) + 7 - sub) : (8 * (i >> 1) + sub);
#ifndef NO_NSA
              att::nsa_unit(lds + RING_OFF, b, g, qt, ws, WS_BIG, WS_G, WS_KC, WS_VC, WS_O, wave, aslot);
#endif
          } }
#endif
    } else if (kind == 1) {
        { unsigned char* ws = WSP;
          pg8::Epi<pg8::EM_FOX> E{(bf16_t*)(ws + WS_BIG), FOX_LDP, nullptr, nullptr, nullptr, (float*)(ws + WS_LF), INP(10)};
          run_gemm<pg8::EM_FOX, 0>(lds + RING_OFF, (const bf16_t*)(ws + WS_XN), (const bf16_t*)(ws + WS_WFOX), M, FOX_NP, D, E, wave_s); }
        GRID_BAR();
#if REP_GIN >= 2
        { unsigned char* ws = WSP;
          pg8::Epi<pg8::EM_FOX> E{(bf16_t*)(ws + WS_BIG), FOX_LDP, nullptr, nullptr, nullptr, (float*)(ws + WS_LF), INP(10)};
          run_gemm<pg8::EM_FOX, 0>(lds + RING_OFF, (const bf16_t*)(ws + WS_XN), (const bf16_t*)(ws + WS_WFOX), M, FOX_NP, D, E, wave_s); }
        GRID_BAR();
#endif
        { IDS; unsigned char* ws = WSP; const float* LF = (const float*)(ws + WS_LF); float* CB = (float*)(ws + WS_CB);
          if (wave == 0) for (int bh = bx; bh < BATCH * NH; bh += G) {
            const int b = bh >> 4, h = bh & 15; float v[32]; float run = 0.f;
#pragma unroll
            for (int i = 0; i < 32; ++i) { run += LF[((size_t)b * T + 32 * lane + i) * 16 + h]; v[i] = run; }
            float excl = 0.f;
            for (int k = 0; k < 63; ++k) { const float t = __builtin_bit_cast(float, __builtin_amdgcn_readlane(__builtin_bit_cast(int, run), k)); if (lane > k) excl += t; }
#pragma unroll
            for (int i = 0; i < 32; ++i) CB[(size_t)bh * T + 32 * lane + i] = -(v[i] + excl) * LOG2E;
          } }
        GRID_BAR();
#if REP_SCAN >= 2
        { IDS; unsigned char* ws = WSP; const float* LF = (const float*)(ws + WS_LF); float* CB = (float*)(ws + WS_CB);
          if (wave == 0) for (int bh = bx; bh < BATCH * NH; bh += G) {
            const int b = bh >> 4, h = bh & 15; float v[32]; float run = 0.f;
#pragma unroll
            for (int i = 0; i < 32; ++i) { run += LF[((size_t)b * T + 32 * lane + i) * 16 + h]; v[i] = run; }
            float excl = 0.f;
            for (int k = 0; k < 63; ++k) { const float t = __builtin_bit_cast(float, __builtin_amdgcn_readlane(__builtin_bit_cast(int, run), k)); if (lane > k) excl += t; }
#pragma unroll
            for (int i = 0; i < 32; ++i) CB[(size_t)bh * T + 32 * lane + i] = -(v[i] + excl) * LOG2E;
          } }
        GRID_BAR();
#endif
        { IDS; unsigned char* ws = WSP;
          const int xcd = vcu >> 5, c = vcu & 31, sub = c & 3;
          for (int i = 0; i < 8; ++i) { const int bh = 32 * xcd + 8 * (i >> 1) + (c >> 2); const int qb = (i & 1) ? sub : 7 - sub;
#ifndef NO_FOX
              att::fox_unit(lds + RING_OFF, bh >> 4, bh & 15, qb, ws, WS_BIG, WS_CB, WS_O, wave, aslot);
#endif
          } }
#if REP_ATT_FOX >= 2
        GRID_BAR();
        { IDS; unsigned char* ws = WSP;
          const int xcd = vcu >> 5, c = vcu & 31, sub = c & 3;
          for (int i = 0; i < 8; ++i) { const int bh = 32 * xcd + 8 * (i >> 1) + (c >> 2); const int qb = (i & 1) ? sub : 7 - sub;
#ifndef NO_FOX
              att::fox_unit(lds + RING_OFF, bh >> 4, bh & 15, qb, ws, WS_BIG, WS_CB, WS_O, wave, aslot);
#endif
          } }
#endif
    } else {
        { unsigned char* ws = WSP;
          pg8::Epi<pg8::EM_SWA> E{(bf16_t*)(ws + WS_BIG), SWA_LDP, (const float*)(ws + WS_SWAB), (const float*)(ws + WS_ROPEC), (const float*)(ws + WS_ROPES), nullptr, nullptr};
          run_gemm<pg8::EM_SWA, 0>(lds + RING_OFF, (const bf16_t*)(ws + WS_XN), (const bf16_t*)(ws + WS_WSWA), M, SWA_NP, D, E, wave_s); }
        GRID_BAR();
#if REP_GIN >= 2
        { unsigned char* ws = WSP;
          pg8::Epi<pg8::EM_SWA> E{(bf16_t*)(ws + WS_BIG), SWA_LDP, (const float*)(ws + WS_SWAB), (const float*)(ws + WS_ROPEC), (const float*)(ws + WS_ROPES), nullptr, nullptr};
          run_gemm<pg8::EM_SWA, 0>(lds + RING_OFF, (const bf16_t*)(ws + WS_XN), (const bf16_t*)(ws + WS_WSWA), M, SWA_NP, D, E, wave_s); }
        GRID_BAR();
#endif
        { IDS; unsigned char* ws = WSP; const float* sinks = INP(14);
          const int bg = vcu >> 3, sub = vcu & 7;
          for (int i = 0; i < 8; ++i) {
#ifndef NO_SWA
              att::swa_unit(lds + RING_OFF, bg >> 1, bg & 1, 8 * i + sub, ws, WS_BIG, WS_O, sinks, wave, aslot);
#endif
          } }
#if REP_ATT_SWA >= 2
        GRID_BAR();
        { IDS; unsigned char* ws = WSP; const float* sinks = INP(14);
          const int bg = vcu >> 3, sub = vcu & 7;
          for (int i = 0; i < 8; ++i) {
#ifndef NO_SWA
              att::swa_unit(lds + RING_OFF, bg >> 1, bg & 1, 8 * i + sub, ws, WS_BIG, WS_O, sinks, wave, aslot);
#endif
          } }
#endif
    }
    GRID_BAR();
    { unsigned char* ws = WSP;
      pg8::Epi<pg8::EM_PLAIN> E{(bf16_t*)(ws + WS_BIG), D, kind == 2 ? INP(16) : nullptr, nullptr, nullptr, nullptr, nullptr};
      run_gemm<pg8::EM_PLAIN, 0>(lds + RING_OFF, (const bf16_t*)(ws + WS_O), (const bf16_t*)(ws + WS_WOUT) + (size_t)L * D * D, M, D, D, E, wave_s); }
    GRID_BAR();
#if REP_GOUT >= 2
    { unsigned char* ws = WSP;
      pg8::Epi<pg8::EM_PLAIN> E{(bf16_t*)(ws + WS_BIG), D, kind == 2 ? INP(16) : nullptr, nullptr, nullptr, nullptr, nullptr};
      run_gemm<pg8::EM_PLAIN, 0>(lds + RING_OFF, (const bf16_t*)(ws + WS_O), (const bf16_t*)(ws + WS_WOUT) + (size_t)L * D * D, M, D, D, E, wave_s); }
    GRID_BAR();
#endif
    { IDS; unsigned char* ws = WSP; const float* gL = INP(1) + (size_t)L * 4 * D; const float* xin = (L == 0) ? INP(0) : (const float*)OUTP; float* xout = OUTP;
      const bf16_t* MB = (const bf16_t*)(ws + WS_BIG); bf16_t* XN = (bf16_t*)(ws + WS_XN);
      for (int m = gw; m < M; m += NGW) resnorm_row(xin + (size_t)m * D, MB + (size_t)m * D, gL + D, xout + (size_t)m * D, gL + 2 * D, XN + (size_t)m * D, lane); }
    GRID_BAR();
    { unsigned char* ws = WSP;
      pg8::Epi<pg8::EM_RELU2> E{(bf16_t*)(ws + WS_BIG), FF, nullptr, nullptr, nullptr, nullptr, nullptr};
      run_gemm<pg8::EM_RELU2, 0>(lds + RING_OFF, (const bf16_t*)(ws + WS_XN), (const bf16_t*)(ws + WS_WUP) + (size_t)L * D * FF, M, FF, D, E, wave_s); }
    GRID_BAR();
#if REP_MLP >= 2
    { unsigned char* ws = WSP;
      pg8::Epi<pg8::EM_RELU2> E{(bf16_t*)(ws + WS_BIG), FF, nullptr, nullptr, nullptr, nullptr, nullptr};
      run_gemm<pg8::EM_RELU2, 0>(lds + RING_OFF, (const bf16_t*)(ws + WS_XN), (const bf16_t*)(ws + WS_WUP) + (size_t)L * D * FF, M, FF, D, E, wave_s); }
    GRID_BAR();
#endif
    { unsigned char* ws = WSP;
      pg8::Epi<pg8::EM_PLAIN> E{(bf16_t*)(ws + WS_XN), D, nullptr, nullptr, nullptr, nullptr, nullptr};
      run_gemm<pg8::EM_PLAIN, 0>(lds + RING_OFF, (const bf16_t*)(ws + WS_BIG), (const bf16_t*)(ws + WS_WDN) + (size_t)L * D * FF, M, D, FF, E, wave_s); }
    GRID_BAR();
#if REP_MLP >= 2
    { unsigned char* ws = WSP;
      pg8::Epi<pg8::EM_PLAIN> E{(bf16_t*)(ws + WS_XN), D, nullptr, nullptr, nullptr, nullptr, nullptr};
      run_gemm<pg8::EM_PLAIN, 0>(lds + RING_OFF, (const bf16_t*)(ws + WS_BIG), (const bf16_t*)(ws + WS_WDN) + (size_t)L * D * FF, M, D, FF, E, wave_s); }
    GRID_BAR();
#endif
    { IDS; unsigned char* ws = WSP; const float* gL = INP(1) + (size_t)L * 4 * D; float* xout = OUTP; bf16_t* XN = (bf16_t*)(ws + WS_XN);
      for (int m = gw; m < M; m += NGW) resnorm_row(xout + (size_t)m * D, XN + (size_t)m * D, gL + 3 * D, xout + (size_t)m * D, (L + 1 < DEPTH) ? gL + 4 * D : nullptr, XN + (size_t)m * D, lane); }
    if (L + 1 < DEPTH) GRID_BAR();
#undef GRID_BAR
}

__global__ void __launch_bounds__(NWAVES * 64, 2) fwd_kernel(Args args) {
    extern __shared__ __attribute__((aligned(16))) unsigned char lds_raw[];
    LAS unsigned char* lds = (LAS unsigned char*)lds_raw;
    const int wave_s = __builtin_amdgcn_readfirstlane((int)threadIdx.x >> 6);
    for (int u = threadIdx.x; u < (LDS_BYTES - LDSCTL_OFF) / 4; u += NWAVES * 64) ((LAS unsigned*)(lds + LDSCTL_OFF))[u] = 0u;
    __syncthreads();
    if (threadIdx.x == 0) {
        LAS unsigned long long* pt = (LAS unsigned long long*)(lds + PT_OFF);
#pragma unroll
        for (int i = 0; i < 17; ++i) pt[i] = (unsigned long long)args.in[i];
        pt[17] = (unsigned long long)args.out; pt[18] = (unsigned long long)args.ws;
    }
    __syncthreads();
    volatile LAS unsigned* MISC = (volatile LAS unsigned*)(lds + MISC_OFF);
    XcdBarrier bar = xcd_barrier_post((unsigned*)(WSP + WS_CTL) + CW_BAR, MISC + 8);

    {
        IDS; unsigned char* ws = WSP;
        const float* x_in = INP(0); const float* norm_g = INP(1); const float* mlp_up = INP(2); const float* mlp_dn = INP(3);
        const float* nsa_w_in = INP(4); const float* nsa_pos = INP(5); const float* nsa_w1 = INP(6); const float* nsa_w_out = INP(8);
        const float* fox_w_in = INP(9); const float* fox_w_out = INP(11); const float* swa_w_in = INP(12); const float* swa_b_in = INP(13); const float* swa_w_out = INP(15);
        bf16_t* W_UP = (bf16_t*)(ws + WS_WUP); bf16_t* W_DN = (bf16_t*)(ws + WS_WDN); bf16_t* W_NSA = (bf16_t*)(ws + WS_WNSA); bf16_t* W_OUT = (bf16_t*)(ws + WS_WOUT);
        bf16_t* W_FOX = (bf16_t*)(ws + WS_WFOX); bf16_t* W_SWA = (bf16_t*)(ws + WS_WSWA); bf16_t* W_CMP = (bf16_t*)(ws + WS_WCMP);
        float* ROPEC = (float*)(ws + WS_ROPEC); float* ROPES = (float*)(ws + WS_ROPES); float* CMPB = (float*)(ws + WS_CMPB); float* SWAB = (float*)(ws + WS_SWAB);
        bf16_t* XN = (bf16_t*)(ws + WS_XN);
        LAS float* scr = (LAS float*)(lds + RING_OFF + wave * 16384);
        constexpr int I_UP = (D / 64) * (FF / 32), I_DN = (FF / 64) * (D / 32), I_NSA = (D / 64) * (NSA_NP / 32), I_OUT = (D / 64) * (D / 32), I_FOX = (D / 64) * (FOX_NP / 32), I_SWA = (D / 64) * (SWA_NP / 32), I_CMP = (2048 / 64) * (256 / 32);
        constexpr int NITEMS = 4 * I_UP + 4 * I_DN + 2 * I_NSA + 4 * I_OUT + I_FOX + I_SWA + 4 * I_CMP;
        for (int it = gw; it < NITEMS; it += NGW) {
            int r = it;
            if (r < 4 * I_UP) { const int Lw = r / I_UP; conv_item(mlp_up + (size_t)Lw * D * FF, D, FF, W_UP + (size_t)Lw * D * FF, FF, 0, r % I_UP, scr, lane); continue; } r -= 4 * I_UP;
            if (r < 4 * I_DN) { const int Lw = r / I_DN; conv_item(mlp_dn + (size_t)Lw * D * FF, FF, D, W_DN + (size_t)Lw * D * FF, D, 0, r % I_DN, scr, lane); continue; } r -= 4 * I_DN;
            if (r < 2 * I_NSA) { const int s = r / I_NSA; conv_item(nsa_w_in + (size_t)s * D * NSA_N, D, NSA_N, W_NSA + (size_t)s * NSA_NP * D, NSA_NP, 1, r % I_NSA, scr, lane); continue; } r -= 2 * I_NSA;
            if (r < 4 * I_OUT) { const int Lw = r / I_OUT; const float* src = (Lw == 1) ? fox_w_out : (Lw == 2) ? swa_w_out : nsa_w_out + (size_t)(Lw / 3) * D * D;
                conv_item(src, D, D, W_OUT + (size_t)Lw * D * D, D, 0, r % I_OUT, scr, lane); continue; } r -= 4 * I_OUT;
            if (r < I_FOX) { conv_item(fox_w_in, D, FOX_N, W_FOX, FOX_NP, 2, r, scr, lane); continue; } r -= I_FOX;
            if (r < I_SWA) { conv_item(swa_w_in, D, SWA_N, W_SWA, SWA_NP, 3, r, scr, lane); continue; } r -= I_SWA;
            { const int sw = r / I_CMP;
                conv_item(nsa_w1 + (size_t)sw * 2048 * 256, 2048, 256, W_CMP + (size_t)sw * 256 * 2048, 256, (sw & 1) ? 0 : 4, r % I_CMP, scr, lane); }
        }
        for (int e = bx * 512 + tid; e < T * 32; e += G * 512) { const int t = e >> 5, i = e & 31; const float inv = powf(10000.0f, -(float)(2 * i) / 64.0f); const float ang = (float)t * inv;
            ROPEC[e] = cosf(ang); ROPES[e] = sinf(ang); }
        for (int e = bx * 512 + tid; e < SWA_N; e += G * 512) SWAB[e] = swa_b_in[src_n(3, e)];
        for (int task = bx; task < 16; task += G) {
            const int sw = task >> 2, n0 = (task & 3) * 64, kq = tid >> 6, nn = tid & 63;
            const float* pos = nsa_pos + (size_t)sw * 2048; const float* w1 = nsa_w1 + (size_t)sw * 2048 * 256;
            float acc = 0.f;
            for (int k = kq * 256; k < kq * 256 + 256; ++k) acc += pos[k] * w1[(size_t)k * 256 + n0 + nn];
            LAS float* red = (LAS float*)(lds + RING_OFF);
            __syncthreads();
            red[kq * 64 + nn] = acc;
            __syncthreads();
            if (tid < 64) { float sm = 0.f; for (int q = 0; q < 8; ++q) sm += red[q * 64 + tid]; CMPB[sw * 256 + n0 + tid] = sm; }
            __syncthreads();
        }
        for (int m = gw; m < M; m += NGW) norm_row(x_in + (size_t)m * D, norm_g, XN + (size_t)m * D, lane);
    }
#if REP_PRO >= 2
    xcd_barrier(bar);
    {
        IDS; unsigned char* ws = WSP;
        const float* x_in = INP(0); const float* norm_g = INP(1); const float* mlp_up = INP(2); const float* mlp_dn = INP(3);
        const float* nsa_w_in = INP(4); const float* nsa_pos = INP(5); const float* nsa_w1 = INP(6); const float* nsa_w_out = INP(8);
        const float* fox_w_in = INP(9); const float* fox_w_out = INP(11); const float* swa_w_in = INP(12); const float* swa_b_in = INP(13); const float* swa_w_out = INP(15);
        bf16_t* W_UP = (bf16_t*)(ws + WS_WUP); bf16_t* W_DN = (bf16_t*)(ws + WS_WDN); bf16_t* W_NSA = (bf16_t*)(ws + WS_WNSA); bf16_t* W_OUT = (bf16_t*)(ws + WS_WOUT);
        bf16_t* W_FOX = (bf16_t*)(ws + WS_WFOX); bf16_t* W_SWA = (bf16_t*)(ws + WS_WSWA); bf16_t* W_CMP = (bf16_t*)(ws + WS_WCMP);
        float* ROPEC = (float*)(ws + WS_ROPEC); float* ROPES = (float*)(ws + WS_ROPES); float* CMPB = (float*)(ws + WS_CMPB); float* SWAB = (float*)(ws + WS_SWAB);
        bf16_t* XN = (bf16_t*)(ws + WS_XN);
        LAS float* scr = (LAS float*)(lds + RING_OFF + wave * 16384);
        constexpr int I_UP = (D / 64) * (FF / 32), I_DN = (FF / 64) * (D / 32), I_NSA = (D / 64) * (NSA_NP / 32), I_OUT = (D / 64) * (D / 32), I_FOX = (D / 64) * (FOX_NP / 32), I_SWA = (D / 64) * (SWA_NP / 32), I_CMP = (2048 / 64) * (256 / 32);
        constexpr int NITEMS = 4 * I_UP + 4 * I_DN + 2 * I_NSA + 4 * I_OUT + I_FOX + I_SWA + 4 * I_CMP;
        for (int it = gw; it < NITEMS; it += NGW) {
            int r = it;
            if (r < 4 * I_UP) { const int Lw = r / I_UP; conv_item(mlp_up + (size_t)Lw * D * FF, D, FF, W_UP + (size_t)Lw * D * FF, FF, 0, r % I_UP, scr, lane); continue; } r -= 4 * I_UP;
            if (r < 4 * I_DN) { const int Lw = r / I_DN; conv_item(mlp_dn + (size_t)Lw * D * FF, FF, D, W_DN + (size_t)Lw * D * FF, D, 0, r % I_DN, scr, lane); continue; } r -= 4 * I_DN;
            if (r < 2 * I_NSA) { const int s = r / I_NSA; conv_item(nsa_w_in + (size_t)s * D * NSA_N, D, NSA_N, W_NSA + (size_t)s * NSA_NP * D, NSA_NP, 1, r % I_NSA, scr, lane); continue; } r -= 2 * I_NSA;
            if (r < 4 * I_OUT) { const int Lw = r / I_OUT; const float* src = (Lw == 1) ? fox_w_out : (Lw == 2) ? swa_w_out : nsa_w_out + (size_t)(Lw / 3) * D * D;
                conv_item(src, D, D, W_OUT + (size_t)Lw * D * D, D, 0, r % I_OUT, scr, lane); continue; } r -= 4 * I_OUT;
            if (r < I_FOX) { conv_item(fox_w_in, D, FOX_N, W_FOX, FOX_NP, 2, r, scr, lane); continue; } r -= I_FOX;
            if (r < I_SWA) { conv_item(swa_w_in, D, SWA_N, W_SWA, SWA_NP, 3, r, scr, lane); continue; } r -= I_SWA;
            { const int sw = r / I_CMP;
                conv_item(nsa_w1 + (size_t)sw * 2048 * 256, 2048, 256, W_CMP + (size_t)sw * 256 * 2048, 256, (sw & 1) ? 0 : 4, r % I_CMP, scr, lane); }
        }
        for (int e = bx * 512 + tid; e < T * 32; e += G * 512) { const int t = e >> 5, i = e & 31; const float inv = powf(10000.0f, -(float)(2 * i) / 64.0f); const float ang = (float)t * inv;
            ROPEC[e] = cosf(ang); ROPES[e] = sinf(ang); }
        for (int e = bx * 512 + tid; e < SWA_N; e += G * 512) SWAB[e] = swa_b_in[src_n(3, e)];
        for (int task = bx; task < 16; task += G) {
            const int sw = task >> 2, n0 = (task & 3) * 64, kq = tid >> 6, nn = tid & 63;
            const float* pos = nsa_pos + (size_t)sw * 2048; const float* w1 = nsa_w1 + (size_t)sw * 2048 * 256;
            float acc = 0.f;
            for (int k = kq * 256; k < kq * 256 + 256; ++k) acc += pos[k] * w1[(size_t)k * 256 + n0 + nn];
            LAS float* red = (LAS float*)(lds + RING_OFF);
            __syncthreads();
            red[kq * 64 + nn] = acc;
            __syncthreads();
            if (tid < 64) { float sm = 0.f; for (int q = 0; q < 8; ++q) sm += red[q * 64 + tid]; CMPB[sw * 256 + n0 + tid] = sm; }
            __syncthreads();
        }
        for (int m = gw; m < M; m += NGW) norm_row(x_in + (size_t)m * D, norm_g, XN + (size_t)m * D, lane);
    }
#endif
    xcd_barrier(bar);

    int aslot = 0;
    if (L_LO <= 0 && 0 < L_HI) layer_body<0>(lds, bar, aslot, wave_s);
    if (L_LO <= 1 && 1 < L_HI) layer_body<1>(lds, bar, aslot, wave_s);
    if (L_LO <= 2 && 2 < L_HI) layer_body<2>(lds, bar, aslot, wave_s);
    if (L_LO <= 3 && 3 < L_HI) layer_body<3>(lds, bar, aslot, wave_s);
}

extern "C" void kernel_launch(void* const* d_in, const int* in_sizes, int n_in, void* d_out, int out_size, void* d_ws, size_t ws_size, hipStream_t stream) {
    static int grid = 0;
    if (grid == 0) {
        if (n_in != 17 || in_sizes[0] != M * D || out_size != M * D || ws_size < WS_END) { fprintf(stderr, "kernel_launch: unexpected problem shape (n_in %d, in0 %d, out %d, ws %zu)\n", n_in, n_in > 0 ? in_sizes[0] : -1, out_size, ws_size); grid = -1; return; }
        int dev = 0, cus = 0, per_cu = 0;
        if (hipGetDevice(&dev) != hipSuccess || hipDeviceGetAttribute(&cus, hipDeviceAttributeMultiprocessorCount, dev) != hipSuccess) { grid = -1; return; }
        if (hipFuncSetAttribute((const void*)fwd_kernel, hipFuncAttributeMaxDynamicSharedMemorySize, LDS_BYTES) != hipSuccess) { fprintf(stderr, "kernel_launch: hipFuncSetAttribute failed\n"); grid = -1; return; }
        if (hipOccupancyMaxActiveBlocksPerMultiprocessor(&per_cu, (const void*)fwd_kernel, NWAVES * 64, LDS_BYTES) != hipSuccess || per_cu < 1) { fprintf(stderr, "kernel_launch: occupancy query reports %d\n", per_cu); }
        (void)hipGetLastError();
        if (cus < 256) { fprintf(stderr, "kernel_launch: needs 256 CUs, device has %d\n", cus); grid = -1; return; }
        grid = 256;
    }
    if (grid < 0) return;
    if (hipMemsetAsync((char*)d_ws + WS_CTL, 0, CTL_ZERO_BYTES, stream) != hipSuccess) return;
    Args a{};
    for (int i = 0; i < 17; ++i) a.in[i] = (const float*)d_in[i];
    a.out = (float*)d_out; a.ws = (unsigned char*)d_ws;
    hipLaunchKernelGGL(fwd_kernel, dim3(grid), dim3(NWAVES * 64), LDS_BYTES, stream, a);
}
```

```cpp
#include <hip/hip_runtime.h>
#include <cstdio>
#include <cstdint>

#define LAS __attribute__((address_space(3)))
#define GAS __attribute__((address_space(1)))
typedef unsigned short bf16_t;
typedef short bf16x8 __attribute__((ext_vector_type(8)));
typedef short s16x4 __attribute__((ext_vector_type(4)));
typedef float f32x2 __attribute__((ext_vector_type(2)));
typedef float f32x4 __attribute__((ext_vector_type(4)));
typedef float f32x16 __attribute__((ext_vector_type(16)));
typedef unsigned u32x2 __attribute__((ext_vector_type(2)));
typedef unsigned u32x4 __attribute__((ext_vector_type(4)));

constexpr int BATCH = 16, T = 2048, D = 1024, NH = 16, HD = 64, FF = 4096, DEPTH = 4;
constexpr int M = BATCH * T;
constexpr int NSA_N = 2608, NSA_NP = 2816, NSA_LDP = 1536;
constexpr int FOX_N = 3088, FOX_NP = 3328, FOX_LDP = 1024;
constexpr int SWA_N = 1280, SWA_NP = 1280, SWA_LDP = 1024;
constexpr int CMP_LDP = NSA_LDP;
constexpr int NC = 127, NCP = 128;
constexpr int CMP_ROWS = BATCH * NCP * 4;
constexpr size_t NSA_HM_OFF = (size_t)96 << 20, NSA_HM_STRIDE = (size_t)8 << 20;
constexpr size_t FOX_HM_OFF = (size_t)64 << 20, FOX_HM_STRIDE = (size_t)32 << 20;
constexpr size_t SWA_HM_OFF = (size_t)64 << 20, SWA_HM_STRIDE = (size_t)4 << 20;
constexpr float LOG2E = 1.4426950408889634f;
constexpr float C2 = 0.125f * LOG2E;
constexpr float NORM_EPS = 1e-6f;

__device__ __forceinline__ unsigned cvt_pk_bf16(float lo, float hi) { unsigned r; asm volatile("v_cvt_pk_bf16_f32 %0, %1, %2" : "=v"(r) : "v"(lo), "v"(hi)); return r; }
__device__ __forceinline__ void store8(bf16_t* p, f32x4 a, f32x4 b) { u32x4 w; w.x = cvt_pk_bf16(a[0], a[1]); w.y = cvt_pk_bf16(a[2], a[3]); w.z = cvt_pk_bf16(b[0], b[1]); w.w = cvt_pk_bf16(b[2], b[3]); *(u32x4*)p = w; }

__device__ __forceinline__ int lane_id_volatile() { int x; asm volatile("v_mbcnt_lo_u32_b32 %0, -1, 0\n\tv_mbcnt_hi_u32_b32 %0, -1, %0" : "=v"(x)); return x; }

namespace pg8 {
#define PG8_LAS __attribute__((address_space(3)))
constexpr int BM = 256, BK = 64, HALF = 128, HTB = HALF * BK * 2  , STAGE_BYTES = 8 * HTB, NXCD = 8, WGM = 8;

__host__ __device__ __forceinline__ int lds_byte(int r, int c) { const int st = (r >> 4) * 2 + (c >> 5), rr = r & 15, cc = c & 31, ob = rr * 64 + cc * 2; return st * 1024 + (ob ^ (((ob >> 9) & 1) << 5)); }
__host__ __device__ __forceinline__ void stage_rc(int b, int& R, int& C) { const int st = b / 1024, sb = b % 1024, swz = sb ^ (((sb >> 9) & 1) << 5); R = (st >> 1) * 16 + swz / 64; C = (st & 1) * 32 + (swz % 64) / 2; }
__host__ __device__ __forceinline__ int perm32(int rho) { const int n = rho >> 4, i = rho & 15; return 8 * (i >> 2) + 4 * n + (i & 3); }

struct Unit { int pm, pn; };
struct Gemm { const bf16_t* A; const bf16_t* Bt; int M, N, K; };

struct StaticOrder {
    int nM, nN, nwg, G, c;
    __host__ __device__ void init(int M_, int N_, int G_, int c_) { nM = M_ / BM; nN = N_ / BM; nwg = nM * nN; G = G_; c = c_; }
    __host__ __device__ bool next(int i, Unit& u) const {
        const long L = (long)i * G + c; if (L >= nwg) return false;
        int wgid = (int)L; { const int q = nwg / NXCD, r = nwg % NXCD, xcd = wgid % NXCD, off = wgid / NXCD; wgid = (xcd < r ? xcd * (q + 1) : r * (q + 1) + (xcd - r) * q) + off; }
        const int nig = WGM * nN, gid = wgid / nig, fm = gid * WGM, gsz = (nM - fm) < WGM ? (nM - fm) : WGM;
        u.pm = fm + ((wgid % nig) % gsz); u.pn = (wgid % nig) / gsz; return true;
    }
    __device__ __forceinline__ void a_ready(const Unit&) const {}
    __device__ __forceinline__ void done(const Unit&) const {}
};

enum EpiMode { EM_PLAIN = 0, EM_RELU2 = 1, EM_NSA = 2, EM_FOX = 3, EM_SWA = 4, EM_CMP = 5 };

__device__ __forceinline__ void rope4(f32x4& v, float c0, float s0, float c1, float s1) {
    const float a0 = v[0], b0 = v[1], a1 = v[2], b1 = v[3];
    v[0] = a0 * c0 - b0 * s0; v[1] = b0 * c0 + a0 * s0; v[2] = a1 * c1 - b1 * s1; v[3] = b1 * c1 + a1 * s1;
}
__device__ __forceinline__ float sigmoidf_(float x) { return 1.0f / (1.0f + __expf(-x)); }
__device__ __forceinline__ float logsigmoidf_(float x) { return fminf(x, 0.f) - log1pf(expf(-fabsf(x))); }

template <int MODE> struct Epi {
    static constexpr bool PERM = true, AFTER_DRAIN = false;
    bf16_t* O; int ldc; const float* bias; const float* rc; const float* rs; float* aux; const float* auxb;
    bf16_t* hm0; size_t hm_stride;
    __device__ __forceinline__ void operator()(const f32x4 (&acc)[2][2][4][2], const Unit& u, int wr, int wc, int fr, int fq) const {
        const int row0 = u.pm * BM + wr * 64 + fr;
        const int cw = wc * 32 + 8 * fq;
        const int colt = u.pn * BM;
        if (MODE == EM_NSA && u.pn == 10) {
            if (cw < 48) {
#pragma unroll
                for (int ai = 0; ai < 2; ++ai)
#pragma unroll
                    for (int m = 0; m < 4; ++m) { const size_t row = (size_t)(row0 + ai * HALF + m * 16); f32x4 v0 = acc[ai][0][m][0], v1 = acc[ai][0][m][1];
#pragma unroll
                        for (int j = 0; j < 4; ++j) { v0[j] = sigmoidf_(v0[j]); v1[j] = sigmoidf_(v1[j]); }
                        *(f32x4*)(aux + row * 48 + cw) = v0; *(f32x4*)(aux + row * 48 + cw + 4) = v1; }
            }
            return;
        }
        if (MODE == EM_FOX && u.pn == 12) {
            if (cw < 16) {
                const f32x4 b0 = *(const f32x4*)(auxb + cw), b1 = *(const f32x4*)(auxb + cw + 4);
#pragma unroll
                for (int ai = 0; ai < 2; ++ai)
#pragma unroll
                    for (int m = 0; m < 4; ++m) { const size_t row = (size_t)(row0 + ai * HALF + m * 16); f32x4 v0 = acc[ai][0][m][0] + b0, v1 = acc[ai][0][m][1] + b1;
#pragma unroll
                        for (int j = 0; j < 4; ++j) { v0[j] = logsigmoidf_(v0[j]); v1[j] = logsigmoidf_(v1[j]); }
                        *(f32x4*)(aux + row * 16 + cw) = v0; *(f32x4*)(aux + row * 16 + cw + 4) = v1; }
            }
            return;
        }
        bool rope0 = false, rope1 = false; float sc = 1.f;
        if (MODE == EM_NSA) { if (u.pn < 4) { rope0 = rope1 = true; sc = C2; } else if (!(u.pn & 1)) { rope0 = rope1 = true; } }
        if (MODE == EM_FOX) { if (u.pn < 4) sc = C2; }
        if (MODE == EM_SWA) { if (u.pn < 4) { rope0 = rope1 = true; sc = C2; } else { rope0 = true; } }
        f32x4 bv[2][2];
#pragma unroll
        for (int bj = 0; bj < 2; ++bj)
#pragma unroll
            for (int n = 0; n < 2; ++n) bv[bj][n] = bias ? *(const f32x4*)(bias + colt + bj * HALF + cw + 4 * n) : (f32x4){0.f, 0.f, 0.f, 0.f};
        const int ib = 16 * (wc & 1) + 4 * fq;
        bf16_t* base = O; int colo = colt; size_t rowo = 0;
        if (MODE == EM_CMP) { colo = 0; rowo = (size_t)u.pn * CMP_ROWS; }
        bool hm = false; bf16_t* hb[2] = {nullptr, nullptr}; int hd[2] = {0, 0}; int HG = 1;
        if (MODE == EM_FOX && u.pn >= 4) { hm = true; HG = 16; hb[0] = hb[1] = hm0 + (u.pn >= 8 ? hm_stride : 0); hd[0] = ((u.pn - 4) & 3) * 4 + (wc >> 1); hd[1] = hd[0] + 2; }
        if (MODE == EM_NSA && u.pn >= 6) { hm = true; HG = 4; hb[0] = hb[1] = hm0 + (size_t)(u.pn - 6) * hm_stride; hd[0] = (wc >> 1); hd[1] = hd[0] + 2; }
        if (MODE == EM_SWA && u.pn == 4) { hm = true; HG = 2; hb[0] = hm0; hb[1] = hm0 + hm_stride; hd[0] = hd[1] = (wc >> 1); }
#pragma unroll
        for (int ai = 0; ai < 2; ++ai)
#pragma unroll
            for (int m = 0; m < 4; ++m) {
                const int row = row0 + ai * HALF + m * 16;
                f32x4 cc = {1.f, 1.f, 1.f, 1.f}, ss = {0.f, 0.f, 0.f, 0.f};
                if (MODE == EM_NSA || MODE == EM_SWA) { if (rope0) { const int t = row & (T - 1); cc = *(const f32x4*)(rc + t * 32 + ib); ss = *(const f32x4*)(rs + t * 32 + ib); } }
                bf16_t* rowp = base + (rowo + (size_t)row) * ldc + colo + cw;
#pragma unroll
                for (int bj = 0; bj < 2; ++bj) {
                    f32x4 v0 = acc[ai][bj][m][0] + bv[bj][0], v1 = acc[ai][bj][m][1] + bv[bj][1];
                    if (MODE == EM_NSA || MODE == EM_SWA) { if (bj == 0 ? rope0 : rope1) { rope4(v0, cc[0], ss[0], cc[1], ss[1]); rope4(v1, cc[2], ss[2], cc[3], ss[3]); } }
                    if (MODE == EM_RELU2) {
#pragma unroll
                        for (int j = 0; j < 4; ++j) { const float a = fmaxf(v0[j], 0.f), b = fmaxf(v1[j], 0.f); v0[j] = a * a; v1[j] = b * b; } }
                    if (MODE == EM_CMP) {
#pragma unroll
                        for (int j = 0; j < 4; ++j) { v0[j] = v0[j] * sigmoidf_(v0[j]); v1[j] = v1[j] * sigmoidf_(v1[j]); } }
                    if (MODE == EM_NSA || MODE == EM_FOX || MODE == EM_SWA) { v0 = v0 * sc; v1 = v1 * sc; }
                    if ((MODE == EM_FOX || MODE == EM_NSA || MODE == EM_SWA) && hm) store8(hb[bj] + (((size_t)(row >> 11) * HG + hd[bj]) * T + (row & (T - 1))) * 64 + (cw & 63), v0, v1);
                    else store8(rowp + bj * HALF, v0, v1);
                }
            }
    }
};

template <class Epi, class Sched, int AMODE, bool ALIGN_EPI = false, bool SP2 = false>
__device__ __forceinline__ void gemm_phase(PG8_LAS unsigned char* lds, const Gemm g, const Sched& S, const Epi& E, int wave_id) {
    int tid_; { int x_; asm volatile("v_mbcnt_lo_u32_b32 %0, -1, 0\n\tv_mbcnt_hi_u32_b32 %0, -1, %0" : "=v"(x_)); tid_ = wave_id * 64 + x_; }
    const int tid = tid_, wid = __builtin_amdgcn_readfirstlane(tid >> 6), lane = tid & 63, wr = wid >> 2, wc = wid & 3, fr = lane & 15, fq = lane >> 4;
    const int K = g.K, nt = K / BK;
    unsigned voffA[2], voffB[2];
#pragma unroll
    for (int i = 0; i < 2; ++i) { int R, C; stage_rc(tid * 16 + i * 8192, R, C); const int Rb = Epi::PERM ? ((R & ~31) + perm32(R & 31)) : R;
        voffA[i] = (AMODE == 1) ? (unsigned)((16 * (R >> 2)) * CMP_LDP + (R & 3) * 64 + C) * 2u : (unsigned)(R * K + C) * 2u; voffB[i] = (unsigned)(Rb * K + C) * 2u; }
    const size_t kstepB = (size_t)(BK * 2);
    const size_t hstepB = (size_t)HALF * K * 2;
    const size_t tstepB = 2 * hstepB;
    const size_t kstepA = (AMODE == 1) ? (size_t)CMP_LDP * 2 : kstepB;
    const size_t hstepA = (AMODE == 1) ? (size_t)512 * CMP_LDP * 2 : hstepB;
    const size_t tstepA = 2 * hstepA;
    const size_t pnstepA = (AMODE == 1) ? (size_t)512 : (size_t)0;
    const unsigned ldsw = (unsigned)wid * 1024u;
    const int aoff = lds_byte(wr * 64 + fr, fq * 8), boff = lds_byte(wc * 32 + fr, fq * 8);
#define PG8_SA(b, h) (((b) * 2 + (h)) * HTB)
#define PG8_SB(b, h) ((4 + (b) * 2 + (h)) * HTB)
#define PG8_STAGE(bufoff, gbase, voff) do { _Pragma("unroll") for (int _i = 0; _i < 2; ++_i) \
        __builtin_amdgcn_global_load_lds((const unsigned*)((const char*)(gbase) + (voff)[_i]), (PG8_LAS unsigned*)(lds + (bufoff) + ldsw + _i * 8192), 16, 0, 0); } while (0)
#define PG8_LDA(dst, b, h) do { _Pragma("unroll") for (int m = 0; m < 4; ++m) _Pragma("unroll") for (int k = 0; k < 2; ++k) dst[m][k] = *(const PG8_LAS bf16x8*)(lds + PG8_SA(b, h) + aoff + m * 2048 + k * 1024); } while (0)
#define PG8_LDB(dst, b, h) do { _Pragma("unroll") for (int n = 0; n < 2; ++n) _Pragma("unroll") for (int k = 0; k < 2; ++k) dst[n][k] = *(const PG8_LAS bf16x8*)(lds + PG8_SB(b, h) + boff + n * 2048 + k * 1024); } while (0)
#define PG8_MMA(ai, bj, At, Bt) do { __builtin_amdgcn_s_setprio(1); _Pragma("unroll") for (int m = 0; m < 4; ++m) _Pragma("unroll") for (int n = 0; n < 2; ++n) _Pragma("unroll") for (int k = 0; k < 2; ++k) \
        acc[ai][bj][m][n] = __builtin_amdgcn_mfma_f32_16x16x32_bf16(Bt[n][k], At[m][k], acc[ai][bj][m][n], 0, 0, 0); __builtin_amdgcn_s_setprio(0); } while (0)
#define PG8_WAIT_V(n) asm volatile("s_waitcnt vmcnt(" #n ")" ::: "memory")
#define PG8_WAIT_L(n) asm volatile("s_waitcnt lgkmcnt(" #n ")" ::: "memory")
#define PG8_BAR __builtin_amdgcn_s_barrier()
#define PG8_SCHED __builtin_amdgcn_sched_barrier(0)
    Unit cur, nxt; int ui = 0;
    if (!S.next(0, cur)) return;
    f32x4 acc[2][2][4][2];
#pragma unroll
    for (int a = 0; a < 2; ++a)
#pragma unroll
        for (int b = 0; b < 2; ++b)
#pragma unroll
            for (int m = 0; m < 4; ++m)
#pragma unroll
                for (int n = 0; n < 2; ++n) acc[a][b][m][n] = (f32x4){0.f, 0.f, 0.f, 0.f};
    bf16x8 At[4][2], B0[2][2], B1[2][2];
    const char* cA = (const char*)g.A + (size_t)cur.pm * tstepA + (size_t)cur.pn * pnstepA; const char* cB = (const char*)g.Bt + (size_t)cur.pn * tstepB;
    S.a_ready(cur);
    if constexpr (SP2) {
        PG8_STAGE(PG8_SB(0, 0), cB, voffB); PG8_STAGE(PG8_SB(0, 1), cB + hstepB, voffB); PG8_STAGE(PG8_SA(0, 0), cA, voffA); PG8_STAGE(PG8_SA(0, 1), cA + hstepA, voffA);
        if (wr == 1) PG8_BAR;
        PG8_WAIT_V(2); PG8_BAR;
        PG8_STAGE(PG8_SB(1, 0), cB + kstepB, voffB); PG8_STAGE(PG8_SA(1, 0), cA + kstepA, voffA); PG8_STAGE(PG8_SB(1, 1), cB + hstepB + kstepB, voffB);
        PG8_WAIT_V(6); PG8_BAR;
    } else {
        PG8_STAGE(PG8_SB(0, 0), cB, voffB); PG8_STAGE(PG8_SA(0, 0), cA, voffA); PG8_STAGE(PG8_SB(0, 1), cB + hstepB, voffB); PG8_STAGE(PG8_SA(0, 1), cA + hstepA, voffA);
        if (wr == 1) PG8_BAR;
        PG8_WAIT_V(4); PG8_BAR;
        PG8_STAGE(PG8_SB(1, 0), cB + kstepB, voffB); PG8_STAGE(PG8_SA(1, 0), cA + kstepA, voffA); PG8_STAGE(PG8_SB(1, 1), cB + hstepB + kstepB, voffB);
        PG8_WAIT_V(6); PG8_BAR;
    }
    for (;;) {
        const bool has_next = S.next(ui + 1, nxt);
        const char* nA = has_next ? (const char*)g.A + (size_t)nxt.pm * tstepA + (size_t)nxt.pn * pnstepA : cA; const char* nB = has_next ? (const char*)g.Bt + (size_t)nxt.pn * tstepB : cB;
        for (int t = 0; t < nt; t += 2) {
            const bool last = (t == nt - 2);
            const char* a1 = cA + (size_t)(t + 1) * kstepA;
            const char* a2 = last ? nA : cA + (size_t)(t + 2) * kstepA; const char* b2 = last ? nB : cB + (size_t)(t + 2) * kstepB;
            const char* a3 = a2 + kstepA; const char* b3 = b2 + kstepB;
            if (last && has_next) S.a_ready(nxt);
            if constexpr (SP2) {
            PG8_LDB(B0, 0, 0); PG8_LDB(B1, 0, 1); PG8_SCHED; PG8_LDA(At, 0, 0); PG8_STAGE(PG8_SA(1, 1), a1 + hstepA, voffA);
            PG8_WAIT_V(8); PG8_WAIT_L(0); PG8_BAR; PG8_MMA(0, 0, At, B0); PG8_MMA(0, 1, At, B1); PG8_BAR; PG8_SCHED;
            PG8_LDA(At, 0, 1); PG8_STAGE(PG8_SB(0, 0), b2, voffB); PG8_STAGE(PG8_SB(0, 1), b2 + hstepB, voffB); PG8_STAGE(PG8_SA(0, 0), a2, voffA);
            PG8_WAIT_V(8); PG8_WAIT_L(0); PG8_BAR; PG8_MMA(1, 0, At, B0); PG8_MMA(1, 1, At, B1); PG8_BAR; PG8_SCHED;
            PG8_LDB(B0, 1, 0); PG8_LDB(B1, 1, 1); PG8_SCHED; PG8_LDA(At, 1, 0); PG8_STAGE(PG8_SA(0, 1), a2 + hstepA, voffA);
            PG8_WAIT_V(8); PG8_WAIT_L(0); PG8_BAR; PG8_MMA(0, 0, At, B0); PG8_MMA(0, 1, At, B1); PG8_BAR; PG8_SCHED;
            PG8_LDA(At, 1, 1); PG8_STAGE(PG8_SB(1, 0), b3, voffB); PG8_STAGE(PG8_SB(1, 1), b3 + hstepB, voffB); PG8_STAGE(PG8_SA(1, 0), a3, voffA);
            PG8_WAIT_V(8); PG8_WAIT_L(0); PG8_BAR; PG8_MMA(1, 0, At, B0); PG8_MMA(1, 1, At, B1); PG8_BAR; PG8_SCHED;
            } else {
            PG8_LDB(B0, 0, 0); PG8_SCHED; PG8_LDA(At, 0, 0); PG8_STAGE(PG8_SA(1, 1), a1 + hstepA, voffA);
            PG8_WAIT_L(8); PG8_BAR; PG8_WAIT_L(0); PG8_MMA(0, 0, At, B0); PG8_BAR; PG8_SCHED;
            PG8_LDB(B1, 0, 1); PG8_STAGE(PG8_SB(0, 0), b2, voffB);
            PG8_BAR; PG8_WAIT_L(0); PG8_MMA(0, 1, At, B1); PG8_BAR;
            PG8_LDA(At, 0, 1); PG8_STAGE(PG8_SA(0, 0), a2, voffA);
            PG8_BAR; PG8_WAIT_L(0); PG8_MMA(1, 0, At, B0); PG8_BAR; PG8_SCHED;
            PG8_STAGE(PG8_SB(0, 1), b2 + hstepB, voffB);
            PG8_WAIT_V(6); PG8_BAR; PG8_MMA(1, 1, At, B1); PG8_BAR;
            PG8_LDB(B0, 1, 0); PG8_SCHED; PG8_LDA(At, 1, 0); PG8_STAGE(PG8_SA(0, 1), a2 + hstepA, voffA);
            PG8_WAIT_L(8); PG8_BAR; PG8_WAIT_L(0); PG8_MMA(0, 0, At, B0); PG8_BAR; PG8_SCHED;
            PG8_LDB(B1, 1, 1); PG8_STAGE(PG8_SB(1, 0), b3, voffB);
            PG8_BAR; PG8_WAIT_L(0); PG8_MMA(0, 1, At, B1); PG8_BAR;
            PG8_LDA(At, 1, 1); PG8_STAGE(PG8_SA(1, 0), a3, voffA);
            PG8_BAR; PG8_WAIT_L(0); PG8_MMA(1, 0, At, B0); PG8_BAR; PG8_SCHED;
            PG8_STAGE(PG8_SB(1, 1), b3 + hstepB, voffB);
            PG8_WAIT_V(6); PG8_BAR; PG8_MMA(1, 1, At, B1); PG8_BAR;
            }
        }
        if constexpr (ALIGN_EPI) { if (wr == 0) PG8_BAR; }
        if constexpr (!Epi::AFTER_DRAIN) { E(acc, cur, wr, wc, fr, fq); S.done(cur); }
        if (!has_next) break;
#pragma unroll
        for (int a = 0; a < 2; ++a)
#pragma unroll
            for (int b = 0; b < 2; ++b)
#pragma unroll
                for (int m = 0; m < 4; ++m)
#pragma unroll
                    for (int n = 0; n < 2; ++n) acc[a][b][m][n] = (f32x4){0.f, 0.f, 0.f, 0.f};
        cur = nxt; cA = nA; cB = nB; ++ui;
        if constexpr (ALIGN_EPI) { if (wr == 1) PG8_BAR; }
    }
    PG8_WAIT_V(0);
    if constexpr (!ALIGN_EPI) { if (wr == 0) PG8_BAR; }
    PG8_BAR;
    if constexpr (Epi::AFTER_DRAIN) { E.fused(acc, cur, wr, wc, fr, fq, lds, wid, lane); S.done(cur); }
#undef PG8_SA
#undef PG8_SB
#undef PG8_STAGE
#undef PG8_LDA
#undef PG8_LDB
#undef PG8_MMA
#undef PG8_WAIT_V
#undef PG8_WAIT_L
#undef PG8_BAR
#undef PG8_SCHED
}
}

namespace att {
constexpr int SLOTB = 8192;
constexpr int NSLOT = 4;
constexpr int L_K = 0, L_V = 32768, L_WS = 65536, L_OST = 67584, L_PSUM = L_OST, L_IMP = 133120, L_KB = L_IMP, L_SEL = 141312, L_END = 141568;
constexpr float PFIX = 268435456.0f;
constexpr float THR = 8.0f;

__device__ __forceinline__ int crow(int r, int hh) { return (r & 3) + 8 * (r >> 2) + 4 * hh; }
typedef float f32x2_t __attribute__((ext_vector_type(2))); typedef __bf16 bf16x2_t __attribute__((ext_vector_type(2)));
__device__ __forceinline__ unsigned cvtpk_s(float lo, float hi) { f32x2_t v = {lo, hi}; bf16x2_t b = __builtin_convertvector(v, bf16x2_t); return __builtin_bit_cast(unsigned, b); }
typedef short v4i16_t __attribute__((ext_vector_type(4)));
__device__ __forceinline__ s16x4 vtr(const LAS unsigned char* p) { return __builtin_bit_cast(s16x4, __builtin_amdgcn_ds_read_tr16_b64_v4i16((LAS v4i16_t*)p)); }
__device__ __forceinline__ float swap_sum(float v) { auto rr = __builtin_amdgcn_permlane32_swap(__float_as_uint(v), __float_as_uint(v), false, false); return __uint_as_float(rr[0]) + __uint_as_float(rr[1]); }
__device__ __forceinline__ float swap_max(float v) { auto rr = __builtin_amdgcn_permlane32_swap(__float_as_uint(v), __float_as_uint(v), false, false); return fmaxf(__uint_as_float(rr[0]), __uint_as_float(rr[1])); }
__device__ __forceinline__ bool trailing_half(int wid) { asm volatile("" : "+s"(wid)); return (wid >> 2) != 0; }
#define ATT_BAR() do { __builtin_amdgcn_s_barrier(); asm volatile("" ::: "memory"); } while (0)

__device__ __forceinline__ void dma_tile(const bf16_t* Kb, const bf16_t* Vb, int pitch, int tile, LAS unsigned char* shm, int slot, int wid, int lane) {
    const bf16_t* ks = Kb + (size_t)(tile * 64 + lane) * pitch + wid * 8;
    const bf16_t* vs = Vb + (size_t)(tile * 64 + 16 * (wid & 3) + (lane >> 2)) * pitch + (wid >> 2) * 32 + (lane & 3) * 8;
    __builtin_amdgcn_global_load_lds((const unsigned*)ks, (LAS unsigned*)(shm + L_K + slot * SLOTB + wid * 1024), 16, 0, 0);
    __builtin_amdgcn_global_load_lds((const unsigned*)vs, (LAS unsigned*)(shm + L_V + slot * SLOTB + wid * 1024), 16, 0, 0);
#ifdef PROBE_DMA2
    __builtin_amdgcn_global_load_lds((const unsigned*)ks, (LAS unsigned*)(shm + L_K + slot * SLOTB + wid * 1024), 16, 0, 0);
    __builtin_amdgcn_global_load_lds((const unsigned*)vs, (LAS unsigned*)(shm + L_V + slot * SLOTB + wid * 1024), 16, 0, 0);
#endif
}
#ifdef PROBE_DMA2
#define VMW2 "4"
#define VMW4 "8"
#else
#define VMW2 "2"
#define VMW4 "4"
#endif
__device__ __forceinline__ void qkt(f32x16& p0, f32x16& p1, const LAS unsigned char* shm, int slot, const bf16x8 (&qr)[4], const f32x16& cinit, int r32, int hh) {
    const LAS unsigned char* kb = shm + L_K + slot * SLOTB + hh * 1024 + r32 * 16;
#pragma unroll
    for (int d0 = 0; d0 < 4; ++d0) {
        const bf16x8 b0 = *(const LAS bf16x8*)(kb + d0 * 2048), b1 = *(const LAS bf16x8*)(kb + d0 * 2048 + 512);
        if (d0 == 0) { p0 = __builtin_amdgcn_mfma_f32_32x32x16_bf16(b0, qr[0], cinit, 0, 0, 0); p1 = __builtin_amdgcn_mfma_f32_32x32x16_bf16(b1, qr[0], cinit, 0, 0, 0); }
        else { p0 = __builtin_amdgcn_mfma_f32_32x32x16_bf16(b0, qr[d0], p0, 0, 0, 0); p1 = __builtin_amdgcn_mfma_f32_32x32x16_bf16(b1, qr[d0], p1, 0, 0, 0); }
        if (d0 == 1) asm volatile("" ::: "memory");
    }
}
__device__ __forceinline__ void load_k(bf16x8 (&kf)[8], const LAS unsigned char* shm, int slot, int r32, int hh) {
    const LAS unsigned char* kb = shm + L_K + slot * SLOTB + hh * 1024 + r32 * 16;
#pragma unroll
    for (int d0 = 0; d0 < 4; ++d0) { kf[2 * d0] = *(const LAS bf16x8*)(kb + d0 * 2048); kf[2 * d0 + 1] = *(const LAS bf16x8*)(kb + d0 * 2048 + 512); }
}
__device__ __forceinline__ void mma_qk(f32x16& p0, f32x16& p1, const bf16x8 (&kf)[8], const bf16x8 (&qr)[4], const f32x16& cinit) {
    p0 = __builtin_amdgcn_mfma_f32_32x32x16_bf16(kf[0], qr[0], cinit, 0, 0, 0); p1 = __builtin_amdgcn_mfma_f32_32x32x16_bf16(kf[1], qr[0], cinit, 0, 0, 0);
#pragma unroll
    for (int d0 = 1; d0 < 4; ++d0) { p0 = __builtin_amdgcn_mfma_f32_32x32x16_bf16(kf[2 * d0], qr[d0], p0, 0, 0, 0); p1 = __builtin_amdgcn_mfma_f32_32x32x16_bf16(kf[2 * d0 + 1], qr[d0], p1, 0, 0, 0); }
}
__device__ __forceinline__ void load_v(bf16x8 (&vf)[8], const LAS unsigned char* shm, int slot, int lane, int hh) {
    const LAS unsigned char* vb = shm + L_V + slot * SLOTB + ((lane >> 4) & 1) * 32 + (lane & 3) * 8 + (4 * hh + ((lane & 15) >> 2)) * 64;
#pragma unroll
    for (int ks = 0; ks < 4; ++ks)
#pragma unroll
        for (int d0 = 0; d0 < 2; ++d0) {
            const s16x4 vl = vtr(vb + d0 * 4096 + ks * 1024), vh = vtr(vb + d0 * 4096 + ks * 1024 + 512);
            vf[2 * ks + d0] = (bf16x8){vl[0], vl[1], vl[2], vl[3], vh[0], vh[1], vh[2], vh[3]};
        }
}
__device__ __forceinline__ void mma_pv(f32x16 (&o)[2], const u32x4 (&pw)[4], const bf16x8 (&vf)[8]) {
#pragma unroll
    for (int ks = 0; ks < 4; ++ks)
#pragma unroll
        for (int d0 = 0; d0 < 2; ++d0) o[d0] = __builtin_amdgcn_mfma_f32_32x32x16_bf16(__builtin_bit_cast(bf16x8, pw[ks]), vf[2 * ks + d0], o[d0], 0, 0, 0);
}
__device__ __forceinline__ void pv_seq(f32x16 (&o)[2], const u32x4 (&pw)[4], const LAS unsigned char* shm, int slot, int lane, int hh) {
    const LAS unsigned char* vb = shm + L_V + slot * SLOTB + ((lane >> 4) & 1) * 32 + (lane & 3) * 8 + (4 * hh + ((lane & 15) >> 2)) * 64;
#pragma unroll
    for (int ks = 0; ks < 4; ++ks) {
#pragma unroll
        for (int d0 = 0; d0 < 2; ++d0) {
            const s16x4 vl = vtr(vb + d0 * 4096 + ks * 1024), vh = vtr(vb + d0 * 4096 + ks * 1024 + 512);
            const bf16x8 vf = {vl[0], vl[1], vl[2], vl[3], vh[0], vh[1], vh[2], vh[3]};
            o[d0] = __builtin_amdgcn_mfma_f32_32x32x16_bf16(__builtin_bit_cast(bf16x8, pw[ks]), vf, o[d0], 0, 0, 0);
        }
        if (ks == 1) asm volatile("" ::: "memory");
    }
}
__device__ __forceinline__ void range_mask(f32x16& p0, f32x16& p1, int kb, int lo, int hi) {
#pragma unroll
    for (int r = 0; r < 16; ++r) { const int k = kb + (r & 3) + 8 * (r >> 2); if (k < lo || k > hi) p0[r] = -INFINITY; if (k + 32 < lo || k + 32 > hi) p1[r] = -INFINITY; }
}
__device__ __forceinline__ void rescale_o(f32x16 (&o)[2], const LAS float* wsf, int hh) {
#pragma unroll
    for (int g = 0; g < 4; ++g) { const f32x4 a4 = *(const LAS f32x4*)(wsf + 8 * g + 4 * hh);
#pragma unroll
        for (int j = 0; j < 4; ++j) { o[0][4 * g + j] *= a4[j]; o[1][4 * g + j] *= a4[j]; } }
}

__device__ __forceinline__ float max3f(float a, float b, float c) { float r; asm("v_max3_f32 %0, %1, %2, %3" : "=v"(r) : "v"(a), "v"(b), "v"(c)); return r; }
template <int MODE, bool NOMAX, bool LEAN = false>
__device__ __forceinline__ void sweep(f32x16 (&o)[2], float& mhat, float& l, const bf16x8 (&qr)[4], const bf16_t* Kb, const bf16_t* Vb, int pitch, int t0, int NT, int lo, int hi,
                                      unsigned rowsel, LAS unsigned char* shm, int& ring, int wid, int lane) {
    static_assert(!(MODE == 1 && NOMAX), "the FoX key bias grows without bound: it needs the running max");
    asm volatile("" : "+v"(lane));
    const int r32 = lane & 31, hh = lane >> 5;
    LAS float* wsf = (LAS float*)(shm + L_WS + wid * 256);
    const int lo_max = __builtin_amdgcn_readlane(lo, 31), hi_min = __builtin_amdgcn_readfirstlane(hi);
#define RING_NEXT(x) (((x) + 1) & (NSLOT - 1))
    int s_pv = ring, s_qk = ring, s_dma = ring;
    dma_tile(Kb, Vb, pitch, t0, shm, s_dma, wid, lane); s_dma = RING_NEXT(s_dma);
    if (NT > 1) { dma_tile(Kb, Vb, pitch, t0 + 1, shm, s_dma, wid, lane); s_dma = RING_NEXT(s_dma); }
    if (NT > 2) { dma_tile(Kb, Vb, pitch, t0 + 2, shm, s_dma, wid, lane); s_dma = RING_NEXT(s_dma); }
    if (NT > 2) asm volatile("s_waitcnt vmcnt(4)" ::: "memory"); else if (NT > 1) asm volatile("s_waitcnt vmcnt(2)" ::: "memory"); else asm volatile("s_waitcnt vmcnt(0)" ::: "memory");
    ATT_BAR();
    if (trailing_half(wid)) ATT_BAR();
    f32x16 s0, s1, cini; u32x4 pw[4]; float alpha = 1.0f;
#pragma unroll
    for (int r = 0; r < 16; ++r) cini[r] = 0.f;
    if (MODE == 2) { const float c0 = ((rowsel >> t0) & 1u) ? 0.f : -INFINITY;
#pragma unroll
        for (int r = 0; r < 16; ++r) cini[r] = c0; }
    bf16x8 kf[8], vf[8];
    if (LEAN) qkt(s0, s1, shm, s_qk, qr, cini, r32, hh);
    else { load_k(kf, shm, s_qk, r32, hh); mma_qk(s0, s1, kf, qr, cini); }
    s_qk = RING_NEXT(s_qk);
    for (int j = 0;; ++j) {
        asm volatile("s_waitcnt lgkmcnt(0)" ::: "memory");
        if (trailing_half(wid)) { if (j + 2 < NT) asm volatile("s_waitcnt vmcnt(2)" ::: "memory"); else asm volatile("s_waitcnt vmcnt(0)" ::: "memory"); }
        ATT_BAR();
        if (trailing_half(wid) && j + 3 < NT) { dma_tile(Kb, Vb, pitch, t0 + j + 3, shm, s_dma, wid, lane); }
        {
            const int tile = t0 + j;
            if (MODE == 1) { const LAS float* kb = (const LAS float*)(shm + L_KB) + tile * 64 + 4 * hh;
#pragma unroll
                for (int k = 0; k < 4; ++k) { const f32x4 b0 = *(const LAS f32x4*)(kb + 8 * k), b1 = *(const LAS f32x4*)(kb + 32 + 8 * k);
#pragma unroll
                    for (int e = 0; e < 4; ++e) { s0[4 * k + e] += b0[e]; s1[4 * k + e] += b1[e]; } } }
            if (tile * 64 < lo_max || tile * 64 + 63 > hi_min) range_mask(s0, s1, tile * 64 + 4 * hh, lo, hi);
            if (!NOMAX) {
                float ra = max3f(s0[0], s0[1], s1[0]), rb = max3f(s0[2], s0[3], s1[1]); ra = max3f(ra, s1[2], s1[3]);
#pragma unroll
                for (int r = 4; r < 16; r += 4) { ra = max3f(ra, s0[r], s0[r + 1]); rb = max3f(rb, s0[r + 2], s0[r + 3]); ra = max3f(ra, s1[r], s1[r + 1]); rb = max3f(rb, s1[r + 2], s1[r + 3]); }
                float rm = swap_max(fmaxf(ra, rb));
                const bool first = (j == 0);
                alpha = 1.0f;
                if (first || __any(rm > THR)) {
                    float dl = first ? rm : fmaxf(rm, 0.f); if (dl == -INFINITY) dl = 0.f;
                    mhat += dl;
#pragma unroll
                    for (int r = 0; r < 16; ++r) { s0[r] -= dl; s1[r] -= dl; cini[r] = -mhat; }
                    if (!first) { alpha = __builtin_amdgcn_exp2f(-dl); l *= alpha; }
                }
                if (hh == 0) wsf[r32] = alpha;
            }
            float ls0 = 0.f, ls1 = 0.f;
#pragma unroll
            for (int r = 0; r < 16; ++r) { s0[r] = __builtin_amdgcn_exp2f(s0[r]); s1[r] = __builtin_amdgcn_exp2f(s1[r]); ls0 += s0[r]; ls1 += s1[r]; }
            l += ls0 + ls1;
#pragma unroll
            for (int e = 0; e < 4; ++e) { pw[0][e] = cvtpk_s(s0[2 * e], s0[2 * e + 1]); pw[1][e] = cvtpk_s(s0[8 + 2 * e], s0[9 + 2 * e]); pw[2][e] = cvtpk_s(s1[2 * e], s1[2 * e + 1]); pw[3][e] = cvtpk_s(s1[8 + 2 * e], s1[9 + 2 * e]); }
            if (MODE == 2) { const float c1 = ((rowsel >> (tile + 1)) & 1u) ? 0.f : -INFINITY;
#pragma unroll
                for (int r = 0; r < 16; ++r) cini[r] = c1; }
        }
        if (!trailing_half(wid)) { if (j + 2 < NT) asm volatile("s_waitcnt vmcnt(2)" ::: "memory"); else asm volatile("s_waitcnt vmcnt(0)" ::: "memory"); }
        ATT_BAR();
        if (j + 1 >= NT) break;
        if (!trailing_half(wid) && j + 3 < NT) { dma_tile(Kb, Vb, pitch, t0 + j + 3, shm, s_dma, wid, lane); }
        s_dma = RING_NEXT(s_dma);
        if (LEAN) {
            if (!NOMAX) rescale_o(o, wsf, hh);
            pv_seq(o, pw, shm, s_pv, lane, hh);
            qkt(s0, s1, shm, s_qk, qr, cini, r32, hh);
        } else {
            load_v(vf, shm, s_pv, lane, hh);
            load_k(kf, shm, s_qk, r32, hh);
            __builtin_amdgcn_sched_barrier(0);
            if (!NOMAX) rescale_o(o, wsf, hh);
            mma_pv(o, pw, vf);
            __builtin_amdgcn_sched_barrier(0);
            mma_qk(s0, s1, kf, qr, cini);
        }
        s_pv = RING_NEXT(s_pv); s_qk = RING_NEXT(s_qk);
    }
    if (!NOMAX) rescale_o(o, wsf, hh);
    if (LEAN) pv_seq(o, pw, shm, s_pv, lane, hh); else { load_v(vf, shm, s_pv, lane, hh); mma_pv(o, pw, vf); }
    asm volatile("s_waitcnt lgkmcnt(0)" ::: "memory");
    if (!trailing_half(wid)) ATT_BAR();
    ring = s_qk;
#undef RING_NEXT
}
template <bool FIRST>
__device__ __forceinline__ void merge(const f32x16 (&o)[2], float scale, LAS unsigned char* shm, int wid, int r32, int hh) {
    LAS float* wsf = (LAS float*)(shm + L_WS + wid * 256);
    LAS float* stg = (LAS float*)(shm + L_OST + wid * 8192) + r32;
    if (hh == 0) wsf[r32] = scale;
#pragma unroll
    for (int g = 0; g < 4; ++g) { const f32x4 s4 = *(const LAS f32x4*)(wsf + 8 * g + 4 * hh);
#pragma unroll
        for (int j = 0; j < 4; ++j) { LAS float* p = stg + (8 * g + 4 * hh + j) * 64;
            if (FIRST) { p[0] = o[0][4 * g + j] * s4[j]; p[32] = o[1][4 * g + j] * s4[j]; }
            else { p[0] += o[0][4 * g + j] * s4[j]; p[32] += o[1][4 * g + j] * s4[j]; } } }
}
__device__ __forceinline__ void store_o(bf16_t* Ow, LAS unsigned char* shm, int wid, int lane) {
    const LAS float* stg = (const LAS float*)(shm + L_OST + wid * 8192);
#pragma unroll
    for (int i = 0; i < 4; ++i) { const int rowl = i * 8 + (lane >> 3), ch = lane & 7; const f32x4 a = *(const LAS f32x4*)(stg + rowl * 64 + ch * 8), c = *(const LAS f32x4*)(stg + rowl * 64 + ch * 8 + 4);
        u32x4 v; v.x = cvtpk_s(a[0], a[1]); v.y = cvtpk_s(a[2], a[3]); v.z = cvtpk_s(c[0], c[1]); v.w = cvtpk_s(c[2], c[3]); *(GAS u32x4*)(Ow + (size_t)rowl * D + ch * 8) = v; }
}
__device__ __forceinline__ void zero_o(f32x16 (&o)[2]) { o[0] = (f32x16){0.f, 0.f, 0.f, 0.f, 0.f, 0.f, 0.f, 0.f, 0.f, 0.f, 0.f, 0.f, 0.f, 0.f, 0.f, 0.f}; o[1] = o[0]; }
#define ATT_LOADQ(Qrow_) bf16x8 qr[4]; _Pragma("unroll") for (int d0 = 0; d0 < 4; ++d0) qr[d0] = *(const GAS bf16x8*)((Qrow_) + d0 * 16 + hh * 8)

__device__ __forceinline__ void fox_unit(LAS unsigned char* shm, int b, int h, int qb, unsigned char* ws_, size_t off_p, size_t off_cb, size_t off_o, int wid, int& ring) {
    const int lane = lane_id_volatile();
    unsigned char* ws = ws_; asm volatile("" : "+s"(ws)); const bf16_t* P = (const bf16_t*)(ws + off_p); const float* CB = (const float*)(ws + off_cb); bf16_t* O = (bf16_t*)(ws + off_o);
    const int r32 = lane & 31, hh = lane >> 5;
    const int pos = 256 * qb + 32 * wid + r32;
    const size_t row = (size_t)b * T + pos;
    ATT_LOADQ(P + row * FOX_LDP + h * 64);
    const bf16_t* Kb = (const bf16_t*)(ws + off_p + FOX_HM_OFF) + (size_t)(b * NH + h) * T * 64; const bf16_t* Vb = Kb + FOX_HM_STRIDE;
    f32x16 o[2]; zero_o(o); float m = 0.f, l = 0.f;
    { const float* cb = CB + (size_t)(b * NH + h) * T; LAS float* kbl = (LAS float*)(shm + L_KB);
      for (int i = wid * 64 + lane; i < 64 * (4 * qb + 4); i += 512) kbl[i] = cb[i]; }
    sweep<1, false>(o, m, l, qr, Kb, Vb, 64, 0, 4 * qb + 4, 0, pos, 0u, shm, ring, wid, lane);
    const float lt = swap_sum(l); const float inv = lt > 0.f ? 1.0f / lt : 0.f;
    merge<true>(o, inv, shm, wid, r32, hh);
    store_o(O + ((size_t)b * T + 256 * qb + 32 * wid) * D + h * 64, shm, wid, lane);
}
__device__ __forceinline__ void swa_unit(LAS unsigned char* shm, int b, int g, int qt, unsigned char* ws_, size_t off_p, size_t off_o, const float* sinks, int wid, int& ring) {
    const int lane = lane_id_volatile();
    unsigned char* ws = ws_; asm volatile("" : "+s"(ws)); const bf16_t* P = (const bf16_t*)(ws + off_p); bf16_t* O = (bf16_t*)(ws + off_o);
    const int r32 = lane & 31, hh = lane >> 5;
    const int q0 = 32 * qt, pos = q0 + r32, head = 8 * g + wid;
    const size_t row = (size_t)b * T + pos;
    ATT_LOADQ(P + row * SWA_LDP + head * 64);
    const bf16_t* Kb = (const bf16_t*)(ws + off_p + SWA_HM_OFF) + (size_t)(b * 2 + g) * T * 64; const bf16_t* Vb = Kb + SWA_HM_STRIDE;
    f32x16 o[2]; zero_o(o); float m = 0.f, l = 0.f;
    const int tlo = (q0 - 127) > 0 ? ((q0 - 127) >> 6) : 0, thi = (q0 + 31) >> 6;
    sweep<0, true, true>(o, m, l, qr, Kb, Vb, 64, tlo, thi - tlo + 1, pos - 127, pos, 0u, shm, ring, wid, lane);
    const float lt = swap_sum(l) + __builtin_amdgcn_exp2f(sinks[head] * LOG2E - m);
    const float inv = 1.0f / lt;
    merge<true>(o, inv, shm, wid, r32, hh);
    store_o(O + ((size_t)b * T + q0) * D + head * 64, shm, wid, lane);
}
__device__ __forceinline__ void nsa_unit(LAS unsigned char* shm, int b, int g, int qt, unsigned char* ws_, size_t off_p, size_t off_g, size_t off_kc, size_t off_vc, size_t off_o, int wid, int& ring) {
#define NSA_WS() unsigned char* ws = ws_; asm volatile("" : "+s"(ws)); const bf16_t* P = (const bf16_t*)(ws + off_p); const float* G = (const float*)(ws + off_g); const bf16_t* Hb = (const bf16_t*)(ws + off_p + NSA_HM_OFF) + (size_t)(b * 4 + g) * T * 64; (void)G; (void)Hb
    const int hq = 4 * g + (wid >> 1), ph = wid & 1, q0 = 64 * qt;
    LAS unsigned* PSUM = (LAS unsigned*)(shm + L_PSUM); LAS float* IMP = (LAS float*)(shm + L_IMP); LAS unsigned* SEL = (LAS unsigned*)(shm + L_SEL);
#define NSA_LANE() const int lane = lane_id_volatile(); const int r32 = lane & 31, hh = lane >> 5; const int pos = q0 + 32 * ph + r32; const size_t row = (size_t)b * T + pos; (void)hh; (void)row
#define NSA_QROW (P + row * NSA_LDP + hq * 64)
    asm volatile("s_waitcnt lgkmcnt(0)" ::: "memory"); ATT_BAR();
    { const int tid = wid * 64 + lane_id_volatile(); for (int i = tid; i < 8192; i += 512) PSUM[i] = 0u; }
    f32x16 ocmp[2]; float inv_cmp;
    {
        NSA_LANE(); NSA_WS();
        const bf16_t* Kb = (const bf16_t*)(ws + off_kc) + (size_t)(b * 4 + g) * NCP * 64; const bf16_t* Vb = (const bf16_t*)(ws + off_vc) + (size_t)(b * 4 + g) * NCP * 64;
        const int cm = (pos < 31) ? -1 : (((pos - 31) >> 4) < 126 ? ((pos - 31) >> 4) : 126);
        const int ntile = qt >= 16 ? 2 : 1;
        ATT_LOADQ(NSA_QROW);
        f32x16 o[2]; zero_o(o); float m = 0.f, l = 0.f;
        const int ring0 = ring;
        sweep<0, true>(o, m, l, qr, Kb, Vb, 64, 0, ntile, 0, cm, 0u, shm, ring, wid, lane);
        const float lt = swap_sum(l); const float inv = lt > 0.f ? 1.0f / lt : 0.f;
        f32x16 negm;
#pragma unroll
        for (int r = 0; r < 16; ++r) negm[r] = -m;
        for (int tile = 0; tile < ntile; ++tile) {
            const int sl = (ring0 + tile) & (NSLOT - 1);
            f32x16 p0, p1; qkt(p0, p1, shm, sl, qr, negm, r32, hh);
            range_mask(p0, p1, tile * 64 + 4 * hh, 0, cm);
            LAS unsigned* pb = PSUM + (tile * 64 + 4 * hh) * 64 + 32 * ph + r32;
            asm volatile("" : "+v"(pb));
#pragma unroll
            for (int r = 0; r < 16; ++r) {
                const float a = __builtin_amdgcn_exp2f(p0[r]) * inv, c = __builtin_amdgcn_exp2f(p1[r]) * inv;
                __hip_atomic_fetch_add(pb + ((r & 3) + 8 * (r >> 2)) * 64, (unsigned)(a * PFIX + 0.5f), __ATOMIC_RELAXED, __HIP_MEMORY_SCOPE_WORKGROUP);
                __hip_atomic_fetch_add(pb + ((r & 3) + 8 * (r >> 2) + 32) * 64, (unsigned)(c * PFIX + 0.5f), __ATOMIC_RELAXED, __HIP_MEMORY_SCOPE_WORKGROUP);
            }
        }
        ocmp[0] = o[0]; ocmp[1] = o[1]; inv_cmp = inv;
    }
    asm volatile("s_waitcnt lgkmcnt(0)" ::: "memory"); ATT_BAR();
    {
        const int tid = wid * 64 + lane_id_volatile();
        const int rw = tid & 63, ng = tid >> 6;
        LAS unsigned* pb = PSUM + (16 * ng - 1) * 64 + rw;
        LAS float* ib = IMP + (4 * ng) * 64 + rw;
        asm volatile("" : "+v"(pb), "+v"(ib));
        float pc[17];
#pragma unroll
        for (int e = 0; e < 17; ++e) pc[e] = (float)pb[e * 64] * (1.0f / PFIX);
        if (ng == 0) pc[0] = 0.f;
#pragma unroll
        for (int k = 0; k < 4; ++k) ib[k * 64] = pc[4 * k + 1] + pc[4 * k + 2] + pc[4 * k + 3] + 0.5f * (pc[4 * k + 4] + pc[4 * k]);
        const unsigned init = qt < 16 ? ((2u << qt) - 1u) : (1u | (1u << qt) | (1u << (qt - 1)));
        if (tid < 64) SEL[tid] = init;
    }
    asm volatile("s_waitcnt lgkmcnt(0)" ::: "memory"); ATT_BAR();
    if (qt >= 16) {
        const int tid = wid * 64 + lane_id_volatile();
        const int rw = tid & 63, ng = tid >> 6; unsigned bits = 0u;
        LAS float* ib = IMP + rw; asm volatile("" : "+v"(ib));
        float v[4]; int cnt[4] = {0, 0, 0, 0};
#pragma unroll
        for (int k = 0; k < 4; ++k) v[k] = ib[(4 * ng + k) * 64];
        for (int n2 = 1; n2 <= qt - 2; ++n2) { const float v2 = ib[n2 * 64];
#pragma unroll
            for (int k = 0; k < 4; ++k) cnt[k] += (v2 > v[k] || (v2 == v[k] && n2 < 4 * ng + k)) ? 1 : 0; }
#pragma unroll
        for (int k = 0; k < 4; ++k) { const int n = 4 * ng + k; if (n >= 1 && n <= qt - 2 && cnt[k] < 13) bits |= 1u << n; }
        if (bits) __hip_atomic_fetch_or(SEL + rw, bits, __ATOMIC_RELAXED, __HIP_MEMORY_SCOPE_WORKGROUP);
    }
    asm volatile("s_waitcnt lgkmcnt(0)" ::: "memory"); ATT_BAR();
    { NSA_LANE(); NSA_WS(); merge<true>(ocmp, G[row * 48 + hq * 3 + 0] * inv_cmp, shm, wid, r32, hh); }
    {
        NSA_LANE(); NSA_WS();
        const unsigned rowsel = SEL[32 * ph + r32];
        ATT_LOADQ(NSA_QROW);
        f32x16 o[2]; zero_o(o); float m = 0.f, l = 0.f;
        sweep<2, true>(o, m, l, qr, Hb, Hb + NSA_HM_STRIDE, 64, 0, qt + 1, 0, pos, rowsel, shm, ring, wid, lane);
        const float lt = swap_sum(l); const float inv = lt > 0.f ? 1.0f / lt : 0.f;
        merge<false>(o, G[row * 48 + hq * 3 + 1] * inv, shm, wid, r32, hh);
    }
    {
        NSA_LANE(); NSA_WS();
        ATT_LOADQ(NSA_QROW);
        f32x16 o[2]; zero_o(o); float m = 0.f, l = 0.f;
        const int tlo = qt > 8 ? qt - 8 : 0;
        sweep<0, true>(o, m, l, qr, Hb + 2 * NSA_HM_STRIDE, Hb + 3 * NSA_HM_STRIDE, 64, tlo, qt - tlo + 1, pos - 511, pos, 0u, shm, ring, wid, lane);
        const float lt = swap_sum(l); const float inv = lt > 0.f ? 1.0f / lt : 0.f;
        merge<false>(o, G[row * 48 + hq * 3 + 2] * inv, shm, wid, r32, hh);
    }
    { unsigned char* ws = ws_; asm volatile("" : "+s"(ws)); store_o((bf16_t*)(ws + off_o) + ((size_t)b * T + q0 + 32 * ph) * D + hq * 64, shm, wid, lane_id_volatile()); }
#undef NSA_WS
#undef NSA_LANE
#undef NSA_QROW
}
#undef ATT_LOADQ
#undef ATT_BAR
}

constexpr size_t MiB = 1u << 20;
constexpr size_t WS_CTL = 0, CTL_ZERO_BYTES = 1 * MiB;
constexpr size_t WS_WUP = 1 * MiB, WS_WDN = 33 * MiB;
constexpr size_t WS_WNSA = 65 * MiB, WNSA_STRIDE = (size_t)NSA_NP * D * 2;
constexpr size_t WS_WOUT = 76 * MiB;
constexpr size_t WS_WFOX = 84 * MiB;
constexpr size_t WS_WSWA = 84 * MiB + 6656 * 1024;
constexpr size_t WS_WCMP = 93 * MiB;
constexpr size_t WS_ROPEC = 97 * MiB, WS_ROPES = WS_ROPEC + 256 * 1024;
constexpr size_t WS_CMPB = WS_ROPES + 256 * 1024;
constexpr size_t WS_SWAB = WS_CMPB + 64 * 1024;
constexpr size_t WS_RSTD = 98 * MiB;
constexpr size_t WS_XN = 100 * MiB;
constexpr size_t WS_BIG = 164 * MiB;
constexpr size_t WS_O = WS_BIG + 192 * MiB;
constexpr size_t WS_G = 420 * MiB, WS_LF = 426 * MiB, WS_CB = 428 * MiB, WS_KC = 430 * MiB, WS_VC = 431 * MiB, WS_HID = 432 * MiB, WS_M2 = 440 * MiB, WS_END = 504 * MiB;
static_assert(WS_WSWA + (size_t)SWA_NP * D * 2 <= WS_WCMP && WS_WFOX + (size_t)FOX_NP * D * 2 <= WS_WSWA && WS_WNSA + 2 * WNSA_STRIDE <= WS_WOUT && WS_SWAB + 8192 <= WS_XN, "d_ws map");
static_assert((size_t)M * FF * 2 == 256 * MiB && WS_O + (size_t)M * D * 2 == WS_G && (size_t)M * 3072 * 2 == 192 * MiB, "d_ws map");
constexpr int CW_TMO = 0, CW_BAR = 4096;

constexpr int RING_OFF = 0, RING_BYTES = 142336;
constexpr int LDSCTL_OFF = RING_BYTES, MISC_OFF = LDSCTL_OFF + 320;
constexpr int LDS_BYTES = 147456;
static_assert(att::L_END <= RING_BYTES && MISC_OFF + 128 <= LDS_BYTES, "LDS map");
constexpr int NWAVES = 8;
#ifndef L_LO
#define L_LO 0
#endif
#ifndef L_HI
#define L_HI DEPTH
#endif

typedef GAS unsigned gu32;
typedef GAS unsigned long long gu64;
#define RLX_AGENT __ATOMIC_RELAXED, __HIP_MEMORY_SCOPE_AGENT
#define LDS_WAIT() asm volatile("s_waitcnt lgkmcnt(0)" ::: "memory")
#define VM_WAIT() asm volatile("s_waitcnt vmcnt(0)" ::: "memory")
__device__ __forceinline__ unsigned long long rt() { return __builtin_amdgcn_s_memrealtime(); }
__device__ __forceinline__ unsigned f2bf(float f) { unsigned u = __builtin_bit_cast(unsigned, f); return (u + 0x7fffu + ((u >> 16) & 1u)) >> 16; }
__device__ __forceinline__ unsigned pk2(float lo, float hi) { return f2bf(lo) | (f2bf(hi) << 16); }

#define XB_TMO      128
#define XB_XCNT(j)  (256  + 64 * (j))
#define XB_XSUB(j)  (1280 + 64 * (j))
#define XB_XGEN(j)  (2304 + 64 * (j))
#define XB_TOP      3328
#define XB_TOPGEN   3392
#define XCD_BAR_WORDS 3456
#define XB_SPIN_CAP (1u << 18)

__device__ __forceinline__ unsigned xb_ld(unsigned* p)              { return __hip_atomic_load(p, __ATOMIC_RELAXED, __HIP_MEMORY_SCOPE_AGENT); }
__device__ __forceinline__ unsigned xb_add(unsigned* p, unsigned v) { return __hip_atomic_fetch_add(p, v, __ATOMIC_RELAXED, __HIP_MEMORY_SCOPE_AGENT); }
__device__ __forceinline__ unsigned xb_xcc_id() { return (unsigned)__builtin_amdgcn_s_getreg((3 << 11) | 20) & 0xFu; }
#define XB_SPIN(cond, bar) do { unsigned _sp = 0; while (cond) { __builtin_amdgcn_s_sleep(1); \
    if ((++_sp & 255u) == 0u) { if (xb_ld(&(bar)[XB_TMO])) break; if (_sp > XB_SPIN_CAP) { atomicAdd(&(bar)[XB_TMO], 1u); break; } } } } while (0)

struct XcdBarrier {
    unsigned* bar; unsigned x;
    volatile LAS unsigned* st;
};

__device__ __forceinline__ XcdBarrier xcd_barrier_post(unsigned* bar, volatile LAS unsigned* st) {
    XcdBarrier b; b.bar = bar; b.x = xb_xcc_id(); b.st = st;
    if (threadIdx.x == 0) (void)xb_add(&bar[XB_XCNT(b.x)], 1u);
    return b;
}
__device__ __forceinline__ void xcd_barrier_complete(unsigned* bar, unsigned x, unsigned& nloc, unsigned& nx) {
    const unsigned G = gridDim.x * gridDim.y * gridDim.z;
    unsigned sum, cnt, mine, sp = 0u;
    for (;;) {
        sum = 0u; cnt = 0u; mine = 0u;
#pragma unroll
        for (unsigned j = 0; j < 16; ++j) { const unsigned c = xb_ld(&bar[XB_XCNT(j)]); sum += c; cnt += (c > 0u) ? 1u : 0u; mine = (j == x) ? c : mine; }
        if (sum == G) break;
        __builtin_amdgcn_s_sleep(1);
        if ((++sp & 255u) == 0u) { if (xb_ld(&bar[XB_TMO])) break; if (sp > XB_SPIN_CAP) { atomicAdd(&bar[XB_TMO], 1u); break; } }
    }
    nloc = mine > 0u ? mine : 1u; nx = cnt > 0u ? cnt : 1u;
}

__device__ __forceinline__ void xcd_barrier(const XcdBarrier& b) {
    asm volatile("s_waitcnt vmcnt(0)" ::: "memory");
    __syncthreads();
    if (threadIdx.x == 0) {
        unsigned* bar = b.bar;
        __builtin_amdgcn_s_waitcnt(0);
        unsigned nloc = b.st[0], nx = b.st[1];
        if (nloc == 0u) { xcd_barrier_complete(bar, b.x, nloc, nx); b.st[0] = nloc; b.st[1] = nx; }
        const unsigned old = xb_add(&bar[XB_XSUB(b.x)], 1u);
        const unsigned gen = old / nloc;
        if (old + 1u == (gen + 1u) * nloc) {
            __builtin_amdgcn_fence(__ATOMIC_RELEASE, "agent");
            asm volatile("s_waitcnt vmcnt(0)" ::: "memory");
            const unsigned og = xb_add(&bar[XB_TOP], 1u);
            const unsigned tg = og / nx;
            if (og + 1u == (tg + 1u) * nx) xb_add(&bar[XB_TOPGEN], 1u);
            else XB_SPIN(xb_ld(&bar[XB_TOPGEN]) == tg, bar);
            __builtin_amdgcn_fence(__ATOMIC_ACQUIRE, "agent");
            xb_add(&bar[XB_XGEN(b.x)], 1u);
            asm volatile("s_waitcnt vmcnt(0)" ::: "memory");
        } else {
            XB_SPIN(xb_ld(&bar[XB_XGEN(b.x)]) == gen, bar);
            __builtin_amdgcn_fence(__ATOMIC_ACQUIRE, "agent");
            asm volatile("s_waitcnt vmcnt(0)" ::: "memory");
        }
    }
    __syncthreads();
}

__device__ __forceinline__ float wave_sum(float v) {
    v += __builtin_bit_cast(float, __builtin_amdgcn_update_dpp(0, __builtin_bit_cast(int, v), 0xB1, 0xF, 0xF, true));
    v += __builtin_bit_cast(float, __builtin_amdgcn_update_dpp(0, __builtin_bit_cast(int, v), 0x4E, 0xF, 0xF, true));
    v += __builtin_bit_cast(float, __builtin_amdgcn_update_dpp(0, __builtin_bit_cast(int, v), 0x141, 0xF, 0xF, true));
    v += __builtin_bit_cast(float, __builtin_amdgcn_update_dpp(0, __builtin_bit_cast(int, v), 0x140, 0xF, 0xF, true));
    v += __builtin_bit_cast(float, __builtin_amdgcn_ds_swizzle(__builtin_bit_cast(int, v), 0x401F));
    { auto rr = __builtin_amdgcn_permlane32_swap(__float_as_uint(v), __float_as_uint(v), false, false); v = __uint_as_float(rr[0]) + __uint_as_float(rr[1]); }
    return v;
}

__device__ __forceinline__ int il64(int c) { return (c >> 1) + 32 * (c & 1); }
__device__ __forceinline__ int src_n(int mode, int n) {
    if (mode == 1) { if (n >= NSA_N) return -1; const int reg = n >> 8; const bool rope = reg < 4 || reg == 4 || reg == 6 || reg == 8; return rope ? (n & ~63) + il64(n & 63) : n; }
    if (mode == 2) return n < FOX_N ? n : -1;
    if (mode == 3) return n < 1152 ? (n & ~63) + il64(n & 63) : n;
    return n;
}
__device__ __forceinline__ void conv_item(const float* W, int K, int N, bf16_t* WT, int NP, int mode, int item, LAS float* scr, int lane) {
    const int nblk = NP / 32, kb = item / nblk, nb = item % nblk, k0 = 64 * kb, n0 = 32 * nb;
    const int sn = src_n(mode, n0 + (lane & 31));
#pragma unroll 8
    for (int i = 0; i < 32; ++i) { const int kk = 2 * i + (lane >> 5); const int sk = (mode == 4) ? il64(kk) : kk;
        scr[kk * 33 + (lane & 31)] = sn >= 0 ? W[(size_t)(k0 + sk) * N + sn] : 0.f; }
    LDS_WAIT(); asm volatile("" ::: "memory");
    const int c = lane & 7;
#pragma unroll
    for (int j = 0; j < 4; ++j) { const int n = (lane >> 3) + 8 * j; const LAS float* s = scr + (8 * c) * 33 + n;
        u32x4 o; o.x = pk2(s[0 * 33], s[1 * 33]); o.y = pk2(s[2 * 33], s[3 * 33]); o.z = pk2(s[4 * 33], s[5 * 33]); o.w = pk2(s[6 * 33], s[7 * 33]);
        *(GAS u32x4*)(WT + (size_t)(n0 + n) * K + k0 + 8 * c) = o; }
    LDS_WAIT(); asm volatile("" ::: "memory");
}
__device__ __forceinline__ void norm_row(const float* xrow, const float* g, bf16_t* orow, float* rstd_out, int lane) {
    f32x4 v[4]; float s = 0.f;
#pragma unroll
    for (int j = 0; j < 4; ++j) { v[j] = ((const GAS f32x4*)xrow)[lane + 64 * j]; s += (v[j][0] * v[j][0] + v[j][1] * v[j][1]) + (v[j][2] * v[j][2] + v[j][3] * v[j][3]); }
    const float rstd = 1.0f / sqrtf(wave_sum(s) * (1.0f / D) + NORM_EPS);
#pragma unroll
    for (int j = 0; j < 4; ++j) { const f32x4 gg = ((const GAS f32x4*)g)[lane + 64 * j]; u32x2 w; w.x = pk2(v[j][0] * rstd * gg[0], v[j][1] * rstd * gg[1]); w.y = pk2(v[j][2] * rstd * gg[2], v[j][3] * rstd * gg[3]);
        ((GAS u32x2*)orow)[lane + 64 * j] = w; }
    if (lane == 0) *rstd_out = rstd;
}
__device__ __forceinline__ void unpack4(u32x2 w, f32x4& o) { o[0] = __uint_as_float(w.x << 16); o[1] = __uint_as_float(w.x & 0xffff0000u); o[2] = __uint_as_float(w.y << 16); o[3] = __uint_as_float(w.y & 0xffff0000u); }
__device__ __forceinline__ void resnorm_row(const float* xin_f32, bf16_t* xn, float* rstd_io, const float* gcur, const bf16_t* mrow, const float* gpost, const float* gnext, float* xout_f32, int lane) {
    f32x4 xv[4], mv[4]; float s = 0.f;
    if (xin_f32) {
#pragma unroll
        for (int j = 0; j < 4; ++j) xv[j] = ((const GAS f32x4*)xin_f32)[lane + 64 * j];
    } else {
        const float inv_rstd = 1.0f / *rstd_io;
#pragma unroll
        for (int j = 0; j < 4; ++j) { unpack4(((const GAS u32x2*)xn)[lane + 64 * j], xv[j]); const f32x4 gg = ((const GAS f32x4*)gcur)[lane + 64 * j];
#pragma unroll
            for (int e = 0; e < 4; ++e) xv[j][e] = xv[j][e] * inv_rstd / gg[e]; }
    }
#pragma unroll
    for (int j = 0; j < 4; ++j) { unpack4(((const GAS u32x2*)mrow)[lane + 64 * j], mv[j]); s += (mv[j][0] * mv[j][0] + mv[j][1] * mv[j][1]) + (mv[j][2] * mv[j][2] + mv[j][3] * mv[j][3]); }
    const float rstd = 1.0f / sqrtf(wave_sum(s) * (1.0f / D) + NORM_EPS);
    float s2 = 0.f;
#pragma unroll
    for (int j = 0; j < 4; ++j) { const f32x4 gg = ((const GAS f32x4*)gpost)[lane + 64 * j];
#pragma unroll
        for (int e = 0; e < 4; ++e) { xv[j][e] += mv[j][e] * rstd * gg[e]; s2 += xv[j][e] * xv[j][e]; } }
    if (gnext) {
        const float rstd2 = 1.0f / sqrtf(wave_sum(s2) * (1.0f / D) + NORM_EPS);
#pragma unroll
        for (int j = 0; j < 4; ++j) { const f32x4 gg = ((const GAS f32x4*)gnext)[lane + 64 * j]; u32x2 w; w.x = pk2(xv[j][0] * rstd2 * gg[0], xv[j][1] * rstd2 * gg[1]); w.y = pk2(xv[j][2] * rstd2 * gg[2], xv[j][3] * rstd2 * gg[3]);
            ((GAS u32x2*)xn)[lane + 64 * j] = w; }
        if (lane == 0) *rstd_io = rstd2;
    } else {
#pragma unroll
        for (int j = 0; j < 4; ++j) ((GAS f32x4*)xout_f32)[lane + 64 * j] = xv[j];
    }
}

struct Args { const float* in[17]; float* out; unsigned char* ws; };
constexpr int PT_OFF = LDSCTL_OFF;
__device__ __forceinline__ unsigned char* ldptr(LAS unsigned char* lds, int idx) {
    const volatile LAS unsigned* p = (const volatile LAS unsigned*)(lds + PT_OFF + idx * 8);
    const unsigned lo = (unsigned)__builtin_amdgcn_readfirstlane((int)p[0]), hi = (unsigned)__builtin_amdgcn_readfirstlane((int)p[1]);
    return (unsigned char*)(((unsigned long long)hi << 32) | lo);
}
#define INP(i) ((const float*)ldptr(lds, (i)))
#define OUTP ((float*)ldptr(lds, 17))
#define WSP (ldptr(lds, 18))
#define IDS int tid_ = wave_s * 64 + lane_id_volatile(); const int tid = tid_, lane = tid & 63, wave = wave_s; const int G = gridDim.x, bx = blockIdx.x; \
    const int vcu = (G % 8 == 0) ? (bx % 8) * (G / 8) + bx / 8 : bx; const int gw = vcu * NWAVES + wave, NGW = G * NWAVES; (void)lane; (void)gw; (void)NGW; (void)vcu; (void)bx; (void)tid; (void)wave
template <int MODE, int AMODE>
__device__ __forceinline__ void run_gemm(LAS unsigned char* lds, const bf16_t* A, const bf16_t* Bt, int Mr, int N, int K, const pg8::Epi<MODE>& E, int wave_s) {
    pg8::Gemm g{A, Bt, Mr, N, K}; pg8::StaticOrder S; S.init(Mr, N, (int)gridDim.x, (int)blockIdx.x);
#ifndef NO_GEMM
#ifdef ONLY_MODE
    if (MODE == ONLY_MODE)
#endif
    pg8::gemm_phase<pg8::Epi<MODE>, pg8::StaticOrder, AMODE, true, true>(lds, g, S, E, wave_s);
#endif
}

#ifndef REP_GIN
#define REP_GIN 1
#endif
#ifndef REP_CMP
#define REP_CMP 1
#endif
#ifndef REP_SCAN
#define REP_SCAN 1
#endif
#ifndef REP_ATT_NSA
#define REP_ATT_NSA 1
#endif
#ifndef REP_ATT_FOX
#define REP_ATT_FOX 1
#endif
#ifndef REP_ATT_SWA
#define REP_ATT_SWA 1
#endif
#ifndef REP_GOUT
#define REP_GOUT 1
#endif
#ifndef REP_MLP
#define REP_MLP 1
#endif
#ifndef REP_PRO
#define REP_PRO 1
#endif
template <int L>
__device__ __forceinline__ void layer_body(LAS unsigned char* lds, const XcdBarrier& bar, int& aslot, const int wave_s) {
#define GRID_BAR() xcd_barrier(bar)
    constexpr int kind = L % 3, sl = L / 3;
    if (kind == 0) {
        { unsigned char* ws = WSP;
          pg8::Epi<pg8::EM_NSA> E{(bf16_t*)(ws + WS_BIG), NSA_LDP, nullptr, (const float*)(ws + WS_ROPEC), (const float*)(ws + WS_ROPES), (float*)(ws + WS_G), nullptr, (bf16_t*)(ws + WS_BIG + NSA_HM_OFF), NSA_HM_STRIDE};
          run_gemm<pg8::EM_NSA, 0>(lds + RING_OFF, (const bf16_t*)(ws + WS_XN), (const bf16_t*)(ws + WS_WNSA) + (size_t)sl * NSA_NP * D, M, NSA_NP, D, E, wave_s); }
        GRID_BAR();
#if REP_GIN >= 2
        { unsigned char* ws = WSP;
          pg8::Epi<pg8::EM_NSA> E{(bf16_t*)(ws + WS_BIG), NSA_LDP, nullptr, (const float*)(ws + WS_ROPEC), (const float*)(ws + WS_ROPES), (float*)(ws + WS_G), nullptr, (bf16_t*)(ws + WS_BIG + NSA_HM_OFF), NSA_HM_STRIDE};
          run_gemm<pg8::EM_NSA, 0>(lds + RING_OFF, (const bf16_t*)(ws + WS_XN), (const bf16_t*)(ws + WS_WNSA) + (size_t)sl * NSA_NP * D, M, NSA_NP, D, E, wave_s); }
        GRID_BAR();
#endif
        { unsigned char* ws = WSP;
          pg8::Epi<pg8::EM_CMP> E{(bf16_t*)(ws + WS_HID), 256, (const float*)(ws + WS_CMPB) + sl * 512, nullptr, nullptr, nullptr, nullptr, nullptr, 0};
          run_gemm<pg8::EM_CMP, 1>(lds + RING_OFF, (const bf16_t*)(ws + WS_BIG) + 1024, (const bf16_t*)(ws + WS_WCMP) + (size_t)sl * 2 * 256 * 2048, CMP_ROWS, 512, 2048, E, wave_s); }
        GRID_BAR();
#if REP_CMP >= 2
        { unsigned char* ws = WSP;
          pg8::Epi<pg8::EM_CMP> E{(bf16_t*)(ws + WS_HID), 256, (const float*)(ws + WS_CMPB) + sl * 512, nullptr, nullptr, nullptr, nullptr, nullptr, 0};
          run_gemm<pg8::EM_CMP, 1>(lds + RING_OFF, (const bf16_t*)(ws + WS_BIG) + 1024, (const bf16_t*)(ws + WS_WCMP) + (size_t)sl * 2 * 256 * 2048, CMP_ROWS, 512, 2048, E, wave_s); }
        GRID_BAR();
#endif
        { IDS; unsigned char* ws = WSP; const bf16_t* HID = (const bf16_t*)(ws + WS_HID); const float* nsa_w2 = INP(7);
          const int which = bx >> 7, wl = bx & 127;
          LAS float* w2s = (LAS float*)(lds + RING_OFF);
          { const GAS f32x4* w2g = (const GAS f32x4*)(nsa_w2 + (size_t)(sl * 2 + which) * 256 * 64); for (int i = tid; i < 4096; i += 512) ((LAS f32x4*)w2s)[i] = w2g[i]; }
          __syncthreads();
          const int r0 = (wl * 8 + wave) * 8;
          float f[8][4], acc[8];
#pragma unroll
          for (int q = 0; q < 8; ++q) { const u32x2 hw = *(const GAS u32x2*)(HID + ((size_t)which * CMP_ROWS + r0 + q) * 256 + 4 * lane);
              f[q][0] = __uint_as_float(hw.x << 16); f[q][1] = __uint_as_float(hw.x & 0xffff0000u); f[q][2] = __uint_as_float(hw.y << 16); f[q][3] = __uint_as_float(hw.y & 0xffff0000u); acc[q] = 0.f; }
          const LAS float* wcol = w2s + (which ? lane : il64(lane));
          for (int jj = 0; jj < 64; ++jj) {
#pragma unroll
              for (int s = 0; s < 4; ++s) { const float w = wcol[(4 * jj + s) * 64];
#pragma unroll
                  for (int q = 0; q < 8; ++q) acc[q] += __builtin_bit_cast(float, __builtin_amdgcn_readlane(__builtin_bit_cast(int, f[q][s]), jj)) * w; }
          }
          bf16_t* dstb = (bf16_t*)(ws + (which ? WS_VC : WS_KC));
#pragma unroll
          for (int q = 0; q < 8; ++q) { const int r = r0 + q, gg = r & 3, c = (r >> 2) & 127, b = r >> 9;
              dstb[(size_t)((b * 4 + gg) * NCP + c) * 64 + lane] = (bf16_t)f2bf(c == NC ? 0.f : acc[q]); }
          __syncthreads();
        }
        GRID_BAR();
#if REP_CMP >= 2
        { IDS; unsigned char* ws = WSP; const bf16_t* HID = (const bf16_t*)(ws + WS_HID); const float* nsa_w2 = INP(7);
          const int which = bx >> 7, wl = bx & 127;
          LAS float* w2s = (LAS float*)(lds + RING_OFF);
          { const GAS f32x4* w2g = (const GAS f32x4*)(nsa_w2 + (size_t)(sl * 2 + which) * 256 * 64); for (int i = tid; i < 4096; i += 512) ((LAS f32x4*)w2s)[i] = w2g[i]; }
          __syncthreads();
          const int r0 = (wl * 8 + wave) * 8;
          float f[8][4], acc[8];
#pragma unroll
          for (int q = 0; q < 8; ++q) { const u32x2 hw = *(const GAS u32x2*)(HID + ((size_t)which * CMP_ROWS + r0 + q) * 256 + 4 * lane);
              f[q][0] = __uint_as_float(hw.x << 16); f[q][1] = __uint_as_float(hw.x & 0xffff0000u); f[q][2] = __uint_as_float(hw.y << 16); f[q][3] = __uint_as_float(hw.y & 0xffff0000u); acc[q] = 0.f; }
          const LAS float* wcol = w2s + (which ? lane : il64(lane));
          for (int jj = 0; jj < 64; ++jj) {
#pragma unroll
              for (int s = 0; s < 4; ++s) { const float w = wcol[(4 * jj + s) * 64];
#pragma unroll
                  for (int q = 0; q < 8; ++q) acc[q] += __builtin_bit_cast(float, __builtin_amdgcn_readlane(__builtin_bit_cast(int, f[q][s]), jj)) * w; }
          }
          bf16_t* dstb = (bf16_t*)(ws + (which ? WS_VC : WS_KC));
#pragma unroll
          for (int q = 0; q < 8; ++q) { const int r = r0 + q, gg = r & 3, c = (r >> 2) & 127, b = r >> 9;
              dstb[(size_t)((b * 4 + gg) * NCP + c) * 64 + lane] = (bf16_t)f2bf(c == NC ? 0.f : acc[q]); }
          __syncthreads();
        }
        GRID_BAR();
#endif
        { IDS; unsigned char* ws = WSP;
          const int bg = vcu >> 2, sub = vcu & 3, b = bg >> 2, g = bg & 3;
          for (int i = 0; i < 8; ++i) { const int qt = (i & 1) ? (8 * (i >> 1) + 7 - sub) : (8 * (i >> 1) + sub);
#ifndef NO_NSA
              att::nsa_unit(lds + RING_OFF, b, g, qt, ws, WS_BIG, WS_G, WS_KC, WS_VC, WS_O, wave, aslot);
#endif
          } }
#if REP_ATT_NSA >= 2
        GRID_BAR();
        { IDS; unsigned char* ws = WSP;
          const int bg = vcu >> 2, sub = vcu & 3, b = bg >> 2, g = bg & 3;
          for (int i = 0; i < 8; ++i) { const int qt = (i & 1) ? (8 * (i >> 1) + 7 - sub) : (8 * (i >> 1) + sub);
#ifndef NO_NSA
              att::nsa_unit(lds + RING_OFF, b, g, qt, ws, WS_BIG, WS_G, WS_KC, WS_VC, WS_O, wave, aslot);
#endif
          } }
#endif
    } else if (kind == 1) {
        { unsigned char* ws = WSP;
          pg8::Epi<pg8::EM_FOX> E{(bf16_t*)(ws + WS_BIG), FOX_LDP, nullptr, nullptr, nullptr, (float*)(ws + WS_LF), INP(10), (bf16_t*)(ws + WS_BIG + FOX_HM_OFF), FOX_HM_STRIDE};
          run_gemm<pg8::EM_FOX, 0>(lds + RING_OFF, (const bf16_t*)(ws + WS_XN), (const bf16_t*)(ws + WS_WFOX), M, FOX_NP, D, E, wave_s); }
        GRID_BAR();
#if REP_GIN >= 2
        { unsigned char* ws = WSP;
          pg8::Epi<pg8::EM_FOX> E{(bf16_t*)(ws + WS_BIG), FOX_LDP, nullptr, nullptr, nullptr, (float*)(ws + WS_LF), INP(10), (bf16_t*)(ws + WS_BIG + FOX_HM_OFF), FOX_HM_STRIDE};
          run_gemm<pg8::EM_FOX, 0>(lds + RING_OFF, (const bf16_t*)(ws + WS_XN), (const bf16_t*)(ws + WS_WFOX), M, FOX_NP, D, E, wave_s); }
        GRID_BAR();
#endif
        { IDS; unsigned char* ws = WSP; const float* LF = (const float*)(ws + WS_LF); float* CB = (float*)(ws + WS_CB);
          if (wave == 0) for (int bh = bx; bh < BATCH * NH; bh += G) {
            const int b = bh >> 4, h = bh & 15; float v[32]; float run = 0.f;
#pragma unroll
            for (int i = 0; i < 32; ++i) { run += LF[((size_t)b * T + 32 * lane + i) * 16 + h]; v[i] = run; }
            float excl = 0.f;
            for (int k = 0; k < 63; ++k) { const float t = __builtin_bit_cast(float, __builtin_amdgcn_readlane(__builtin_bit_cast(int, run), k)); if (lane > k) excl += t; }
#pragma unroll
            for (int i = 0; i < 32; ++i) CB[(size_t)bh * T + 32 * lane + i] = -(v[i] + excl) * LOG2E;
          } }
        GRID_BAR();
#if REP_SCAN >= 2
        { IDS; unsigned char* ws = WSP; const float* LF = (const float*)(ws + WS_LF); float* CB = (float*)(ws + WS_CB);
          if (wave == 0) for (int bh = bx; bh < BATCH * NH; bh += G) {
            const int b = bh >> 4, h = bh & 15; float v[32]; float run = 0.f;
#pragma unroll
            for (int i = 0; i < 32; ++i) { run += LF[((size_t)b * T + 32 * lane + i) * 16 + h]; v[i] = run; }
            float excl = 0.f;
            for (int k = 0; k < 63; ++k) { const float t = __builtin_bit_cast(float, __builtin_amdgcn_readlane(__builtin_bit_cast(int, run), k)); if (lane > k) excl += t; }
#pragma unroll
            for (int i = 0; i < 32; ++i) CB[(size_t)bh * T + 32 * lane + i] = -(v[i] + excl) * LOG2E;
          } }
        GRID_BAR();
#endif
        { IDS; unsigned char* ws = WSP;
          const int xcd = vcu >> 5, c = vcu & 31, sub = c & 3;
          for (int i = 0; i < 8; ++i) { const int bh = 32 * xcd + 8 * (i >> 1) + (c >> 2); const int qb = (i & 1) ? sub : 7 - sub;
#ifndef NO_FOX
              att::fox_unit(lds + RING_OFF, bh >> 4, bh & 15, qb, ws, WS_BIG, WS_CB, WS_O, wave, aslot);
#endif
          } }
#if REP_ATT_FOX >= 2
        GRID_BAR();
        { IDS; unsigned char* ws = WSP;
          const int xcd = vcu >> 5, c = vcu & 31, sub = c & 3;
          for (int i = 0; i < 8; ++i) { const int bh = 32 * xcd + 8 * (i >> 1) + (c >> 2); const int qb = (i & 1) ? sub : 7 - sub;
#ifndef NO_FOX
              att::fox_unit(lds + RING_OFF, bh >> 4, bh & 15, qb, ws, WS_BIG, WS_CB, WS_O, wave, aslot);
#endif
          } }
#endif
    } else {
        { unsigned char* ws = WSP;
          pg8::Epi<pg8::EM_SWA> E{(bf16_t*)(ws + WS_BIG), SWA_LDP, (const float*)(ws + WS_SWAB), (const float*)(ws + WS_ROPEC), (const float*)(ws + WS_ROPES), nullptr, nullptr, (bf16_t*)(ws + WS_BIG + SWA_HM_OFF), SWA_HM_STRIDE};
          run_gemm<pg8::EM_SWA, 0>(lds + RING_OFF, (const bf16_t*)(ws + WS_XN), (const bf16_t*)(ws + WS_WSWA), M, SWA_NP, D, E, wave_s); }
        GRID_BAR();
#if REP_GIN >= 2
        { unsigned char* ws = WSP;
          pg8::Epi<pg8::EM_SWA> E{(bf16_t*)(ws + WS_BIG), SWA_LDP, (const float*)(ws + WS_SWAB), (const float*)(ws + WS_ROPEC), (const float*)(ws + WS_ROPES), nullptr, nullptr, (bf16_t*)(ws + WS_BIG + SWA_HM_OFF), SWA_HM_STRIDE};
          run_gemm<pg8::EM_SWA, 0>(lds + RING_OFF, (const bf16_t*)(ws + WS_XN), (const bf16_t*)(ws + WS_WSWA), M, SWA_NP, D, E, wave_s); }
        GRID_BAR();
#endif
        { IDS; unsigned char* ws = WSP; const float* sinks = INP(14);
          const int bg = vcu >> 3, sub = vcu & 7;
          for (int i = 0; i < 8; ++i) {
#ifndef NO_SWA
              att::swa_unit(lds + RING_OFF, bg >> 1, bg & 1, 8 * i + sub, ws, WS_BIG, WS_O, sinks, wave, aslot);
#endif
          } }
#if REP_ATT_SWA >= 2
        GRID_BAR();
        { IDS; unsigned char* ws = WSP; const float* sinks = INP(14);
          const int bg = vcu >> 3, sub = vcu & 7;
          for (int i = 0; i < 8; ++i) {
#ifndef NO_SWA
              att::swa_unit(lds + RING_OFF, bg >> 1, bg & 1, 8 * i + sub, ws, WS_BIG, WS_O, sinks, wave, aslot);
#endif
          } }
#endif
    }
    GRID_BAR();
    { unsigned char* ws = WSP;
      pg8::Epi<pg8::EM_PLAIN> E{(bf16_t*)(ws + WS_BIG), D, kind == 2 ? INP(16) : nullptr, nullptr, nullptr, nullptr, nullptr, nullptr, 0};
      run_gemm<pg8::EM_PLAIN, 0>(lds + RING_OFF, (const bf16_t*)(ws + WS_O), (const bf16_t*)(ws + WS_WOUT) + (size_t)L * D * D, M, D, D, E, wave_s); }
    GRID_BAR();
#if REP_GOUT >= 2
    { unsigned char* ws = WSP;
      pg8::Epi<pg8::EM_PLAIN> E{(bf16_t*)(ws + WS_BIG), D, kind == 2 ? INP(16) : nullptr, nullptr, nullptr, nullptr, nullptr, nullptr, 0};
      run_gemm<pg8::EM_PLAIN, 0>(lds + RING_OFF, (const bf16_t*)(ws + WS_O), (const bf16_t*)(ws + WS_WOUT) + (size_t)L * D * D, M, D, D, E, wave_s); }
    GRID_BAR();
#endif
    { IDS; unsigned char* ws = WSP; const float* gL = INP(1) + (size_t)L * 4 * D; const float* xin = (L == 0) ? INP(0) : nullptr;
      const bf16_t* MB = (const bf16_t*)(ws + WS_BIG); bf16_t* XN = (bf16_t*)(ws + WS_XN); float* RSTD = (float*)(ws + WS_RSTD);
      for (int m = gw; m < M; m += NGW) resnorm_row(xin ? xin + (size_t)m * D : nullptr, XN + (size_t)m * D, RSTD + m, gL, MB + (size_t)m * D, gL + D, gL + 2 * D, nullptr, lane); }
    GRID_BAR();
    { unsigned char* ws = WSP;
      pg8::Epi<pg8::EM_RELU2> E{(bf16_t*)(ws + WS_BIG), FF, nullptr, nullptr, nullptr, nullptr, nullptr, nullptr, 0};
      run_gemm<pg8::EM_RELU2, 0>(lds + RING_OFF, (const bf16_t*)(ws + WS_XN), (const bf16_t*)(ws + WS_WUP) + (size_t)L * D * FF, M, FF, D, E, wave_s); }
    GRID_BAR();
#if REP_MLP >= 2
    { unsigned char* ws = WSP;
      pg8::Epi<pg8::EM_RELU2> E{(bf16_t*)(ws + WS_BIG), FF, nullptr, nullptr, nullptr, nullptr, nullptr, nullptr, 0};
      run_gemm<pg8::EM_RELU2, 0>(lds + RING_OFF, (const bf16_t*)(ws + WS_XN), (const bf16_t*)(ws + WS_WUP) + (size_t)L * D * FF, M, FF, D, E, wave_s); }
    GRID_BAR();
#endif
    { unsigned char* ws = WSP;
      pg8::Epi<pg8::EM_PLAIN> E{(bf16_t*)(ws + WS_M2), D, nullptr, nullptr, nullptr, nullptr, nullptr, nullptr, 0};
      run_gemm<pg8::EM_PLAIN, 0>(lds + RING_OFF, (const bf16_t*)(ws + WS_BIG), (const bf16_t*)(ws + WS_WDN) + (size_t)L * D * FF, M, D, FF, E, wave_s); }
    GRID_BAR();
#if REP_MLP >= 2
    { unsigned char* ws = WSP;
      pg8::Epi<pg8::EM_PLAIN> E{(bf16_t*)(ws + WS_M2), D, nullptr, nullptr, nullptr, nullptr, nullptr, nullptr, 0};
      run_gemm<pg8::EM_PLAIN, 0>(lds + RING_OFF, (const bf16_t*)(ws + WS_BIG), (const bf16_t*)(ws + WS_WDN) + (size_t)L * D * FF, M, D, FF, E, wave_s); }
    GRID_BAR();
#endif
    { IDS; unsigned char* ws = WSP; const float* gL = INP(1) + (size_t)L * 4 * D; float* xout = OUTP; bf16_t* XN = (bf16_t*)(ws + WS_XN); const bf16_t* M2 = (const bf16_t*)(ws + WS_M2); float* RSTD = (float*)(ws + WS_RSTD);
      for (int m = gw; m < M; m += NGW) resnorm_row(nullptr, XN + (size_t)m * D, RSTD + m, gL + 2 * D, M2 + (size_t)m * D, gL + 3 * D, (L + 1 < DEPTH) ? gL + 4 * D : nullptr, xout + (size_t)m * D, lane); }
    if (L + 1 < DEPTH) GRID_BAR();
#undef GRID_BAR
}

__global__ void __launch_bounds__(NWAVES * 64, 2) fwd_kernel(Args args) {
    extern __shared__ __attribute__((aligned(16))) unsigned char lds_raw[];
    LAS unsigned char* lds = (LAS unsigned char*)lds_raw;
    const int wave_s = __builtin_amdgcn_readfirstlane((int)threadIdx.x >> 6);
    for (int u = threadIdx.x; u < (LDS_BYTES - LDSCTL_OFF) / 4; u += NWAVES * 64) ((LAS unsigned*)(lds + LDSCTL_OFF))[u] = 0u;
    __syncthreads();
    if (threadIdx.x == 0) {
        LAS unsigned long long* pt = (LAS unsigned long long*)(lds + PT_OFF);
#pragma unroll
        for (int i = 0; i < 17; ++i) pt[i] = (unsigned long long)args.in[i];
        pt[17] = (unsigned long long)args.out; pt[18] = (unsigned long long)args.ws;
    }
    __syncthreads();
    volatile LAS unsigned* MISC = (volatile LAS unsigned*)(lds + MISC_OFF);
    XcdBarrier bar = xcd_barrier_post((unsigned*)(WSP + WS_CTL) + CW_BAR, MISC + 8);

    {
        IDS; unsigned char* ws = WSP;
        const float* x_in = INP(0); const float* norm_g = INP(1); const float* mlp_up = INP(2); const float* mlp_dn = INP(3);
        const float* nsa_w_in = INP(4); const float* nsa_pos = INP(5); const float* nsa_w1 = INP(6); const float* nsa_w_out = INP(8);
        const float* fox_w_in = INP(9); const float* fox_w_out = INP(11); const float* swa_w_in = INP(12); const float* swa_b_in = INP(13); const float* swa_w_out = INP(15);
        bf16_t* W_UP = (bf16_t*)(ws + WS_WUP); bf16_t* W_DN = (bf16_t*)(ws + WS_WDN); bf16_t* W_NSA = (bf16_t*)(ws + WS_WNSA); bf16_t* W_OUT = (bf16_t*)(ws + WS_WOUT);
        bf16_t* W_FOX = (bf16_t*)(ws + WS_WFOX); bf16_t* W_SWA = (bf16_t*)(ws + WS_WSWA); bf16_t* W_CMP = (bf16_t*)(ws + WS_WCMP);
        float* ROPEC = (float*)(ws + WS_ROPEC); float* ROPES = (float*)(ws + WS_ROPES); float* CMPB = (float*)(ws + WS_CMPB); float* SWAB = (float*)(ws + WS_SWAB);
        bf16_t* XN = (bf16_t*)(ws + WS_XN);
        LAS float* scr = (LAS float*)(lds + RING_OFF + wave * 16384);
        constexpr int I_UP = (D / 64) * (FF / 32), I_DN = (FF / 64) * (D / 32), I_NSA = (D / 64) * (NSA_NP / 32), I_OUT = (D / 64) * (D / 32), I_FOX = (D / 64) * (FOX_NP / 32), I_SWA = (D / 64) * (SWA_NP / 32), I_CMP = (2048 / 64) * (256 / 32);
        constexpr int NITEMS = 4 * I_UP + 4 * I_DN + 2 * I_NSA + 4 * I_OUT + I_FOX + I_SWA + 4 * I_CMP;
        for (int it = gw; it < NITEMS; it += NGW) {
            int r = it;
            if (r < 4 * I_UP) { const int Lw = r / I_UP; conv_item(mlp_up + (size_t)Lw * D * FF, D, FF, W_UP + (size_t)Lw * D * FF, FF, 0, r % I_UP, scr, lane); continue; } r -= 4 * I_UP;
            if (r < 4 * I_DN) { const int Lw = r / I_DN; conv_item(mlp_dn + (size_t)Lw * D * FF, FF, D, W_DN + (size_t)Lw * D * FF, D, 0, r % I_DN, scr, lane); continue; } r -= 4 * I_DN;
            if (r < 2 * I_NSA) { const int s = r / I_NSA; conv_item(nsa_w_in + (size_t)s * D * NSA_N, D, NSA_N, W_NSA + (size_t)s * NSA_NP * D, NSA_NP, 1, r % I_NSA, scr, lane); continue; } r -= 2 * I_NSA;
            if (r < 4 * I_OUT) { const int Lw = r / I_OUT; const float* src = (Lw == 1) ? fox_w_out : (Lw == 2) ? swa_w_out : nsa_w_out + (size_t)(Lw / 3) * D * D;
                conv_item(src, D, D, W_OUT + (size_t)Lw * D * D, D, 0, r % I_OUT, scr, lane); continue; } r -= 4 * I_OUT;
            if (r < I_FOX) { conv_item(fox_w_in, D, FOX_N, W_FOX, FOX_NP, 2, r, scr, lane); continue; } r -= I_FOX;
            if (r < I_SWA) { conv_item(swa_w_in, D, SWA_N, W_SWA, SWA_NP, 3, r, scr, lane); continue; } r -= I_SWA;
            { const int sw = r / I_CMP;
                conv_item(nsa_w1 + (size_t)sw * 2048 * 256, 2048, 256, W_CMP + (size_t)sw * 256 * 2048, 256, (sw & 1) ? 0 : 4, r % I_CMP, scr, lane); }
        }
        for (int e = bx * 512 + tid; e < T * 32; e += G * 512) { const int t = e >> 5, i = e & 31; const float inv = powf(10000.0f, -(float)(2 * i) / 64.0f); const float ang = (float)t * inv;
            ROPEC[e] = cosf(ang); ROPES[e] = sinf(ang); }
        for (int e = bx * 512 + tid; e < SWA_N; e += G * 512) SWAB[e] = swa_b_in[src_n(3, e)];
        for (int task = bx; task < 64; task += G) {
            const int sw = task >> 4, n0 = (task & 15) * 16, kq = tid >> 4, nn = tid & 15;
            const float* pos = nsa_pos + (size_t)sw * 2048; const float* w1 = nsa_w1 + (size_t)sw * 2048 * 256;
            float acc = 0.f;
#pragma unroll 8
            for (int k = kq * 64; k < kq * 64 + 64; ++k) acc += pos[k] * w1[(size_t)k * 256 + n0 + nn];
            LAS float* red = (LAS float*)(lds + RING_OFF);
            __syncthreads();
            red[kq * 16 + nn] = acc;
            __syncthreads();
            if (tid < 16) { float sm = 0.f; for (int q = 0; q < 32; ++q) sm += red[q * 16 + tid]; CMPB[sw * 256 + n0 + tid] = sm; }
            __syncthreads();
        }
        for (int m = gw; m < M; m += NGW) norm_row(x_in + (size_t)m * D, norm_g, XN + (size_t)m * D, (float*)(ws + WS_RSTD) + m, lane);
    }
#if REP_PRO >= 2
    xcd_barrier(bar);
    {
        IDS; unsigned char* ws = WSP;
        const float* x_in = INP(0); const float* norm_g = INP(1); const float* mlp_up = INP(2); const float* mlp_dn = INP(3);
        const float* nsa_w_in = INP(4); const float* nsa_pos = INP(5); const float* nsa_w1 = INP(6); const float* nsa_w_out = INP(8);
        const float* fox_w_in = INP(9); const float* fox_w_out = INP(11); const float* swa_w_in = INP(12); const float* swa_b_in = INP(13); const float* swa_w_out = INP(15);
        bf16_t* W_UP = (bf16_t*)(ws + WS_WUP); bf16_t* W_DN = (bf16_t*)(ws + WS_WDN); bf16_t* W_NSA = (bf16_t*)(ws + WS_WNSA); bf16_t* W_OUT = (bf16_t*)(ws + WS_WOUT);
        bf16_t* W_FOX = (bf16_t*)(ws + WS_WFOX); bf16_t* W_SWA = (bf16_t*)(ws + WS_WSWA); bf16_t* W_CMP = (bf16_t*)(ws + WS_WCMP);
        float* ROPEC = (float*)(ws + WS_ROPEC); float* ROPES = (float*)(ws + WS_ROPES); float* CMPB = (float*)(ws + WS_CMPB); float* SWAB = (float*)(ws + WS_SWAB);
        bf16_t* XN = (bf16_t*)(ws + WS_XN);
        LAS float* scr = (LAS float*)(lds + RING_OFF + wave * 16384);
        constexpr int I_UP = (D / 64) * (FF / 32), I_DN = (FF / 64) * (D / 32), I_NSA = (D / 64) * (NSA_NP / 32), I_OUT = (D / 64) * (D / 32), I_FOX = (D / 64) * (FOX_NP / 32), I_SWA = (D / 64) * (SWA_NP / 32), I_CMP = (2048 / 64) * (256 / 32);
        constexpr int NITEMS = 4 * I_UP + 4 * I_DN + 2 * I_NSA + 4 * I_OUT + I_FOX + I_SWA + 4 * I_CMP;
        for (int it = gw; it < NITEMS; it += NGW) {
            int r = it;
            if (r < 4 * I_UP) { const int Lw = r / I_UP; conv_item(mlp_up + (size_t)Lw * D * FF, D, FF, W_UP + (size_t)Lw * D * FF, FF, 0, r % I_UP, scr, lane); continue; } r -= 4 * I_UP;
            if (r < 4 * I_DN) { const int Lw = r / I_DN; conv_item(mlp_dn + (size_t)Lw * D * FF, FF, D, W_DN + (size_t)Lw * D * FF, D, 0, r % I_DN, scr, lane); continue; } r -= 4 * I_DN;
            if (r < 2 * I_NSA) { const int s = r / I_NSA; conv_item(nsa_w_in + (size_t)s * D * NSA_N, D, NSA_N, W_NSA + (size_t)s * NSA_NP * D, NSA_NP, 1, r % I_NSA, scr, lane); continue; } r -= 2 * I_NSA;
            if (r < 4 * I_OUT) { const int Lw = r / I_OUT; const float* src = (Lw == 1) ? fox_w_out : (Lw == 2) ? swa_w_out : nsa_w_out + (size_t)(Lw / 3) * D * D;
                conv_item(src, D, D, W_OUT + (size_t)Lw * D * D, D, 0, r % I_OUT, scr, lane); continue; } r -= 4 * I_OUT;
            if (r < I_FOX) { conv_item(fox_w_in, D, FOX_N, W_FOX, FOX_NP, 2, r, scr, lane); continue; } r -= I_FOX;
            if (r < I_SWA) { conv_item(swa_w_in, D, SWA_N, W_SWA, SWA_NP, 3, r, scr, lane); continue; } r -= I_SWA;
            { const int sw = r / I_CMP;
                conv_item(nsa_w1 + (size_t)sw * 2048 * 256, 2048, 256, W_CMP + (size_t)sw * 256 * 2048, 256, (sw & 1) ? 0 : 4, r % I_CMP, scr, lane); }
        }
        for (int e = bx * 512 + tid; e < T * 32; e += G * 512) { const int t = e >> 5, i = e & 31; const float inv = powf(10000.0f, -(float)(2 * i) / 64.0f); const float ang = (float)t * inv;
            ROPEC[e] = cosf(ang); ROPES[e] = sinf(ang); }
        for (int e = bx * 512 + tid; e < SWA_N; e += G * 512) SWAB[e] = swa_b_in[src_n(3, e)];
        for (int task = bx; task < 64; task += G) {
            const int sw = task >> 4, n0 = (task & 15) * 16, kq = tid >> 4, nn = tid & 15;
            const float* pos = nsa_pos + (size_t)sw * 2048; const float* w1 = nsa_w1 + (size_t)sw * 2048 * 256;
            float acc = 0.f;
#pragma unroll 8
            for (int k = kq * 64; k < kq * 64 + 64; ++k) acc += pos[k] * w1[(size_t)k * 256 + n0 + nn];
            LAS float* red = (LAS float*)(lds + RING_OFF);
            __syncthreads();
            red[kq * 16 + nn] = acc;
            __syncthreads();
            if (tid < 16) { float sm = 0.f; for (int q = 0; q < 32; ++q) sm += red[q * 16 + tid]; CMPB[sw * 256 + n0 + tid] = sm; }
            __syncthreads();
        }
        for (int m = gw; m < M; m += NGW) norm_row(x_in + (size_t)m * D, norm_g, XN + (size_t)m * D, (float*)(ws + WS_RSTD) + m, lane);
    }
#endif
    xcd_barrier(bar);

    int aslot = 0;
    if (L_LO <= 0 && 0 < L_HI) layer_body<0>(lds, bar, aslot, wave_s);
    if (L_LO <= 1 && 1 < L_HI) layer_body<1>(lds, bar, aslot, wave_s);
    if (L_LO <= 2 && 2 < L_HI) layer_body<2>(lds, bar, aslot, wave_s);
    if (L_LO <= 3 && 3 < L_HI) layer_body<3>(lds, bar, aslot, wave_s);
}

extern "C" void kernel_launch(void* const* d_in, const int* in_sizes, int n_in, void* d_out, int out_size, void* d_ws, size_t ws_size, hipStream_t stream) {
    static int grid = 0;
    if (grid == 0) {
        if (n_in != 17 || in_sizes[0] != M * D || out_size != M * D || ws_size < WS_END) { fprintf(stderr, "kernel_launch: unexpected problem shape (n_in %d, in0 %d, out %d, ws %zu)\n", n_in, n_in > 0 ? in_sizes[0] : -1, out_size, ws_size); grid = -1; return; }
        int dev = 0, cus = 0, per_cu = 0;
        if (hipGetDevice(&dev) != hipSuccess || hipDeviceGetAttribute(&cus, hipDeviceAttributeMultiprocessorCount, dev) != hipSuccess) { grid = -1; return; }
        if (hipFuncSetAttribute((const void*)fwd_kernel, hipFuncAttributeMaxDynamicSharedMemorySize, LDS_BYTES) != hipSuccess) { fprintf(stderr, "kernel_launch: hipFuncSetAttribute failed\n"); grid = -1; return; }
        if (hipOccupancyMaxActiveBlocksPerMultiprocessor(&per_cu, (const void*)fwd_kernel, NWAVES * 64, LDS_BYTES) != hipSuccess || per_cu < 1) { fprintf(stderr, "kernel_launch: occupancy query reports %d\n", per_cu); }
        (void)hipGetLastError();
        if (cus < 256) { fprintf(stderr, "kernel_launch: needs 256 CUs, device has %d\n", cus); grid = -1; return; }
        grid = 256;
    }
    if (grid < 0) return;
    if (hipMemsetAsync((char*)d_ws + WS_CTL, 0, CTL_ZERO_BYTES, stream) != hipSuccess) return;
    Args a{};
    for (int i = 0; i < 17; ++i) a.in[i] = (const float*)d_in[i];
    a.out = (float*)d_out; a.ws = (unsigned char*)d_ws;
    hipLaunchKernelGGL(fwd_kernel, dim3(grid), dim3(NWAVES * 64), LDS_BYTES, stream, a);
}
```

```cpp
#include <hip/hip_runtime.h>
#include <cstdio>
#include <cstdint>

#define LAS __attribute__((address_space(3)))
#define GAS __attribute__((address_space(1)))
typedef unsigned short bf16_t;
typedef short bf16x8 __attribute__((ext_vector_type(8)));
typedef short s16x4 __attribute__((ext_vector_type(4)));
typedef float f32x2 __attribute__((ext_vector_type(2)));
typedef float f32x4 __attribute__((ext_vector_type(4)));
typedef float f32x16 __attribute__((ext_vector_type(16)));
typedef unsigned u32x2 __attribute__((ext_vector_type(2)));
typedef unsigned u32x4 __attribute__((ext_vector_type(4)));

constexpr int BATCH = 16, T = 2048, D = 1024, NH = 16, HD = 64, FF = 4096, DEPTH = 4;
constexpr int M = BATCH * T;
constexpr int NSA_N = 2608, NSA_NP = 2816, NSA_LDP = 1536;
constexpr int FOX_N = 3088, FOX_NP = 3328, FOX_LDP = 1024;
constexpr int SWA_N = 1280, SWA_NP = 1280, SWA_LDP = 1024;
constexpr int CMP_LDP = NSA_LDP;
constexpr int NC = 127, NCP = 128;
constexpr int CMP_ROWS = BATCH * NCP * 4;
constexpr size_t NSA_HM_OFF = (size_t)96 << 20, NSA_HM_STRIDE = (size_t)8 << 20;
constexpr size_t FOX_HM_OFF = (size_t)64 << 20, FOX_HM_STRIDE = (size_t)32 << 20;
constexpr size_t SWA_HM_OFF = (size_t)64 << 20, SWA_HM_STRIDE = (size_t)4 << 20;
constexpr float LOG2E = 1.4426950408889634f;
constexpr float C2 = 0.125f * LOG2E;
constexpr float NORM_EPS = 1e-6f;

__device__ __forceinline__ unsigned cvt_pk_bf16(float lo, float hi) { unsigned r; asm volatile("v_cvt_pk_bf16_f32 %0, %1, %2" : "=v"(r) : "v"(lo), "v"(hi)); return r; }
__device__ __forceinline__ void store8(bf16_t* p, f32x4 a, f32x4 b) { u32x4 w; w.x = cvt_pk_bf16(a[0], a[1]); w.y = cvt_pk_bf16(a[2], a[3]); w.z = cvt_pk_bf16(b[0], b[1]); w.w = cvt_pk_bf16(b[2], b[3]); *(u32x4*)p = w; }

__device__ __forceinline__ int lane_id_volatile() { int x; asm volatile("v_mbcnt_lo_u32_b32 %0, -1, 0\n\tv_mbcnt_hi_u32_b32 %0, -1, %0" : "=v"(x)); return x; }

namespace pg8 {
#define PG8_LAS __attribute__((address_space(3)))
constexpr int BM = 256, BK = 64, HALF = 128, HTB = HALF * BK * 2  , STAGE_BYTES = 8 * HTB, NXCD = 8, WGM = 8;

__host__ __device__ __forceinline__ int lds_byte(int r, int c) { const int st = (r >> 4) * 2 + (c >> 5), rr = r & 15, cc = c & 31, ob = rr * 64 + cc * 2; return st * 1024 + (ob ^ (((ob >> 9) & 1) << 5)); }
__host__ __device__ __forceinline__ void stage_rc(int b, int& R, int& C) { const int st = b / 1024, sb = b % 1024, swz = sb ^ (((sb >> 9) & 1) << 5); R = (st >> 1) * 16 + swz / 64; C = (st & 1) * 32 + (swz % 64) / 2; }
__host__ __device__ __forceinline__ int perm32(int rho) { const int n = rho >> 4, i = rho & 15; return 8 * (i >> 2) + 4 * n + (i & 3); }

struct Unit { int pm, pn; };
struct Gemm { const bf16_t* A; const bf16_t* Bt; int M, N, K; };

struct StaticOrder {
    int nM, nN, nwg, G, c;
    __host__ __device__ void init(int M_, int N_, int G_, int c_) { nM = M_ / BM; nN = N_ / BM; nwg = nM * nN; G = G_; c = c_; }
    __host__ __device__ bool next(int i, Unit& u) const {
        const long L = (long)i * G + c; if (L >= nwg) return false;
        int wgid = (int)L; { const int q = nwg / NXCD, r = nwg % NXCD, xcd = wgid % NXCD, off = wgid / NXCD; wgid = (xcd < r ? xcd * (q + 1) : r * (q + 1) + (xcd - r) * q) + off; }
        const int nig = WGM * nN, gid = wgid / nig, fm = gid * WGM, gsz = (nM - fm) < WGM ? (nM - fm) : WGM;
        u.pm = fm + ((wgid % nig) % gsz); u.pn = (wgid % nig) / gsz; return true;
    }
    __device__ __forceinline__ void a_ready(const Unit&) const {}
    __device__ __forceinline__ void done(const Unit&) const {}
};

enum EpiMode { EM_PLAIN = 0, EM_RELU2 = 1, EM_NSA = 2, EM_FOX = 3, EM_SWA = 4, EM_CMP = 5 };

__device__ __forceinline__ void rope4(f32x4& v, float c0, float s0, float c1, float s1) {
    const float a0 = v[0], b0 = v[1], a1 = v[2], b1 = v[3];
    v[0] = a0 * c0 - b0 * s0; v[1] = b0 * c0 + a0 * s0; v[2] = a1 * c1 - b1 * s1; v[3] = b1 * c1 + a1 * s1;
}
__device__ __forceinline__ float sigmoidf_(float x) { return 1.0f / (1.0f + __expf(-x)); }
__device__ __forceinline__ float logsigmoidf_(float x) { return fminf(x, 0.f) - log1pf(expf(-fabsf(x))); }

template <int MODE> struct Epi {
    static constexpr bool PERM = true, AFTER_DRAIN = false;
    bf16_t* O; int ldc; const float* bias; const float* rc; const float* rs; float* aux; const float* auxb;
    bf16_t* hm0; size_t hm_stride;
    __device__ __forceinline__ void operator()(const f32x4 (&acc)[2][2][4][2], const Unit& u, int wr, int wc, int fr, int fq) const {
        const int row0 = u.pm * BM + wr * 64 + fr;
        const int cw = wc * 32 + 8 * fq;
        const int colt = u.pn * BM;
        if (MODE == EM_NSA && u.pn == 10) {
            if (cw < 48) {
#pragma unroll
                for (int ai = 0; ai < 2; ++ai)
#pragma unroll
                    for (int m = 0; m < 4; ++m) { const size_t row = (size_t)(row0 + ai * HALF + m * 16); f32x4 v0 = acc[ai][0][m][0], v1 = acc[ai][0][m][1];
#pragma unroll
                        for (int j = 0; j < 4; ++j) { v0[j] = sigmoidf_(v0[j]); v1[j] = sigmoidf_(v1[j]); }
                        *(f32x4*)(aux + row * 48 + cw) = v0; *(f32x4*)(aux + row * 48 + cw + 4) = v1; }
            }
            return;
        }
        if (MODE == EM_FOX && u.pn == 12) {
            if (cw < 16) {
                const f32x4 b0 = *(const f32x4*)(auxb + cw), b1 = *(const f32x4*)(auxb + cw + 4);
#pragma unroll
                for (int ai = 0; ai < 2; ++ai)
#pragma unroll
                    for (int m = 0; m < 4; ++m) { const size_t row = (size_t)(row0 + ai * HALF + m * 16); f32x4 v0 = acc[ai][0][m][0] + b0, v1 = acc[ai][0][m][1] + b1;
#pragma unroll
                        for (int j = 0; j < 4; ++j) { v0[j] = logsigmoidf_(v0[j]); v1[j] = logsigmoidf_(v1[j]); }
                        *(f32x4*)(aux + row * 16 + cw) = v0; *(f32x4*)(aux + row * 16 + cw + 4) = v1; }
            }
            return;
        }
        bool rope0 = false, rope1 = false; float sc = 1.f;
        if (MODE == EM_NSA) { if (u.pn < 4) { rope0 = rope1 = true; sc = C2; } else if (!(u.pn & 1)) { rope0 = rope1 = true; } }
        if (MODE == EM_FOX) { if (u.pn < 4) sc = C2; }
        if (MODE == EM_SWA) { if (u.pn < 4) { rope0 = rope1 = true; sc = C2; } else { rope0 = true; } }
        f32x4 bv[2][2];
#pragma unroll
        for (int bj = 0; bj < 2; ++bj)
#pragma unroll
            for (int n = 0; n < 2; ++n) bv[bj][n] = bias ? *(const f32x4*)(bias + colt + bj * HALF + cw + 4 * n) : (f32x4){0.f, 0.f, 0.f, 0.f};
        const int ib = 16 * (wc & 1) + 4 * fq;
        bf16_t* base = O; int colo = colt; size_t rowo = 0;
        if (MODE == EM_CMP) { colo = 0; rowo = (size_t)u.pn * CMP_ROWS; }
        bool hm = false; bf16_t* hb[2] = {nullptr, nullptr}; int hd[2] = {0, 0}; int HG = 1;
        if (MODE == EM_FOX && u.pn >= 4) { hm = true; HG = 16; hb[0] = hb[1] = hm0 + (u.pn >= 8 ? hm_stride : 0); hd[0] = ((u.pn - 4) & 3) * 4 + (wc >> 1); hd[1] = hd[0] + 2; }
        if (MODE == EM_NSA && u.pn >= 6) { hm = true; HG = 4; hb[0] = hb[1] = hm0 + (size_t)(u.pn - 6) * hm_stride; hd[0] = (wc >> 1); hd[1] = hd[0] + 2; }
        if (MODE == EM_SWA && u.pn == 4) { hm = true; HG = 2; hb[0] = hm0; hb[1] = hm0 + hm_stride; hd[0] = hd[1] = (wc >> 1); }
#pragma unroll
        for (int ai = 0; ai < 2; ++ai)
#pragma unroll
            for (int m = 0; m < 4; ++m) {
                const int row = row0 + ai * HALF + m * 16;
                f32x4 cc = {1.f, 1.f, 1.f, 1.f}, ss = {0.f, 0.f, 0.f, 0.f};
                if (MODE == EM_NSA || MODE == EM_SWA) { if (rope0) { const int t = row & (T - 1); cc = *(const f32x4*)(rc + t * 32 + ib); ss = *(const f32x4*)(rs + t * 32 + ib); } }
                bf16_t* rowp = base + (rowo + (size_t)row) * ldc + colo + cw;
#pragma unroll
                for (int bj = 0; bj < 2; ++bj) {
                    f32x4 v0 = acc[ai][bj][m][0] + bv[bj][0], v1 = acc[ai][bj][m][1] + bv[bj][1];
                    if (MODE == EM_NSA || MODE == EM_SWA) { if (bj == 0 ? rope0 : rope1) { rope4(v0, cc[0], ss[0], cc[1], ss[1]); rope4(v1, cc[2], ss[2], cc[3], ss[3]); } }
                    if (MODE == EM_RELU2) {
#pragma unroll
                        for (int j = 0; j < 4; ++j) { const float a = fmaxf(v0[j], 0.f), b = fmaxf(v1[j], 0.f); v0[j] = a * a; v1[j] = b * b; } }
                    if (MODE == EM_CMP) {
#pragma unroll
                        for (int j = 0; j < 4; ++j) { v0[j] = v0[j] * sigmoidf_(v0[j]); v1[j] = v1[j] * sigmoidf_(v1[j]); } }
                    if (MODE == EM_NSA || MODE == EM_FOX || MODE == EM_SWA) { v0 = v0 * sc; v1 = v1 * sc; }
                    if ((MODE == EM_FOX || MODE == EM_NSA || MODE == EM_SWA) && hm) store8(hb[bj] + (((size_t)(row >> 11) * HG + hd[bj]) * T + (row & (T - 1))) * 64 + (cw & 63), v0, v1);
                    else store8(rowp + bj * HALF, v0, v1);
                }
            }
    }
};

template <class Epi, class Sched, int AMODE, bool ALIGN_EPI = false, bool SP2 = false>
__device__ __forceinline__ void gemm_phase(PG8_LAS unsigned char* lds, const Gemm g, const Sched& S, const Epi& E, int wave_id) {
    int tid_; { int x_; asm volatile("v_mbcnt_lo_u32_b32 %0, -1, 0\n\tv_mbcnt_hi_u32_b32 %0, -1, %0" : "=v"(x_)); tid_ = wave_id * 64 + x_; }
    const int tid = tid_, wid = __builtin_amdgcn_readfirstlane(tid >> 6), lane = tid & 63, wr = wid >> 2, wc = wid & 3, fr = lane & 15, fq = lane >> 4;
    const int K = g.K, nt = K / BK;
    unsigned voffA[2], voffB[2];
#pragma unroll
    for (int i = 0; i < 2; ++i) { int R, C; stage_rc(tid * 16 + i * 8192, R, C); const int Rb = Epi::PERM ? ((R & ~31) + perm32(R & 31)) : R;
        voffA[i] = (AMODE == 1) ? (unsigned)((16 * (R >> 2)) * CMP_LDP + (R & 3) * 64 + C) * 2u : (unsigned)(R * K + C) * 2u; voffB[i] = (unsigned)(Rb * K + C) * 2u; }
    const size_t kstepB = (size_t)(BK * 2);
    const size_t hstepB = (size_t)HALF * K * 2;
    const size_t tstepB = 2 * hstepB;
    const size_t kstepA = (AMODE == 1) ? (size_t)CMP_LDP * 2 : kstepB;
    const size_t hstepA = (AMODE == 1) ? (size_t)512 * CMP_LDP * 2 : hstepB;
    const size_t tstepA = 2 * hstepA;
    const size_t pnstepA = (AMODE == 1) ? (size_t)512 : (size_t)0;
    const unsigned ldsw = (unsigned)wid * 1024u;
    const int aoff = lds_byte(wr * 64 + fr, fq * 8), boff = lds_byte(wc * 32 + fr, fq * 8);
#define PG8_SA(b, h) (((b) * 2 + (h)) * HTB)
#define PG8_SB(b, h) ((4 + (b) * 2 + (h)) * HTB)
#define PG8_STAGE(bufoff, gbase, voff) do { _Pragma("unroll") for (int _i = 0; _i < 2; ++_i) \
        __builtin_amdgcn_global_load_lds((const unsigned*)((const char*)(gbase) + (voff)[_i]), (PG8_LAS unsigned*)(lds + (bufoff) + ldsw + _i * 8192), 16, 0, 0); } while (0)
#define PG8_LDA(dst, b, h) do { _Pragma("unroll") for (int m = 0; m < 4; ++m) _Pragma("unroll") for (int k = 0; k < 2; ++k) dst[m][k] = *(const PG8_LAS bf16x8*)(lds + PG8_SA(b, h) + aoff + m * 2048 + k * 1024); } while (0)
#define PG8_LDB(dst, b, h) do { _Pragma("unroll") for (int n = 0; n < 2; ++n) _Pragma("unroll") for (int k = 0; k < 2; ++k) dst[n][k] = *(const PG8_LAS bf16x8*)(lds + PG8_SB(b, h) + boff + n * 2048 + k * 1024); } while (0)
#define PG8_MMA(ai, bj, At, Bt) do { __builtin_amdgcn_s_setprio(1); _Pragma("unroll") for (int m = 0; m < 4; ++m) _Pragma("unroll") for (int n = 0; n < 2; ++n) _Pragma("unroll") for (int k = 0; k < 2; ++k) \
        acc[ai][bj][m][n] = __builtin_amdgcn_mfma_f32_16x16x32_bf16(Bt[n][k], At[m][k], acc[ai][bj][m][n], 0, 0, 0); __builtin_amdgcn_s_setprio(0); } while (0)
#define PG8_WAIT_V(n) asm volatile("s_waitcnt vmcnt(" #n ")" ::: "memory")
#define PG8_WAIT_L(n) asm volatile("s_waitcnt lgkmcnt(" #n ")" ::: "memory")
#define PG8_BAR __builtin_amdgcn_s_barrier()
#define PG8_SCHED __builtin_amdgcn_sched_barrier(0)
    Unit cur, nxt; int ui = 0;
    if (!S.next(0, cur)) return;
    f32x4 acc[2][2][4][2];
#pragma unroll
    for (int a = 0; a < 2; ++a)
#pragma unroll
        for (int b = 0; b < 2; ++b)
#pragma unroll
            for (int m = 0; m < 4; ++m)
#pragma unroll
                for (int n = 0; n < 2; ++n) acc[a][b][m][n] = (f32x4){0.f, 0.f, 0.f, 0.f};
    bf16x8 At[4][2], B0[2][2], B1[2][2];
    const char* cA = (const char*)g.A + (size_t)cur.pm * tstepA + (size_t)cur.pn * pnstepA; const char* cB = (const char*)g.Bt + (size_t)cur.pn * tstepB;
    S.a_ready(cur);
    if constexpr (SP2) {
        PG8_STAGE(PG8_SB(0, 0), cB, voffB); PG8_STAGE(PG8_SB(0, 1), cB + hstepB, voffB); PG8_STAGE(PG8_SA(0, 0), cA, voffA); PG8_STAGE(PG8_SA(0, 1), cA + hstepA, voffA);
        if (wr == 1) PG8_BAR;
        PG8_WAIT_V(2); PG8_BAR;
        PG8_STAGE(PG8_SB(1, 0), cB + kstepB, voffB); PG8_STAGE(PG8_SA(1, 0), cA + kstepA, voffA); PG8_STAGE(PG8_SB(1, 1), cB + hstepB + kstepB, voffB);
        PG8_WAIT_V(6); PG8_BAR;
    } else {
        PG8_STAGE(PG8_SB(0, 0), cB, voffB); PG8_STAGE(PG8_SA(0, 0), cA, voffA); PG8_STAGE(PG8_SB(0, 1), cB + hstepB, voffB); PG8_STAGE(PG8_SA(0, 1), cA + hstepA, voffA);
        if (wr == 1) PG8_BAR;
        PG8_WAIT_V(4); PG8_BAR;
        PG8_STAGE(PG8_SB(1, 0), cB + kstepB, voffB); PG8_STAGE(PG8_SA(1, 0), cA + kstepA, voffA); PG8_STAGE(PG8_SB(1, 1), cB + hstepB + kstepB, voffB);
        PG8_WAIT_V(6); PG8_BAR;
    }
    for (;;) {
        const bool has_next = S.next(ui + 1, nxt);
        const char* nA = has_next ? (const char*)g.A + (size_t)nxt.pm * tstepA + (size_t)nxt.pn * pnstepA : cA; const char* nB = has_next ? (const char*)g.Bt + (size_t)nxt.pn * tstepB : cB;
        for (int t = 0; t < nt; t += 2) {
            const bool last = (t == nt - 2);
            const char* a1 = cA + (size_t)(t + 1) * kstepA;
            const char* a2 = last ? nA : cA + (size_t)(t + 2) * kstepA; const char* b2 = last ? nB : cB + (size_t)(t + 2) * kstepB;
            const char* a3 = a2 + kstepA; const char* b3 = b2 + kstepB;
            if (last && has_next) S.a_ready(nxt);
            if constexpr (SP2) {
            PG8_LDB(B0, 0, 0); PG8_LDB(B1, 0, 1); PG8_SCHED; PG8_LDA(At, 0, 0); PG8_STAGE(PG8_SA(1, 1), a1 + hstepA, voffA);
            PG8_WAIT_V(8); PG8_WAIT_L(0); PG8_BAR; PG8_MMA(0, 0, At, B0); PG8_MMA(0, 1, At, B1); PG8_BAR; PG8_SCHED;
            PG8_LDA(At, 0, 1); PG8_STAGE(PG8_SB(0, 0), b2, voffB); PG8_STAGE(PG8_SB(0, 1), b2 + hstepB, voffB); PG8_STAGE(PG8_SA(0, 0), a2, voffA);
            PG8_WAIT_V(8); PG8_WAIT_L(0); PG8_BAR; PG8_MMA(1, 0, At, B0); PG8_MMA(1, 1, At, B1); PG8_BAR; PG8_SCHED;
            PG8_LDB(B0, 1, 0); PG8_LDB(B1, 1, 1); PG8_SCHED; PG8_LDA(At, 1, 0); PG8_STAGE(PG8_SA(0, 1), a2 + hstepA, voffA);
            PG8_WAIT_V(8); PG8_WAIT_L(0); PG8_BAR; PG8_MMA(0, 0, At, B0); PG8_MMA(0, 1, At, B1); PG8_BAR; PG8_SCHED;
            PG8_LDA(At, 1, 1); PG8_STAGE(PG8_SB(1, 0), b3, voffB); PG8_STAGE(PG8_SB(1, 1), b3 + hstepB, voffB); PG8_STAGE(PG8_SA(1, 0), a3, voffA);
            PG8_WAIT_V(8); PG8_WAIT_L(0); PG8_BAR; PG8_MMA(1, 0, At, B0); PG8_MMA(1, 1, At, B1); PG8_BAR; PG8_SCHED;
            } else {
            PG8_LDB(B0, 0, 0); PG8_SCHED; PG8_LDA(At, 0, 0); PG8_STAGE(PG8_SA(1, 1), a1 + hstepA, voffA);
            PG8_WAIT_L(8); PG8_BAR; PG8_WAIT_L(0); PG8_MMA(0, 0, At, B0); PG8_BAR; PG8_SCHED;
            PG8_LDB(B1, 0, 1); PG8_STAGE(PG8_SB(0, 0), b2, voffB);
            PG8_BAR; PG8_WAIT_L(0); PG8_MMA(0, 1, At, B1); PG8_BAR;
            PG8_LDA(At, 0, 1); PG8_STAGE(PG8_SA(0, 0), a2, voffA);
            PG8_BAR; PG8_WAIT_L(0); PG8_MMA(1, 0, At, B0); PG8_BAR; PG8_SCHED;
            PG8_STAGE(PG8_SB(0, 1), b2 + hstepB, voffB);
            PG8_WAIT_V(6); PG8_BAR; PG8_MMA(1, 1, At, B1); PG8_BAR;
            PG8_LDB(B0, 1, 0); PG8_SCHED; PG8_LDA(At, 1, 0); PG8_STAGE(PG8_SA(0, 1), a2 + hstepA, voffA);
            PG8_WAIT_L(8); PG8_BAR; PG8_WAIT_L(0); PG8_MMA(0, 0, At, B0); PG8_BAR; PG8_SCHED;
            PG8_LDB(B1, 1, 1); PG8_STAGE(PG8_SB(1, 0), b3, voffB);
            PG8_BAR; PG8_WAIT_L(0); PG8_MMA(0, 1, At, B1); PG8_BAR;
            PG8_LDA(At, 1, 1); PG8_STAGE(PG8_SA(1, 0), a3, voffA);
            PG8_BAR; PG8_WAIT_L(0); PG8_MMA(1, 0, At, B0); PG8_BAR; PG8_SCHED;
            PG8_STAGE(PG8_SB(1, 1), b3 + hstepB, voffB);
            PG8_WAIT_V(6); PG8_BAR; PG8_MMA(1, 1, At, B1); PG8_BAR;
            }
        }
        if constexpr (ALIGN_EPI) { if (wr == 0) PG8_BAR; }
        if constexpr (!Epi::AFTER_DRAIN) { E(acc, cur, wr, wc, fr, fq); S.done(cur); }
        if (!has_next) break;
#pragma unroll
        for (int a = 0; a < 2; ++a)
#pragma unroll
            for (int b = 0; b < 2; ++b)
#pragma unroll
                for (int m = 0; m < 4; ++m)
#pragma unroll
                    for (int n = 0; n < 2; ++n) acc[a][b][m][n] = (f32x4){0.f, 0.f, 0.f, 0.f};
        cur = nxt; cA = nA; cB = nB; ++ui;
        if constexpr (ALIGN_EPI) { if (wr == 1) PG8_BAR; }
    }
    PG8_WAIT_V(0);
    if constexpr (!ALIGN_EPI) { if (wr == 0) PG8_BAR; }
    PG8_BAR;
    if constexpr (Epi::AFTER_DRAIN) { E.fused(acc, cur, wr, wc, fr, fq, lds, wid, lane); S.done(cur); }
#undef PG8_SA
#undef PG8_SB
#undef PG8_STAGE
#undef PG8_LDA
#undef PG8_LDB
#undef PG8_MMA
#undef PG8_WAIT_V
#undef PG8_WAIT_L
#undef PG8_BAR
#undef PG8_SCHED
}
}

namespace att {
constexpr int SLOTB = 8192;
constexpr int NSLOT = 4;
constexpr int L_K = 0, L_V = 32768, L_WS = 65536, L_OST = 67584, L_PSUM = L_OST, L_IMP = 133120, L_KB = L_IMP, L_SEL = 141312, L_END = 141568;
constexpr float PFIX = 268435456.0f;
constexpr float THR = 8.0f;

__device__ __forceinline__ int crow(int r, int hh) { return (r & 3) + 8 * (r >> 2) + 4 * hh; }
typedef float f32x2_t __attribute__((ext_vector_type(2))); typedef __bf16 bf16x2_t __attribute__((ext_vector_type(2)));
__device__ __forceinline__ unsigned cvtpk_s(float lo, float hi) { f32x2_t v = {lo, hi}; bf16x2_t b = __builtin_convertvector(v, bf16x2_t); return __builtin_bit_cast(unsigned, b); }
typedef short v4i16_t __attribute__((ext_vector_type(4)));
__device__ __forceinline__ s16x4 vtr(const LAS unsigned char* p) { return __builtin_bit_cast(s16x4, __builtin_amdgcn_ds_read_tr16_b64_v4i16((LAS v4i16_t*)p)); }
__device__ __forceinline__ float swap_sum(float v) { auto rr = __builtin_amdgcn_permlane32_swap(__float_as_uint(v), __float_as_uint(v), false, false); return __uint_as_float(rr[0]) + __uint_as_float(rr[1]); }
__device__ __forceinline__ float swap_max(float v) { auto rr = __builtin_amdgcn_permlane32_swap(__float_as_uint(v), __float_as_uint(v), false, false); return fmaxf(__uint_as_float(rr[0]), __uint_as_float(rr[1])); }
__device__ __forceinline__ bool trailing_half(int wid) { asm volatile("" : "+s"(wid)); return (wid >> 2) != 0; }
#define ATT_BAR() do { __builtin_amdgcn_s_barrier(); asm volatile("" ::: "memory"); } while (0)

__device__ __forceinline__ void dma_tile(const bf16_t* Kb, const bf16_t* Vb, int pitch, int tile, LAS unsigned char* shm, int slot, int wid, int lane) {
    const bf16_t* ks = Kb + (size_t)(tile * 64 + lane) * pitch + wid * 8;
    const bf16_t* vs = Vb + (size_t)(tile * 64 + 16 * (wid & 3) + (lane >> 2)) * pitch + (wid >> 2) * 32 + (lane & 3) * 8;
    __builtin_amdgcn_global_load_lds((const unsigned*)ks, (LAS unsigned*)(shm + L_K + slot * SLOTB + wid * 1024), 16, 0, 0);
    __builtin_amdgcn_global_load_lds((const unsigned*)vs, (LAS unsigned*)(shm + L_V + slot * SLOTB + wid * 1024), 16, 0, 0);
#ifdef PROBE_DMA2
    __builtin_amdgcn_global_load_lds((const unsigned*)ks, (LAS unsigned*)(shm + L_K + slot * SLOTB + wid * 1024), 16, 0, 0);
    __builtin_amdgcn_global_load_lds((const unsigned*)vs, (LAS unsigned*)(shm + L_V + slot * SLOTB + wid * 1024), 16, 0, 0);
#endif
}
#ifdef PROBE_DMA2
#define VMW2 "4"
#define VMW4 "8"
#else
#define VMW2 "2"
#define VMW4 "4"
#endif
__device__ __forceinline__ void qkt(f32x16& p0, f32x16& p1, const LAS unsigned char* shm, int slot, const bf16x8 (&qr)[4], const f32x16& cinit, int r32, int hh) {
    const LAS unsigned char* kb = shm + L_K + slot * SLOTB + hh * 1024 + r32 * 16;
#pragma unroll
    for (int d0 = 0; d0 < 4; ++d0) {
        const bf16x8 b0 = *(const LAS bf16x8*)(kb + d0 * 2048), b1 = *(const LAS bf16x8*)(kb + d0 * 2048 + 512);
        if (d0 == 0) { p0 = __builtin_amdgcn_mfma_f32_32x32x16_bf16(b0, qr[0], cinit, 0, 0, 0); p1 = __builtin_amdgcn_mfma_f32_32x32x16_bf16(b1, qr[0], cinit, 0, 0, 0); }
        else { p0 = __builtin_amdgcn_mfma_f32_32x32x16_bf16(b0, qr[d0], p0, 0, 0, 0); p1 = __builtin_amdgcn_mfma_f32_32x32x16_bf16(b1, qr[d0], p1, 0, 0, 0); }
        if (d0 == 1) asm volatile("" ::: "memory");
    }
}
__device__ __forceinline__ void load_k(bf16x8 (&kf)[8], const LAS unsigned char* shm, int slot, int r32, int hh) {
    const LAS unsigned char* kb = shm + L_K + slot * SLOTB + hh * 1024 + r32 * 16;
#pragma unroll
    for (int d0 = 0; d0 < 4; ++d0) { kf[2 * d0] = *(const LAS bf16x8*)(kb + d0 * 2048); kf[2 * d0 + 1] = *(const LAS bf16x8*)(kb + d0 * 2048 + 512); }
}
__device__ __forceinline__ void mma_qk(f32x16& p0, f32x16& p1, const bf16x8 (&kf)[8], const bf16x8 (&qr)[4], const f32x16& cinit) {
    p0 = __builtin_amdgcn_mfma_f32_32x32x16_bf16(kf[0], qr[0], cinit, 0, 0, 0); p1 = __builtin_amdgcn_mfma_f32_32x32x16_bf16(kf[1], qr[0], cinit, 0, 0, 0);
#pragma unroll
    for (int d0 = 1; d0 < 4; ++d0) { p0 = __builtin_amdgcn_mfma_f32_32x32x16_bf16(kf[2 * d0], qr[d0], p0, 0, 0, 0); p1 = __builtin_amdgcn_mfma_f32_32x32x16_bf16(kf[2 * d0 + 1], qr[d0], p1, 0, 0, 0); }
}
__device__ __forceinline__ void load_v(bf16x8 (&vf)[8], const LAS unsigned char* shm, int slot, int lane, int hh) {
    const LAS unsigned char* vb = shm + L_V + slot * SLOTB + ((lane >> 4) & 1) * 32 + (lane & 3) * 8 + (4 * hh + ((lane & 15) >> 2)) * 64;
#pragma unroll
    for (int ks = 0; ks < 4; ++ks)
#pragma unroll
        for (int d0 = 0; d0 < 2; ++d0) {
            const s16x4 vl = vtr(vb + d0 * 4096 + ks * 1024), vh = vtr(vb + d0 * 4096 + ks * 1024 + 512);
            vf[2 * ks + d0] = (bf16x8){vl[0], vl[1], vl[2], vl[3], vh[0], vh[1], vh[2], vh[3]};
        }
}
__device__ __forceinline__ void mma_pv(f32x16 (&o)[2], const u32x4 (&pw)[4], const bf16x8 (&vf)[8]) {
#pragma unroll
    for (int ks = 0; ks < 4; ++ks)
#pragma unroll
        for (int d0 = 0; d0 < 2; ++d0) o[d0] = __builtin_amdgcn_mfma_f32_32x32x16_bf16(__builtin_bit_cast(bf16x8, pw[ks]), vf[2 * ks + d0], o[d0], 0, 0, 0);
}
__device__ __forceinline__ void pv_seq(f32x16 (&o)[2], const u32x4 (&pw)[4], const LAS unsigned char* shm, int slot, int lane, int hh) {
    const LAS unsigned char* vb = shm + L_V + slot * SLOTB + ((lane >> 4) & 1) * 32 + (lane & 3) * 8 + (4 * hh + ((lane & 15) >> 2)) * 64;
#pragma unroll
    for (int ks = 0; ks < 4; ++ks) {
#pragma unroll
        for (int d0 = 0; d0 < 2; ++d0) {
            const s16x4 vl = vtr(vb + d0 * 4096 + ks * 1024), vh = vtr(vb + d0 * 4096 + ks * 1024 + 512);
            const bf16x8 vf = {vl[0], vl[1], vl[2], vl[3], vh[0], vh[1], vh[2], vh[3]};
            o[d0] = __builtin_amdgcn_mfma_f32_32x32x16_bf16(__builtin_bit_cast(bf16x8, pw[ks]), vf, o[d0], 0, 0, 0);
        }
        if (ks == 1) asm volatile("" ::: "memory");
    }
}
__device__ __forceinline__ void range_mask(f32x16& p0, f32x16& p1, int kb, int lo, int hi) {
#pragma unroll
    for (int r = 0; r < 16; ++r) { const int k = kb + (r & 3) + 8 * (r >> 2); if (k < lo || k > hi) p0[r] = -INFINITY; if (k + 32 < lo || k + 32 > hi) p1[r] = -INFINITY; }
}
__device__ __forceinline__ void rescale_o(f32x16 (&o)[2], const LAS float* wsf, int hh) {
#pragma unroll
    for (int g = 0; g < 4; ++g) { const f32x4 a4 = *(const LAS f32x4*)(wsf + 8 * g + 4 * hh);
#pragma unroll
        for (int j = 0; j < 4; ++j) { o[0][4 * g + j] *= a4[j]; o[1][4 * g + j] *= a4[j]; } }
}

__device__ __forceinline__ float max3f(float a, float b, float c) { float r; asm("v_max3_f32 %0, %1, %2, %3" : "=v"(r) : "v"(a), "v"(b), "v"(c)); return r; }
template <int MODE, bool NOMAX, bool LEAN = false>
__device__ __forceinline__ void sweep(f32x16 (&o)[2], float& mhat, float& l, const bf16x8 (&qr)[4], const bf16_t* Kb, const bf16_t* Vb, int pitch, int t0, int NT, int lo, int hi,
                                      unsigned rowsel, LAS unsigned char* shm, int& ring, int wid, int lane) {
    static_assert(!(MODE == 1 && NOMAX), "the FoX key bias grows without bound: it needs the running max");
    asm volatile("" : "+v"(lane));
    const int r32 = lane & 31, hh = lane >> 5;
    LAS float* wsf = (LAS float*)(shm + L_WS + wid * 256);
    const int lo_max = __builtin_amdgcn_readlane(lo, 31), hi_min = __builtin_amdgcn_readfirstlane(hi);
#define RING_NEXT(x) (((x) + 1) & (NSLOT - 1))
    int s_pv = ring, s_qk = ring, s_dma = ring;
    dma_tile(Kb, Vb, pitch, t0, shm, s_dma, wid, lane); s_dma = RING_NEXT(s_dma);
    if (NT > 1) { dma_tile(Kb, Vb, pitch, t0 + 1, shm, s_dma, wid, lane); s_dma = RING_NEXT(s_dma); }
    if (NT > 2) { dma_tile(Kb, Vb, pitch, t0 + 2, shm, s_dma, wid, lane); s_dma = RING_NEXT(s_dma); }
    if (NT > 2) asm volatile("s_waitcnt vmcnt(4)" ::: "memory"); else if (NT > 1) asm volatile("s_waitcnt vmcnt(2)" ::: "memory"); else asm volatile("s_waitcnt vmcnt(0)" ::: "memory");
    ATT_BAR();
    if (trailing_half(wid)) ATT_BAR();
    f32x16 s0, s1, cini; u32x4 pw[4]; float alpha = 1.0f;
#pragma unroll
    for (int r = 0; r < 16; ++r) cini[r] = 0.f;
    if (MODE == 2) { const float c0 = ((rowsel >> t0) & 1u) ? 0.f : -INFINITY;
#pragma unroll
        for (int r = 0; r < 16; ++r) cini[r] = c0; }
    bf16x8 kf[8], vf[8];
    if (LEAN) qkt(s0, s1, shm, s_qk, qr, cini, r32, hh);
    else { load_k(kf, shm, s_qk, r32, hh); mma_qk(s0, s1, kf, qr, cini); }
    s_qk = RING_NEXT(s_qk);
    for (int j = 0;; ++j) {
        asm volatile("s_waitcnt lgkmcnt(0)" ::: "memory");
        if (trailing_half(wid)) { if (j + 2 < NT) asm volatile("s_waitcnt vmcnt(2)" ::: "memory"); else asm volatile("s_waitcnt vmcnt(0)" ::: "memory"); }
        ATT_BAR();
        if (trailing_half(wid) && j + 3 < NT) { dma_tile(Kb, Vb, pitch, t0 + j + 3, shm, s_dma, wid, lane); }
        {
            const int tile = t0 + j;
            if (MODE == 1) { const LAS float* kb = (const LAS float*)(shm + L_KB) + tile * 64 + 4 * hh;
#pragma unroll
                for (int k = 0; k < 4; ++k) { const f32x4 b0 = *(const LAS f32x4*)(kb + 8 * k), b1 = *(const LAS f32x4*)(kb + 32 + 8 * k);
#pragma unroll
                    for (int e = 0; e < 4; ++e) { s0[4 * k + e] += b0[e]; s1[4 * k + e] += b1[e]; } } }
            if (tile * 64 < lo_max || tile * 64 + 63 > hi_min) range_mask(s0, s1, tile * 64 + 4 * hh, lo, hi);
            if (!NOMAX) {
                float ra = max3f(s0[0], s0[1], s1[0]), rb = max3f(s0[2], s0[3], s1[1]); ra = max3f(ra, s1[2], s1[3]);
#pragma unroll
                for (int r = 4; r < 16; r += 4) { ra = max3f(ra, s0[r], s0[r + 1]); rb = max3f(rb, s0[r + 2], s0[r + 3]); ra = max3f(ra, s1[r], s1[r + 1]); rb = max3f(rb, s1[r + 2], s1[r + 3]); }
                float rm = swap_max(fmaxf(ra, rb));
                const bool first = (j == 0);
                alpha = 1.0f;
                if (first || __any(rm > THR)) {
                    float dl = first ? rm : fmaxf(rm, 0.f); if (dl == -INFINITY) dl = 0.f;
                    mhat += dl;
#pragma unroll
                    for (int r = 0; r < 16; ++r) { s0[r] -= dl; s1[r] -= dl; cini[r] = -mhat; }
                    if (!first) { alpha = __builtin_amdgcn_exp2f(-dl); l *= alpha; }
                }
                if (hh == 0) wsf[r32] = alpha;
            }
            float ls0 = 0.f, ls1 = 0.f;
#pragma unroll
            for (int r = 0; r < 16; ++r) { s0[r] = __builtin_amdgcn_exp2f(s0[r]); s1[r] = __builtin_amdgcn_exp2f(s1[r]); ls0 += s0[r]; ls1 += s1[r]; }
            l += ls0 + ls1;
#ifdef PROBE_EXTRA_EXP
            { float dm_ = 0.f;
#pragma unroll
              for (int r = 0; r < 16; ++r) { float t0_ = s0[r] * 0.5f, t1_ = s1[r] * 0.5f; asm volatile("v_exp_f32 %0, %0\n\tv_exp_f32 %1, %1\n\tv_exp_f32 %0, %0\n\tv_exp_f32 %1, %1" : "+v"(t0_), "+v"(t1_)); dm_ += t0_ + t1_; }
              asm volatile("" :: "v"(dm_)); }
#endif
#pragma unroll
            for (int e = 0; e < 4; ++e) { pw[0][e] = cvtpk_s(s0[2 * e], s0[2 * e + 1]); pw[1][e] = cvtpk_s(s0[8 + 2 * e], s0[9 + 2 * e]); pw[2][e] = cvtpk_s(s1[2 * e], s1[2 * e + 1]); pw[3][e] = cvtpk_s(s1[8 + 2 * e], s1[9 + 2 * e]); }
            if (MODE == 2) { const float c1 = ((rowsel >> (tile + 1)) & 1u) ? 0.f : -INFINITY;
#pragma unroll
                for (int r = 0; r < 16; ++r) cini[r] = c1; }
        }
        if (!trailing_half(wid)) { if (j + 2 < NT) asm volatile("s_waitcnt vmcnt(2)" ::: "memory"); else asm volatile("s_waitcnt vmcnt(0)" ::: "memory"); }
        ATT_BAR();
        if (j + 1 >= NT) break;
        if (!trailing_half(wid) && j + 3 < NT) { dma_tile(Kb, Vb, pitch, t0 + j + 3, shm, s_dma, wid, lane); }
        s_dma = RING_NEXT(s_dma);
        if (LEAN) {
            if (!NOMAX) rescale_o(o, wsf, hh);
            pv_seq(o, pw, shm, s_pv, lane, hh);
            qkt(s0, s1, shm, s_qk, qr, cini, r32, hh);
        } else {
            load_v(vf, shm, s_pv, lane, hh);
            load_k(kf, shm, s_qk, r32, hh);
            __builtin_amdgcn_sched_barrier(0);
            if (!NOMAX) rescale_o(o, wsf, hh);
            mma_pv(o, pw, vf);
            __builtin_amdgcn_sched_barrier(0);
            mma_qk(s0, s1, kf, qr, cini);
        }
        s_pv = RING_NEXT(s_pv); s_qk = RING_NEXT(s_qk);
    }
    if (!NOMAX) rescale_o(o, wsf, hh);
    if (LEAN) pv_seq(o, pw, shm, s_pv, lane, hh); else { load_v(vf, shm, s_pv, lane, hh); mma_pv(o, pw, vf); }
    asm volatile("s_waitcnt lgkmcnt(0)" ::: "memory");
    if (!trailing_half(wid)) ATT_BAR();
    ring = s_qk;
#undef RING_NEXT
}
template <bool FIRST>
__device__ __forceinline__ void merge(const f32x16 (&o)[2], float scale, LAS unsigned char* shm, int wid, int r32, int hh) {
    LAS float* wsf = (LAS float*)(shm + L_WS + wid * 256);
    LAS float* stg = (LAS float*)(shm + L_OST + wid * 8192) + r32;
    if (hh == 0) wsf[r32] = scale;
#pragma unroll
    for (int g = 0; g < 4; ++g) { const f32x4 s4 = *(const LAS f32x4*)(wsf + 8 * g + 4 * hh);
#pragma unroll
        for (int j = 0; j < 4; ++j) { LAS float* p = stg + (8 * g + 4 * hh + j) * 64;
            if (FIRST) { p[0] = o[0][4 * g + j] * s4[j]; p[32] = o[1][4 * g + j] * s4[j]; }
            else { p[0] += o[0][4 * g + j] * s4[j]; p[32] += o[1][4 * g + j] * s4[j]; } } }
}
__device__ __forceinline__ void store_o(bf16_t* Ow, LAS unsigned char* shm, int wid, int lane) {
    const LAS float* stg = (const LAS float*)(shm + L_OST + wid * 8192);
#pragma unroll
    for (int i = 0; i < 4; ++i) { const int rowl = i * 8 + (lane >> 3), ch = lane & 7; const f32x4 a = *(const LAS f32x4*)(stg + rowl * 64 + ch * 8), c = *(const LAS f32x4*)(stg + rowl * 64 + ch * 8 + 4);
        u32x4 v; v.x = cvtpk_s(a[0], a[1]); v.y = cvtpk_s(a[2], a[3]); v.z = cvtpk_s(c[0], c[1]); v.w = cvtpk_s(c[2], c[3]); *(GAS u32x4*)(Ow + (size_t)rowl * D + ch * 8) = v; }
}
__device__ __forceinline__ void zero_o(f32x16 (&o)[2]) { o[0] = (f32x16){0.f, 0.f, 0.f, 0.f, 0.f, 0.f, 0.f, 0.f, 0.f, 0.f, 0.f, 0.f, 0.f, 0.f, 0.f, 0.f}; o[1] = o[0]; }
#define ATT_LOADQ(Qrow_) bf16x8 qr[4]; _Pragma("unroll") for (int d0 = 0; d0 < 4; ++d0) qr[d0] = *(const GAS bf16x8*)((Qrow_) + d0 * 16 + hh * 8)

__device__ __forceinline__ void fox_unit(LAS unsigned char* shm, int b, int h, int qb, unsigned char* ws_, size_t off_p, size_t off_cb, size_t off_o, int wid, int& ring) {
    const int lane = lane_id_volatile();
    unsigned char* ws = ws_; asm volatile("" : "+s"(ws)); const bf16_t* P = (const bf16_t*)(ws + off_p); const float* CB = (const float*)(ws + off_cb); bf16_t* O = (bf16_t*)(ws + off_o);
    const int r32 = lane & 31, hh = lane >> 5;
    const int pos = 256 * qb + 32 * wid + r32;
    const size_t row = (size_t)b * T + pos;
    ATT_LOADQ(P + row * FOX_LDP + h * 64);
    const bf16_t* Kb = (const bf16_t*)(ws + off_p + FOX_HM_OFF) + (size_t)(b * NH + h) * T * 64; const bf16_t* Vb = Kb + FOX_HM_STRIDE;
    f32x16 o[2]; zero_o(o); float m = 0.f, l = 0.f;
    { const float* cb = CB + (size_t)(b * NH + h) * T; LAS float* kbl = (LAS float*)(shm + L_KB);
      for (int i = wid * 64 + lane; i < 64 * (4 * qb + 4); i += 512) kbl[i] = cb[i]; }
    sweep<1, false>(o, m, l, qr, Kb, Vb, 64, 0, 4 * qb + 4, 0, pos, 0u, shm, ring, wid, lane);
    const float lt = swap_sum(l); const float inv = lt > 0.f ? 1.0f / lt : 0.f;
    merge<true>(o, inv, shm, wid, r32, hh);
    store_o(O + ((size_t)b * T + 256 * qb + 32 * wid) * D + h * 64, shm, wid, lane);
}
__device__ __forceinline__ void swa_unit(LAS unsigned char* shm, int b, int g, int qt, unsigned char* ws_, size_t off_p, size_t off_o, const float* sinks, int wid, int& ring) {
    const int lane = lane_id_volatile();
    unsigned char* ws = ws_; asm volatile("" : "+s"(ws)); const bf16_t* P = (const bf16_t*)(ws + off_p); bf16_t* O = (bf16_t*)(ws + off_o);
    const int r32 = lane & 31, hh = lane >> 5;
    const int q0 = 32 * qt, pos = q0 + r32, head = 8 * g + wid;
    const size_t row = (size_t)b * T + pos;
    ATT_LOADQ(P + row * SWA_LDP + head * 64);
    const bf16_t* Kb = (const bf16_t*)(ws + off_p + SWA_HM_OFF) + (size_t)(b * 2 + g) * T * 64; const bf16_t* Vb = Kb + SWA_HM_STRIDE;
    f32x16 o[2]; zero_o(o); float m = 0.f, l = 0.f;
    const int tlo = (q0 - 127) > 0 ? ((q0 - 127) >> 6) : 0, thi = (q0 + 31) >> 6;
    sweep<0, true, true>(o, m, l, qr, Kb, Vb, 64, tlo, thi - tlo + 1, pos - 127, pos, 0u, shm, ring, wid, lane);
    const float lt = swap_sum(l) + __builtin_amdgcn_exp2f(sinks[head] * LOG2E - m);
    const float inv = 1.0f / lt;
    merge<true>(o, inv, shm, wid, r32, hh);
    store_o(O + ((size_t)b * T + q0) * D + head * 64, shm, wid, lane);
}
__device__ __forceinline__ void nsa_unit(LAS unsigned char* shm, int b, int g, int qt, unsigned char* ws_, size_t off_p, size_t off_g, size_t off_kc, size_t off_vc, size_t off_o, int wid, int& ring) {
#define NSA_WS() unsigned char* ws = ws_; asm volatile("" : "+s"(ws)); const bf16_t* P = (const bf16_t*)(ws + off_p); const float* G = (const float*)(ws + off_g); const bf16_t* Hb = (const bf16_t*)(ws + off_p + NSA_HM_OFF) + (size_t)(b * 4 + g) * T * 64; (void)G; (void)Hb
    const int hq = 4 * g + (wid >> 1), ph = wid & 1, q0 = 64 * qt;
    LAS unsigned* PSUM = (LAS unsigned*)(shm + L_PSUM); LAS float* IMP = (LAS float*)(shm + L_IMP); LAS unsigned* SEL = (LAS unsigned*)(shm + L_SEL);
#define NSA_LANE() const int lane = lane_id_volatile(); const int r32 = lane & 31, hh = lane >> 5; const int pos = q0 + 32 * ph + r32; const size_t row = (size_t)b * T + pos; (void)hh; (void)row
#define NSA_QROW (P + row * NSA_LDP + hq * 64)
    asm volatile("s_waitcnt lgkmcnt(0)" ::: "memory"); ATT_BAR();
    { const int tid = wid * 64 + lane_id_volatile(); for (int i = tid; i < 8192; i += 512) PSUM[i] = 0u; }
    f32x16 ocmp[2]; float inv_cmp;
    {
        NSA_LANE(); NSA_WS();
        const bf16_t* Kb = (const bf16_t*)(ws + off_kc) + (size_t)(b * 4 + g) * NCP * 64; const bf16_t* Vb = (const bf16_t*)(ws + off_vc) + (size_t)(b * 4 + g) * NCP * 64;
        const int cm = (pos < 31) ? -1 : (((pos - 31) >> 4) < 126 ? ((pos - 31) >> 4) : 126);
        const int ntile = qt >= 16 ? 2 : 1;
        ATT_LOADQ(NSA_QROW);
        f32x16 o[2]; zero_o(o); float m = 0.f, l = 0.f;
        const int ring0 = ring;
        sweep<0, true>(o, m, l, qr, Kb, Vb, 64, 0, ntile, 0, cm, 0u, shm, ring, wid, lane);
        const float lt = swap_sum(l); const float inv = lt > 0.f ? 1.0f / lt : 0.f;
        f32x16 negm;
#pragma unroll
        for (int r = 0; r < 16; ++r) negm[r] = -m;
        for (int tile = 0; tile < ntile; ++tile) {
            const int sl = (ring0 + tile) & (NSLOT - 1);
            f32x16 p0, p1; qkt(p0, p1, shm, sl, qr, negm, r32, hh);
            range_mask(p0, p1, tile * 64 + 4 * hh, 0, cm);
            LAS unsigned* pb = PSUM + (tile * 64 + 4 * hh) * 64 + 32 * ph + r32;
            asm volatile("" : "+v"(pb));
#pragma unroll
            for (int r = 0; r < 16; ++r) {
                const float a = __builtin_amdgcn_exp2f(p0[r]) * inv, c = __builtin_amdgcn_exp2f(p1[r]) * inv;
                __hip_atomic_fetch_add(pb + ((r & 3) + 8 * (r >> 2)) * 64, (unsigned)(a * PFIX + 0.5f), __ATOMIC_RELAXED, __HIP_MEMORY_SCOPE_WORKGROUP);
                __hip_atomic_fetch_add(pb + ((r & 3) + 8 * (r >> 2) + 32) * 64, (unsigned)(c * PFIX + 0.5f), __ATOMIC_RELAXED, __HIP_MEMORY_SCOPE_WORKGROUP);
            }
        }
        ocmp[0] = o[0]; ocmp[1] = o[1]; inv_cmp = inv;
    }
    asm volatile("s_waitcnt lgkmcnt(0)" ::: "memory"); ATT_BAR();
    {
        const int tid = wid * 64 + lane_id_volatile();
        const int rw = tid & 63, ng = tid >> 6;
        LAS unsigned* pb = PSUM + (16 * ng - 1) * 64 + rw;
        LAS float* ib = IMP + (4 * ng) * 64 + rw;
        asm volatile("" : "+v"(pb), "+v"(ib));
        float pc[17];
#pragma unroll
        for (int e = 0; e < 17; ++e) pc[e] = (float)pb[e * 64] * (1.0f / PFIX);
        if (ng == 0) pc[0] = 0.f;
#pragma unroll
        for (int k = 0; k < 4; ++k) ib[k * 64] = pc[4 * k + 1] + pc[4 * k + 2] + pc[4 * k + 3] + 0.5f * (pc[4 * k + 4] + pc[4 * k]);
        const unsigned init = qt < 16 ? ((2u << qt) - 1u) : (1u | (1u << qt) | (1u << (qt - 1)));
        if (tid < 64) SEL[tid] = init;
    }
    asm volatile("s_waitcnt lgkmcnt(0)" ::: "memory"); ATT_BAR();
    if (qt >= 16) {
        const int tid = wid * 64 + lane_id_volatile();
        const int rw = tid & 63, ng = tid >> 6; unsigned bits = 0u;
        LAS float* ib = IMP + rw; asm volatile("" : "+v"(ib));
        float v[4]; int cnt[4] = {0, 0, 0, 0};
#pragma unroll
        for (int k = 0; k < 4; ++k) v[k] = ib[(4 * ng + k) * 64];
        for (int n2 = 1; n2 <= qt - 2; ++n2) { const float v2 = ib[n2 * 64];
#pragma unroll
            for (int k = 0; k < 4; ++k) cnt[k] += (v2 > v[k] || (v2 == v[k] && n2 < 4 * ng + k)) ? 1 : 0; }
#pragma unroll
        for (int k = 0; k < 4; ++k) { const int n = 4 * ng + k; if (n >= 1 && n <= qt - 2 && cnt[k] < 13) bits |= 1u << n; }
        if (bits) __hip_atomic_fetch_or(SEL + rw, bits, __ATOMIC_RELAXED, __HIP_MEMORY_SCOPE_WORKGROUP);
    }
    asm volatile("s_waitcnt lgkmcnt(0)" ::: "memory"); ATT_BAR();
    { NSA_LANE(); NSA_WS(); merge<true>(ocmp, G[row * 48 + hq * 3 + 0] * inv_cmp, shm, wid, r32, hh); }
    {
        NSA_LANE(); NSA_WS();
        const unsigned rowsel = SEL[32 * ph + r32];
        ATT_LOADQ(NSA_QROW);
        f32x16 o[2]; zero_o(o); float m = 0.f, l = 0.f;
        sweep<2, true>(o, m, l, qr, Hb, Hb + NSA_HM_STRIDE, 64, 0, qt + 1, 0, pos, rowsel, shm, ring, wid, lane);
        const float lt = swap_sum(l); const float inv = lt > 0.f ? 1.0f / lt : 0.f;
        merge<false>(o, G[row * 48 + hq * 3 + 1] * inv, shm, wid, r32, hh);
    }
    {
        NSA_LANE(); NSA_WS();
        ATT_LOADQ(NSA_QROW);
        f32x16 o[2]; zero_o(o); float m = 0.f, l = 0.f;
        const int tlo = qt > 8 ? qt - 8 : 0;
        sweep<0, true>(o, m, l, qr, Hb + 2 * NSA_HM_STRIDE, Hb + 3 * NSA_HM_STRIDE, 64, tlo, qt - tlo + 1, pos - 511, pos, 0u, shm, ring, wid, lane);
        const float lt = swap_sum(l); const float inv = lt > 0.f ? 1.0f / lt : 0.f;
        merge<false>(o, G[row * 48 + hq * 3 + 2] * inv, shm, wid, r32, hh);
    }
    { unsigned char* ws = ws_; asm volatile("" : "+s"(ws)); store_o((bf16_t*)(ws + off_o) + ((size_t)b * T + q0 + 32 * ph) * D + hq * 64, shm, wid, lane_id_volatile()); }
#undef NSA_WS
#undef NSA_LANE
#undef NSA_QROW
}
#undef ATT_LOADQ
#undef ATT_BAR
}

constexpr size_t MiB = 1u << 20;
constexpr size_t WS_CTL = 0, CTL_ZERO_BYTES = 1 * MiB;
constexpr size_t WS_WUP = 1 * MiB, WS_WDN = 33 * MiB;
constexpr size_t WS_WNSA = 65 * MiB, WNSA_STRIDE = (size_t)NSA_NP * D * 2;
constexpr size_t WS_WOUT = 76 * MiB;
constexpr size_t WS_WFOX = 84 * MiB;
constexpr size_t WS_WSWA = 84 * MiB + 6656 * 1024;
constexpr size_t WS_WCMP = 93 * MiB;
constexpr size_t WS_ROPEC = 97 * MiB, WS_ROPES = WS_ROPEC + 256 * 1024;
constexpr size_t WS_CMPB = WS_ROPES + 256 * 1024;
constexpr size_t WS_SWAB = WS_CMPB + 64 * 1024;
constexpr size_t WS_RSTD = 98 * MiB;
constexpr size_t WS_XN = 100 * MiB;
constexpr size_t WS_BIG = 164 * MiB;
constexpr size_t WS_O = WS_BIG + 192 * MiB;
constexpr size_t WS_G = 420 * MiB, WS_LF = 426 * MiB, WS_CB = 428 * MiB, WS_KC = 430 * MiB, WS_VC = 431 * MiB, WS_HID = 432 * MiB, WS_M2 = 440 * MiB, WS_END = 504 * MiB;
static_assert(WS_WSWA + (size_t)SWA_NP * D * 2 <= WS_WCMP && WS_WFOX + (size_t)FOX_NP * D * 2 <= WS_WSWA && WS_WNSA + 2 * WNSA_STRIDE <= WS_WOUT && WS_SWAB + 8192 <= WS_XN, "d_ws map");
static_assert((size_t)M * FF * 2 == 256 * MiB && WS_O + (size_t)M * D * 2 == WS_G && (size_t)M * 3072 * 2 == 192 * MiB, "d_ws map");
constexpr int CW_TMO = 0, CW_BAR = 4096;

constexpr int RING_OFF = 0, RING_BYTES = 142336;
constexpr int LDSCTL_OFF = RING_BYTES, MISC_OFF = LDSCTL_OFF + 320;
constexpr int LDS_BYTES = 147456;
static_assert(att::L_END <= RING_BYTES && MISC_OFF + 128 <= LDS_BYTES, "LDS map");
constexpr int NWAVES = 8;
#ifndef L_LO
#define L_LO 0
#endif
#ifndef L_HI
#define L_HI DEPTH
#endif

typedef GAS unsigned gu32;
typedef GAS unsigned long long gu64;
#define RLX_AGENT __ATOMIC_RELAXED, __HIP_MEMORY_SCOPE_AGENT
#define LDS_WAIT() asm volatile("s_waitcnt lgkmcnt(0)" ::: "memory")
#define VM_WAIT() asm volatile("s_waitcnt vmcnt(0)" ::: "memory")
__device__ __forceinline__ unsigned long long rt() { return __builtin_amdgcn_s_memrealtime(); }
__device__ __forceinline__ unsigned f2bf(float f) { unsigned u = __builtin_bit_cast(unsigned, f); return (u + 0x7fffu + ((u >> 16) & 1u)) >> 16; }
__device__ __forceinline__ unsigned pk2(float lo, float hi) { return f2bf(lo) | (f2bf(hi) << 16); }

#define XB_TMO      128
#define XB_XCNT(j)  (256  + 64 * (j))
#define XB_XSUB(j)  (1280 + 64 * (j))
#define XB_XGEN(j)  (2304 + 64 * (j))
#define XB_TOP      3328
#define XB_TOPGEN   3392
#define XCD_BAR_WORDS 3456
#define XB_SPIN_CAP (1u << 18)

__device__ __forceinline__ unsigned xb_ld(unsigned* p)              { return __hip_atomic_load(p, __ATOMIC_RELAXED, __HIP_MEMORY_SCOPE_AGENT); }
__device__ __forceinline__ unsigned xb_add(unsigned* p, unsigned v) { return __hip_atomic_fetch_add(p, v, __ATOMIC_RELAXED, __HIP_MEMORY_SCOPE_AGENT); }
__device__ __forceinline__ unsigned xb_xcc_id() { return (unsigned)__builtin_amdgcn_s_getreg((3 << 11) | 20) & 0xFu; }
#define XB_SPIN(cond, bar) do { unsigned _sp = 0; while (cond) { __builtin_amdgcn_s_sleep(1); \
    if ((++_sp & 255u) == 0u) { if (xb_ld(&(bar)[XB_TMO])) break; if (_sp > XB_SPIN_CAP) { atomicAdd(&(bar)[XB_TMO], 1u); break; } } } } while (0)

struct XcdBarrier {
    unsigned* bar; unsigned x;
    volatile LAS unsigned* st;
};

__device__ __forceinline__ XcdBarrier xcd_barrier_post(unsigned* bar, volatile LAS unsigned* st) {
    XcdBarrier b; b.bar = bar; b.x = xb_xcc_id(); b.st = st;
    if (threadIdx.x == 0) (void)xb_add(&bar[XB_XCNT(b.x)], 1u);
    return b;
}
__device__ __forceinline__ void xcd_barrier_complete(unsigned* bar, unsigned x, unsigned& nloc, unsigned& nx) {
    const unsigned G = gridDim.x * gridDim.y * gridDim.z;
    unsigned sum, cnt, mine, sp = 0u;
    for (;;) {
        sum = 0u; cnt = 0u; mine = 0u;
#pragma unroll
        for (unsigned j = 0; j < 16; ++j) { const unsigned c = xb_ld(&bar[XB_XCNT(j)]); sum += c; cnt += (c > 0u) ? 1u : 0u; mine = (j == x) ? c : mine; }
        if (sum == G) break;
        __builtin_amdgcn_s_sleep(1);
        if ((++sp & 255u) == 0u) { if (xb_ld(&bar[XB_TMO])) break; if (sp > XB_SPIN_CAP) { atomicAdd(&bar[XB_TMO], 1u); break; } }
    }
    nloc = mine > 0u ? mine : 1u; nx = cnt > 0u ? cnt : 1u;
}

__device__ __forceinline__ void xcd_barrier(const XcdBarrier& b) {
    asm volatile("s_waitcnt vmcnt(0)" ::: "memory");
    __syncthreads();
    if (threadIdx.x == 0) {
        unsigned* bar = b.bar;
        __builtin_amdgcn_s_waitcnt(0);
        unsigned nloc = b.st[0], nx = b.st[1];
        if (nloc == 0u) { xcd_barrier_complete(bar, b.x, nloc, nx); b.st[0] = nloc; b.st[1] = nx; }
        const unsigned old = xb_add(&bar[XB_XSUB(b.x)], 1u);
        const unsigned gen = old / nloc;
        if (old + 1u == (gen + 1u) * nloc) {
            __builtin_amdgcn_fence(__ATOMIC_RELEASE, "agent");
            asm volatile("s_waitcnt vmcnt(0)" ::: "memory");
            const unsigned og = xb_add(&bar[XB_TOP], 1u);
            const unsigned tg = og / nx;
            if (og + 1u == (tg + 1u) * nx) xb_add(&bar[XB_TOPGEN], 1u);
            else XB_SPIN(xb_ld(&bar[XB_TOPGEN]) == tg, bar);
            __builtin_amdgcn_fence(__ATOMIC_ACQUIRE, "agent");
            xb_add(&bar[XB_XGEN(b.x)], 1u);
            asm volatile("s_waitcnt vmcnt(0)" ::: "memory");
        } else {
            XB_SPIN(xb_ld(&bar[XB_XGEN(b.x)]) == gen, bar);
            __builtin_amdgcn_fence(__ATOMIC_ACQUIRE, "agent");
            asm volatile("s_waitcnt vmcnt(0)" ::: "memory");
        }
    }
    __syncthreads();
}

__device__ __forceinline__ float wave_sum(float v) {
    v += __builtin_bit_cast(float, __builtin_amdgcn_update_dpp(0, __builtin_bit_cast(int, v), 0xB1, 0xF, 0xF, true));
    v += __builtin_bit_cast(float, __builtin_amdgcn_update_dpp(0, __builtin_bit_cast(int, v), 0x4E, 0xF, 0xF, true));
    v += __builtin_bit_cast(float, __builtin_amdgcn_update_dpp(0, __builtin_bit_cast(int, v), 0x141, 0xF, 0xF, true));
    v += __builtin_bit_cast(float, __builtin_amdgcn_update_dpp(0, __builtin_bit_cast(int, v), 0x140, 0xF, 0xF, true));
    v += __builtin_bit_cast(float, __builtin_amdgcn_ds_swizzle(__builtin_bit_cast(int, v), 0x401F));
    { auto rr = __builtin_amdgcn_permlane32_swap(__float_as_uint(v), __float_as_uint(v), false, false); v = __uint_as_float(rr[0]) + __uint_as_float(rr[1]); }
    return v;
}

__device__ __forceinline__ int il64(int c) { return (c >> 1) + 32 * (c & 1); }
__device__ __forceinline__ int li64(int d) { return 2 * (d & 31) + (d >> 5); }
__device__ __forceinline__ int src_n(int mode, int n) { return (mode == 3 && n < 1152) ? (n & ~63) + il64(n & 63) : n; }
__device__ __forceinline__ int dst_n(int mode, int n) {
    if (mode == 1) { const int reg = n >> 8; const bool rope = reg < 4 || reg == 4 || reg == 6 || reg == 8; return rope ? (n & ~63) + li64(n & 63) : n; }
    if (mode == 3) return n < 1152 ? (n & ~63) + li64(n & 63) : n;
    return n;
}
__device__ __forceinline__ void conv_item(const float* W, int K, int N, bf16_t* WT, int mode, int item, LAS float* scr, int lane) {
    const int nblk = (N + 31) / 32, kb = item / nblk, nb = item % nblk, k0 = 64 * kb, n0 = 32 * nb;
    const int c4 = (lane & 7) * 4; const bool cin = (n0 + c4) < N;
#pragma unroll
    for (int i = 0; i < 8; ++i) { const int kk = (lane >> 3) + 8 * i; const int kd = (mode == 4) ? li64(kk) : kk;
        const f32x4 v = cin ? *(const GAS f32x4*)(W + (size_t)(k0 + kk) * N + n0 + c4) : (f32x4){0.f, 0.f, 0.f, 0.f};
        scr[kd * 33 + c4] = v[0]; scr[kd * 33 + c4 + 1] = v[1]; scr[kd * 33 + c4 + 2] = v[2]; scr[kd * 33 + c4 + 3] = v[3]; }
    LDS_WAIT(); asm volatile("" ::: "memory");
    const int c = lane & 7;
#pragma unroll
    for (int j = 0; j < 4; ++j) { const int n = (lane >> 3) + 8 * j; const LAS float* s = scr + (8 * c) * 33 + n;
        u32x4 o; o.x = pk2(s[0 * 33], s[1 * 33]); o.y = pk2(s[2 * 33], s[3 * 33]); o.z = pk2(s[4 * 33], s[5 * 33]); o.w = pk2(s[6 * 33], s[7 * 33]);
        if (n0 + n < N) *(GAS u32x4*)(WT + (size_t)dst_n(mode, n0 + n) * K + k0 + 8 * c) = o; }
    LDS_WAIT(); asm volatile("" ::: "memory");
}
__device__ __forceinline__ void norm_row(const float* xrow, const float* g, bf16_t* orow, float* rstd_out, int lane) {
    f32x4 v[4]; float s = 0.f;
#pragma unroll
    for (int j = 0; j < 4; ++j) { v[j] = ((const GAS f32x4*)xrow)[lane + 64 * j]; s += (v[j][0] * v[j][0] + v[j][1] * v[j][1]) + (v[j][2] * v[j][2] + v[j][3] * v[j][3]); }
    const float rstd = 1.0f / sqrtf(wave_sum(s) * (1.0f / D) + NORM_EPS);
#pragma unroll
    for (int j = 0; j < 4; ++j) { const f32x4 gg = ((const GAS f32x4*)g)[lane + 64 * j]; u32x2 w; w.x = pk2(v[j][0] * rstd * gg[0], v[j][1] * rstd * gg[1]); w.y = pk2(v[j][2] * rstd * gg[2], v[j][3] * rstd * gg[3]);
        ((GAS u32x2*)orow)[lane + 64 * j] = w; }
    if (lane == 0) *rstd_out = rstd;
}
__device__ __forceinline__ void unpack4(u32x2 w, f32x4& o) { o[0] = __uint_as_float(w.x << 16); o[1] = __uint_as_float(w.x & 0xffff0000u); o[2] = __uint_as_float(w.y << 16); o[3] = __uint_as_float(w.y & 0xffff0000u); }
__device__ __forceinline__ void resnorm_row(const float* xin_f32, bf16_t* xn, float* rstd_io, const float* gcur, const bf16_t* mrow, const float* gpost, const float* gnext, float* xout_f32, int lane) {
    f32x4 xv[4], mv[4]; float s = 0.f;
    if (xin_f32) {
#pragma unroll
        for (int j = 0; j < 4; ++j) xv[j] = ((const GAS f32x4*)xin_f32)[lane + 64 * j];
    } else {
        const float inv_rstd = 1.0f / *rstd_io;
#pragma unroll
        for (int j = 0; j < 4; ++j) { unpack4(((const GAS u32x2*)xn)[lane + 64 * j], xv[j]); const f32x4 gg = ((const GAS f32x4*)gcur)[lane + 64 * j];
#pragma unroll
            for (int e = 0; e < 4; ++e) xv[j][e] = xv[j][e] * inv_rstd / gg[e]; }
    }
#pragma unroll
    for (int j = 0; j < 4; ++j) { unpack4(((const GAS u32x2*)mrow)[lane + 64 * j], mv[j]); s += (mv[j][0] * mv[j][0] + mv[j][1] * mv[j][1]) + (mv[j][2] * mv[j][2] + mv[j][3] * mv[j][3]); }
    const float rstd = 1.0f / sqrtf(wave_sum(s) * (1.0f / D) + NORM_EPS);
    float s2 = 0.f;
#pragma unroll
    for (int j = 0; j < 4; ++j) { const f32x4 gg = ((const GAS f32x4*)gpost)[lane + 64 * j];
#pragma unroll
        for (int e = 0; e < 4; ++e) { xv[j][e] += mv[j][e] * rstd * gg[e]; s2 += xv[j][e] * xv[j][e]; } }
    if (gnext) {
        const float rstd2 = 1.0f / sqrtf(wave_sum(s2) * (1.0f / D) + NORM_EPS);
#pragma unroll
        for (int j = 0; j < 4; ++j) { const f32x4 gg = ((const GAS f32x4*)gnext)[lane + 64 * j]; u32x2 w; w.x = pk2(xv[j][0] * rstd2 * gg[0], xv[j][1] * rstd2 * gg[1]); w.y = pk2(xv[j][2] * rstd2 * gg[2], xv[j][3] * rstd2 * gg[3]);
            ((GAS u32x2*)xn)[lane + 64 * j] = w; }
        if (lane == 0) *rstd_io = rstd2;
    } else {
#pragma unroll
        for (int j = 0; j < 4; ++j) ((GAS f32x4*)xout_f32)[lane + 64 * j] = xv[j];
    }
}

struct Args { const float* in[17]; float* out; unsigned char* ws; };
constexpr int PT_OFF = LDSCTL_OFF;
__device__ __forceinline__ unsigned char* ldptr(LAS unsigned char* lds, int idx) {
    const volatile LAS unsigned* p = (const volatile LAS unsigned*)(lds + PT_OFF + idx * 8);
    const unsigned lo = (unsigned)__builtin_amdgcn_readfirstlane((int)p[0]), hi = (unsigned)__builtin_amdgcn_readfirstlane((int)p[1]);
    return (unsigned char*)(((unsigned long long)hi << 32) | lo);
}
#define INP(i) ((const float*)ldptr(lds, (i)))
#define OUTP ((float*)ldptr(lds, 17))
#define WSP (ldptr(lds, 18))
#define IDS int tid_ = wave_s * 64 + lane_id_volatile(); const int tid = tid_, lane = tid & 63, wave = wave_s; const int G = gridDim.x, bx = blockIdx.x; \
    const int vcu = (G % 8 == 0) ? (bx % 8) * (G / 8) + bx / 8 : bx; const int gw = vcu * NWAVES + wave, NGW = G * NWAVES; (void)lane; (void)gw; (void)NGW; (void)vcu; (void)bx; (void)tid; (void)wave
template <int MODE, int AMODE>
__device__ __forceinline__ void run_gemm(LAS unsigned char* lds, const bf16_t* A, const bf16_t* Bt, int Mr, int N, int K, const pg8::Epi<MODE>& E, int wave_s) {
    pg8::Gemm g{A, Bt, Mr, N, K}; pg8::StaticOrder S; S.init(Mr, N, (int)gridDim.x, (int)blockIdx.x);
#ifndef NO_GEMM
#ifdef ONLY_MODE
    if (MODE == ONLY_MODE)
#endif
    pg8::gemm_phase<pg8::Epi<MODE>, pg8::StaticOrder, AMODE, true, true>(lds, g, S, E, wave_s);
#endif
}

#ifndef REP_GIN
#define REP_GIN 1
#endif
#ifndef REP_CMP
#define REP_CMP 1
#endif
#ifndef REP_SCAN
#define REP_SCAN 1
#endif
#ifndef REP_ATT_NSA
#define REP_ATT_NSA 1
#endif
#ifndef REP_ATT_FOX
#define REP_ATT_FOX 1
#endif
#ifndef REP_ATT_SWA
#define REP_ATT_SWA 1
#endif
#ifndef REP_GOUT
#define REP_GOUT 1
#endif
#ifndef REP_MLP
#define REP_MLP 1
#endif
#ifndef REP_PRO
#define REP_PRO 1
#endif
template <int L>
__device__ __forceinline__ void layer_body(LAS unsigned char* lds, const XcdBarrier& bar, int& aslot, const int wave_s) {
#define GRID_BAR() xcd_barrier(bar)
    constexpr int kind = L % 3, sl = L / 3;
    if (kind == 0) {
        { unsigned char* ws = WSP;
          pg8::Epi<pg8::EM_NSA> E{(bf16_t*)(ws + WS_BIG), NSA_LDP, nullptr, (const float*)(ws + WS_ROPEC), (const float*)(ws + WS_ROPES), (float*)(ws + WS_G), nullptr, (bf16_t*)(ws + WS_BIG + NSA_HM_OFF), NSA_HM_STRIDE};
          run_gemm<pg8::EM_NSA, 0>(lds + RING_OFF, (const bf16_t*)(ws + WS_XN), (const bf16_t*)(ws + WS_WNSA) + (size_t)sl * NSA_NP * D, M, NSA_NP, D, E, wave_s); }
        GRID_BAR();
#if REP_GIN >= 2
        { unsigned char* ws = WSP;
          pg8::Epi<pg8::EM_NSA> E{(bf16_t*)(ws + WS_BIG), NSA_LDP, nullptr, (const float*)(ws + WS_ROPEC), (const float*)(ws + WS_ROPES), (float*)(ws + WS_G), nullptr, (bf16_t*)(ws + WS_BIG + NSA_HM_OFF), NSA_HM_STRIDE};
          run_gemm<pg8::EM_NSA, 0>(lds + RING_OFF, (const bf16_t*)(ws + WS_XN), (const bf16_t*)(ws + WS_WNSA) + (size_t)sl * NSA_NP * D, M, NSA_NP, D, E, wave_s); }
        GRID_BAR();
#endif
        { unsigned char* ws = WSP;
          pg8::Epi<pg8::EM_CMP> E{(bf16_t*)(ws + WS_HID), 256, (const float*)(ws + WS_CMPB) + sl * 512, nullptr, nullptr, nullptr, nullptr, nullptr, 0};
          run_gemm<pg8::EM_CMP, 1>(lds + RING_OFF, (const bf16_t*)(ws + WS_BIG) + 1024, (const bf16_t*)(ws + WS_WCMP) + (size_t)sl * 2 * 256 * 2048, CMP_ROWS, 512, 2048, E, wave_s); }
        GRID_BAR();
#if REP_CMP >= 2
        { unsigned char* ws = WSP;
          pg8::Epi<pg8::EM_CMP> E{(bf16_t*)(ws + WS_HID), 256, (const float*)(ws + WS_CMPB) + sl * 512, nullptr, nullptr, nullptr, nullptr, nullptr, 0};
          run_gemm<pg8::EM_CMP, 1>(lds + RING_OFF, (const bf16_t*)(ws + WS_BIG) + 1024, (const bf16_t*)(ws + WS_WCMP) + (size_t)sl * 2 * 256 * 2048, CMP_ROWS, 512, 2048, E, wave_s); }
        GRID_BAR();
#endif
        { IDS; unsigned char* ws = WSP; const bf16_t* HID = (const bf16_t*)(ws + WS_HID); const float* nsa_w2 = INP(7);
          const int which = bx >> 7, wl = bx & 127;
          LAS float* w2s = (LAS float*)(lds + RING_OFF);
          { const GAS f32x4* w2g = (const GAS f32x4*)(nsa_w2 + (size_t)(sl * 2 + which) * 256 * 64); for (int i = tid; i < 4096; i += 512) ((LAS f32x4*)w2s)[i] = w2g[i]; }
          __syncthreads();
          const int r0 = (wl * 8 + wave) * 8;
          float f[8][4], acc[8];
#pragma unroll
          for (int q = 0; q < 8; ++q) { const u32x2 hw = *(const GAS u32x2*)(HID + ((size_t)which * CMP_ROWS + r0 + q) * 256 + 4 * lane);
              f[q][0] = __uint_as_float(hw.x << 16); f[q][1] = __uint_as_float(hw.x & 0xffff0000u); f[q][2] = __uint_as_float(hw.y << 16); f[q][3] = __uint_as_float(hw.y & 0xffff0000u); acc[q] = 0.f; }
          const LAS float* wcol = w2s + (which ? lane : il64(lane));
          for (int jj = 0; jj < 64; ++jj) {
#pragma unroll
              for (int s = 0; s < 4; ++s) { const float w = wcol[(4 * jj + s) * 64];
#pragma unroll
                  for (int q = 0; q < 8; ++q) acc[q] += __builtin_bit_cast(float, __builtin_amdgcn_readlane(__builtin_bit_cast(int, f[q][s]), jj)) * w; }
          }
          bf16_t* dstb = (bf16_t*)(ws + (which ? WS_VC : WS_KC));
#pragma unroll
          for (int q = 0; q < 8; ++q) { const int r = r0 + q, gg = r & 3, c = (r >> 2) & 127, b = r >> 9;
              dstb[(size_t)((b * 4 + gg) * NCP + c) * 64 + lane] = (bf16_t)f2bf(c == NC ? 0.f : acc[q]); }
          __syncthreads();
        }
        GRID_BAR();
#if REP_CMP >= 2
        { IDS; unsigned char* ws = WSP; const bf16_t* HID = (const bf16_t*)(ws + WS_HID); const float* nsa_w2 = INP(7);
          const int which = bx >> 7, wl = bx & 127;
          LAS float* w2s = (LAS float*)(lds + RING_OFF);
          { const GAS f32x4* w2g = (const GAS f32x4*)(nsa_w2 + (size_t)(sl * 2 + which) * 256 * 64); for (int i = tid; i < 4096; i += 512) ((LAS f32x4*)w2s)[i] = w2g[i]; }
          __syncthreads();
          const int r0 = (wl * 8 + wave) * 8;
          float f[8][4], acc[8];
#pragma unroll
          for (int q = 0; q < 8; ++q) { const u32x2 hw = *(const GAS u32x2*)(HID + ((size_t)which * CMP_ROWS + r0 + q) * 256 + 4 * lane);
              f[q][0] = __uint_as_float(hw.x << 16); f[q][1] = __uint_as_float(hw.x & 0xffff0000u); f[q][2] = __uint_as_float(hw.y << 16); f[q][3] = __uint_as_float(hw.y & 0xffff0000u); acc[q] = 0.f; }
          const LAS float* wcol = w2s + (which ? lane : il64(lane));
          for (int jj = 0; jj < 64; ++jj) {
#pragma unroll
              for (int s = 0; s < 4; ++s) { const float w = wcol[(4 * jj + s) * 64];
#pragma unroll
                  for (int q = 0; q < 8; ++q) acc[q] += __builtin_bit_cast(float, __builtin_amdgcn_readlane(__builtin_bit_cast(int, f[q][s]), jj)) * w; }
          }
          bf16_t* dstb = (bf16_t*)(ws + (which ? WS_VC : WS_KC));
#pragma unroll
          for (int q = 0; q < 8; ++q) { const int r = r0 + q, gg = r & 3, c = (r >> 2) & 127, b = r >> 9;
              dstb[(size_t)((b * 4 + gg) * NCP + c) * 64 + lane] = (bf16_t)f2bf(c == NC ? 0.f : acc[q]); }
          __syncthreads();
        }
        GRID_BAR();
#endif
        { IDS; unsigned char* ws = WSP;
          const int bg = vcu >> 2, sub = vcu & 3, b = bg >> 2, g = bg & 3;
          for (int i = 0; i < 8; ++i) { const int qt = (i & 1) ? (8 * (i >> 1) + 7 - sub) : (8 * (i >> 1) + sub);
#ifndef NO_NSA
              att::nsa_unit(lds + RING_OFF, b, g, qt, ws, WS_BIG, WS_G, WS_KC, WS_VC, WS_O, wave, aslot);
#endif
          } }
#if REP_ATT_NSA >= 2
        GRID_BAR();
        { IDS; unsigned char* ws = WSP;
          const int bg = vcu >> 2, sub = vcu & 3, b = bg >> 2, g = bg & 3;
          for (int i = 0; i < 8; ++i) { const int qt = (i & 1) ? (8 * (i >> 1) + 7 - sub) : (8 * (i >> 1) + sub);
#ifndef NO_NSA
              att::nsa_unit(lds + RING_OFF, b, g, qt, ws, WS_BIG, WS_G, WS_KC, WS_VC, WS_O, wave, aslot);
#endif
          } }
#endif
    } else if (kind == 1) {
        { unsigned char* ws = WSP;
          pg8::Epi<pg8::EM_FOX> E{(bf16_t*)(ws + WS_BIG), FOX_LDP, nullptr, nullptr, nullptr, (float*)(ws + WS_LF), INP(10), (bf16_t*)(ws + WS_BIG + FOX_HM_OFF), FOX_HM_STRIDE};
          run_gemm<pg8::EM_FOX, 0>(lds + RING_OFF, (const bf16_t*)(ws + WS_XN), (const bf16_t*)(ws + WS_WFOX), M, FOX_NP, D, E, wave_s); }
        GRID_BAR();
#if REP_GIN >= 2
        { unsigned char* ws = WSP;
          pg8::Epi<pg8::EM_FOX> E{(bf16_t*)(ws + WS_BIG), FOX_LDP, nullptr, nullptr, nullptr, (float*)(ws + WS_LF), INP(10), (bf16_t*)(ws + WS_BIG + FOX_HM_OFF), FOX_HM_STRIDE};
          run_gemm<pg8::EM_FOX, 0>(lds + RING_OFF, (const bf16_t*)(ws + WS_XN), (const bf16_t*)(ws + WS_WFOX), M, FOX_NP, D, E, wave_s); }
        GRID_BAR();
#endif
        { IDS; unsigned char* ws = WSP; const float* LF = (const float*)(ws + WS_LF); float* CB = (float*)(ws + WS_CB);
          if (wave == 0) for (int bh = bx; bh < BATCH * NH; bh += G) {
            const int b = bh >> 4, h = bh & 15; float v[32]; float run = 0.f;
#pragma unroll
            for (int i = 0; i < 32; ++i) { run += LF[((size_t)b * T + 32 * lane + i) * 16 + h]; v[i] = run; }
            float excl = 0.f;
            for (int k = 0; k < 63; ++k) { const float t = __builtin_bit_cast(float, __builtin_amdgcn_readlane(__builtin_bit_cast(int, run), k)); if (lane > k) excl += t; }
#pragma unroll
            for (int i = 0; i < 32; ++i) CB[(size_t)bh * T + 32 * lane + i] = -(v[i] + excl) * LOG2E;
          } }
        GRID_BAR();
#if REP_SCAN >= 2
        { IDS; unsigned char* ws = WSP; const float* LF = (const float*)(ws + WS_LF); float* CB = (float*)(ws + WS_CB);
          if (wave == 0) for (int bh = bx; bh < BATCH * NH; bh += G) {
            const int b = bh >> 4, h = bh & 15; float v[32]; float run = 0.f;
#pragma unroll
            for (int i = 0; i < 32; ++i) { run += LF[((size_t)b * T + 32 * lane + i) * 16 + h]; v[i] = run; }
            float excl = 0.f;
            for (int k = 0; k < 63; ++k) { const float t = __builtin_bit_cast(float, __builtin_amdgcn_readlane(__builtin_bit_cast(int, run), k)); if (lane > k) excl += t; }
#pragma unroll
            for (int i = 0; i < 32; ++i) CB[(size_t)bh * T + 32 * lane + i] = -(v[i] + excl) * LOG2E;
          } }
        GRID_BAR();
#endif
        { IDS; unsigned char* ws = WSP;
          const int xcd = vcu >> 5, c = vcu & 31, sub = c & 3;
          for (int i = 0; i < 8; ++i) { const int bh = 32 * xcd + 8 * (i >> 1) + (c >> 2); const int qb = (i & 1) ? sub : 7 - sub;
#ifndef NO_FOX
              att::fox_unit(lds + RING_OFF, bh >> 4, bh & 15, qb, ws, WS_BIG, WS_CB, WS_O, wave, aslot);
#endif
          } }
#if REP_ATT_FOX >= 2
        GRID_BAR();
        { IDS; unsigned char* ws = WSP;
          const int xcd = vcu >> 5, c = vcu & 31, sub = c & 3;
          for (int i = 0; i < 8; ++i) { const int bh = 32 * xcd + 8 * (i >> 1) + (c >> 2); const int qb = (i & 1) ? sub : 7 - sub;
#ifndef NO_FOX
              att::fox_unit(lds + RING_OFF, bh >> 4, bh & 15, qb, ws, WS_BIG, WS_CB, WS_O, wave, aslot);
#endif
          } }
#endif
    } else {
        { unsigned char* ws = WSP;
          pg8::Epi<pg8::EM_SWA> E{(bf16_t*)(ws + WS_BIG), SWA_LDP, (const float*)(ws + WS_SWAB), (const float*)(ws + WS_ROPEC), (const float*)(ws + WS_ROPES), nullptr, nullptr, (bf16_t*)(ws + WS_BIG + SWA_HM_OFF), SWA_HM_STRIDE};
          run_gemm<pg8::EM_SWA, 0>(lds + RING_OFF, (const bf16_t*)(ws + WS_XN), (const bf16_t*)(ws + WS_WSWA), M, SWA_NP, D, E, wave_s); }
        GRID_BAR();
#if REP_GIN >= 2
        { unsigned char* ws = WSP;
          pg8::Epi<pg8::EM_SWA> E{(bf16_t*)(ws + WS_BIG), SWA_LDP, (const float*)(ws + WS_SWAB), (const float*)(ws + WS_ROPEC), (const float*)(ws + WS_ROPES), nullptr, nullptr, (bf16_t*)(ws + WS_BIG + SWA_HM_OFF), SWA_HM_STRIDE};
          run_gemm<pg8::EM_SWA, 0>(lds + RING_OFF, (const bf16_t*)(ws + WS_XN), (const bf16_t*)(ws + WS_WSWA), M, SWA_NP, D, E, wave_s); }
        GRID_BAR();
#endif
        { IDS; unsigned char* ws = WSP; const float* sinks = INP(14);
          const int bg = vcu >> 3, sub = vcu & 7;
          for (int i = 0; i < 8; ++i) {
#ifndef NO_SWA
              att::swa_unit(lds + RING_OFF, bg >> 1, bg & 1, 8 * i + sub, ws, WS_BIG, WS_O, sinks, wave, aslot);
#endif
          } }
#if REP_ATT_SWA >= 2
        GRID_BAR();
        { IDS; unsigned char* ws = WSP; const float* sinks = INP(14);
          const int bg = vcu >> 3, sub = vcu & 7;
          for (int i = 0; i < 8; ++i) {
#ifndef NO_SWA
              att::swa_unit(lds + RING_OFF, bg >> 1, bg & 1, 8 * i + sub, ws, WS_BIG, WS_O, sinks, wave, aslot);
#endif
          } }
#endif
    }
    GRID_BAR();
    { unsigned char* ws = WSP;
      pg8::Epi<pg8::EM_PLAIN> E{(bf16_t*)(ws + WS_BIG), D, kind == 2 ? INP(16) : nullptr, nullptr, nullptr, nullptr, nullptr, nullptr, 0};
      run_gemm<pg8::EM_PLAIN, 0>(lds + RING_OFF, (const bf16_t*)(ws + WS_O), (const bf16_t*)(ws + WS_WOUT) + (size_t)L * D * D, M, D, D, E, wave_s); }
    GRID_BAR();
#if REP_GOUT >= 2
    { unsigned char* ws = WSP;
      pg8::Epi<pg8::EM_PLAIN> E{(bf16_t*)(ws + WS_BIG), D, kind == 2 ? INP(16) : nullptr, nullptr, nullptr, nullptr, nullptr, nullptr, 0};
      run_gemm<pg8::EM_PLAIN, 0>(lds + RING_OFF, (const bf16_t*)(ws + WS_O), (const bf16_t*)(ws + WS_WOUT) + (size_t)L * D * D, M, D, D, E, wave_s); }
    GRID_BAR();
#endif
    { IDS; unsigned char* ws = WSP; const float* gL = INP(1) + (size_t)L * 4 * D; const float* xin = (L == 0) ? INP(0) : nullptr;
      const bf16_t* MB = (const bf16_t*)(ws + WS_BIG); bf16_t* XN = (bf16_t*)(ws + WS_XN); float* RSTD = (float*)(ws + WS_RSTD);
      for (int m = gw; m < M; m += NGW) resnorm_row(xin ? xin + (size_t)m * D : nullptr, XN + (size_t)m * D, RSTD + m, gL, MB + (size_t)m * D, gL + D, gL + 2 * D, nullptr, lane); }
    GRID_BAR();
    { unsigned char* ws = WSP;
      pg8::Epi<pg8::EM_RELU2> E{(bf16_t*)(ws + WS_BIG), FF, nullptr, nullptr, nullptr, nullptr, nullptr, nullptr, 0};
      run_gemm<pg8::EM_RELU2, 0>(lds + RING_OFF, (const bf16_t*)(ws + WS_XN), (const bf16_t*)(ws + WS_WUP) + (size_t)L * D * FF, M, FF, D, E, wave_s); }
    GRID_BAR();
#if REP_MLP >= 2
    { unsigned char* ws = WSP;
      pg8::Epi<pg8::EM_RELU2> E{(bf16_t*)(ws + WS_BIG), FF, nullptr, nullptr, nullptr, nullptr, nullptr, nullptr, 0};
      run_gemm<pg8::EM_RELU2, 0>(lds + RING_OFF, (const bf16_t*)(ws + WS_XN), (const bf16_t*)(ws + WS_WUP) + (size_t)L * D * FF, M, FF, D, E, wave_s); }
    GRID_BAR();
#endif
    { unsigned char* ws = WSP;
      pg8::Epi<pg8::EM_PLAIN> E{(bf16_t*)(ws + WS_M2), D, nullptr, nullptr, nullptr, nullptr, nullptr, nullptr, 0};
      run_gemm<pg8::EM_PLAIN, 0>(lds + RING_OFF, (const bf16_t*)(ws + WS_BIG), (const bf16_t*)(ws + WS_WDN) + (size_t)L * D * FF, M, D, FF, E, wave_s); }
    GRID_BAR();
#if REP_MLP >= 2
    { unsigned char* ws = WSP;
      pg8::Epi<pg8::EM_PLAIN> E{(bf16_t*)(ws + WS_M2), D, nullptr, nullptr, nullptr, nullptr, nullptr, nullptr, 0};
      run_gemm<pg8::EM_PLAIN, 0>(lds + RING_OFF, (const bf16_t*)(ws + WS_BIG), (const bf16_t*)(ws + WS_WDN) + (size_t)L * D * FF, M, D, FF, E, wave_s); }
    GRID_BAR();
#endif
    { IDS; unsigned char* ws = WSP; const float* gL = INP(1) + (size_t)L * 4 * D; float* xout = OUTP; bf16_t* XN = (bf16_t*)(ws + WS_XN); const bf16_t* M2 = (const bf16_t*)(ws + WS_M2); float* RSTD = (float*)(ws + WS_RSTD);
      for (int m = gw; m < M; m += NGW) resnorm_row(nullptr, XN + (size_t)m * D, RSTD + m, gL + 2 * D, M2 + (size_t)m * D, gL + 3 * D, (L + 1 < DEPTH) ? gL + 4 * D : nullptr, xout + (size_t)m * D, lane); }
    if (L + 1 < DEPTH) GRID_BAR();
#undef GRID_BAR
}

__global__ void __launch_bounds__(NWAVES * 64, 2) fwd_kernel(Args args) {
    extern __shared__ __attribute__((aligned(16))) unsigned char lds_raw[];
    LAS unsigned char* lds = (LAS unsigned char*)lds_raw;
    const int wave_s = __builtin_amdgcn_readfirstlane((int)threadIdx.x >> 6);
    for (int u = threadIdx.x; u < (LDS_BYTES - LDSCTL_OFF) / 4; u += NWAVES * 64) ((LAS unsigned*)(lds + LDSCTL_OFF))[u] = 0u;
    __syncthreads();
    if (threadIdx.x == 0) {
        LAS unsigned long long* pt = (LAS unsigned long long*)(lds + PT_OFF);
#pragma unroll
        for (int i = 0; i < 17; ++i) pt[i] = (unsigned long long)args.in[i];
        pt[17] = (unsigned long long)args.out; pt[18] = (unsigned long long)args.ws;
    }
    __syncthreads();
    volatile LAS unsigned* MISC = (volatile LAS unsigned*)(lds + MISC_OFF);
    XcdBarrier bar = xcd_barrier_post((unsigned*)(WSP + WS_CTL) + CW_BAR, MISC + 8);

    {
        IDS; unsigned char* ws = WSP;
        const float* x_in = INP(0); const float* norm_g = INP(1); const float* mlp_up = INP(2); const float* mlp_dn = INP(3);
        const float* nsa_w_in = INP(4); const float* nsa_pos = INP(5); const float* nsa_w1 = INP(6); const float* nsa_w_out = INP(8);
        const float* fox_w_in = INP(9); const float* fox_w_out = INP(11); const float* swa_w_in = INP(12); const float* swa_b_in = INP(13); const float* swa_w_out = INP(15);
        bf16_t* W_UP = (bf16_t*)(ws + WS_WUP); bf16_t* W_DN = (bf16_t*)(ws + WS_WDN); bf16_t* W_NSA = (bf16_t*)(ws + WS_WNSA); bf16_t* W_OUT = (bf16_t*)(ws + WS_WOUT);
        bf16_t* W_FOX = (bf16_t*)(ws + WS_WFOX); bf16_t* W_SWA = (bf16_t*)(ws + WS_WSWA); bf16_t* W_CMP = (bf16_t*)(ws + WS_WCMP);
        float* ROPEC = (float*)(ws + WS_ROPEC); float* ROPES = (float*)(ws + WS_ROPES); float* CMPB = (float*)(ws + WS_CMPB); float* SWAB = (float*)(ws + WS_SWAB);
        bf16_t* XN = (bf16_t*)(ws + WS_XN);
        LAS float* scr = (LAS float*)(lds + RING_OFF + wave * 16384);
        constexpr int I_UP = (D / 64) * (FF / 32), I_DN = (FF / 64) * (D / 32), I_NSA = (D / 64) * ((NSA_N + 31) / 32), I_OUT = (D / 64) * (D / 32), I_FOX = (D / 64) * ((FOX_N + 31) / 32), I_SWA = (D / 64) * (SWA_N / 32), I_CMP = (2048 / 64) * (256 / 32);
        constexpr int NITEMS = 4 * I_UP + 4 * I_DN + 2 * I_NSA + 4 * I_OUT + I_FOX + I_SWA + 4 * I_CMP;
        for (int it = gw; it < NITEMS; it += NGW) {
            int r = it;
            if (r < 4 * I_UP) { const int Lw = r / I_UP; conv_item(mlp_up + (size_t)Lw * D * FF, D, FF, W_UP + (size_t)Lw * D * FF, 0, r % I_UP, scr, lane); continue; } r -= 4 * I_UP;
            if (r < 4 * I_DN) { const int Lw = r / I_DN; conv_item(mlp_dn + (size_t)Lw * D * FF, FF, D, W_DN + (size_t)Lw * D * FF, 0, r % I_DN, scr, lane); continue; } r -= 4 * I_DN;
            if (r < 2 * I_NSA) { const int s = r / I_NSA; conv_item(nsa_w_in + (size_t)s * D * NSA_N, D, NSA_N, W_NSA + (size_t)s * NSA_NP * D, 1, r % I_NSA, scr, lane); continue; } r -= 2 * I_NSA;
            if (r < 4 * I_OUT) { const int Lw = r / I_OUT; const float* src = (Lw == 1) ? fox_w_out : (Lw == 2) ? swa_w_out : nsa_w_out + (size_t)(Lw / 3) * D * D;
                conv_item(src, D, D, W_OUT + (size_t)Lw * D * D, 0, r % I_OUT, scr, lane); continue; } r -= 4 * I_OUT;
            if (r < I_FOX) { conv_item(fox_w_in, D, FOX_N, W_FOX, 2, r, scr, lane); continue; } r -= I_FOX;
            if (r < I_SWA) { conv_item(swa_w_in, D, SWA_N, W_SWA, 3, r, scr, lane); continue; } r -= I_SWA;
            { const int sw = r / I_CMP;
                conv_item(nsa_w1 + (size_t)sw * 2048 * 256, 2048, 256, W_CMP + (size_t)sw * 256 * 2048, (sw & 1) ? 0 : 4, r % I_CMP, scr, lane); }
        }
        { constexpr int ZN = (NSA_NP - NSA_N) * D / 8, ZF = (FOX_NP - FOX_N) * D / 8;
          for (int e = bx * 512 + tid; e < 2 * ZN + ZF; e += G * 512) {
              bf16_t* dst = e < ZN ? W_NSA + (size_t)NSA_N * D + (size_t)e * 8 : e < 2 * ZN ? W_NSA + (size_t)NSA_NP * D + (size_t)NSA_N * D + (size_t)(e - ZN) * 8 : W_FOX + (size_t)FOX_N * D + (size_t)(e - 2 * ZN) * 8;
              *(GAS u32x4*)dst = (u32x4){0u, 0u, 0u, 0u}; } }
        for (int e = bx * 512 + tid; e < T * 32; e += G * 512) { const int t = e >> 5, i = e & 31; const float inv = powf(10000.0f, -(float)(2 * i) / 64.0f); const float ang = (float)t * inv;
            ROPEC[e] = cosf(ang); ROPES[e] = sinf(ang); }
        for (int e = bx * 512 + tid; e < SWA_N; e += G * 512) SWAB[e] = swa_b_in[src_n(3, e)];
        for (int task = bx; task < 64; task += G) {
            const int sw = task >> 4, n0 = (task & 15) * 16, kq = tid >> 4, nn = tid & 15;
            const float* pos = nsa_pos + (size_t)sw * 2048; const float* w1 = nsa_w1 + (size_t)sw * 2048 * 256;
            float acc = 0.f;
#pragma unroll 8
            for (int k = kq * 64; k < kq * 64 + 64; ++k) acc += pos[k] * w1[(size_t)k * 256 + n0 + nn];
            LAS float* red = (LAS float*)(lds + RING_OFF);
            __syncthreads();
            red[kq * 16 + nn] = acc;
            __syncthreads();
            if (tid < 16) { float sm = 0.f; for (int q = 0; q < 32; ++q) sm += red[q * 16 + tid]; CMPB[sw * 256 + n0 + tid] = sm; }
            __syncthreads();
        }
        for (int m = gw; m < M; m += NGW) norm_row(x_in + (size_t)m * D, norm_g, XN + (size_t)m * D, (float*)(ws + WS_RSTD) + m, lane);
    }
#if REP_PRO >= 2
    xcd_barrier(bar);
    {
        IDS; unsigned char* ws = WSP;
        const float* x_in = INP(0); const float* norm_g = INP(1); const float* mlp_up = INP(2); const float* mlp_dn = INP(3);
        const float* nsa_w_in = INP(4); const float* nsa_pos = INP(5); const float* nsa_w1 = INP(6); const float* nsa_w_out = INP(8);
        const float* fox_w_in = INP(9); const float* fox_w_out = INP(11); const float* swa_w_in = INP(12); const float* swa_b_in = INP(13); const float* swa_w_out = INP(15);
        bf16_t* W_UP = (bf16_t*)(ws + WS_WUP); bf16_t* W_DN = (bf16_t*)(ws + WS_WDN); bf16_t* W_NSA = (bf16_t*)(ws + WS_WNSA); bf16_t* W_OUT = (bf16_t*)(ws + WS_WOUT);
        bf16_t* W_FOX = (bf16_t*)(ws + WS_WFOX); bf16_t* W_SWA = (bf16_t*)(ws + WS_WSWA); bf16_t* W_CMP = (bf16_t*)(ws + WS_WCMP);
        float* ROPEC = (float*)(ws + WS_ROPEC); float* ROPES = (float*)(ws + WS_ROPES); float* CMPB = (float*)(ws + WS_CMPB); float* SWAB = (float*)(ws + WS_SWAB);
        bf16_t* XN = (bf16_t*)(ws + WS_XN);
        LAS float* scr = (LAS float*)(lds + RING_OFF + wave * 16384);
        constexpr int I_UP = (D / 64) * (FF / 32), I_DN = (FF / 64) * (D / 32), I_NSA = (D / 64) * ((NSA_N + 31) / 32), I_OUT = (D / 64) * (D / 32), I_FOX = (D / 64) * ((FOX_N + 31) / 32), I_SWA = (D / 64) * (SWA_N / 32), I_CMP = (2048 / 64) * (256 / 32);
        constexpr int NITEMS = 4 * I_UP + 4 * I_DN + 2 * I_NSA + 4 * I_OUT + I_FOX + I_SWA + 4 * I_CMP;
        for (int it = gw; it < NITEMS; it += NGW) {
            int r = it;
            if (r < 4 * I_UP) { const int Lw = r / I_UP; conv_item(mlp_up + (size_t)Lw * D * FF, D, FF, W_UP + (size_t)Lw * D * FF, 0, r % I_UP, scr, lane); continue; } r -= 4 * I_UP;
            if (r < 4 * I_DN) { const int Lw = r / I_DN; conv_item(mlp_dn + (size_t)Lw * D * FF, FF, D, W_DN + (size_t)Lw * D * FF, 0, r % I_DN, scr, lane); continue; } r -= 4 * I_DN;
            if (r < 2 * I_NSA) { const int s = r / I_NSA; conv_item(nsa_w_in + (size_t)s * D * NSA_N, D, NSA_N, W_NSA + (size_t)s * NSA_NP * D, 1, r % I_NSA, scr, lane); continue; } r -= 2 * I_NSA;
            if (r < 4 * I_OUT) { const int Lw = r / I_OUT; const float* src = (Lw == 1) ? fox_w_out : (Lw == 2) ? swa_w_out : nsa_w_out + (size_t)(Lw / 3) * D * D;
                conv_item(src, D, D, W_OUT + (size_t)Lw * D * D, 0, r % I_OUT, scr, lane); continue; } r -= 4 * I_OUT;
            if (r < I_FOX) { conv_item(fox_w_in, D, FOX_N, W_FOX, 2, r, scr, lane); continue; } r -= I_FOX;
            if (r < I_SWA) { conv_item(swa_w_in, D, SWA_N, W_SWA, 3, r, scr, lane); continue; } r -= I_SWA;
            { const int sw = r / I_CMP;
                conv_item(nsa_w1 + (size_t)sw * 2048 * 256, 2048, 256, W_CMP + (size_t)sw * 256 * 2048, (sw & 1) ? 0 : 4, r % I_CMP, scr, lane); }
        }
        { constexpr int ZN = (NSA_NP - NSA_N) * D / 8, ZF = (FOX_NP - FOX_N) * D / 8;
          for (int e = bx * 512 + tid; e < 2 * ZN + ZF; e += G * 512) {
              bf16_t* dst = e < ZN ? W_NSA + (size_t)NSA_N * D + (size_t)e * 8 : e < 2 * ZN ? W_NSA + (size_t)NSA_NP * D + (size_t)NSA_N * D + (size_t)(e - ZN) * 8 : W_FOX + (size_t)FOX_N * D + (size_t)(e - 2 * ZN) * 8;
              *(GAS u32x4*)dst = (u32x4){0u, 0u, 0u, 0u}; } }
        for (int e = bx * 512 + tid; e < T * 32; e += G * 512) { const int t = e >> 5, i = e & 31; const float inv = powf(10000.0f, -(float)(2 * i) / 64.0f); const float ang = (float)t * inv;
            ROPEC[e] = cosf(ang); ROPES[e] = sinf(ang); }
        for (int e = bx * 512 + tid; e < SWA_N; e += G * 512) SWAB[e] = swa_b_in[src_n(3, e)];
        for (int task = bx; task < 64; task += G) {
            const int sw = task >> 4, n0 = (task & 15) * 16, kq = tid >> 4, nn = tid & 15;
            const float* pos = nsa_pos + (size_t)sw * 2048; const float* w1 = nsa_w1 + (size_t)sw * 2048 * 256;
            float acc = 0.f;
#pragma unroll 8
            for (int k = kq * 64; k < kq * 64 + 64; ++k) acc += pos[k] * w1[(size_t)k * 256 + n0 + nn];
            LAS float* red = (LAS float*)(lds + RING_OFF);
            __syncthreads();
            red[kq * 16 + nn] = acc;
            __syncthreads();
            if (tid < 16) { float sm = 0.f; for (int q = 0; q < 32; ++q) sm += red[q * 16 + tid]; CMPB[sw * 256 + n0 + tid] = sm; }
            __syncthreads();
        }
        for (int m = gw; m < M; m += NGW) norm_row(x_in + (size_t)m * D, norm_g, XN + (size_t)m * D, (float*)(ws + WS_RSTD) + m, lane);
    }
#endif
    xcd_barrier(bar);

    int aslot = 0;
    if (L_LO <= 0 && 0 < L_HI) layer_body<0>(lds, bar, aslot, wave_s);
    if (L_LO <= 1 && 1 < L_HI) layer_body<1>(lds, bar, aslot, wave_s);
    if (L_LO <= 2 && 2 < L_HI) layer_body<2>(lds, bar, aslot, wave_s);
    if (L_LO <= 3 && 3 < L_HI) layer_body<3>(lds, bar, aslot, wave_s);
}

extern "C" void kernel_launch(void* const* d_in, const int* in_sizes, int n_in, void* d_out, int out_size, void* d_ws, size_t ws_size, hipStream_t stream) {
    static int grid = 0;
    if (grid == 0) {
        if (n_in != 17 || in_sizes[0] != M * D || out_size != M * D || ws_size < WS_END) { fprintf(stderr, "kernel_launch: unexpected problem shape (n_in %d, in0 %d, out %d, ws %zu)\n", n_in, n_in > 0 ? in_sizes[0] : -1, out_size, ws_size); grid = -1; return; }
        int dev = 0, cus = 0, per_cu = 0;
        if (hipGetDevice(&dev) != hipSuccess || hipDeviceGetAttribute(&cus, hipDeviceAttributeMultiprocessorCount, dev) != hipSuccess) { grid = -1; return; }
        if (hipFuncSetAttribute((const void*)fwd_kernel, hipFuncAttributeMaxDynamicSharedMemorySize, LDS_BYTES) != hipSuccess) { fprintf(stderr, "kernel_launch: hipFuncSetAttribute failed\n"); grid = -1; return; }
        if (hipOccupancyMaxActiveBlocksPerMultiprocessor(&per_cu, (const void*)fwd_kernel, NWAVES * 64, LDS_BYTES) != hipSuccess || per_cu < 1) { fprintf(stderr, "kernel_launch: occupancy query reports %d\n", per_cu); }
        (void)hipGetLastError();
        if (cus < 256) { fprintf(stderr, "kernel_launch: needs 256 CUs, device has %d\n", cus); grid = -1; return; }
        grid = 256;
    }
    if (grid < 0) return;
    if (hipMemsetAsync((char*)d_ws + WS_CTL, 0, CTL_ZERO_BYTES, stream) != hipSuccess) return;
    Args a{};
    for (int i = 0; i < 17; ++i) a.in[i] = (const float*)d_in[i];
    a.out = (float*)d_out; a.ws = (unsigned char*)d_ws;
    hipLaunchKernelGGL(fwd_kernel, dim3(grid), dim3(NWAVES * 64), LDS_BYTES, stream, a);
}
```

```cpp
#include <hip/hip_runtime.h>
#include <cstdio>
#include <cstdint>

#define LAS __attribute__((address_space(3)))
#define GAS __attribute__((address_space(1)))
typedef unsigned short bf16_t;
typedef short bf16x8 __attribute__((ext_vector_type(8)));
typedef short s16x4 __attribute__((ext_vector_type(4)));
typedef float f32x2 __attribute__((ext_vector_type(2)));
typedef float f32x4 __attribute__((ext_vector_type(4)));
typedef float f32x16 __attribute__((ext_vector_type(16)));
typedef unsigned u32x2 __attribute__((ext_vector_type(2)));
typedef unsigned u32x4 __attribute__((ext_vector_type(4)));

constexpr int BATCH = 16, T = 2048, D = 1024, NH = 16, HD = 64, FF = 4096, DEPTH = 4;
constexpr int M = BATCH * T;
constexpr int NSA_N = 2608, NSA_NP = 2816, NSA_LDP = 1536;
constexpr int FOX_N = 3088, FOX_NP = 3328, FOX_LDP = 1024;
constexpr int SWA_N = 1280, SWA_NP = 1280, SWA_LDP = 1024;
constexpr int CMP_LDP = NSA_LDP;
constexpr int NC = 127, NCP = 128;
constexpr int CMP_ROWS = BATCH * NCP * 4;
constexpr size_t NSA_HM_OFF = (size_t)96 << 20, NSA_HM_STRIDE = (size_t)8 << 20;
constexpr size_t FOX_HM_OFF = (size_t)64 << 20, FOX_HM_STRIDE = (size_t)32 << 20;
constexpr size_t SWA_HM_OFF = (size_t)64 << 20, SWA_HM_STRIDE = (size_t)4 << 20;
constexpr float LOG2E = 1.4426950408889634f;
constexpr float C2 = 0.125f * LOG2E;
constexpr float NORM_EPS = 1e-6f;

__device__ __forceinline__ unsigned cvt_pk_bf16(float lo, float hi) { unsigned r; asm volatile("v_cvt_pk_bf16_f32 %0, %1, %2" : "=v"(r) : "v"(lo), "v"(hi)); return r; }
__device__ __forceinline__ void store8(bf16_t* p, f32x4 a, f32x4 b) { u32x4 w; w.x = cvt_pk_bf16(a[0], a[1]); w.y = cvt_pk_bf16(a[2], a[3]); w.z = cvt_pk_bf16(b[0], b[1]); w.w = cvt_pk_bf16(b[2], b[3]); *(u32x4*)p = w; }

__device__ __forceinline__ int lane_id_volatile() { int x; asm volatile("v_mbcnt_lo_u32_b32 %0, -1, 0\n\tv_mbcnt_hi_u32_b32 %0, -1, %0" : "=v"(x)); return x; }

namespace pg8 {
#define PG8_LAS __attribute__((address_space(3)))
constexpr int BM = 256, BK = 64, HALF = 128, HTB = HALF * BK * 2  , STAGE_BYTES = 8 * HTB, NXCD = 8, WGM = 8;

__host__ __device__ __forceinline__ int lds_byte(int r, int c) { const int st = (r >> 4) * 2 + (c >> 5), rr = r & 15, cc = c & 31, ob = rr * 64 + cc * 2; return st * 1024 + (ob ^ (((ob >> 9) & 1) << 5)); }
__host__ __device__ __forceinline__ void stage_rc(int b, int& R, int& C) { const int st = b / 1024, sb = b % 1024, swz = sb ^ (((sb >> 9) & 1) << 5); R = (st >> 1) * 16 + swz / 64; C = (st & 1) * 32 + (swz % 64) / 2; }
__host__ __device__ __forceinline__ int perm32(int rho) { const int n = rho >> 4, i = rho & 15; return 8 * (i >> 2) + 4 * n + (i & 3); }

struct Unit { int pm, pn; };
struct Gemm { const bf16_t* A; const bf16_t* Bt; int M, N, K; };

struct StaticOrder {
    int nM, nN, nwg, G, c;
    __host__ __device__ void init(int M_, int N_, int G_, int c_) { nM = M_ / BM; nN = N_ / BM; nwg = nM * nN; G = G_; c = c_; }
    __host__ __device__ bool next(int i, Unit& u) const {
        const long L = (long)i * G + c; if (L >= nwg) return false;
        int wgid = (int)L; { const int q = nwg / NXCD, r = nwg % NXCD, xcd = wgid % NXCD, off = wgid / NXCD; wgid = (xcd < r ? xcd * (q + 1) : r * (q + 1) + (xcd - r) * q) + off; }
        const int nig = WGM * nN, gid = wgid / nig, fm = gid * WGM, gsz = (nM - fm) < WGM ? (nM - fm) : WGM;
        u.pm = fm + ((wgid % nig) % gsz); u.pn = (wgid % nig) / gsz; return true;
    }
    __device__ __forceinline__ void a_ready(const Unit&) const {}
    __device__ __forceinline__ void done(const Unit&) const {}
};

enum EpiMode { EM_PLAIN = 0, EM_RELU2 = 1, EM_NSA = 2, EM_FOX = 3, EM_SWA = 4, EM_CMP = 5 };

__device__ __forceinline__ void rope4(f32x4& v, float c0, float s0, float c1, float s1) {
    const float a0 = v[0], b0 = v[1], a1 = v[2], b1 = v[3];
    v[0] = a0 * c0 - b0 * s0; v[1] = b0 * c0 + a0 * s0; v[2] = a1 * c1 - b1 * s1; v[3] = b1 * c1 + a1 * s1;
}
__device__ __forceinline__ float sigmoidf_(float x) { return 1.0f / (1.0f + __expf(-x)); }
__device__ __forceinline__ float logsigmoidf_(float x) { return fminf(x, 0.f) - log1pf(expf(-fabsf(x))); }

template <int MODE> struct Epi {
    static constexpr bool PERM = true, AFTER_DRAIN = false;
    bf16_t* O; int ldc; const float* bias; const float* rc; const float* rs; float* aux; const float* auxb;
    bf16_t* hm0; size_t hm_stride;
    __device__ __forceinline__ void operator()(const f32x4 (&acc)[2][2][4][2], const Unit& u, int wr, int wc, int fr, int fq) const {
        const int row0 = u.pm * BM + wr * 64 + fr;
        const int cw = wc * 32 + 8 * fq;
        const int colt = u.pn * BM;
        if (MODE == EM_NSA && u.pn == 10) {
            if (cw < 48) {
#pragma unroll
                for (int ai = 0; ai < 2; ++ai)
#pragma unroll
                    for (int m = 0; m < 4; ++m) { const size_t row = (size_t)(row0 + ai * HALF + m * 16); f32x4 v0 = acc[ai][0][m][0], v1 = acc[ai][0][m][1];
#pragma unroll
                        for (int j = 0; j < 4; ++j) { v0[j] = sigmoidf_(v0[j]); v1[j] = sigmoidf_(v1[j]); }
                        *(f32x4*)(aux + row * 48 + cw) = v0; *(f32x4*)(aux + row * 48 + cw + 4) = v1; }
            }
            return;
        }
        if (MODE == EM_FOX && u.pn == 12) {
            if (cw < 16) {
                const f32x4 b0 = *(const f32x4*)(auxb + cw), b1 = *(const f32x4*)(auxb + cw + 4);
#pragma unroll
                for (int ai = 0; ai < 2; ++ai)
#pragma unroll
                    for (int m = 0; m < 4; ++m) { const size_t row = (size_t)(row0 + ai * HALF + m * 16); f32x4 v0 = acc[ai][0][m][0] + b0, v1 = acc[ai][0][m][1] + b1;
#pragma unroll
                        for (int j = 0; j < 4; ++j) { v0[j] = logsigmoidf_(v0[j]); v1[j] = logsigmoidf_(v1[j]); }
                        *(f32x4*)(aux + row * 16 + cw) = v0; *(f32x4*)(aux + row * 16 + cw + 4) = v1; }
            }
            return;
        }
        bool rope0 = false, rope1 = false; float sc = 1.f;
        if (MODE == EM_NSA) { if (u.pn < 4) { rope0 = rope1 = true; sc = C2; } else if (!(u.pn & 1)) { rope0 = rope1 = true; } }
        if (MODE == EM_FOX) { if (u.pn < 4) sc = C2; }
        if (MODE == EM_SWA) { if (u.pn < 4) { rope0 = rope1 = true; sc = C2; } else { rope0 = true; } }
        f32x4 bv[2][2];
#pragma unroll
        for (int bj = 0; bj < 2; ++bj)
#pragma unroll
            for (int n = 0; n < 2; ++n) bv[bj][n] = bias ? *(const f32x4*)(bias + colt + bj * HALF + cw + 4 * n) : (f32x4){0.f, 0.f, 0.f, 0.f};
        const int ib = 16 * (wc & 1) + 4 * fq;
        bf16_t* base = O; int colo = colt; size_t rowo = 0;
        if (MODE == EM_CMP) { colo = 0; rowo = (size_t)u.pn * CMP_ROWS; }
        bool hm = false; bf16_t* hb[2] = {nullptr, nullptr}; int hd[2] = {0, 0}; int HG = 1;
        if (MODE == EM_FOX && u.pn >= 4) { hm = true; HG = 16; hb[0] = hb[1] = hm0 + (u.pn >= 8 ? hm_stride : 0); hd[0] = ((u.pn - 4) & 3) * 4 + (wc >> 1); hd[1] = hd[0] + 2; }
        if (MODE == EM_NSA && u.pn >= 6) { hm = true; HG = 4; hb[0] = hb[1] = hm0 + (size_t)(u.pn - 6) * hm_stride; hd[0] = (wc >> 1); hd[1] = hd[0] + 2; }
        if (MODE == EM_SWA && u.pn == 4) { hm = true; HG = 2; hb[0] = hm0; hb[1] = hm0 + hm_stride; hd[0] = hd[1] = (wc >> 1); }
#pragma unroll
        for (int ai = 0; ai < 2; ++ai)
#pragma unroll
            for (int m = 0; m < 4; ++m) {
                const int row = row0 + ai * HALF + m * 16;
                f32x4 cc = {1.f, 1.f, 1.f, 1.f}, ss = {0.f, 0.f, 0.f, 0.f};
                if (MODE == EM_NSA || MODE == EM_SWA) { if (rope0) { const int t = row & (T - 1); cc = *(const f32x4*)(rc + t * 32 + ib); ss = *(const f32x4*)(rs + t * 32 + ib); } }
                bf16_t* rowp = base + (rowo + (size_t)row) * ldc + colo + cw;
#pragma unroll
                for (int bj = 0; bj < 2; ++bj) {
                    f32x4 v0 = acc[ai][bj][m][0] + bv[bj][0], v1 = acc[ai][bj][m][1] + bv[bj][1];
                    if (MODE == EM_NSA || MODE == EM_SWA) { if (bj == 0 ? rope0 : rope1) { rope4(v0, cc[0], ss[0], cc[1], ss[1]); rope4(v1, cc[2], ss[2], cc[3], ss[3]); } }
                    if (MODE == EM_RELU2) {
#pragma unroll
                        for (int j = 0; j < 4; ++j) { const float a = fmaxf(v0[j], 0.f), b = fmaxf(v1[j], 0.f); v0[j] = a * a; v1[j] = b * b; } }
                    if (MODE == EM_CMP) {
#pragma unroll
                        for (int j = 0; j < 4; ++j) { v0[j] = v0[j] * sigmoidf_(v0[j]); v1[j] = v1[j] * sigmoidf_(v1[j]); } }
                    if (MODE == EM_NSA || MODE == EM_FOX || MODE == EM_SWA) { v0 = v0 * sc; v1 = v1 * sc; }
                    if ((MODE == EM_FOX || MODE == EM_NSA || MODE == EM_SWA) && hm) store8(hb[bj] + (((size_t)(row >> 11) * HG + hd[bj]) * T + (row & (T - 1))) * 64 + (cw & 63), v0, v1);
                    else store8(rowp + bj * HALF, v0, v1);
                }
            }
    }
};

template <class Epi, class Sched, int AMODE, bool ALIGN_EPI = false, bool SP2 = false>
__device__ __forceinline__ void gemm_phase(PG8_LAS unsigned char* lds, const Gemm g, const Sched& S, const Epi& E, int wave_id) {
    int tid_; { int x_; asm volatile("v_mbcnt_lo_u32_b32 %0, -1, 0\n\tv_mbcnt_hi_u32_b32 %0, -1, %0" : "=v"(x_)); tid_ = wave_id * 64 + x_; }
    const int tid = tid_, wid = __builtin_amdgcn_readfirstlane(tid >> 6), lane = tid & 63, wr = wid >> 2, wc = wid & 3, fr = lane & 15, fq = lane >> 4;
    const int K = g.K, nt = K / BK;
    unsigned voffA[2], voffB[2];
#pragma unroll
    for (int i = 0; i < 2; ++i) { int R, C; stage_rc(tid * 16 + i * 8192, R, C); const int Rb = Epi::PERM ? ((R & ~31) + perm32(R & 31)) : R;
        voffA[i] = (AMODE == 1) ? (unsigned)((16 * (R >> 2)) * CMP_LDP + (R & 3) * 64 + C) * 2u : (unsigned)(R * K + C) * 2u; voffB[i] = (unsigned)(Rb * K + C) * 2u; }
    const size_t kstepB = (size_t)(BK * 2);
    const size_t hstepB = (size_t)HALF * K * 2;
    const size_t tstepB = 2 * hstepB;
    const size_t kstepA = (AMODE == 1) ? (size_t)CMP_LDP * 2 : kstepB;
    const size_t hstepA = (AMODE == 1) ? (size_t)512 * CMP_LDP * 2 : hstepB;
    const size_t tstepA = 2 * hstepA;
    const size_t pnstepA = (AMODE == 1) ? (size_t)512 : (size_t)0;
    const unsigned ldsw = (unsigned)wid * 1024u;
    const int aoff = lds_byte(wr * 64 + fr, fq * 8), boff = lds_byte(wc * 32 + fr, fq * 8);
#define PG8_SA(b, h) (((b) * 2 + (h)) * HTB)
#define PG8_SB(b, h) ((4 + (b) * 2 + (h)) * HTB)
#define PG8_STAGE(bufoff, gbase, voff) do { _Pragma("unroll") for (int _i = 0; _i < 2; ++_i) \
        __builtin_amdgcn_global_load_lds((const unsigned*)((const char*)(gbase) + (voff)[_i]), (PG8_LAS unsigned*)(lds + (bufoff) + ldsw + _i * 8192), 16, 0, 0); } while (0)
#define PG8_LDA(dst, b, h) do { _Pragma("unroll") for (int m = 0; m < 4; ++m) _Pragma("unroll") for (int k = 0; k < 2; ++k) dst[m][k] = *(const PG8_LAS bf16x8*)(lds + PG8_SA(b, h) + aoff + m * 2048 + k * 1024); } while (0)
#define PG8_LDB(dst, b, h) do { _Pragma("unroll") for (int n = 0; n < 2; ++n) _Pragma("unroll") for (int k = 0; k < 2; ++k) dst[n][k] = *(const PG8_LAS bf16x8*)(lds + PG8_SB(b, h) + boff + n * 2048 + k * 1024); } while (0)
#define PG8_MMA(ai, bj, At, Bt) do { __builtin_amdgcn_s_setprio(1); _Pragma("unroll") for (int m = 0; m < 4; ++m) _Pragma("unroll") for (int n = 0; n < 2; ++n) _Pragma("unroll") for (int k = 0; k < 2; ++k) \
        acc[ai][bj][m][n] = __builtin_amdgcn_mfma_f32_16x16x32_bf16(Bt[n][k], At[m][k], acc[ai][bj][m][n], 0, 0, 0); __builtin_amdgcn_s_setprio(0); } while (0)
#define PG8_WAIT_V(n) asm volatile("s_waitcnt vmcnt(" #n ")" ::: "memory")
#define PG8_WAIT_L(n) asm volatile("s_waitcnt lgkmcnt(" #n ")" ::: "memory")
#define PG8_BAR __builtin_amdgcn_s_barrier()
#define PG8_SCHED __builtin_amdgcn_sched_barrier(0)
    Unit cur, nxt; int ui = 0;
    if (!S.next(0, cur)) return;
    f32x4 acc[2][2][4][2];
#pragma unroll
    for (int a = 0; a < 2; ++a)
#pragma unroll
        for (int b = 0; b < 2; ++b)
#pragma unroll
            for (int m = 0; m < 4; ++m)
#pragma unroll
                for (int n = 0; n < 2; ++n) acc[a][b][m][n] = (f32x4){0.f, 0.f, 0.f, 0.f};
    bf16x8 At[4][2], B0[2][2], B1[2][2];
    const char* cA = (const char*)g.A + (size_t)cur.pm * tstepA + (size_t)cur.pn * pnstepA; const char* cB = (const char*)g.Bt + (size_t)cur.pn * tstepB;
    S.a_ready(cur);
    if constexpr (SP2) {
        PG8_STAGE(PG8_SB(0, 0), cB, voffB); PG8_STAGE(PG8_SB(0, 1), cB + hstepB, voffB); PG8_STAGE(PG8_SA(0, 0), cA, voffA); PG8_STAGE(PG8_SA(0, 1), cA + hstepA, voffA);
        if (wr == 1) PG8_BAR;
        PG8_WAIT_V(2); PG8_BAR;
        PG8_STAGE(PG8_SB(1, 0), cB + kstepB, voffB); PG8_STAGE(PG8_SA(1, 0), cA + kstepA, voffA); PG8_STAGE(PG8_SB(1, 1), cB + hstepB + kstepB, voffB);
        PG8_WAIT_V(6); PG8_BAR;
    } else {
        PG8_STAGE(PG8_SB(0, 0), cB, voffB); PG8_STAGE(PG8_SA(0, 0), cA, voffA); PG8_STAGE(PG8_SB(0, 1), cB + hstepB, voffB); PG8_STAGE(PG8_SA(0, 1), cA + hstepA, voffA);
        if (wr == 1) PG8_BAR;
        PG8_WAIT_V(4); PG8_BAR;
        PG8_STAGE(PG8_SB(1, 0), cB + kstepB, voffB); PG8_STAGE(PG8_SA(1, 0), cA + kstepA, voffA); PG8_STAGE(PG8_SB(1, 1), cB + hstepB + kstepB, voffB);
        PG8_WAIT_V(6); PG8_BAR;
    }
    for (;;) {
        const bool has_next = S.next(ui + 1, nxt);
        const char* nA = has_next ? (const char*)g.A + (size_t)nxt.pm * tstepA + (size_t)nxt.pn * pnstepA : cA; const char* nB = has_next ? (const char*)g.Bt + (size_t)nxt.pn * tstepB : cB;
        for (int t = 0; t < nt; t += 2) {
            const bool last = (t == nt - 2);
            const char* a1 = cA + (size_t)(t + 1) * kstepA;
            const char* a2 = last ? nA : cA + (size_t)(t + 2) * kstepA; const char* b2 = last ? nB : cB + (size_t)(t + 2) * kstepB;
            const char* a3 = a2 + kstepA; const char* b3 = b2 + kstepB;
            if (last && has_next) S.a_ready(nxt);
            if constexpr (SP2) {
            PG8_LDB(B0, 0, 0); PG8_LDB(B1, 0, 1); PG8_SCHED; PG8_LDA(At, 0, 0); PG8_STAGE(PG8_SA(1, 1), a1 + hstepA, voffA);
            PG8_WAIT_V(8); PG8_WAIT_L(0); PG8_BAR; PG8_MMA(0, 0, At, B0); PG8_MMA(0, 1, At, B1); PG8_BAR; PG8_SCHED;
            PG8_LDA(At, 0, 1); PG8_STAGE(PG8_SB(0, 0), b2, voffB); PG8_STAGE(PG8_SB(0, 1), b2 + hstepB, voffB); PG8_STAGE(PG8_SA(0, 0), a2, voffA);
            PG8_WAIT_V(8); PG8_WAIT_L(0); PG8_BAR; PG8_MMA(1, 0, At, B0); PG8_MMA(1, 1, At, B1); PG8_BAR; PG8_SCHED;
            PG8_LDB(B0, 1, 0); PG8_LDB(B1, 1, 1); PG8_SCHED; PG8_LDA(At, 1, 0); PG8_STAGE(PG8_SA(0, 1), a2 + hstepA, voffA);
            PG8_WAIT_V(8); PG8_WAIT_L(0); PG8_BAR; PG8_MMA(0, 0, At, B0); PG8_MMA(0, 1, At, B1); PG8_BAR; PG8_SCHED;
            PG8_LDA(At, 1, 1); PG8_STAGE(PG8_SB(1, 0), b3, voffB); PG8_STAGE(PG8_SB(1, 1), b3 + hstepB, voffB); PG8_STAGE(PG8_SA(1, 0), a3, voffA);
            PG8_WAIT_V(8); PG8_WAIT_L(0); PG8_BAR; PG8_MMA(1, 0, At, B0); PG8_MMA(1, 1, At, B1); PG8_BAR; PG8_SCHED;
            } else {
            PG8_LDB(B0, 0, 0); PG8_SCHED; PG8_LDA(At, 0, 0); PG8_STAGE(PG8_SA(1, 1), a1 + hstepA, voffA);
            PG8_WAIT_L(8); PG8_BAR; PG8_WAIT_L(0); PG8_MMA(0, 0, At, B0); PG8_BAR; PG8_SCHED;
            PG8_LDB(B1, 0, 1); PG8_STAGE(PG8_SB(0, 0), b2, voffB);
            PG8_BAR; PG8_WAIT_L(0); PG8_MMA(0, 1, At, B1); PG8_BAR;
            PG8_LDA(At, 0, 1); PG8_STAGE(PG8_SA(0, 0), a2, voffA);
            PG8_BAR; PG8_WAIT_L(0); PG8_MMA(1, 0, At, B0); PG8_BAR; PG8_SCHED;
            PG8_STAGE(PG8_SB(0, 1), b2 + hstepB, voffB);
            PG8_WAIT_V(6); PG8_BAR; PG8_MMA(1, 1, At, B1); PG8_BAR;
            PG8_LDB(B0, 1, 0); PG8_SCHED; PG8_LDA(At, 1, 0); PG8_STAGE(PG8_SA(0, 1), a2 + hstepA, voffA);
            PG8_WAIT_L(8); PG8_BAR; PG8_WAIT_L(0); PG8_MMA(0, 0, At, B0); PG8_BAR; PG8_SCHED;
            PG8_LDB(B1, 1, 1); PG8_STAGE(PG8_SB(1, 0), b3, voffB);
            PG8_BAR; PG8_WAIT_L(0); PG8_MMA(0, 1, At, B1); PG8_BAR;
            PG8_LDA(At, 1, 1); PG8_STAGE(PG8_SA(1, 0), a3, voffA);
            PG8_BAR; PG8_WAIT_L(0); PG8_MMA(1, 0, At, B0); PG8_BAR; PG8_SCHED;
            PG8_STAGE(PG8_SB(1, 1), b3 + hstepB, voffB);
            PG8_WAIT_V(6); PG8_BAR; PG8_MMA(1, 1, At, B1); PG8_BAR;
            }
        }
        if constexpr (ALIGN_EPI) { if (wr == 0) PG8_BAR; }
        if constexpr (!Epi::AFTER_DRAIN) { E(acc, cur, wr, wc, fr, fq); S.done(cur); }
        if (!has_next) break;
#pragma unroll
        for (int a = 0; a < 2; ++a)
#pragma unroll
            for (int b = 0; b < 2; ++b)
#pragma unroll
                for (int m = 0; m < 4; ++m)
#pragma unroll
                    for (int n = 0; n < 2; ++n) acc[a][b][m][n] = (f32x4){0.f, 0.f, 0.f, 0.f};
        cur = nxt; cA = nA; cB = nB; ++ui;
        if constexpr (ALIGN_EPI) { if (wr == 1) PG8_BAR; }
    }
    PG8_WAIT_V(0);
    if constexpr (!ALIGN_EPI) { if (wr == 0) PG8_BAR; }
    PG8_BAR;
    if constexpr (Epi::AFTER_DRAIN) { E.fused(acc, cur, wr, wc, fr, fq, lds, wid, lane); S.done(cur); }
#undef PG8_SA
#undef PG8_SB
#undef PG8_STAGE
#undef PG8_LDA
#undef PG8_LDB
#undef PG8_MMA
#undef PG8_WAIT_V
#undef PG8_WAIT_L
#undef PG8_BAR
#undef PG8_SCHED
}
}

namespace att {
constexpr int SLOTB = 8192;
constexpr int NSLOT = 4;
constexpr int L_K = 0, L_V = 32768, L_WS = 65536, L_OST = 67584, L_PSUM = L_OST, L_IMP = 133120, L_KB = L_IMP, L_SEL = 141312, L_END = 141568;
constexpr float PFIX = 268435456.0f;
constexpr float THR = 8.0f;

__device__ __forceinline__ int crow(int r, int hh) { return (r & 3) + 8 * (r >> 2) + 4 * hh; }
typedef float f32x2_t __attribute__((ext_vector_type(2))); typedef __bf16 bf16x2_t __attribute__((ext_vector_type(2)));
__device__ __forceinline__ unsigned cvtpk_s(float lo, float hi) { f32x2_t v = {lo, hi}; bf16x2_t b = __builtin_convertvector(v, bf16x2_t); return __builtin_bit_cast(unsigned, b); }
typedef short v4i16_t __attribute__((ext_vector_type(4)));
__device__ __forceinline__ s16x4 vtr(const LAS unsigned char* p) { return __builtin_bit_cast(s16x4, __builtin_amdgcn_ds_read_tr16_b64_v4i16((LAS v4i16_t*)p)); }
__device__ __forceinline__ float swap_sum(float v) { auto rr = __builtin_amdgcn_permlane32_swap(__float_as_uint(v), __float_as_uint(v), false, false); return __uint_as_float(rr[0]) + __uint_as_float(rr[1]); }
__device__ __forceinline__ float swap_max(float v) { auto rr = __builtin_amdgcn_permlane32_swap(__float_as_uint(v), __float_as_uint(v), false, false); return fmaxf(__uint_as_float(rr[0]), __uint_as_float(rr[1])); }
__device__ __forceinline__ bool trailing_half(int wid) { asm volatile("" : "+s"(wid)); return (wid >> 2) != 0; }
#define ATT_BAR() do { __builtin_amdgcn_s_barrier(); asm volatile("" ::: "memory"); } while (0)

__device__ __forceinline__ void dma_tile(const bf16_t* Kb, const bf16_t* Vb, int pitch, int tile, LAS unsigned char* shm, int slot, int wid, int lane) {
    const bf16_t* ks = Kb + (size_t)(tile * 64 + lane) * pitch + wid * 8;
    const bf16_t* vs = Vb + (size_t)(tile * 64 + 16 * (wid & 3) + (lane >> 2)) * pitch + (wid >> 2) * 32 + (lane & 3) * 8;
    __builtin_amdgcn_global_load_lds((const unsigned*)ks, (LAS unsigned*)(shm + L_K + slot * SLOTB + wid * 1024), 16, 0, 0);
    __builtin_amdgcn_global_load_lds((const unsigned*)vs, (LAS unsigned*)(shm + L_V + slot * SLOTB + wid * 1024), 16, 0, 0);
#ifdef PROBE_DMA2
    __builtin_amdgcn_global_load_lds((const unsigned*)ks, (LAS unsigned*)(shm + L_K + slot * SLOTB + wid * 1024), 16, 0, 0);
    __builtin_amdgcn_global_load_lds((const unsigned*)vs, (LAS unsigned*)(shm + L_V + slot * SLOTB + wid * 1024), 16, 0, 0);
#endif
}
#ifdef PROBE_DMA2
#define VMW2 "4"
#define VMW4 "8"
#else
#define VMW2 "2"
#define VMW4 "4"
#endif
__device__ __forceinline__ void qkt(f32x16& p0, f32x16& p1, const LAS unsigned char* shm, int slot, const bf16x8 (&qr)[4], const f32x16& cinit, int r32, int hh) {
    const LAS unsigned char* kb = shm + L_K + slot * SLOTB + hh * 1024 + r32 * 16;
#pragma unroll
    for (int d0 = 0; d0 < 4; ++d0) {
        const bf16x8 b0 = *(const LAS bf16x8*)(kb + d0 * 2048), b1 = *(const LAS bf16x8*)(kb + d0 * 2048 + 512);
        if (d0 == 0) { p0 = __builtin_amdgcn_mfma_f32_32x32x16_bf16(b0, qr[0], cinit, 0, 0, 0); p1 = __builtin_amdgcn_mfma_f32_32x32x16_bf16(b1, qr[0], cinit, 0, 0, 0); }
        else { p0 = __builtin_amdgcn_mfma_f32_32x32x16_bf16(b0, qr[d0], p0, 0, 0, 0); p1 = __builtin_amdgcn_mfma_f32_32x32x16_bf16(b1, qr[d0], p1, 0, 0, 0); }
        if (d0 == 1) asm volatile("" ::: "memory");
    }
}
__device__ __forceinline__ void load_k(bf16x8 (&kf)[8], const LAS unsigned char* shm, int slot, int r32, int hh) {
    const LAS unsigned char* kb = shm + L_K + slot * SLOTB + hh * 1024 + r32 * 16;
#pragma unroll
    for (int d0 = 0; d0 < 4; ++d0) { kf[2 * d0] = *(const LAS bf16x8*)(kb + d0 * 2048); kf[2 * d0 + 1] = *(const LAS bf16x8*)(kb + d0 * 2048 + 512); }
}
__device__ __forceinline__ void mma_qk(f32x16& p0, f32x16& p1, const bf16x8 (&kf)[8], const bf16x8 (&qr)[4], const f32x16& cinit) {
    p0 = __builtin_amdgcn_mfma_f32_32x32x16_bf16(kf[0], qr[0], cinit, 0, 0, 0); p1 = __builtin_amdgcn_mfma_f32_32x32x16_bf16(kf[1], qr[0], cinit, 0, 0, 0);
#pragma unroll
    for (int d0 = 1; d0 < 4; ++d0) { p0 = __builtin_amdgcn_mfma_f32_32x32x16_bf16(kf[2 * d0], qr[d0], p0, 0, 0, 0); p1 = __builtin_amdgcn_mfma_f32_32x32x16_bf16(kf[2 * d0 + 1], qr[d0], p1, 0, 0, 0); }
}
__device__ __forceinline__ void load_v(bf16x8 (&vf)[8], const LAS unsigned char* shm, int slot, int lane, int hh) {
    const LAS unsigned char* vb = shm + L_V + slot * SLOTB + ((lane >> 4) & 1) * 32 + (lane & 3) * 8 + (4 * hh + ((lane & 15) >> 2)) * 64;
#pragma unroll
    for (int ks = 0; ks < 4; ++ks)
#pragma unroll
        for (int d0 = 0; d0 < 2; ++d0) {
            const s16x4 vl = vtr(vb + d0 * 4096 + ks * 1024), vh = vtr(vb + d0 * 4096 + ks * 1024 + 512);
            vf[2 * ks + d0] = (bf16x8){vl[0], vl[1], vl[2], vl[3], vh[0], vh[1], vh[2], vh[3]};
        }
}
__device__ __forceinline__ void mma_pv(f32x16 (&o)[2], const u32x4 (&pw)[4], const bf16x8 (&vf)[8]) {
#pragma unroll
    for (int ks = 0; ks < 4; ++ks)
#pragma unroll
        for (int d0 = 0; d0 < 2; ++d0) o[d0] = __builtin_amdgcn_mfma_f32_32x32x16_bf16(__builtin_bit_cast(bf16x8, pw[ks]), vf[2 * ks + d0], o[d0], 0, 0, 0);
}
__device__ __forceinline__ void pv_seq(f32x16 (&o)[2], const u32x4 (&pw)[4], const LAS unsigned char* shm, int slot, int lane, int hh) {
    const LAS unsigned char* vb = shm + L_V + slot * SLOTB + ((lane >> 4) & 1) * 32 + (lane & 3) * 8 + (4 * hh + ((lane & 15) >> 2)) * 64;
#pragma unroll
    for (int ks = 0; ks < 4; ++ks) {
#pragma unroll
        for (int d0 = 0; d0 < 2; ++d0) {
            const s16x4 vl = vtr(vb + d0 * 4096 + ks * 1024), vh = vtr(vb + d0 * 4096 + ks * 1024 + 512);
            const bf16x8 vf = {vl[0], vl[1], vl[2], vl[3], vh[0], vh[1], vh[2], vh[3]};
            o[d0] = __builtin_amdgcn_mfma_f32_32x32x16_bf16(__builtin_bit_cast(bf16x8, pw[ks]), vf, o[d0], 0, 0, 0);
        }
        if (ks == 1) asm volatile("" ::: "memory");
    }
}
__device__ __forceinline__ void range_mask(f32x16& p0, f32x16& p1, int kb, int lo, int hi) {
#pragma unroll
    for (int r = 0; r < 16; ++r) { const int k = kb + (r & 3) + 8 * (r >> 2); if (k < lo || k > hi) p0[r] = -INFINITY; if (k + 32 < lo || k + 32 > hi) p1[r] = -INFINITY; }
}
__device__ __forceinline__ void rescale_o(f32x16 (&o)[2], const LAS float* wsf, int hh) {
#pragma unroll
    for (int g = 0; g < 4; ++g) { const f32x4 a4 = *(const LAS f32x4*)(wsf + 8 * g + 4 * hh);
#pragma unroll
        for (int j = 0; j < 4; ++j) { o[0][4 * g + j] *= a4[j]; o[1][4 * g + j] *= a4[j]; } }
}

__device__ __forceinline__ float max3f(float a, float b, float c) { float r; asm("v_max3_f32 %0, %1, %2, %3" : "=v"(r) : "v"(a), "v"(b), "v"(c)); return r; }
#define MM(a, b, c) __builtin_amdgcn_mfma_f32_32x32x16_bf16(a, b, c, 0, 0, 0)
#define SGB(mask, n) __builtin_amdgcn_sched_group_barrier(mask, n, 0)
template <int MODE, bool NOMAX, bool LEAN = false>
__device__ __forceinline__ void sweep(f32x16 (&o)[2], float& mhat, float& l, const bf16x8 (&qr)[4], const bf16_t* Kb, const bf16_t* Vb, int pitch, int t0, int NT, int lo, int hi,
                                      unsigned rowsel, LAS unsigned char* shm, int& ring, int wid, int lane) {
    static_assert(!(MODE == 1 && NOMAX), "the FoX key bias grows without bound: it needs the running max");
    asm volatile("" : "+v"(lane));
    const int r32 = lane & 31, hh = lane >> 5;
    LAS float* wsf = (LAS float*)(shm + L_WS + wid * 256);
    const int lo_max = __builtin_amdgcn_readlane(lo, 31), hi_min = __builtin_amdgcn_readfirstlane(hi);
    const int ring0 = ring;
#define SLOT(i_) ((ring0 + (i_)) & (NSLOT - 1))
    dma_tile(Kb, Vb, pitch, t0, shm, SLOT(0), wid, lane);
    if (NT > 1) dma_tile(Kb, Vb, pitch, t0 + 1, shm, SLOT(1), wid, lane);
    f32x16 a0, a1, b0, b1, cini; u32x4 pw[4]; bf16x8 kf[8], vf[8]; float ls0 = 0.f, ls1 = 0.f; bool resc = false;
#pragma unroll
    for (int r = 0; r < 16; ++r) cini[r] = 0.f;
#define SET_CINI(i_) do { if (MODE == 2) { const float c_ = ((rowsel >> (t0 + (i_))) & 1u) ? 0.f : -INFINITY; _Pragma("unroll") for (int r = 0; r < 16; ++r) cini[r] = c_; } } while (0)
#define POST(C0, C1, i_) do { const int tile_ = t0 + (i_); \
        if (MODE == 1) { const LAS float* kb_ = (const LAS float*)(shm + L_KB) + tile_ * 64 + 4 * hh; \
            _Pragma("unroll") for (int k_ = 0; k_ < 4; ++k_) { const f32x4 x0_ = *(const LAS f32x4*)(kb_ + 8 * k_), x1_ = *(const LAS f32x4*)(kb_ + 32 + 8 * k_); \
                _Pragma("unroll") for (int e_ = 0; e_ < 4; ++e_) { C0[4 * k_ + e_] += x0_[e_]; C1[4 * k_ + e_] += x1_[e_]; } } } \
        if (tile_ * 64 < lo_max || tile_ * 64 + 63 > hi_min) range_mask(C0, C1, tile_ * 64 + 4 * hh, lo, hi); \
        if (!NOMAX) { \
            float ra_ = max3f(C0[0], C0[1], C1[0]), rb_ = max3f(C0[2], C0[3], C1[1]); ra_ = max3f(ra_, C1[2], C1[3]); \
            _Pragma("unroll") for (int r = 4; r < 16; r += 4) { ra_ = max3f(ra_, C0[r], C0[r + 1]); rb_ = max3f(rb_, C0[r + 2], C0[r + 3]); ra_ = max3f(ra_, C1[r], C1[r + 1]); rb_ = max3f(rb_, C1[r + 2], C1[r + 3]); } \
            const float rm_ = swap_max(fmaxf(ra_, rb_)); const bool first_ = ((i_) == 0); \
            if (first_ || __any(rm_ > THR)) { \
                float dl_ = first_ ? rm_ : fmaxf(rm_, 0.f); if (dl_ == -INFINITY) dl_ = 0.f; \
                mhat += dl_; \
                _Pragma("unroll") for (int r = 0; r < 16; ++r) { C0[r] -= dl_; C1[r] -= dl_; cini[r] = -mhat; } \
                if (!first_) { const float al_ = __builtin_amdgcn_exp2f(-dl_); l *= al_; ls0 *= al_; ls1 *= al_; if (hh == 0) wsf[r32] = al_; resc = true; } } } \
    } while (0)
    asm volatile("s_waitcnt lgkmcnt(0)" ::: "memory");
    if (NT > 1) asm volatile("s_waitcnt vmcnt(2)" ::: "memory"); else asm volatile("s_waitcnt vmcnt(0)" ::: "memory");
    ATT_BAR();
    if (NT > 2) dma_tile(Kb, Vb, pitch, t0 + 2, shm, SLOT(2), wid, lane);
    SET_CINI(0);
    load_k(kf, shm, SLOT(0), r32, hh);
    mma_qk(a0, a1, kf, qr, cini);
    POST(a0, a1, 0);
#pragma unroll
    for (int r = 0; r < 16; ++r) { a0[r] = __builtin_amdgcn_exp2f(a0[r]); a1[r] = __builtin_amdgcn_exp2f(a1[r]); }
#define STEP(i_, C0, C1, P0, P1) do { \
        asm volatile("s_waitcnt lgkmcnt(0)" ::: "memory"); \
        if ((i_) + 1 < NT) asm volatile("s_waitcnt vmcnt(2)" ::: "memory"); else asm volatile("s_waitcnt vmcnt(0)" ::: "memory"); \
        ATT_BAR(); \
        if ((i_) + 2 < NT) dma_tile(Kb, Vb, pitch, t0 + (i_) + 2, shm, SLOT((i_) + 2), wid, lane); \
        SET_CINI(i_); \
        load_k(kf, shm, SLOT(i_), r32, hh); \
        load_v(vf, shm, SLOT((i_) - 1), lane, hh); \
        __builtin_amdgcn_sched_barrier(0); \
          \
        C0 = MM(kf[0], qr[0], cini); C1 = MM(kf[1], qr[0], cini); \
        _Pragma("unroll") for (int d_ = 1; d_ < 4; ++d_) { C0 = MM(kf[2 * d_], qr[d_], C0); C1 = MM(kf[2 * d_ + 1], qr[d_], C1); } \
        _Pragma("unroll") for (int r = 0; r < 16; ++r) { ls0 += P0[r]; ls1 += P1[r]; } \
        _Pragma("unroll") for (int e_ = 0; e_ < 4; ++e_) { pw[0][e_] = cvtpk_s(P0[2 * e_], P0[2 * e_ + 1]); pw[1][e_] = cvtpk_s(P0[8 + 2 * e_], P0[9 + 2 * e_]); pw[2][e_] = cvtpk_s(P1[2 * e_], P1[2 * e_ + 1]); pw[3][e_] = cvtpk_s(P1[8 + 2 * e_], P1[9 + 2 * e_]); } \
        _Pragma("unroll") for (int g_ = 0; g_ < 8; ++g_) { SGB(0x008, 1); SGB(0x002, 6); } \
        __builtin_amdgcn_sched_barrier(0); \
        POST(C0, C1, i_); \
        __builtin_amdgcn_sched_barrier(0); \
          \
        _Pragma("unroll") for (int ks_ = 0; ks_ < 4; ++ks_) _Pragma("unroll") for (int d_ = 0; d_ < 2; ++d_) o[d_] = MM(__builtin_bit_cast(bf16x8, pw[ks_]), vf[2 * ks_ + d_], o[d_]); \
        _Pragma("unroll") for (int r = 0; r < 16; ++r) { C0[r] = __builtin_amdgcn_exp2f(C0[r]); C1[r] = __builtin_amdgcn_exp2f(C1[r]); } \
        _Pragma("unroll") for (int g_ = 0; g_ < 8; ++g_) { SGB(0x008, 1); SGB(0x400, 4); } \
        __builtin_amdgcn_sched_barrier(0); \
        if (!NOMAX) { if (resc) { rescale_o(o, wsf, hh); resc = false; } } \
    } while (0)
    int i = 1;
    for (; i + 1 < NT; i += 2) { STEP(i, b0, b1, a0, a1); STEP(i + 1, a0, a1, b0, b1); }
    if (i < NT) {
        STEP(i, b0, b1, a0, a1);
#pragma unroll
        for (int r = 0; r < 16; ++r) { a0[r] = b0[r]; a1[r] = b1[r]; }
    }
#pragma unroll
    for (int r = 0; r < 16; ++r) { ls0 += a0[r]; ls1 += a1[r]; }
#pragma unroll
    for (int e = 0; e < 4; ++e) { pw[0][e] = cvtpk_s(a0[2 * e], a0[2 * e + 1]); pw[1][e] = cvtpk_s(a0[8 + 2 * e], a0[9 + 2 * e]); pw[2][e] = cvtpk_s(a1[2 * e], a1[2 * e + 1]); pw[3][e] = cvtpk_s(a1[8 + 2 * e], a1[9 + 2 * e]); }
    load_v(vf, shm, SLOT(NT - 1), lane, hh);
    mma_pv(o, pw, vf);
    l += ls0 + ls1;
    asm volatile("s_waitcnt lgkmcnt(0)" ::: "memory");
    ring = SLOT(NT);
#undef STEP
#undef POST
#undef SET_CINI
#undef SLOT
}
#undef MM
#undef SGB
template <bool FIRST>
__device__ __forceinline__ void merge(const f32x16 (&o)[2], float scale, LAS unsigned char* shm, int wid, int r32, int hh) {
    LAS float* wsf = (LAS float*)(shm + L_WS + wid * 256);
    LAS float* stg = (LAS float*)(shm + L_OST + wid * 8192) + r32;
    if (hh == 0) wsf[r32] = scale;
#pragma unroll
    for (int g = 0; g < 4; ++g) { const f32x4 s4 = *(const LAS f32x4*)(wsf + 8 * g + 4 * hh);
#pragma unroll
        for (int j = 0; j < 4; ++j) { LAS float* p = stg + (8 * g + 4 * hh + j) * 64;
            if (FIRST) { p[0] = o[0][4 * g + j] * s4[j]; p[32] = o[1][4 * g + j] * s4[j]; }
            else { p[0] += o[0][4 * g + j] * s4[j]; p[32] += o[1][4 * g + j] * s4[j]; } } }
}
__device__ __forceinline__ void store_o(bf16_t* Ow, LAS unsigned char* shm, int wid, int lane) {
    const LAS float* stg = (const LAS float*)(shm + L_OST + wid * 8192);
#pragma unroll
    for (int i = 0; i < 4; ++i) { const int rowl = i * 8 + (lane >> 3), ch = lane & 7; const f32x4 a = *(const LAS f32x4*)(stg + rowl * 64 + ch * 8), c = *(const LAS f32x4*)(stg + rowl * 64 + ch * 8 + 4);
        u32x4 v; v.x = cvtpk_s(a[0], a[1]); v.y = cvtpk_s(a[2], a[3]); v.z = cvtpk_s(c[0], c[1]); v.w = cvtpk_s(c[2], c[3]); *(GAS u32x4*)(Ow + (size_t)rowl * D + ch * 8) = v; }
}
__device__ __forceinline__ void zero_o(f32x16 (&o)[2]) { o[0] = (f32x16){0.f, 0.f, 0.f, 0.f, 0.f, 0.f, 0.f, 0.f, 0.f, 0.f, 0.f, 0.f, 0.f, 0.f, 0.f, 0.f}; o[1] = o[0]; }
#define ATT_LOADQ(Qrow_) bf16x8 qr[4]; _Pragma("unroll") for (int d0 = 0; d0 < 4; ++d0) qr[d0] = *(const GAS bf16x8*)((Qrow_) + d0 * 16 + hh * 8)

__device__ __forceinline__ void fox_unit(LAS unsigned char* shm, int b, int h, int qb, unsigned char* ws_, size_t off_p, size_t off_cb, size_t off_o, int wid, int& ring) {
    const int lane = lane_id_volatile();
    unsigned char* ws = ws_; asm volatile("" : "+s"(ws)); const bf16_t* P = (const bf16_t*)(ws + off_p); const float* CB = (const float*)(ws + off_cb); bf16_t* O = (bf16_t*)(ws + off_o);
    const int r32 = lane & 31, hh = lane >> 5;
    const int pos = 256 * qb + 32 * wid + r32;
    const size_t row = (size_t)b * T + pos;
    ATT_LOADQ(P + row * FOX_LDP + h * 64);
    const bf16_t* Kb = (const bf16_t*)(ws + off_p + FOX_HM_OFF) + (size_t)(b * NH + h) * T * 64; const bf16_t* Vb = Kb + FOX_HM_STRIDE;
    f32x16 o[2]; zero_o(o); float m = 0.f, l = 0.f;
    asm volatile("s_waitcnt lgkmcnt(0)" ::: "memory"); ATT_BAR();
    { const float* cb = CB + (size_t)(b * NH + h) * T; LAS float* kbl = (LAS float*)(shm + L_KB);
      for (int i = wid * 64 + lane; i < 64 * (4 * qb + 4); i += 512) kbl[i] = cb[i]; }
    sweep<1, false>(o, m, l, qr, Kb, Vb, 64, 0, 4 * qb + 4, 0, pos, 0u, shm, ring, wid, lane);
    const float lt = swap_sum(l); const float inv = lt > 0.f ? 1.0f / lt : 0.f;
    merge<true>(o, inv, shm, wid, r32, hh);
    store_o(O + ((size_t)b * T + 256 * qb + 32 * wid) * D + h * 64, shm, wid, lane);
}
__device__ __forceinline__ void swa_unit(LAS unsigned char* shm, int b, int g, int qt, unsigned char* ws_, size_t off_p, size_t off_o, const float* sinks, int wid, int& ring) {
    const int lane = lane_id_volatile();
    unsigned char* ws = ws_; asm volatile("" : "+s"(ws)); const bf16_t* P = (const bf16_t*)(ws + off_p); bf16_t* O = (bf16_t*)(ws + off_o);
    const int r32 = lane & 31, hh = lane >> 5;
    const int q0 = 32 * qt, pos = q0 + r32, head = 8 * g + wid;
    const size_t row = (size_t)b * T + pos;
    ATT_LOADQ(P + row * SWA_LDP + head * 64);
    const bf16_t* Kb = (const bf16_t*)(ws + off_p + SWA_HM_OFF) + (size_t)(b * 2 + g) * T * 64; const bf16_t* Vb = Kb + SWA_HM_STRIDE;
    f32x16 o[2]; zero_o(o); float m = 0.f, l = 0.f;
    const int tlo = (q0 - 127) > 0 ? ((q0 - 127) >> 6) : 0, thi = (q0 + 31) >> 6;
    sweep<0, true, true>(o, m, l, qr, Kb, Vb, 64, tlo, thi - tlo + 1, pos - 127, pos, 0u, shm, ring, wid, lane);
    const float lt = swap_sum(l) + __builtin_amdgcn_exp2f(sinks[head] * LOG2E - m);
    const float inv = 1.0f / lt;
    merge<true>(o, inv, shm, wid, r32, hh);
    store_o(O + ((size_t)b * T + q0) * D + head * 64, shm, wid, lane);
}
__device__ __forceinline__ void nsa_unit(LAS unsigned char* shm, int b, int g, int qt, unsigned char* ws_, size_t off_p, size_t off_g, size_t off_kc, size_t off_vc, size_t off_o, int wid, int& ring) {
#define NSA_WS() unsigned char* ws = ws_; asm volatile("" : "+s"(ws)); const bf16_t* P = (const bf16_t*)(ws + off_p); const float* G = (const float*)(ws + off_g); const bf16_t* Hb = (const bf16_t*)(ws + off_p + NSA_HM_OFF) + (size_t)(b * 4 + g) * T * 64; (void)G; (void)Hb
    const int hq = 4 * g + (wid >> 1), ph = wid & 1, q0 = 64 * qt;
    LAS unsigned* PSUM = (LAS unsigned*)(shm + L_PSUM); LAS float* IMP = (LAS float*)(shm + L_IMP); LAS unsigned* SEL = (LAS unsigned*)(shm + L_SEL);
#define NSA_LANE() const int lane = lane_id_volatile(); const int r32 = lane & 31, hh = lane >> 5; const int pos = q0 + 32 * ph + r32; const size_t row = (size_t)b * T + pos; (void)hh; (void)row
#define NSA_QROW (P + row * NSA_LDP + hq * 64)
    asm volatile("s_waitcnt lgkmcnt(0)" ::: "memory"); ATT_BAR();
    { const int tid = wid * 64 + lane_id_volatile(); for (int i = tid; i < 8192; i += 512) PSUM[i] = 0u; }
    f32x16 ocmp[2]; float inv_cmp;
    {
        NSA_LANE(); NSA_WS();
        const bf16_t* Kb = (const bf16_t*)(ws + off_kc) + (size_t)(b * 4 + g) * NCP * 64; const bf16_t* Vb = (const bf16_t*)(ws + off_vc) + (size_t)(b * 4 + g) * NCP * 64;
        const int cm = (pos < 31) ? -1 : (((pos - 31) >> 4) < 126 ? ((pos - 31) >> 4) : 126);
        const int ntile = qt >= 16 ? 2 : 1;
        ATT_LOADQ(NSA_QROW);
        f32x16 o[2]; zero_o(o); float m = 0.f, l = 0.f;
        const int ring0 = ring;
        sweep<0, true>(o, m, l, qr, Kb, Vb, 64, 0, ntile, 0, cm, 0u, shm, ring, wid, lane);
        const float lt = swap_sum(l); const float inv = lt > 0.f ? 1.0f / lt : 0.f;
        f32x16 negm;
#pragma unroll
        for (int r = 0; r < 16; ++r) negm[r] = -m;
        for (int tile = 0; tile < ntile; ++tile) {
            const int sl = (ring0 + tile) & (NSLOT - 1);
            f32x16 p0, p1; qkt(p0, p1, shm, sl, qr, negm, r32, hh);
            range_mask(p0, p1, tile * 64 + 4 * hh, 0, cm);
            LAS unsigned* pb = PSUM + (tile * 64 + 4 * hh) * 64 + 32 * ph + r32;
            asm volatile("" : "+v"(pb));
#pragma unroll
            for (int r = 0; r < 16; ++r) {
                const float a = __builtin_amdgcn_exp2f(p0[r]) * inv, c = __builtin_amdgcn_exp2f(p1[r]) * inv;
                __hip_atomic_fetch_add(pb + ((r & 3) + 8 * (r >> 2)) * 64, (unsigned)(a * PFIX + 0.5f), __ATOMIC_RELAXED, __HIP_MEMORY_SCOPE_WORKGROUP);
                __hip_atomic_fetch_add(pb + ((r & 3) + 8 * (r >> 2) + 32) * 64, (unsigned)(c * PFIX + 0.5f), __ATOMIC_RELAXED, __HIP_MEMORY_SCOPE_WORKGROUP);
            }
        }
        ocmp[0] = o[0]; ocmp[1] = o[1]; inv_cmp = inv;
    }
    asm volatile("s_waitcnt lgkmcnt(0)" ::: "memory"); ATT_BAR();
    {
        const int tid = wid * 64 + lane_id_volatile();
        const int rw = tid & 63, ng = tid >> 6;
        LAS unsigned* pb = PSUM + (16 * ng - 1) * 64 + rw;
        LAS float* ib = IMP + (4 * ng) * 64 + rw;
        asm volatile("" : "+v"(pb), "+v"(ib));
        float pc[17];
#pragma unroll
        for (int e = 0; e < 17; ++e) pc[e] = (float)pb[e * 64] * (1.0f / PFIX);
        if (ng == 0) pc[0] = 0.f;
#pragma unroll
        for (int k = 0; k < 4; ++k) ib[k * 64] = pc[4 * k + 1] + pc[4 * k + 2] + pc[4 * k + 3] + 0.5f * (pc[4 * k + 4] + pc[4 * k]);
        const unsigned init = qt < 16 ? ((2u << qt) - 1u) : (1u | (1u << qt) | (1u << (qt - 1)));
        if (tid < 64) SEL[tid] = init;
    }
    asm volatile("s_waitcnt lgkmcnt(0)" ::: "memory"); ATT_BAR();
    if (qt >= 16) {
        const int tid = wid * 64 + lane_id_volatile();
        const int rw = tid & 63, ng = tid >> 6; unsigned bits = 0u;
        LAS float* ib = IMP + rw; asm volatile("" : "+v"(ib));
        float v[4]; int cnt[4] = {0, 0, 0, 0};
#pragma unroll
        for (int k = 0; k < 4; ++k) v[k] = ib[(4 * ng + k) * 64];
        for (int n2 = 1; n2 <= qt - 2; ++n2) { const float v2 = ib[n2 * 64];
#pragma unroll
            for (int k = 0; k < 4; ++k) cnt[k] += (v2 > v[k] || (v2 == v[k] && n2 < 4 * ng + k)) ? 1 : 0; }
#pragma unroll
        for (int k = 0; k < 4; ++k) { const int n = 4 * ng + k; if (n >= 1 && n <= qt - 2 && cnt[k] < 13) bits |= 1u << n; }
        if (bits) __hip_atomic_fetch_or(SEL + rw, bits, __ATOMIC_RELAXED, __HIP_MEMORY_SCOPE_WORKGROUP);
    }
    asm volatile("s_waitcnt lgkmcnt(0)" ::: "memory"); ATT_BAR();
    { NSA_LANE(); NSA_WS(); merge<true>(ocmp, G[row * 48 + hq * 3 + 0] * inv_cmp, shm, wid, r32, hh); }
    {
        NSA_LANE(); NSA_WS();
        const unsigned rowsel = SEL[32 * ph + r32];
        ATT_LOADQ(NSA_QROW);
        f32x16 o[2]; zero_o(o); float m = 0.f, l = 0.f;
        sweep<2, true>(o, m, l, qr, Hb, Hb + NSA_HM_STRIDE, 64, 0, qt + 1, 0, pos, rowsel, shm, ring, wid, lane);
        const float lt = swap_sum(l); const float inv = lt > 0.f ? 1.0f / lt : 0.f;
        merge<false>(o, G[row * 48 + hq * 3 + 1] * inv, shm, wid, r32, hh);
    }
    {
        NSA_LANE(); NSA_WS();
        ATT_LOADQ(NSA_QROW);
        f32x16 o[2]; zero_o(o); float m = 0.f, l = 0.f;
        const int tlo = qt > 8 ? qt - 8 : 0;
        sweep<0, true>(o, m, l, qr, Hb + 2 * NSA_HM_STRIDE, Hb + 3 * NSA_HM_STRIDE, 64, tlo, qt - tlo + 1, pos - 511, pos, 0u, shm, ring, wid, lane);
        const float lt = swap_sum(l); const float inv = lt > 0.f ? 1.0f / lt : 0.f;
        merge<false>(o, G[row * 48 + hq * 3 + 2] * inv, shm, wid, r32, hh);
    }
    { unsigned char* ws = ws_; asm volatile("" : "+s"(ws)); store_o((bf16_t*)(ws + off_o) + ((size_t)b * T + q0 + 32 * ph) * D + hq * 64, shm, wid, lane_id_volatile()); }
#undef NSA_WS
#undef NSA_LANE
#undef NSA_QROW
}
#undef ATT_LOADQ
#undef ATT_BAR
}

constexpr size_t MiB = 1u << 20;
constexpr size_t WS_CTL = 0, CTL_ZERO_BYTES = 1 * MiB;
constexpr size_t WS_WUP = 1 * MiB, WS_WDN = 33 * MiB;
constexpr size_t WS_WNSA = 65 * MiB, WNSA_STRIDE = (size_t)NSA_NP * D * 2;
constexpr size_t WS_WOUT = 76 * MiB;
constexpr size_t WS_WFOX = 84 * MiB;
constexpr size_t WS_WSWA = 84 * MiB + 6656 * 1024;
constexpr size_t WS_WCMP = 93 * MiB;
constexpr size_t WS_ROPEC = 97 * MiB, WS_ROPES = WS_ROPEC + 256 * 1024;
constexpr size_t WS_CMPB = WS_ROPES + 256 * 1024;
constexpr size_t WS_SWAB = WS_CMPB + 64 * 1024;
constexpr size_t WS_RSTD = 98 * MiB;
constexpr size_t WS_XN = 100 * MiB;
constexpr size_t WS_BIG = 164 * MiB;
constexpr size_t WS_O = WS_BIG + 192 * MiB;
constexpr size_t WS_G = 420 * MiB, WS_LF = 426 * MiB, WS_CB = 428 * MiB, WS_KC = 430 * MiB, WS_VC = 431 * MiB, WS_HID = 432 * MiB, WS_M2 = 440 * MiB, WS_END = 504 * MiB;
static_assert(WS_WSWA + (size_t)SWA_NP * D * 2 <= WS_WCMP && WS_WFOX + (size_t)FOX_NP * D * 2 <= WS_WSWA && WS_WNSA + 2 * WNSA_STRIDE <= WS_WOUT && WS_SWAB + 8192 <= WS_XN, "d_ws map");
static_assert((size_t)M * FF * 2 == 256 * MiB && WS_O + (size_t)M * D * 2 == WS_G && (size_t)M * 3072 * 2 == 192 * MiB, "d_ws map");
constexpr int CW_TMO = 0, CW_BAR = 4096;

constexpr int RING_OFF = 0, RING_BYTES = 142336;
constexpr int LDSCTL_OFF = RING_BYTES, MISC_OFF = LDSCTL_OFF + 320;
constexpr int LDS_BYTES = 147456;
static_assert(att::L_END <= RING_BYTES && MISC_OFF + 128 <= LDS_BYTES, "LDS map");
constexpr int NWAVES = 8;
#ifndef L_LO
#define L_LO 0
#endif
#ifndef L_HI
#define L_HI DEPTH
#endif

typedef GAS unsigned gu32;
typedef GAS unsigned long long gu64;
#define RLX_AGENT __ATOMIC_RELAXED, __HIP_MEMORY_SCOPE_AGENT
#define LDS_WAIT() asm volatile("s_waitcnt lgkmcnt(0)" ::: "memory")
#define VM_WAIT() asm volatile("s_waitcnt vmcnt(0)" ::: "memory")
__device__ __forceinline__ unsigned long long rt() { return __builtin_amdgcn_s_memrealtime(); }
__device__ __forceinline__ unsigned f2bf(float f) { unsigned u = __builtin_bit_cast(unsigned, f); return (u + 0x7fffu + ((u >> 16) & 1u)) >> 16; }
__device__ __forceinline__ unsigned pk2(float lo, float hi) { return f2bf(lo) | (f2bf(hi) << 16); }

#define XB_TMO      128
#define XB_XCNT(j)  (256  + 64 * (j))
#define XB_XSUB(j)  (1280 + 64 * (j))
#define XB_XGEN(j)  (2304 + 64 * (j))
#define XB_TOP      3328
#define XB_TOPGEN   3392
#define XCD_BAR_WORDS 3456
#define XB_SPIN_CAP (1u << 18)

__device__ __forceinline__ unsigned xb_ld(unsigned* p)              { return __hip_atomic_load(p, __ATOMIC_RELAXED, __HIP_MEMORY_SCOPE_AGENT); }
__device__ __forceinline__ unsigned xb_add(unsigned* p, unsigned v) { return __hip_atomic_fetch_add(p, v, __ATOMIC_RELAXED, __HIP_MEMORY_SCOPE_AGENT); }
__device__ __forceinline__ unsigned xb_xcc_id() { return (unsigned)__builtin_amdgcn_s_getreg((3 << 11) | 20) & 0xFu; }
#define XB_SPIN(cond, bar) do { unsigned _sp = 0; while (cond) { __builtin_amdgcn_s_sleep(1); \
    if ((++_sp & 255u) == 0u) { if (xb_ld(&(bar)[XB_TMO])) break; if (_sp > XB_SPIN_CAP) { atomicAdd(&(bar)[XB_TMO], 1u); break; } } } } while (0)

struct XcdBarrier {
    unsigned* bar; unsigned x;
    volatile LAS unsigned* st;
};

__device__ __forceinline__ XcdBarrier xcd_barrier_post(unsigned* bar, volatile LAS unsigned* st) {
    XcdBarrier b; b.bar = bar; b.x = xb_xcc_id(); b.st = st;
    if (threadIdx.x == 0) (void)xb_add(&bar[XB_XCNT(b.x)], 1u);
    return b;
}
__device__ __forceinline__ void xcd_barrier_complete(unsigned* bar, unsigned x, unsigned& nloc, unsigned& nx) {
    const unsigned G = gridDim.x * gridDim.y * gridDim.z;
    unsigned sum, cnt, mine, sp = 0u;
    for (;;) {
        sum = 0u; cnt = 0u; mine = 0u;
#pragma unroll
        for (unsigned j = 0; j < 16; ++j) { const unsigned c = xb_ld(&bar[XB_XCNT(j)]); sum += c; cnt += (c > 0u) ? 1u : 0u; mine = (j == x) ? c : mine; }
        if (sum == G) break;
        __builtin_amdgcn_s_sleep(1);
        if ((++sp & 255u) == 0u) { if (xb_ld(&bar[XB_TMO])) break; if (sp > XB_SPIN_CAP) { atomicAdd(&bar[XB_TMO], 1u); break; } }
    }
    nloc = mine > 0u ? mine : 1u; nx = cnt > 0u ? cnt : 1u;
}

__device__ __forceinline__ void xcd_barrier(const XcdBarrier& b) {
    asm volatile("s_waitcnt vmcnt(0)" ::: "memory");
    __syncthreads();
    if (threadIdx.x == 0) {
        unsigned* bar = b.bar;
        __builtin_amdgcn_s_waitcnt(0);
        unsigned nloc = b.st[0], nx = b.st[1];
        if (nloc == 0u) { xcd_barrier_complete(bar, b.x, nloc, nx); b.st[0] = nloc; b.st[1] = nx; }
        const unsigned old = xb_add(&bar[XB_XSUB(b.x)], 1u);
        const unsigned gen = old / nloc;
        if (old + 1u == (gen + 1u) * nloc) {
            __builtin_amdgcn_fence(__ATOMIC_RELEASE, "agent");
            asm volatile("s_waitcnt vmcnt(0)" ::: "memory");
            const unsigned og = xb_add(&bar[XB_TOP], 1u);
            const unsigned tg = og / nx;
            if (og + 1u == (tg + 1u) * nx) xb_add(&bar[XB_TOPGEN], 1u);
            else XB_SPIN(xb_ld(&bar[XB_TOPGEN]) == tg, bar);
            __builtin_amdgcn_fence(__ATOMIC_ACQUIRE, "agent");
            xb_add(&bar[XB_XGEN(b.x)], 1u);
            asm volatile("s_waitcnt vmcnt(0)" ::: "memory");
        } else {
            XB_SPIN(xb_ld(&bar[XB_XGEN(b.x)]) == gen, bar);
            __builtin_amdgcn_fence(__ATOMIC_ACQUIRE, "agent");
            asm volatile("s_waitcnt vmcnt(0)" ::: "memory");
        }
    }
    __syncthreads();
}

__device__ __forceinline__ float wave_sum(float v) {
    v += __builtin_bit_cast(float, __builtin_amdgcn_update_dpp(0, __builtin_bit_cast(int, v), 0xB1, 0xF, 0xF, true));
    v += __builtin_bit_cast(float, __builtin_amdgcn_update_dpp(0, __builtin_bit_cast(int, v), 0x4E, 0xF, 0xF, true));
    v += __builtin_bit_cast(float, __builtin_amdgcn_update_dpp(0, __builtin_bit_cast(int, v), 0x141, 0xF, 0xF, true));
    v += __builtin_bit_cast(float, __builtin_amdgcn_update_dpp(0, __builtin_bit_cast(int, v), 0x140, 0xF, 0xF, true));
    v += __builtin_bit_cast(float, __builtin_amdgcn_ds_swizzle(__builtin_bit_cast(int, v), 0x401F));
    { auto rr = __builtin_amdgcn_permlane32_swap(__float_as_uint(v), __float_as_uint(v), false, false); v = __uint_as_float(rr[0]) + __uint_as_float(rr[1]); }
    return v;
}

__device__ __forceinline__ int il64(int c) { return (c >> 1) + 32 * (c & 1); }
__device__ __forceinline__ int li64(int d) { return 2 * (d & 31) + (d >> 5); }
__device__ __forceinline__ int src_n(int mode, int n) { return (mode == 3 && n < 1152) ? (n & ~63) + il64(n & 63) : n; }
__device__ __forceinline__ int dst_n(int mode, int n) {
    if (mode == 1) { const int reg = n >> 8; const bool rope = reg < 4 || reg == 4 || reg == 6 || reg == 8; return rope ? (n & ~63) + li64(n & 63) : n; }
    if (mode == 3) return n < 1152 ? (n & ~63) + li64(n & 63) : n;
    return n;
}
__device__ __forceinline__ void conv_item(const float* W, int K, int N, bf16_t* WT, int mode, int item, LAS float* scr, int lane) {
    const int nblk = (N + 31) / 32, kb = item / nblk, nb = item % nblk, k0 = 64 * kb, n0 = 32 * nb;
    const int c4 = (lane & 7) * 4; const bool cin = (n0 + c4) < N;
#pragma unroll
    for (int i = 0; i < 8; ++i) { const int kk = (lane >> 3) + 8 * i; const int kd = (mode == 4) ? li64(kk) : kk;
        const f32x4 v = cin ? *(const GAS f32x4*)(W + (size_t)(k0 + kk) * N + n0 + c4) : (f32x4){0.f, 0.f, 0.f, 0.f};
        scr[kd * 33 + c4] = v[0]; scr[kd * 33 + c4 + 1] = v[1]; scr[kd * 33 + c4 + 2] = v[2]; scr[kd * 33 + c4 + 3] = v[3]; }
    LDS_WAIT(); asm volatile("" ::: "memory");
    const int c = lane & 7;
#pragma unroll
    for (int j = 0; j < 4; ++j) { const int n = (lane >> 3) + 8 * j; const LAS float* s = scr + (8 * c) * 33 + n;
        u32x4 o; o.x = pk2(s[0 * 33], s[1 * 33]); o.y = pk2(s[2 * 33], s[3 * 33]); o.z = pk2(s[4 * 33], s[5 * 33]); o.w = pk2(s[6 * 33], s[7 * 33]);
        if (n0 + n < N) *(GAS u32x4*)(WT + (size_t)dst_n(mode, n0 + n) * K + k0 + 8 * c) = o; }
    LDS_WAIT(); asm volatile("" ::: "memory");
}
__device__ __forceinline__ void norm_row(const float* xrow, const float* g, bf16_t* orow, float* rstd_out, int lane) {
    f32x4 v[4]; float s = 0.f;
#pragma unroll
    for (int j = 0; j < 4; ++j) { v[j] = ((const GAS f32x4*)xrow)[lane + 64 * j]; s += (v[j][0] * v[j][0] + v[j][1] * v[j][1]) + (v[j][2] * v[j][2] + v[j][3] * v[j][3]); }
    const float rstd = 1.0f / sqrtf(wave_sum(s) * (1.0f / D) + NORM_EPS);
#pragma unroll
    for (int j = 0; j < 4; ++j) { const f32x4 gg = ((const GAS f32x4*)g)[lane + 64 * j]; u32x2 w; w.x = pk2(v[j][0] * rstd * gg[0], v[j][1] * rstd * gg[1]); w.y = pk2(v[j][2] * rstd * gg[2], v[j][3] * rstd * gg[3]);
        ((GAS u32x2*)orow)[lane + 64 * j] = w; }
    if (lane == 0) *rstd_out = rstd;
}
__device__ __forceinline__ void unpack4(u32x2 w, f32x4& o) { o[0] = __uint_as_float(w.x << 16); o[1] = __uint_as_float(w.x & 0xffff0000u); o[2] = __uint_as_float(w.y << 16); o[3] = __uint_as_float(w.y & 0xffff0000u); }
__device__ __forceinline__ void resnorm_row(const float* xin_f32, bf16_t* xn, float* rstd_io, const float* gcur, const bf16_t* mrow, const float* gpost, const float* gnext, float* xout_f32, int lane) {
    f32x4 xv[4], mv[4]; float s = 0.f;
    if (xin_f32) {
#pragma unroll
        for (int j = 0; j < 4; ++j) xv[j] = ((const GAS f32x4*)xin_f32)[lane + 64 * j];
    } else {
        const float inv_rstd = 1.0f / *rstd_io;
#pragma unroll
        for (int j = 0; j < 4; ++j) { unpack4(((const GAS u32x2*)xn)[lane + 64 * j], xv[j]); const f32x4 gg = ((const GAS f32x4*)gcur)[lane + 64 * j];
#pragma unroll
            for (int e = 0; e < 4; ++e) xv[j][e] = xv[j][e] * inv_rstd / gg[e]; }
    }
#pragma unroll
    for (int j = 0; j < 4; ++j) { unpack4(((const GAS u32x2*)mrow)[lane + 64 * j], mv[j]); s += (mv[j][0] * mv[j][0] + mv[j][1] * mv[j][1]) + (mv[j][2] * mv[j][2] + mv[j][3] * mv[j][3]); }
    const float rstd = 1.0f / sqrtf(wave_sum(s) * (1.0f / D) + NORM_EPS);
    float s2 = 0.f;
#pragma unroll
    for (int j = 0; j < 4; ++j) { const f32x4 gg = ((const GAS f32x4*)gpost)[lane + 64 * j];
#pragma unroll
        for (int e = 0; e < 4; ++e) { xv[j][e] += mv[j][e] * rstd * gg[e]; s2 += xv[j][e] * xv[j][e]; } }
    if (gnext) {
        const float rstd2 = 1.0f / sqrtf(wave_sum(s2) * (1.0f / D) + NORM_EPS);
#pragma unroll
        for (int j = 0; j < 4; ++j) { const f32x4 gg = ((const GAS f32x4*)gnext)[lane + 64 * j]; u32x2 w; w.x = pk2(xv[j][0] * rstd2 * gg[0], xv[j][1] * rstd2 * gg[1]); w.y = pk2(xv[j][2] * rstd2 * gg[2], xv[j][3] * rstd2 * gg[3]);
            ((GAS u32x2*)xn)[lane + 64 * j] = w; }
        if (lane == 0) *rstd_io = rstd2;
    } else {
#pragma unroll
        for (int j = 0; j < 4; ++j) ((GAS f32x4*)xout_f32)[lane + 64 * j] = xv[j];
    }
}

struct Args { const float* in[17]; float* out; unsigned char* ws; };
constexpr int PT_OFF = LDSCTL_OFF;
__device__ __forceinline__ unsigned char* ldptr(LAS unsigned char* lds, int idx) {
    const volatile LAS unsigned* p = (const volatile LAS unsigned*)(lds + PT_OFF + idx * 8);
    const unsigned lo = (unsigned)__builtin_amdgcn_readfirstlane((int)p[0]), hi = (unsigned)__builtin_amdgcn_readfirstlane((int)p[1]);
    return (unsigned char*)(((unsigned long long)hi << 32) | lo);
}
#define INP(i) ((const float*)ldptr(lds, (i)))
#define OUTP ((float*)ldptr(lds, 17))
#define WSP (ldptr(lds, 18))
#define IDS int tid_ = wave_s * 64 + lane_id_volatile(); const int tid = tid_, lane = tid & 63, wave = wave_s; const int G = gridDim.x, bx = blockIdx.x; \
    const int vcu = (G % 8 == 0) ? (bx % 8) * (G / 8) + bx / 8 : bx; const int gw = vcu * NWAVES + wave, NGW = G * NWAVES; (void)lane; (void)gw; (void)NGW; (void)vcu; (void)bx; (void)tid; (void)wave
template <int MODE, int AMODE>
__device__ __forceinline__ void run_gemm(LAS unsigned char* lds, const bf16_t* A, const bf16_t* Bt, int Mr, int N, int K, const pg8::Epi<MODE>& E, int wave_s) {
    pg8::Gemm g{A, Bt, Mr, N, K}; pg8::StaticOrder S; S.init(Mr, N, (int)gridDim.x, (int)blockIdx.x);
#ifndef NO_GEMM
#ifdef ONLY_MODE
    if (MODE == ONLY_MODE)
#endif
    pg8::gemm_phase<pg8::Epi<MODE>, pg8::StaticOrder, AMODE, true, true>(lds, g, S, E, wave_s);
#endif
}

#ifndef REP_GIN
#define REP_GIN 1
#endif
#ifndef REP_CMP
#define REP_CMP 1
#endif
#ifndef REP_SCAN
#define REP_SCAN 1
#endif
#ifndef REP_ATT_NSA
#define REP_ATT_NSA 1
#endif
#ifndef REP_ATT_FOX
#define REP_ATT_FOX 1
#endif
#ifndef REP_ATT_SWA
#define REP_ATT_SWA 1
#endif
#ifndef REP_GOUT
#define REP_GOUT 1
#endif
#ifndef REP_MLP
#define REP_MLP 1
#endif
#ifndef REP_PRO
#define REP_PRO 1
#endif
template <int L>
__device__ __forceinline__ void layer_body(LAS unsigned char* lds, const XcdBarrier& bar, int& aslot, const int wave_s) {
#define GRID_BAR() xcd_barrier(bar)
    constexpr int kind = L % 3, sl = L / 3;
    if (kind == 0) {
        { unsigned char* ws = WSP;
          pg8::Epi<pg8::EM_NSA> E{(bf16_t*)(ws + WS_BIG), NSA_LDP, nullptr, (const float*)(ws + WS_ROPEC), (const float*)(ws + WS_ROPES), (float*)(ws + WS_G), nullptr, (bf16_t*)(ws + WS_BIG + NSA_HM_OFF), NSA_HM_STRIDE};
          run_gemm<pg8::EM_NSA, 0>(lds + RING_OFF, (const bf16_t*)(ws + WS_XN), (const bf16_t*)(ws + WS_WNSA) + (size_t)sl * NSA_NP * D, M, NSA_NP, D, E, wave_s); }
        GRID_BAR();
#if REP_GIN >= 2
        { unsigned char* ws = WSP;
          pg8::Epi<pg8::EM_NSA> E{(bf16_t*)(ws + WS_BIG), NSA_LDP, nullptr, (const float*)(ws + WS_ROPEC), (const float*)(ws + WS_ROPES), (float*)(ws + WS_G), nullptr, (bf16_t*)(ws + WS_BIG + NSA_HM_OFF), NSA_HM_STRIDE};
          run_gemm<pg8::EM_NSA, 0>(lds + RING_OFF, (const bf16_t*)(ws + WS_XN), (const bf16_t*)(ws + WS_WNSA) + (size_t)sl * NSA_NP * D, M, NSA_NP, D, E, wave_s); }
        GRID_BAR();
#endif
        { unsigned char* ws = WSP;
          pg8::Epi<pg8::EM_CMP> E{(bf16_t*)(ws + WS_HID), 256, (const float*)(ws + WS_CMPB) + sl * 512, nullptr, nullptr, nullptr, nullptr, nullptr, 0};
          run_gemm<pg8::EM_CMP, 1>(lds + RING_OFF, (const bf16_t*)(ws + WS_BIG) + 1024, (const bf16_t*)(ws + WS_WCMP) + (size_t)sl * 2 * 256 * 2048, CMP_ROWS, 512, 2048, E, wave_s); }
        GRID_BAR();
#if REP_CMP >= 2
        { unsigned char* ws = WSP;
          pg8::Epi<pg8::EM_CMP> E{(bf16_t*)(ws + WS_HID), 256, (const float*)(ws + WS_CMPB) + sl * 512, nullptr, nullptr, nullptr, nullptr, nullptr, 0};
          run_gemm<pg8::EM_CMP, 1>(lds + RING_OFF, (const bf16_t*)(ws + WS_BIG) + 1024, (const bf16_t*)(ws + WS_WCMP) + (size_t)sl * 2 * 256 * 2048, CMP_ROWS, 512, 2048, E, wave_s); }
        GRID_BAR();
#endif
        { IDS; unsigned char* ws = WSP; const bf16_t* HID = (const bf16_t*)(ws + WS_HID); const float* nsa_w2 = INP(7);
          const int which = bx >> 7, wl = bx & 127;
          LAS float* w2s = (LAS float*)(lds + RING_OFF);
          { const GAS f32x4* w2g = (const GAS f32x4*)(nsa_w2 + (size_t)(sl * 2 + which) * 256 * 64); for (int i = tid; i < 4096; i += 512) ((LAS f32x4*)w2s)[i] = w2g[i]; }
          __syncthreads();
          const int r0 = (wl * 8 + wave) * 8;
          float f[8][4], acc[8];
#pragma unroll
          for (int q = 0; q < 8; ++q) { const u32x2 hw = *(const GAS u32x2*)(HID + ((size_t)which * CMP_ROWS + r0 + q) * 256 + 4 * lane);
              f[q][0] = __uint_as_float(hw.x << 16); f[q][1] = __uint_as_float(hw.x & 0xffff0000u); f[q][2] = __uint_as_float(hw.y << 16); f[q][3] = __uint_as_float(hw.y & 0xffff0000u); acc[q] = 0.f; }
          const LAS float* wcol = w2s + (which ? lane : il64(lane));
          for (int jj = 0; jj < 64; ++jj) {
#pragma unroll
              for (int s = 0; s < 4; ++s) { const float w = wcol[(4 * jj + s) * 64];
#pragma unroll
                  for (int q = 0; q < 8; ++q) acc[q] += __builtin_bit_cast(float, __builtin_amdgcn_readlane(__builtin_bit_cast(int, f[q][s]), jj)) * w; }
          }
          bf16_t* dstb = (bf16_t*)(ws + (which ? WS_VC : WS_KC));
#pragma unroll
          for (int q = 0; q < 8; ++q) { const int r = r0 + q, gg = r & 3, c = (r >> 2) & 127, b = r >> 9;
              dstb[(size_t)((b * 4 + gg) * NCP + c) * 64 + lane] = (bf16_t)f2bf(c == NC ? 0.f : acc[q]); }
          __syncthreads();
        }
        GRID_BAR();
#if REP_CMP >= 2
        { IDS; unsigned char* ws = WSP; const bf16_t* HID = (const bf16_t*)(ws + WS_HID); const float* nsa_w2 = INP(7);
          const int which = bx >> 7, wl = bx & 127;
          LAS float* w2s = (LAS float*)(lds + RING_OFF);
          { const GAS f32x4* w2g = (const GAS f32x4*)(nsa_w2 + (size_t)(sl * 2 + which) * 256 * 64); for (int i = tid; i < 4096; i += 512) ((LAS f32x4*)w2s)[i] = w2g[i]; }
          __syncthreads();
          const int r0 = (wl * 8 + wave) * 8;
          float f[8][4], acc[8];
#pragma unroll
          for (int q = 0; q < 8; ++q) { const u32x2 hw = *(const GAS u32x2*)(HID + ((size_t)which * CMP_ROWS + r0 + q) * 256 + 4 * lane);
              f[q][0] = __uint_as_float(hw.x << 16); f[q][1] = __uint_as_float(hw.x & 0xffff0000u); f[q][2] = __uint_as_float(hw.y << 16); f[q][3] = __uint_as_float(hw.y & 0xffff0000u); acc[q] = 0.f; }
          const LAS float* wcol = w2s + (which ? lane : il64(lane));
          for (int jj = 0; jj < 64; ++jj) {
#pragma unroll
              for (int s = 0; s < 4; ++s) { const float w = wcol[(4 * jj + s) * 64];
#pragma unroll
                  for (int q = 0; q < 8; ++q) acc[q] += __builtin_bit_cast(float, __builtin_amdgcn_readlane(__builtin_bit_cast(int, f[q][s]), jj)) * w; }
          }
          bf16_t* dstb = (bf16_t*)(ws + (which ? WS_VC : WS_KC));
#pragma unroll
          for (int q = 0; q < 8; ++q) { const int r = r0 + q, gg = r & 3, c = (r >> 2) & 127, b = r >> 9;
              dstb[(size_t)((b * 4 + gg) * NCP + c) * 64 + lane] = (bf16_t)f2bf(c == NC ? 0.f : acc[q]); }
          __syncthreads();
        }
        GRID_BAR();
#endif
        { IDS; unsigned char* ws = WSP;
          const int bg = vcu >> 2, sub = vcu & 3, b = bg >> 2, g = bg & 3;
          for (int i = 0; i < 8; ++i) { const int qt = (i & 1) ? (8 * (i >> 1) + 7 - sub) : (8 * (i >> 1) + sub);
#ifndef NO_NSA
              att::nsa_unit(lds + RING_OFF, b, g, qt, ws, WS_BIG, WS_G, WS_KC, WS_VC, WS_O, wave, aslot);
#endif
          } }
#if REP_ATT_NSA >= 2
        GRID_BAR();
        { IDS; unsigned char* ws = WSP;
          const int bg = vcu >> 2, sub = vcu & 3, b = bg >> 2, g = bg & 3;
          for (int i = 0; i < 8; ++i) { const int qt = (i & 1) ? (8 * (i >> 1) + 7 - sub) : (8 * (i >> 1) + sub);
#ifndef NO_NSA
              att::nsa_unit(lds + RING_OFF, b, g, qt, ws, WS_BIG, WS_G, WS_KC, WS_VC, WS_O, wave, aslot);
#endif
          } }
#endif
    } else if (kind == 1) {
        { unsigned char* ws = WSP;
          pg8::Epi<pg8::EM_FOX> E{(bf16_t*)(ws + WS_BIG), FOX_LDP, nullptr, nullptr, nullptr, (float*)(ws + WS_LF), INP(10), (bf16_t*)(ws + WS_BIG + FOX_HM_OFF), FOX_HM_STRIDE};
          run_gemm<pg8::EM_FOX, 0>(lds + RING_OFF, (const bf16_t*)(ws + WS_XN), (const bf16_t*)(ws + WS_WFOX), M, FOX_NP, D, E, wave_s); }
        GRID_BAR();
#if REP_GIN >= 2
        { unsigned char* ws = WSP;
          pg8::Epi<pg8::EM_FOX> E{(bf16_t*)(ws + WS_BIG), FOX_LDP, nullptr, nullptr, nullptr, (float*)(ws + WS_LF), INP(10), (bf16_t*)(ws + WS_BIG + FOX_HM_OFF), FOX_HM_STRIDE};
          run_gemm<pg8::EM_FOX, 0>(lds + RING_OFF, (const bf16_t*)(ws + WS_XN), (const bf16_t*)(ws + WS_WFOX), M, FOX_NP, D, E, wave_s); }
        GRID_BAR();
#endif
        { IDS; unsigned char* ws = WSP; const float* LF = (const float*)(ws + WS_LF); float* CB = (float*)(ws + WS_CB);
          if (wave == 0) for (int bh = bx; bh < BATCH * NH; bh += G) {
            const int b = bh >> 4, h = bh & 15; float v[32]; float run = 0.f;
#pragma unroll
            for (int i = 0; i < 32; ++i) { run += LF[((size_t)b * T + 32 * lane + i) * 16 + h]; v[i] = run; }
            float excl = 0.f;
            for (int k = 0; k < 63; ++k) { const float t = __builtin_bit_cast(float, __builtin_amdgcn_readlane(__builtin_bit_cast(int, run), k)); if (lane > k) excl += t; }
#pragma unroll
            for (int i = 0; i < 32; ++i) CB[(size_t)bh * T + 32 * lane + i] = -(v[i] + excl) * LOG2E;
          } }
        GRID_BAR();
#if REP_SCAN >= 2
        { IDS; unsigned char* ws = WSP; const float* LF = (const float*)(ws + WS_LF); float* CB = (float*)(ws + WS_CB);
          if (wave == 0) for (int bh = bx; bh < BATCH * NH; bh += G) {
            const int b = bh >> 4, h = bh & 15; float v[32]; float run = 0.f;
#pragma unroll
            for (int i = 0; i < 32; ++i) { run += LF[((size_t)b * T + 32 * lane + i) * 16 + h]; v[i] = run; }
            float excl = 0.f;
            for (int k = 0; k < 63; ++k) { const float t = __builtin_bit_cast(float, __builtin_amdgcn_readlane(__builtin_bit_cast(int, run), k)); if (lane > k) excl += t; }
#pragma unroll
            for (int i = 0; i < 32; ++i) CB[(size_t)bh * T + 32 * lane + i] = -(v[i] + excl) * LOG2E;
          } }
        GRID_BAR();
#endif
        { IDS; unsigned char* ws = WSP;
          const int xcd = vcu >> 5, c = vcu & 31, sub = c & 3;
          for (int i = 0; i < 8; ++i) { const int bh = 32 * xcd + 8 * (i >> 1) + (c >> 2); const int qb = (i & 1) ? sub : 7 - sub;
#ifndef NO_FOX
              att::fox_unit(lds + RING_OFF, bh >> 4, bh & 15, qb, ws, WS_BIG, WS_CB, WS_O, wave, aslot);
#endif
          } }
#if REP_ATT_FOX >= 2
        GRID_BAR();
        { IDS; unsigned char* ws = WSP;
          const int xcd = vcu >> 5, c = vcu & 31, sub = c & 3;
          for (int i = 0; i < 8; ++i) { const int bh = 32 * xcd + 8 * (i >> 1) + (c >> 2); const int qb = (i & 1) ? sub : 7 - sub;
#ifndef NO_FOX
              att::fox_unit(lds + RING_OFF, bh >> 4, bh & 15, qb, ws, WS_BIG, WS_CB, WS_O, wave, aslot);
#endif
          } }
#endif
    } else {
        { unsigned char* ws = WSP;
          pg8::Epi<pg8::EM_SWA> E{(bf16_t*)(ws + WS_BIG), SWA_LDP, (const float*)(ws + WS_SWAB), (const float*)(ws + WS_ROPEC), (const float*)(ws + WS_ROPES), nullptr, nullptr, (bf16_t*)(ws + WS_BIG + SWA_HM_OFF), SWA_HM_STRIDE};
          run_gemm<pg8::EM_SWA, 0>(lds + RING_OFF, (const bf16_t*)(ws + WS_XN), (const bf16_t*)(ws + WS_WSWA), M, SWA_NP, D, E, wave_s); }
        GRID_BAR();
#if REP_GIN >= 2
        { unsigned char* ws = WSP;
          pg8::Epi<pg8::EM_SWA> E{(bf16_t*)(ws + WS_BIG), SWA_LDP, (const float*)(ws + WS_SWAB), (const float*)(ws + WS_ROPEC), (const float*)(ws + WS_ROPES), nullptr, nullptr, (bf16_t*)(ws + WS_BIG + SWA_HM_OFF), SWA_HM_STRIDE};
          run_gemm<pg8::EM_SWA, 0>(lds + RING_OFF, (const bf16_t*)(ws + WS_XN), (const bf16_t*)(ws + WS_WSWA), M, SWA_NP, D, E, wave_s); }
        GRID_BAR();
#endif
        { IDS; unsigned char* ws = WSP; const float* sinks = INP(14);
          const int bg = vcu >> 3, sub = vcu & 7;
          for (int i = 0; i < 8; ++i) {
#ifndef NO_SWA
              att::swa_unit(lds + RING_OFF, bg >> 1, bg & 1, 8 * i + sub, ws, WS_BIG, WS_O, sinks, wave, aslot);
#endif
          } }
#if REP_ATT_SWA >= 2
        GRID_BAR();
        { IDS; unsigned char* ws = WSP; const float* sinks = INP(14);
          const int bg = vcu >> 3, sub = vcu & 7;
          for (int i = 0; i < 8; ++i) {
#ifndef NO_SWA
              att::swa_unit(lds + RING_OFF, bg >> 1, bg & 1, 8 * i + sub, ws, WS_BIG, WS_O, sinks, wave, aslot);
#endif
          } }
#endif
    }
    GRID_BAR();
    { unsigned char* ws = WSP;
      pg8::Epi<pg8::EM_PLAIN> E{(bf16_t*)(ws + WS_BIG), D, kind == 2 ? INP(16) : nullptr, nullptr, nullptr, nullptr, nullptr, nullptr, 0};
      run_gemm<pg8::EM_PLAIN, 0>(lds + RING_OFF, (const bf16_t*)(ws + WS_O), (const bf16_t*)(ws + WS_WOUT) + (size_t)L * D * D, M, D, D, E, wave_s); }
    GRID_BAR();
#if REP_GOUT >= 2
    { unsigned char* ws = WSP;
      pg8::Epi<pg8::EM_PLAIN> E{(bf16_t*)(ws + WS_BIG), D, kind == 2 ? INP(16) : nullptr, nullptr, nullptr, nullptr, nullptr, nullptr, 0};
      run_gemm<pg8::EM_PLAIN, 0>(lds + RING_OFF, (const bf16_t*)(ws + WS_O), (const bf16_t*)(ws + WS_WOUT) + (size_t)L * D * D, M, D, D, E, wave_s); }
    GRID_BAR();
#endif
    { IDS; unsigned char* ws = WSP; const float* gL = INP(1) + (size_t)L * 4 * D; const float* xin = (L == 0) ? INP(0) : nullptr;
      const bf16_t* MB = (const bf16_t*)(ws + WS_BIG); bf16_t* XN = (bf16_t*)(ws + WS_XN); float* RSTD = (float*)(ws + WS_RSTD);
      for (int m = gw; m < M; m += NGW) resnorm_row(xin ? xin + (size_t)m * D : nullptr, XN + (size_t)m * D, RSTD + m, gL, MB + (size_t)m * D, gL + D, gL + 2 * D, nullptr, lane); }
    GRID_BAR();
    { unsigned char* ws = WSP;
      pg8::Epi<pg8::EM_RELU2> E{(bf16_t*)(ws + WS_BIG), FF, nullptr, nullptr, nullptr, nullptr, nullptr, nullptr, 0};
      run_gemm<pg8::EM_RELU2, 0>(lds + RING_OFF, (const bf16_t*)(ws + WS_XN), (const bf16_t*)(ws + WS_WUP) + (size_t)L * D * FF, M, FF, D, E, wave_s); }
    GRID_BAR();
#if REP_MLP >= 2
    { unsigned char* ws = WSP;
      pg8::Epi<pg8::EM_RELU2> E{(bf16_t*)(ws + WS_BIG), FF, nullptr, nullptr, nullptr, nullptr, nullptr, nullptr, 0};
      run_gemm<pg8::EM_RELU2, 0>(lds + RING_OFF, (const bf16_t*)(ws + WS_XN), (const bf16_t*)(ws + WS_WUP) + (size_t)L * D * FF, M, FF, D, E, wave_s); }
    GRID_BAR();
#endif
    { unsigned char* ws = WSP;
      pg8::Epi<pg8::EM_PLAIN> E{(bf16_t*)(ws + WS_M2), D, nullptr, nullptr, nullptr, nullptr, nullptr, nullptr, 0};
      run_gemm<pg8::EM_PLAIN, 0>(lds + RING_OFF, (const bf16_t*)(ws + WS_BIG), (const bf16_t*)(ws + WS_WDN) + (size_t)L * D * FF, M, D, FF, E, wave_s); }
    GRID_BAR();
#if REP_MLP >= 2
    { unsigned char* ws = WSP;
      pg8::Epi<pg8::EM_PLAIN> E{(bf16_t*)(ws + WS_M2), D, nullptr, nullptr, nullptr, nullptr, nullptr, nullptr, 0};
      run_gemm<pg8::EM_PLAIN, 0>(lds + RING_OFF, (const bf16_t*)(ws + WS_BIG), (const bf16_t*)(ws + WS_WDN) + (size_t)L * D * FF, M, D, FF, E, wave_s); }
    GRID_BAR();
#endif
    { IDS; unsigned char* ws = WSP; const float* gL = INP(1) + (size_t)L * 4 * D; float* xout = OUTP; bf16_t* XN = (bf16_t*)(ws + WS_XN); const bf16_t* M2 = (const bf16_t*)(ws + WS_M2); float* RSTD = (float*)(ws + WS_RSTD);
      for (int m = gw; m < M; m += NGW) resnorm_row(nullptr, XN + (size_t)m * D, RSTD + m, gL + 2 * D, M2 + (size_t)m * D, gL + 3 * D, (L + 1 < DEPTH) ? gL + 4 * D : nullptr, xout + (size_t)m * D, lane); }
    if (L + 1 < DEPTH) GRID_BAR();
#undef GRID_BAR
}

__global__ void __launch_bounds__(NWAVES * 64, 2) fwd_kernel(Args args) {
    extern __shared__ __attribute__((aligned(16))) unsigned char lds_raw[];
    LAS unsigned char* lds = (LAS unsigned char*)lds_raw;
    const int wave_s = __builtin_amdgcn_readfirstlane((int)threadIdx.x >> 6);
    for (int u = threadIdx.x; u < (LDS_BYTES - LDSCTL_OFF) / 4; u += NWAVES * 64) ((LAS unsigned*)(lds + LDSCTL_OFF))[u] = 0u;
    __syncthreads();
    if (threadIdx.x == 0) {
        LAS unsigned long long* pt = (LAS unsigned long long*)(lds + PT_OFF);
#pragma unroll
        for (int i = 0; i < 17; ++i) pt[i] = (unsigned long long)args.in[i];
        pt[17] = (unsigned long long)args.out; pt[18] = (unsigned long long)args.ws;
    }
    __syncthreads();
    volatile LAS unsigned* MISC = (volatile LAS unsigned*)(lds + MISC_OFF);
    XcdBarrier bar = xcd_barrier_post((unsigned*)(WSP + WS_CTL) + CW_BAR, MISC + 8);

    {
        IDS; unsigned char* ws = WSP;
        const float* x_in = INP(0); const float* norm_g = INP(1); const float* mlp_up = INP(2); const float* mlp_dn = INP(3);
        const float* nsa_w_in = INP(4); const float* nsa_pos = INP(5); const float* nsa_w1 = INP(6); const float* nsa_w_out = INP(8);
        const float* fox_w_in = INP(9); const float* fox_w_out = INP(11); const float* swa_w_in = INP(12); const float* swa_b_in = INP(13); const float* swa_w_out = INP(15);
        bf16_t* W_UP = (bf16_t*)(ws + WS_WUP); bf16_t* W_DN = (bf16_t*)(ws + WS_WDN); bf16_t* W_NSA = (bf16_t*)(ws + WS_WNSA); bf16_t* W_OUT = (bf16_t*)(ws + WS_WOUT);
        bf16_t* W_FOX = (bf16_t*)(ws + WS_WFOX); bf16_t* W_SWA = (bf16_t*)(ws + WS_WSWA); bf16_t* W_CMP = (bf16_t*)(ws + WS_WCMP);
        float* ROPEC = (float*)(ws + WS_ROPEC); float* ROPES = (float*)(ws + WS_ROPES); float* CMPB = (float*)(ws + WS_CMPB); float* SWAB = (float*)(ws + WS_SWAB);
        bf16_t* XN = (bf16_t*)(ws + WS_XN);
        LAS float* scr = (LAS float*)(lds + RING_OFF + wave * 16384);
        constexpr int I_UP = (D / 64) * (FF / 32), I_DN = (FF / 64) * (D / 32), I_NSA = (D / 64) * ((NSA_N + 31) / 32), I_OUT = (D / 64) * (D / 32), I_FOX = (D / 64) * ((FOX_N + 31) / 32), I_SWA = (D / 64) * (SWA_N / 32), I_CMP = (2048 / 64) * (256 / 32);
        constexpr int NITEMS = 4 * I_UP + 4 * I_DN + 2 * I_NSA + 4 * I_OUT + I_FOX + I_SWA + 4 * I_CMP;
        for (int it = gw; it < NITEMS; it += NGW) {
            int r = it;
            if (r < 4 * I_UP) { const int Lw = r / I_UP; conv_item(mlp_up + (size_t)Lw * D * FF, D, FF, W_UP + (size_t)Lw * D * FF, 0, r % I_UP, scr, lane); continue; } r -= 4 * I_UP;
            if (r < 4 * I_DN) { const int Lw = r / I_DN; conv_item(mlp_dn + (size_t)Lw * D * FF, FF, D, W_DN + (size_t)Lw * D * FF, 0, r % I_DN, scr, lane); continue; } r -= 4 * I_DN;
            if (r < 2 * I_NSA) { const int s = r / I_NSA; conv_item(nsa_w_in + (size_t)s * D * NSA_N, D, NSA_N, W_NSA + (size_t)s * NSA_NP * D, 1, r % I_NSA, scr, lane); continue; } r -= 2 * I_NSA;
            if (r < 4 * I_OUT) { const int Lw = r / I_OUT; const float* src = (Lw == 1) ? fox_w_out : (Lw == 2) ? swa_w_out : nsa_w_out + (size_t)(Lw / 3) * D * D;
                conv_item(src, D, D, W_OUT + (size_t)Lw * D * D, 0, r % I_OUT, scr, lane); continue; } r -= 4 * I_OUT;
            if (r < I_FOX) { conv_item(fox_w_in, D, FOX_N, W_FOX, 2, r, scr, lane); continue; } r -= I_FOX;
            if (r < I_SWA) { conv_item(swa_w_in, D, SWA_N, W_SWA, 3, r, scr, lane); continue; } r -= I_SWA;
            { const int sw = r / I_CMP;
                conv_item(nsa_w1 + (size_t)sw * 2048 * 256, 2048, 256, W_CMP + (size_t)sw * 256 * 2048, (sw & 1) ? 0 : 4, r % I_CMP, scr, lane); }
        }
        { constexpr int ZN = (NSA_NP - NSA_N) * D / 8, ZF = (FOX_NP - FOX_N) * D / 8;
          for (int e = bx * 512 + tid; e < 2 * ZN + ZF; e += G * 512) {
              bf16_t* dst = e < ZN ? W_NSA + (size_t)NSA_N * D + (size_t)e * 8 : e < 2 * ZN ? W_NSA + (size_t)NSA_NP * D + (size_t)NSA_N * D + (size_t)(e - ZN) * 8 : W_FOX + (size_t)FOX_N * D + (size_t)(e - 2 * ZN) * 8;
              *(GAS u32x4*)dst = (u32x4){0u, 0u, 0u, 0u}; } }
        for (int e = bx * 512 + tid; e < T * 32; e += G * 512) { const int t = e >> 5, i = e & 31; const float inv = powf(10000.0f, -(float)(2 * i) / 64.0f); const float ang = (float)t * inv;
            ROPEC[e] = cosf(ang); ROPES[e] = sinf(ang); }
        for (int e = bx * 512 + tid; e < SWA_N; e += G * 512) SWAB[e] = swa_b_in[src_n(3, e)];
        for (int task = bx; task < 64; task += G) {
            const int sw = task >> 4, n0 = (task & 15) * 16, kq = tid >> 4, nn = tid & 15;
            const float* pos = nsa_pos + (size_t)sw * 2048; const float* w1 = nsa_w1 + (size_t)sw * 2048 * 256;
            float acc = 0.f;
#pragma unroll 8
            for (int k = kq * 64; k < kq * 64 + 64; ++k) acc += pos[k] * w1[(size_t)k * 256 + n0 + nn];
            LAS float* red = (LAS float*)(lds + RING_OFF);
            __syncthreads();
            red[kq * 16 + nn] = acc;
            __syncthreads();
            if (tid < 16) { float sm = 0.f; for (int q = 0; q < 32; ++q) sm += red[q * 16 + tid]; CMPB[sw * 256 + n0 + tid] = sm; }
            __syncthreads();
        }
        for (int m = gw; m < M; m += NGW) norm_row(x_in + (size_t)m * D, norm_g, XN + (size_t)m * D, (float*)(ws + WS_RSTD) + m, lane);
    }
#if REP_PRO >= 2
    xcd_barrier(bar);
    {
        IDS; unsigned char* ws = WSP;
        const float* x_in = INP(0); const float* norm_g = INP(1); const float* mlp_up = INP(2); const float* mlp_dn = INP(3);
        const float* nsa_w_in = INP(4); const float* nsa_pos = INP(5); const float* nsa_w1 = INP(6); const float* nsa_w_out = INP(8);
        const float* fox_w_in = INP(9); const float* fox_w_out = INP(11); const float* swa_w_in = INP(12); const float* swa_b_in = INP(13); const float* swa_w_out = INP(15);
        bf16_t* W_UP = (bf16_t*)(ws + WS_WUP); bf16_t* W_DN = (bf16_t*)(ws + WS_WDN); bf16_t* W_NSA = (bf16_t*)(ws + WS_WNSA); bf16_t* W_OUT = (bf16_t*)(ws + WS_WOUT);
        bf16_t* W_FOX = (bf16_t*)(ws + WS_WFOX); bf16_t* W_SWA = (bf16_t*)(ws + WS_WSWA); bf16_t* W_CMP = (bf16_t*)(ws + WS_WCMP);
        float* ROPEC = (float*)(ws + WS_ROPEC); float* ROPES = (float*)(ws + WS_ROPES); float* CMPB = (float*)(ws + WS_CMPB); float* SWAB = (float*)(ws + WS_SWAB);
        bf16_t* XN = (bf16_t*)(ws + WS_XN);
        LAS float* scr = (LAS float*)(lds + RING_OFF + wave * 16384);
        constexpr int I_UP = (D / 64) * (FF / 32), I_DN = (FF / 64) * (D / 32), I_NSA = (D / 64) * ((NSA_N + 31) / 32), I_OUT = (D / 64) * (D / 32), I_FOX = (D / 64) * ((FOX_N + 31) / 32), I_SWA = (D / 64) * (SWA_N / 32), I_CMP = (2048 / 64) * (256 / 32);
        constexpr int NITEMS = 4 * I_UP + 4 * I_DN + 2 * I_NSA + 4 * I_OUT + I_FOX + I_SWA + 4 * I_CMP;
        for (int it = gw; it < NITEMS; it += NGW) {
            int r = it;
            if (r < 4 * I_UP) { const int Lw = r / I_UP; conv_item(mlp_up + (size_t)Lw * D * FF, D, FF, W_UP + (size_t)Lw * D * FF, 0, r % I_UP, scr, lane); continue; } r -= 4 * I_UP;
            if (r < 4 * I_DN) { const int Lw = r / I_DN; conv_item(mlp_dn + (size_t)Lw * D * FF, FF, D, W_DN + (size_t)Lw * D * FF, 0, r % I_DN, scr, lane); continue; } r -= 4 * I_DN;
            if (r < 2 * I_NSA) { const int s = r / I_NSA; conv_item(nsa_w_in + (size_t)s * D * NSA_N, D, NSA_N, W_NSA + (size_t)s * NSA_NP * D, 1, r % I_NSA, scr, lane); continue; } r -= 2 * I_NSA;
            if (r < 4 * I_OUT) { const int Lw = r / I_OUT; const float* src = (Lw == 1) ? fox_w_out : (Lw == 2) ? swa_w_out : nsa_w_out + (size_t)(Lw / 3) * D * D;
                conv_item(src, D, D, W_OUT + (size_t)Lw * D * D, 0, r % I_OUT, scr, lane); continue; } r -= 4 * I_OUT;
            if (r < I_FOX) { conv_item(fox_w_in, D, FOX_N, W_FOX, 2, r, scr, lane); continue; } r -= I_FOX;
            if (r < I_SWA) { conv_item(swa_w_in, D, SWA_N, W_SWA, 3, r, scr, lane); continue; } r -= I_SWA;
            { const int sw = r / I_CMP;
                conv_item(nsa_w1 + (size_t)sw * 2048 * 256, 2048, 256, W_CMP + (size_t)sw * 256 * 2048, (sw & 1) ? 0 : 4, r % I_CMP, scr, lane); }
        }
        { constexpr int ZN = (NSA_NP - NSA_N) * D / 8, ZF = (FOX_NP - FOX_N) * D / 8;
          for (int e = bx * 512 + tid; e < 2 * ZN + ZF; e += G * 512) {
              bf16_t* dst = e < ZN ? W_NSA + (size_t)NSA_N * D + (size_t)e * 8 : e < 2 * ZN ? W_NSA + (size_t)NSA_NP * D + (size_t)NSA_N * D + (size_t)(e - ZN) * 8 : W_FOX + (size_t)FOX_N * D + (size_t)(e - 2 * ZN) * 8;
              *(GAS u32x4*)dst = (u32x4){0u, 0u, 0u, 0u}; } }
        for (int e = bx * 512 + tid; e < T * 32; e += G * 512) { const int t = e >> 5, i = e & 31; const float inv = powf(10000.0f, -(float)(2 * i) / 64.0f); const float ang = (float)t * inv;
            ROPEC[e] = cosf(ang); ROPES[e] = sinf(ang); }
        for (int e = bx * 512 + tid; e < SWA_N; e += G * 512) SWAB[e] = swa_b_in[src_n(3, e)];
        for (int task = bx; task < 64; task += G) {
            const int sw = task >> 4, n0 = (task & 15) * 16, kq = tid >> 4, nn = tid & 15;
            const float* pos = nsa_pos + (size_t)sw * 2048; const float* w1 = nsa_w1 + (size_t)sw * 2048 * 256;
            float acc = 0.f;
#pragma unroll 8
            for (int k = kq * 64; k < kq * 64 + 64; ++k) acc += pos[k] * w1[(size_t)k * 256 + n0 + nn];
            LAS float* red = (LAS float*)(lds + RING_OFF);
            __syncthreads();
            red[kq * 16 + nn] = acc;
            __syncthreads();
            if (tid < 16) { float sm = 0.f; for (int q = 0; q < 32; ++q) sm += red[q * 16 + tid]; CMPB[sw * 256 + n0 + tid] = sm; }
            __syncthreads();
        }
        for (int m = gw; m < M; m += NGW) norm_row(x_in + (size_t)m * D, norm_g, XN + (size_t)m * D, (float*)(ws + WS_RSTD) + m, lane);
    }
#endif
    xcd_barrier(bar);

    int aslot = 0;
    if (L_LO <= 0 && 0 < L_HI) layer_body<0>(lds, bar, aslot, wave_s);
    if (L_LO <= 1 && 1 < L_HI) layer_body<1>(lds, bar, aslot, wave_s);
    if (L_LO <= 2 && 2 < L_HI) layer_body<2>(lds, bar, aslot, wave_s);
    if (L_LO <= 3 && 3 < L_HI) layer_body<3>(lds, bar, aslot, wave_s);
}

extern "C" void kernel_launch(void* const* d_in, const int* in_sizes, int n_in, void* d_out, int out_size, void* d_ws, size_t ws_size, hipStream_t stream) {
    static int grid = 0;
    if (grid == 0) {
        if (n_in != 17 || in_sizes[0] != M * D || out_size != M * D || ws_size < WS_END) { fprintf(stderr, "kernel_launch: unexpected problem shape (n_in %d, in0 %d, out %d, ws %zu)\n", n_in, n_in > 0 ? in_sizes[0] : -1, out_size, ws_size); grid = -1; return; }
        int dev = 0, cus = 0, per_cu = 0;
        if (hipGetDevice(&dev) != hipSuccess || hipDeviceGetAttribute(&cus, hipDeviceAttributeMultiprocessorCount, dev) != hipSuccess) { grid = -1; return; }
        if (hipFuncSetAttribute((const void*)fwd_kernel, hipFuncAttributeMaxDynamicSharedMemorySize, LDS_BYTES) != hipSuccess) { fprintf(stderr, "kernel_launch: hipFuncSetAttribute failed\n"); grid = -1; return; }
        if (hipOccupancyMaxActiveBlocksPerMultiprocessor(&per_cu, (const void*)fwd_kernel, NWAVES * 64, LDS_BYTES) != hipSuccess || per_cu < 1) { fprintf(stderr, "kernel_launch: occupancy query reports %d\n", per_cu); }
        (void)hipGetLastError();
        if (cus < 256) { fprintf(stderr, "kernel_launch: needs 256 CUs, device has %d\n", cus); grid = -1; return; }
        grid = 256;
    }
    if (grid < 0) return;
    if (hipMemsetAsync((char*)d_ws + WS_CTL, 0, CTL_ZERO_BYTES, stream) != hipSuccess) return;
    Args a{};
    for (int i = 0; i < 17; ++i) a.in[i] = (const float*)d_in[i];
    a.out = (float*)d_out; a.ws = (unsigned char*)d_ws;
    hipLaunchKernelGGL(fwd_kernel, dim3(grid), dim3(NWAVES * 64), LDS_BYTES, stream, a);
}
```

```cpp
#include <hip/hip_runtime.h>
#include <cstdio>
#include <cstdint>

#define LAS __attribute__((address_space(3)))
#define GAS __attribute__((address_space(1)))
typedef unsigned short bf16_t;
typedef short bf16x8 __attribute__((ext_vector_type(8)));
typedef short s16x4 __attribute__((ext_vector_type(4)));
typedef float f32x2 __attribute__((ext_vector_type(2)));
typedef float f32x4 __attribute__((ext_vector_type(4)));
typedef float f32x16 __attribute__((ext_vector_type(16)));
typedef unsigned u32x2 __attribute__((ext_vector_type(2)));
typedef unsigned u32x4 __attribute__((ext_vector_type(4)));

constexpr int BATCH = 16, T = 2048, D = 1024, NH = 16, HD = 64, FF = 4096, DEPTH = 4;
constexpr int M = BATCH * T;
constexpr int NSA_N = 2608, NSA_NP = 2816, NSA_LDP = 1536;
constexpr int FOX_N = 3088, FOX_NP = 3328, FOX_LDP = 1024;
constexpr int SWA_N = 1280, SWA_NP = 1280, SWA_LDP = 1024;
constexpr int CMP_LDP = NSA_LDP;
constexpr int NC = 127, NCP = 128;
constexpr int CMP_ROWS = BATCH * NCP * 4;
constexpr size_t NSA_HM_OFF = (size_t)96 << 20, NSA_HM_STRIDE = (size_t)8 << 20;
constexpr size_t FOX_HM_OFF = (size_t)64 << 20, FOX_HM_STRIDE = (size_t)32 << 20;
constexpr size_t SWA_HM_OFF = (size_t)64 << 20, SWA_HM_STRIDE = (size_t)4 << 20;
constexpr float LOG2E = 1.4426950408889634f;
constexpr float C2 = 0.125f * LOG2E;
constexpr float NORM_EPS = 1e-6f;

__device__ __forceinline__ unsigned cvt_pk_bf16(float lo, float hi) { unsigned r; asm volatile("v_cvt_pk_bf16_f32 %0, %1, %2" : "=v"(r) : "v"(lo), "v"(hi)); return r; }
__device__ __forceinline__ void store8(bf16_t* p, f32x4 a, f32x4 b) { u32x4 w; w.x = cvt_pk_bf16(a[0], a[1]); w.y = cvt_pk_bf16(a[2], a[3]); w.z = cvt_pk_bf16(b[0], b[1]); w.w = cvt_pk_bf16(b[2], b[3]); *(u32x4*)p = w; }

__device__ __forceinline__ int lane_id_volatile() { int x; asm volatile("v_mbcnt_lo_u32_b32 %0, -1, 0\n\tv_mbcnt_hi_u32_b32 %0, -1, %0" : "=v"(x)); return x; }

namespace pg8 {
#define PG8_LAS __attribute__((address_space(3)))
constexpr int BM = 256, BK = 64, HALF = 128, HTB = HALF * BK * 2  , STAGE_BYTES = 8 * HTB, NXCD = 8, WGM = 8;

__host__ __device__ __forceinline__ int lds_byte(int r, int c) { const int st = (r >> 4) * 2 + (c >> 5), rr = r & 15, cc = c & 31, ob = rr * 64 + cc * 2; return st * 1024 + (ob ^ (((ob >> 9) & 1) << 5)); }
__host__ __device__ __forceinline__ void stage_rc(int b, int& R, int& C) { const int st = b / 1024, sb = b % 1024, swz = sb ^ (((sb >> 9) & 1) << 5); R = (st >> 1) * 16 + swz / 64; C = (st & 1) * 32 + (swz % 64) / 2; }
__host__ __device__ __forceinline__ int perm32(int rho) { const int n = rho >> 4, i = rho & 15; return 8 * (i >> 2) + 4 * n + (i & 3); }

struct Unit { int pm, pn; };
struct Gemm { const bf16_t* A; const bf16_t* Bt; int M, N, K; };

struct StaticOrder {
    int nM, nN, nwg, G, c;
    __host__ __device__ void init(int M_, int N_, int G_, int c_) { nM = M_ / BM; nN = N_ / BM; nwg = nM * nN; G = G_; c = c_; }
    __host__ __device__ bool next(int i, Unit& u) const {
        const long L = (long)i * G + c; if (L >= nwg) return false;
        int wgid = (int)L; { const int q = nwg / NXCD, r = nwg % NXCD, xcd = wgid % NXCD, off = wgid / NXCD; wgid = (xcd < r ? xcd * (q + 1) : r * (q + 1) + (xcd - r) * q) + off; }
        const int nig = WGM * nN, gid = wgid / nig, fm = gid * WGM, gsz = (nM - fm) < WGM ? (nM - fm) : WGM;
        u.pm = fm + ((wgid % nig) % gsz); u.pn = (wgid % nig) / gsz; return true;
    }
    __device__ __forceinline__ void a_ready(const Unit&) const {}
    __device__ __forceinline__ void done(const Unit&) const {}
};

enum EpiMode { EM_PLAIN = 0, EM_RELU2 = 1, EM_NSA = 2, EM_FOX = 3, EM_SWA = 4, EM_CMP = 5 };

__device__ __forceinline__ void rope4(f32x4& v, float c0, float s0, float c1, float s1) {
    const float a0 = v[0], b0 = v[1], a1 = v[2], b1 = v[3];
    v[0] = a0 * c0 - b0 * s0; v[1] = b0 * c0 + a0 * s0; v[2] = a1 * c1 - b1 * s1; v[3] = b1 * c1 + a1 * s1;
}
__device__ __forceinline__ float sigmoidf_(float x) { return 1.0f / (1.0f + __expf(-x)); }
__device__ __forceinline__ float logsigmoidf_(float x) { return fminf(x, 0.f) - log1pf(expf(-fabsf(x))); }

template <int MODE> struct Epi {
    static constexpr bool PERM = true, AFTER_DRAIN = false;
    bf16_t* O; int ldc; const float* bias; const float* rc; const float* rs; float* aux; const float* auxb;
    bf16_t* hm0; size_t hm_stride;
    __device__ __forceinline__ void operator()(const f32x4 (&acc)[2][2][4][2], const Unit& u, int wr, int wc, int fr, int fq) const {
        const int row0 = u.pm * BM + wr * 64 + fr;
        const int cw = wc * 32 + 8 * fq;
        const int colt = u.pn * BM;
        if (MODE == EM_NSA && u.pn == 10) {
            if (cw < 48) {
#pragma unroll
                for (int ai = 0; ai < 2; ++ai)
#pragma unroll
                    for (int m = 0; m < 4; ++m) { const size_t row = (size_t)(row0 + ai * HALF + m * 16); f32x4 v0 = acc[ai][0][m][0], v1 = acc[ai][0][m][1];
#pragma unroll
                        for (int j = 0; j < 4; ++j) { v0[j] = sigmoidf_(v0[j]); v1[j] = sigmoidf_(v1[j]); }
                        *(f32x4*)(aux + row * 48 + cw) = v0; *(f32x4*)(aux + row * 48 + cw + 4) = v1; }
            }
            return;
        }
        if (MODE == EM_FOX && u.pn == 12) {
            if (cw < 16) {
                const f32x4 b0 = *(const f32x4*)(auxb + cw), b1 = *(const f32x4*)(auxb + cw + 4);
#pragma unroll
                for (int ai = 0; ai < 2; ++ai)
#pragma unroll
                    for (int m = 0; m < 4; ++m) { const size_t row = (size_t)(row0 + ai * HALF + m * 16); f32x4 v0 = acc[ai][0][m][0] + b0, v1 = acc[ai][0][m][1] + b1;
#pragma unroll
                        for (int j = 0; j < 4; ++j) { v0[j] = logsigmoidf_(v0[j]); v1[j] = logsigmoidf_(v1[j]); }
                        *(f32x4*)(aux + row * 16 + cw) = v0; *(f32x4*)(aux + row * 16 + cw + 4) = v1; }
            }
            return;
        }
        bool rope0 = false, rope1 = false; float sc = 1.f;
        if (MODE == EM_NSA) { if (u.pn < 4) { rope0 = rope1 = true; sc = C2; } else if (!(u.pn & 1)) { rope0 = rope1 = true; } }
        if (MODE == EM_FOX) { if (u.pn < 4) sc = C2; }
        if (MODE == EM_SWA) { if (u.pn < 4) { rope0 = rope1 = true; sc = C2; } else { rope0 = true; } }
        f32x4 bv[2][2];
#pragma unroll
        for (int bj = 0; bj < 2; ++bj)
#pragma unroll
            for (int n = 0; n < 2; ++n) bv[bj][n] = bias ? *(const f32x4*)(bias + colt + bj * HALF + cw + 4 * n) : (f32x4){0.f, 0.f, 0.f, 0.f};
        const int ib = 16 * (wc & 1) + 4 * fq;
        bf16_t* base = O; int colo = colt; size_t rowo = 0;
        if (MODE == EM_CMP) { colo = 0; rowo = (size_t)u.pn * CMP_ROWS; }
        bool hm = false; bf16_t* hb[2] = {nullptr, nullptr}; int hd[2] = {0, 0}; int HG = 1;
        if (MODE == EM_FOX && u.pn >= 4) { hm = true; HG = 16; hb[0] = hb[1] = hm0 + (u.pn >= 8 ? hm_stride : 0); hd[0] = ((u.pn - 4) & 3) * 4 + (wc >> 1); hd[1] = hd[0] + 2; }
        if (MODE == EM_NSA && u.pn >= 6) { hm = true; HG = 4; hb[0] = hb[1] = hm0 + (size_t)(u.pn - 6) * hm_stride; hd[0] = (wc >> 1); hd[1] = hd[0] + 2; }
        if (MODE == EM_SWA && u.pn == 4) { hm = true; HG = 2; hb[0] = hm0; hb[1] = hm0 + hm_stride; hd[0] = hd[1] = (wc >> 1); }
#pragma unroll
        for (int ai = 0; ai < 2; ++ai)
#pragma unroll
            for (int m = 0; m < 4; ++m) {
                const int row = row0 + ai * HALF + m * 16;
                f32x4 cc = {1.f, 1.f, 1.f, 1.f}, ss = {0.f, 0.f, 0.f, 0.f};
                if (MODE == EM_NSA || MODE == EM_SWA) { if (rope0) { const int t = row & (T - 1); cc = *(const f32x4*)(rc + t * 32 + ib); ss = *(const f32x4*)(rs + t * 32 + ib); } }
                bf16_t* rowp = base + (rowo + (size_t)row) * ldc + colo + cw;
#pragma unroll
                for (int bj = 0; bj < 2; ++bj) {
                    f32x4 v0 = acc[ai][bj][m][0] + bv[bj][0], v1 = acc[ai][bj][m][1] + bv[bj][1];
                    if (MODE == EM_NSA || MODE == EM_SWA) { if (bj == 0 ? rope0 : rope1) { rope4(v0, cc[0], ss[0], cc[1], ss[1]); rope4(v1, cc[2], ss[2], cc[3], ss[3]); } }
                    if (MODE == EM_RELU2) {
#pragma unroll
                        for (int j = 0; j < 4; ++j) { const float a = fmaxf(v0[j], 0.f), b = fmaxf(v1[j], 0.f); v0[j] = a * a; v1[j] = b * b; } }
                    if (MODE == EM_CMP) {
#pragma unroll
                        for (int j = 0; j < 4; ++j) { v0[j] = v0[j] * sigmoidf_(v0[j]); v1[j] = v1[j] * sigmoidf_(v1[j]); } }
                    if (MODE == EM_NSA || MODE == EM_FOX || MODE == EM_SWA) { v0 = v0 * sc; v1 = v1 * sc; }
                    if ((MODE == EM_FOX || MODE == EM_NSA || MODE == EM_SWA) && hm) store8(hb[bj] + (((size_t)(row >> 11) * HG + hd[bj]) * T + (row & (T - 1))) * 64 + (cw & 63), v0, v1);
                    else store8(rowp + bj * HALF, v0, v1);
                }
            }
    }
};

template <class Epi, class Sched, int AMODE, bool ALIGN_EPI = false, bool SP2 = false>
__device__ __forceinline__ void gemm_phase(PG8_LAS unsigned char* lds, const Gemm g, const Sched& S, const Epi& E, int wave_id) {
    int tid_; { int x_; asm volatile("v_mbcnt_lo_u32_b32 %0, -1, 0\n\tv_mbcnt_hi_u32_b32 %0, -1, %0" : "=v"(x_)); tid_ = wave_id * 64 + x_; }
    const int tid = tid_, wid = __builtin_amdgcn_readfirstlane(tid >> 6), lane = tid & 63, wr = wid >> 2, wc = wid & 3, fr = lane & 15, fq = lane >> 4;
    const int K = g.K, nt = K / BK;
    unsigned voffA[2], voffB[2];
#pragma unroll
    for (int i = 0; i < 2; ++i) { int R, C; stage_rc(tid * 16 + i * 8192, R, C); const int Rb = Epi::PERM ? ((R & ~31) + perm32(R & 31)) : R;
        voffA[i] = (AMODE == 1) ? (unsigned)((16 * (R >> 2)) * CMP_LDP + (R & 3) * 64 + C) * 2u : (unsigned)(R * K + C) * 2u; voffB[i] = (unsigned)(Rb * K + C) * 2u; }
    const size_t kstepB = (size_t)(BK * 2);
    const size_t hstepB = (size_t)HALF * K * 2;
    const size_t tstepB = 2 * hstepB;
    const size_t kstepA = (AMODE == 1) ? (size_t)CMP_LDP * 2 : kstepB;
    const size_t hstepA = (AMODE == 1) ? (size_t)512 * CMP_LDP * 2 : hstepB;
    const size_t tstepA = 2 * hstepA;
    const size_t pnstepA = (AMODE == 1) ? (size_t)512 : (size_t)0;
    const unsigned ldsw = (unsigned)wid * 1024u;
    const int aoff = lds_byte(wr * 64 + fr, fq * 8), boff = lds_byte(wc * 32 + fr, fq * 8);
#define PG8_SA(b, h) (((b) * 2 + (h)) * HTB)
#define PG8_SB(b, h) ((4 + (b) * 2 + (h)) * HTB)
#define PG8_STAGE(bufoff, gbase, voff) do { _Pragma("unroll") for (int _i = 0; _i < 2; ++_i) \
        __builtin_amdgcn_global_load_lds((const unsigned*)((const char*)(gbase) + (voff)[_i]), (PG8_LAS unsigned*)(lds + (bufoff) + ldsw + _i * 8192), 16, 0, 0); } while (0)
#define PG8_LDA(dst, b, h) do { _Pragma("unroll") for (int m = 0; m < 4; ++m) _Pragma("unroll") for (int k = 0; k < 2; ++k) dst[m][k] = *(const PG8_LAS bf16x8*)(lds + PG8_SA(b, h) + aoff + m * 2048 + k * 1024); } while (0)
#define PG8_LDB(dst, b, h) do { _Pragma("unroll") for (int n = 0; n < 2; ++n) _Pragma("unroll") for (int k = 0; k < 2; ++k) dst[n][k] = *(const PG8_LAS bf16x8*)(lds + PG8_SB(b, h) + boff + n * 2048 + k * 1024); } while (0)
#define PG8_MMA(ai, bj, At, Bt) do { __builtin_amdgcn_s_setprio(1); _Pragma("unroll") for (int m = 0; m < 4; ++m) _Pragma("unroll") for (int n = 0; n < 2; ++n) _Pragma("unroll") for (int k = 0; k < 2; ++k) \
        acc[ai][bj][m][n] = __builtin_amdgcn_mfma_f32_16x16x32_bf16(Bt[n][k], At[m][k], acc[ai][bj][m][n], 0, 0, 0); __builtin_amdgcn_s_setprio(0); } while (0)
#define PG8_WAIT_V(n) asm volatile("s_waitcnt vmcnt(" #n ")" ::: "memory")
#define PG8_WAIT_L(n) asm volatile("s_waitcnt lgkmcnt(" #n ")" ::: "memory")
#define PG8_BAR __builtin_amdgcn_s_barrier()
#define PG8_SCHED __builtin_amdgcn_sched_barrier(0)
    Unit cur, nxt; int ui = 0;
    if (!S.next(0, cur)) return;
    f32x4 acc[2][2][4][2];
#pragma unroll
    for (int a = 0; a < 2; ++a)
#pragma unroll
        for (int b = 0; b < 2; ++b)
#pragma unroll
            for (int m = 0; m < 4; ++m)
#pragma unroll
                for (int n = 0; n < 2; ++n) acc[a][b][m][n] = (f32x4){0.f, 0.f, 0.f, 0.f};
    bf16x8 At[4][2], B0[2][2], B1[2][2];
    const char* cA = (const char*)g.A + (size_t)cur.pm * tstepA + (size_t)cur.pn * pnstepA; const char* cB = (const char*)g.Bt + (size_t)cur.pn * tstepB;
    S.a_ready(cur);
    if constexpr (SP2) {
        PG8_STAGE(PG8_SB(0, 0), cB, voffB); PG8_STAGE(PG8_SB(0, 1), cB + hstepB, voffB); PG8_STAGE(PG8_SA(0, 0), cA, voffA); PG8_STAGE(PG8_SA(0, 1), cA + hstepA, voffA);
        if (wr == 1) PG8_BAR;
        PG8_WAIT_V(2); PG8_BAR;
        PG8_STAGE(PG8_SB(1, 0), cB + kstepB, voffB); PG8_STAGE(PG8_SA(1, 0), cA + kstepA, voffA); PG8_STAGE(PG8_SB(1, 1), cB + hstepB + kstepB, voffB);
        PG8_WAIT_V(6); PG8_BAR;
    } else {
        PG8_STAGE(PG8_SB(0, 0), cB, voffB); PG8_STAGE(PG8_SA(0, 0), cA, voffA); PG8_STAGE(PG8_SB(0, 1), cB + hstepB, voffB); PG8_STAGE(PG8_SA(0, 1), cA + hstepA, voffA);
        if (wr == 1) PG8_BAR;
        PG8_WAIT_V(4); PG8_BAR;
        PG8_STAGE(PG8_SB(1, 0), cB + kstepB, voffB); PG8_STAGE(PG8_SA(1, 0), cA + kstepA, voffA); PG8_STAGE(PG8_SB(1, 1), cB + hstepB + kstepB, voffB);
        PG8_WAIT_V(6); PG8_BAR;
    }
    for (;;) {
        const bool has_next = S.next(ui + 1, nxt);
        const char* nA = has_next ? (const char*)g.A + (size_t)nxt.pm * tstepA + (size_t)nxt.pn * pnstepA : cA; const char* nB = has_next ? (const char*)g.Bt + (size_t)nxt.pn * tstepB : cB;
        for (int t = 0; t < nt; t += 2) {
            const bool last = (t == nt - 2);
            const char* a1 = cA + (size_t)(t + 1) * kstepA;
            const char* a2 = last ? nA : cA + (size_t)(t + 2) * kstepA; const char* b2 = last ? nB : cB + (size_t)(t + 2) * kstepB;
            const char* a3 = a2 + kstepA; const char* b3 = b2 + kstepB;
            if (last && has_next) S.a_ready(nxt);
            if constexpr (SP2) {
            PG8_LDB(B0, 0, 0); PG8_LDB(B1, 0, 1); PG8_SCHED; PG8_LDA(At, 0, 0); PG8_STAGE(PG8_SA(1, 1), a1 + hstepA, voffA);
            PG8_WAIT_V(8); PG8_WAIT_L(0); PG8_BAR; PG8_MMA(0, 0, At, B0); PG8_MMA(0, 1, At, B1); PG8_BAR; PG8_SCHED;
            PG8_LDA(At, 0, 1); PG8_STAGE(PG8_SB(0, 0), b2, voffB); PG8_STAGE(PG8_SB(0, 1), b2 + hstepB, voffB); PG8_STAGE(PG8_SA(0, 0), a2, voffA);
            PG8_WAIT_V(8); PG8_WAIT_L(0); PG8_BAR; PG8_MMA(1, 0, At, B0); PG8_MMA(1, 1, At, B1); PG8_BAR; PG8_SCHED;
            PG8_LDB(B0, 1, 0); PG8_LDB(B1, 1, 1); PG8_SCHED; PG8_LDA(At, 1, 0); PG8_STAGE(PG8_SA(0, 1), a2 + hstepA, voffA);
            PG8_WAIT_V(8); PG8_WAIT_L(0); PG8_BAR; PG8_MMA(0, 0, At, B0); PG8_MMA(0, 1, At, B1); PG8_BAR; PG8_SCHED;
            PG8_LDA(At, 1, 1); PG8_STAGE(PG8_SB(1, 0), b3, voffB); PG8_STAGE(PG8_SB(1, 1), b3 + hstepB, voffB); PG8_STAGE(PG8_SA(1, 0), a3, voffA);
            PG8_WAIT_V(8); PG8_WAIT_L(0); PG8_BAR; PG8_MMA(1, 0, At, B0); PG8_MMA(1, 1, At, B1); PG8_BAR; PG8_SCHED;
            } else {
            PG8_LDB(B0, 0, 0); PG8_SCHED; PG8_LDA(At, 0, 0); PG8_STAGE(PG8_SA(1, 1), a1 + hstepA, voffA);
            PG8_WAIT_L(8); PG8_BAR; PG8_WAIT_L(0); PG8_MMA(0, 0, At, B0); PG8_BAR; PG8_SCHED;
            PG8_LDB(B1, 0, 1); PG8_STAGE(PG8_SB(0, 0), b2, voffB);
            PG8_BAR; PG8_WAIT_L(0); PG8_MMA(0, 1, At, B1); PG8_BAR;
            PG8_LDA(At, 0, 1); PG8_STAGE(PG8_SA(0, 0), a2, voffA);
            PG8_BAR; PG8_WAIT_L(0); PG8_MMA(1, 0, At, B0); PG8_BAR; PG8_SCHED;
            PG8_STAGE(PG8_SB(0, 1), b2 + hstepB, voffB);
            PG8_WAIT_V(6); PG8_BAR; PG8_MMA(1, 1, At, B1); PG8_BAR;
            PG8_LDB(B0, 1, 0); PG8_SCHED; PG8_LDA(At, 1, 0); PG8_STAGE(PG8_SA(0, 1), a2 + hstepA, voffA);
            PG8_WAIT_L(8); PG8_BAR; PG8_WAIT_L(0); PG8_MMA(0, 0, At, B0); PG8_BAR; PG8_SCHED;
            PG8_LDB(B1, 1, 1); PG8_STAGE(PG8_SB(1, 0), b3, voffB);
            PG8_BAR; PG8_WAIT_L(0); PG8_MMA(0, 1, At, B1); PG8_BAR;
            PG8_LDA(At, 1, 1); PG8_STAGE(PG8_SA(1, 0), a3, voffA);
            PG8_BAR; PG8_WAIT_L(0); PG8_MMA(1, 0, At, B0); PG8_BAR; PG8_SCHED;
            PG8_STAGE(PG8_SB(1, 1), b3 + hstepB, voffB);
            PG8_WAIT_V(6); PG8_BAR; PG8_MMA(1, 1, At, B1); PG8_BAR;
            }
        }
        if constexpr (ALIGN_EPI) { if (wr == 0) PG8_BAR; }
        if constexpr (!Epi::AFTER_DRAIN) { E(acc, cur, wr, wc, fr, fq); S.done(cur); }
        if (!has_next) break;
#pragma unroll
        for (int a = 0; a < 2; ++a)
#pragma unroll
            for (int b = 0; b < 2; ++b)
#pragma unroll
                for (int m = 0; m < 4; ++m)
#pragma unroll
                    for (int n = 0; n < 2; ++n) acc[a][b][m][n] = (f32x4){0.f, 0.f, 0.f, 0.f};
        cur = nxt; cA = nA; cB = nB; ++ui;
        if constexpr (ALIGN_EPI) { if (wr == 1) PG8_BAR; }
    }
    PG8_WAIT_V(0);
    if constexpr (!ALIGN_EPI) { if (wr == 0) PG8_BAR; }
    PG8_BAR;
    if constexpr (Epi::AFTER_DRAIN) { E.fused(acc, cur, wr, wc, fr, fq, lds, wid, lane); S.done(cur); }
#undef PG8_SA
#undef PG8_SB
#undef PG8_STAGE
#undef PG8_LDA
#undef PG8_LDB
#undef PG8_MMA
#undef PG8_WAIT_V
#undef PG8_WAIT_L
#undef PG8_BAR
#undef PG8_SCHED
}
}

namespace att {
constexpr int SLOTB = 8192;
constexpr int NSLOT = 4;
constexpr int L_K = 0, L_V = 32768, L_WS = 65536, L_OST = 67584, L_PSUM = L_OST, L_IMP = 133120, L_KB = L_IMP, L_SEL = 141312, L_END = 141568;
constexpr float PFIX = 268435456.0f;
constexpr float THR = 8.0f;

__device__ __forceinline__ int crow(int r, int hh) { return (r & 3) + 8 * (r >> 2) + 4 * hh; }
typedef float f32x2_t __attribute__((ext_vector_type(2))); typedef __bf16 bf16x2_t __attribute__((ext_vector_type(2)));
__device__ __forceinline__ unsigned cvtpk_s(float lo, float hi) { f32x2_t v = {lo, hi}; bf16x2_t b = __builtin_convertvector(v, bf16x2_t); return __builtin_bit_cast(unsigned, b); }
typedef short v4i16_t __attribute__((ext_vector_type(4)));
__device__ __forceinline__ s16x4 vtr(const LAS unsigned char* p) { return __builtin_bit_cast(s16x4, __builtin_amdgcn_ds_read_tr16_b64_v4i16((LAS v4i16_t*)p)); }
__device__ __forceinline__ float swap_sum(float v) { auto rr = __builtin_amdgcn_permlane32_swap(__float_as_uint(v), __float_as_uint(v), false, false); return __uint_as_float(rr[0]) + __uint_as_float(rr[1]); }
__device__ __forceinline__ float swap_max(float v) { auto rr = __builtin_amdgcn_permlane32_swap(__float_as_uint(v), __float_as_uint(v), false, false); return fmaxf(__uint_as_float(rr[0]), __uint_as_float(rr[1])); }
__device__ __forceinline__ bool trailing_half(int wid) { asm volatile("" : "+s"(wid)); return (wid >> 2) != 0; }
#define ATT_BAR() do { __builtin_amdgcn_s_barrier(); asm volatile("" ::: "memory"); } while (0)

__device__ __forceinline__ void dma_tile(const bf16_t* Kb, const bf16_t* Vb, int pitch, int tile, LAS unsigned char* shm, int slot, int wid, int lane) {
    const bf16_t* ks = Kb + (size_t)(tile * 64 + lane) * pitch + wid * 8;
    const bf16_t* vs = Vb + (size_t)(tile * 64 + 16 * (wid & 3) + (lane >> 2)) * pitch + (wid >> 2) * 32 + (lane & 3) * 8;
    __builtin_amdgcn_global_load_lds((const unsigned*)ks, (LAS unsigned*)(shm + L_K + slot * SLOTB + wid * 1024), 16, 0, 0);
    __builtin_amdgcn_global_load_lds((const unsigned*)vs, (LAS unsigned*)(shm + L_V + slot * SLOTB + wid * 1024), 16, 0, 0);
#ifdef PROBE_DMA2
    __builtin_amdgcn_global_load_lds((const unsigned*)ks, (LAS unsigned*)(shm + L_K + slot * SLOTB + wid * 1024), 16, 0, 0);
    __builtin_amdgcn_global_load_lds((const unsigned*)vs, (LAS unsigned*)(shm + L_V + slot * SLOTB + wid * 1024), 16, 0, 0);
#endif
}
#ifdef PROBE_DMA2
#define VMW2 "4"
#define VMW4 "8"
#else
#define VMW2 "2"
#define VMW4 "4"
#endif
__device__ __forceinline__ void qkt(f32x16& p0, f32x16& p1, const LAS unsigned char* shm, int slot, const bf16x8 (&qr)[4], const f32x16& cinit, int r32, int hh) {
    const LAS unsigned char* kb = shm + L_K + slot * SLOTB + hh * 1024 + r32 * 16;
#pragma unroll
    for (int d0 = 0; d0 < 4; ++d0) {
        const bf16x8 b0 = *(const LAS bf16x8*)(kb + d0 * 2048), b1 = *(const LAS bf16x8*)(kb + d0 * 2048 + 512);
        if (d0 == 0) { p0 = __builtin_amdgcn_mfma_f32_32x32x16_bf16(b0, qr[0], cinit, 0, 0, 0); p1 = __builtin_amdgcn_mfma_f32_32x32x16_bf16(b1, qr[0], cinit, 0, 0, 0); }
        else { p0 = __builtin_amdgcn_mfma_f32_32x32x16_bf16(b0, qr[d0], p0, 0, 0, 0); p1 = __builtin_amdgcn_mfma_f32_32x32x16_bf16(b1, qr[d0], p1, 0, 0, 0); }
        if (d0 == 1) asm volatile("" ::: "memory");
    }
}
__device__ __forceinline__ void load_k(bf16x8 (&kf)[8], const LAS unsigned char* shm, int slot, int r32, int hh) {
    const LAS unsigned char* kb = shm + L_K + slot * SLOTB + hh * 1024 + r32 * 16;
#pragma unroll
    for (int d0 = 0; d0 < 4; ++d0) { kf[2 * d0] = *(const LAS bf16x8*)(kb + d0 * 2048); kf[2 * d0 + 1] = *(const LAS bf16x8*)(kb + d0 * 2048 + 512); }
}
__device__ __forceinline__ void mma_qk(f32x16& p0, f32x16& p1, const bf16x8 (&kf)[8], const bf16x8 (&qr)[4], const f32x16& cinit) {
    p0 = __builtin_amdgcn_mfma_f32_32x32x16_bf16(kf[0], qr[0], cinit, 0, 0, 0); p1 = __builtin_amdgcn_mfma_f32_32x32x16_bf16(kf[1], qr[0], cinit, 0, 0, 0);
#pragma unroll
    for (int d0 = 1; d0 < 4; ++d0) { p0 = __builtin_amdgcn_mfma_f32_32x32x16_bf16(kf[2 * d0], qr[d0], p0, 0, 0, 0); p1 = __builtin_amdgcn_mfma_f32_32x32x16_bf16(kf[2 * d0 + 1], qr[d0], p1, 0, 0, 0); }
}
__device__ __forceinline__ void load_v(bf16x8 (&vf)[8], const LAS unsigned char* shm, int slot, int lane, int hh) {
    const LAS unsigned char* vb = shm + L_V + slot * SLOTB + ((lane >> 4) & 1) * 32 + (lane & 3) * 8 + (4 * hh + ((lane & 15) >> 2)) * 64;
#pragma unroll
    for (int ks = 0; ks < 4; ++ks)
#pragma unroll
        for (int d0 = 0; d0 < 2; ++d0) {
            const s16x4 vl = vtr(vb + d0 * 4096 + ks * 1024), vh = vtr(vb + d0 * 4096 + ks * 1024 + 512);
            vf[2 * ks + d0] = (bf16x8){vl[0], vl[1], vl[2], vl[3], vh[0], vh[1], vh[2], vh[3]};
        }
}
__device__ __forceinline__ void mma_pv(f32x16 (&o)[2], const u32x4 (&pw)[4], const bf16x8 (&vf)[8]) {
#pragma unroll
    for (int ks = 0; ks < 4; ++ks)
#pragma unroll
        for (int d0 = 0; d0 < 2; ++d0) o[d0] = __builtin_amdgcn_mfma_f32_32x32x16_bf16(__builtin_bit_cast(bf16x8, pw[ks]), vf[2 * ks + d0], o[d0], 0, 0, 0);
}
__device__ __forceinline__ void pv_seq(f32x16 (&o)[2], const u32x4 (&pw)[4], const LAS unsigned char* shm, int slot, int lane, int hh) {
    const LAS unsigned char* vb = shm + L_V + slot * SLOTB + ((lane >> 4) & 1) * 32 + (lane & 3) * 8 + (4 * hh + ((lane & 15) >> 2)) * 64;
#pragma unroll
    for (int ks = 0; ks < 4; ++ks) {
#pragma unroll
        for (int d0 = 0; d0 < 2; ++d0) {
            const s16x4 vl = vtr(vb + d0 * 4096 + ks * 1024), vh = vtr(vb + d0 * 4096 + ks * 1024 + 512);
            const bf16x8 vf = {vl[0], vl[1], vl[2], vl[3], vh[0], vh[1], vh[2], vh[3]};
            o[d0] = __builtin_amdgcn_mfma_f32_32x32x16_bf16(__builtin_bit_cast(bf16x8, pw[ks]), vf, o[d0], 0, 0, 0);
        }
        if (ks == 1) asm volatile("" ::: "memory");
    }
}
__device__ __forceinline__ void range_mask(f32x16& p0, f32x16& p1, int kb, int lo, int hi) {
#pragma unroll
    for (int r = 0; r < 16; ++r) { const int k = kb + (r & 3) + 8 * (r >> 2); if (k < lo || k > hi) p0[r] = -INFINITY; if (k + 32 < lo || k + 32 > hi) p1[r] = -INFINITY; }
}
__device__ __forceinline__ void mask_hi(f32x16& p0, f32x16& p1, int dh) {
#pragma unroll
    for (int r = 0; r < 16; ++r) { const int c = (r & 3) + 8 * (r >> 2); if (c > dh) p0[r] = -INFINITY; if (c + 32 > dh) p1[r] = -INFINITY; }
}
__device__ __forceinline__ void mask_lo(f32x16& p0, f32x16& p1, int dl) {
#pragma unroll
    for (int r = 0; r < 16; ++r) { const int c = (r & 3) + 8 * (r >> 2); if (c < dl) p0[r] = -INFINITY; if (c + 32 < dl) p1[r] = -INFINITY; }
}
__device__ __forceinline__ void rescale_o(f32x16 (&o)[2], const LAS float* wsf, int hh) {
#pragma unroll
    for (int g = 0; g < 4; ++g) { const f32x4 a4 = *(const LAS f32x4*)(wsf + 8 * g + 4 * hh);
#pragma unroll
        for (int j = 0; j < 4; ++j) { o[0][4 * g + j] *= a4[j]; o[1][4 * g + j] *= a4[j]; } }
}

__device__ __forceinline__ float max3f(float a, float b, float c) { float r; asm("v_max3_f32 %0, %1, %2, %3" : "=v"(r) : "v"(a), "v"(b), "v"(c)); return r; }
#define MM(a, b, c) __builtin_amdgcn_mfma_f32_32x32x16_bf16(a, b, c, 0, 0, 0)
#define SGB(mask, n) __builtin_amdgcn_sched_group_barrier(mask, n, 0)
template <int MODE, bool NOMAX, bool LEAN = false>
__device__ __forceinline__ void sweep(f32x16 (&o)[2], float& mhat, float& l, const bf16x8 (&qr)[4], const bf16_t* Kb, const bf16_t* Vb, int pitch, int t0, int NT, int lo, int hi,
                                      unsigned rowsel, LAS unsigned char* shm, int& ring, int wid, int lane) {
    static_assert(!(MODE == 1 && NOMAX), "the FoX key bias grows without bound: it needs the running max");
    asm volatile("" : "+v"(lane));
    const int r32 = lane & 31, hh = lane >> 5;
    LAS float* wsf = (LAS float*)(shm + L_WS + wid * 256);
    const int lo_max = __builtin_amdgcn_readlane(lo, 31), hi_min = __builtin_amdgcn_readfirstlane(hi);
    const int ring0 = ring;
#define SLOT(i_) ((ring0 + (i_)) & (NSLOT - 1))
    dma_tile(Kb, Vb, pitch, t0, shm, SLOT(0), wid, lane);
    if (NT > 1) dma_tile(Kb, Vb, pitch, t0 + 1, shm, SLOT(1), wid, lane);
    f32x16 a0, a1, b0, b1, cini; u32x4 pw[4]; bf16x8 kf[8], vf[8]; float ls0 = 0.f, ls1 = 0.f; bool resc = false;
#pragma unroll
    for (int r = 0; r < 16; ++r) cini[r] = 0.f;
#define SET_CINI(i_) do { if (MODE == 2) { const float c_ = ((rowsel >> (t0 + (i_))) & 1u) ? 0.f : -INFINITY; _Pragma("unroll") for (int r = 0; r < 16; ++r) cini[r] = c_; } } while (0)
#define POST(C0, C1, i_) do { const int tile_ = t0 + (i_); \
        if (MODE == 1) { const LAS float* kb_ = (const LAS float*)(shm + L_KB) + tile_ * 64 + 4 * hh; \
            _Pragma("unroll") for (int k_ = 0; k_ < 4; ++k_) { const f32x4 x0_ = *(const LAS f32x4*)(kb_ + 8 * k_), x1_ = *(const LAS f32x4*)(kb_ + 32 + 8 * k_); \
                _Pragma("unroll") for (int e_ = 0; e_ < 4; ++e_) { C0[4 * k_ + e_] += x0_[e_]; C1[4 * k_ + e_] += x1_[e_]; } } } \
        if (tile_ * 64 < lo_max || tile_ * 64 + 63 > hi_min) range_mask(C0, C1, tile_ * 64 + 4 * hh, lo, hi); \
        if (!NOMAX) { \
            float ra_ = max3f(C0[0], C0[1], C1[0]), rb_ = max3f(C0[2], C0[3], C1[1]); ra_ = max3f(ra_, C1[2], C1[3]); \
            _Pragma("unroll") for (int r = 4; r < 16; r += 4) { ra_ = max3f(ra_, C0[r], C0[r + 1]); rb_ = max3f(rb_, C0[r + 2], C0[r + 3]); ra_ = max3f(ra_, C1[r], C1[r + 1]); rb_ = max3f(rb_, C1[r + 2], C1[r + 3]); } \
            const float rm_ = swap_max(fmaxf(ra_, rb_)); const bool first_ = ((i_) == 0); \
            if (first_ || __any(rm_ > THR)) { \
                float dl_ = first_ ? rm_ : fmaxf(rm_, 0.f); if (dl_ == -INFINITY) dl_ = 0.f; \
                mhat += dl_; \
                _Pragma("unroll") for (int r = 0; r < 16; ++r) { C0[r] -= dl_; C1[r] -= dl_; cini[r] = -mhat; } \
                if (!first_) { const float al_ = __builtin_amdgcn_exp2f(-dl_); l *= al_; ls0 *= al_; ls1 *= al_; if (hh == 0) wsf[r32] = al_; resc = true; } } } \
    } while (0)
    asm volatile("s_waitcnt lgkmcnt(0)" ::: "memory");
    if (NT > 1) asm volatile("s_waitcnt vmcnt(2)" ::: "memory"); else asm volatile("s_waitcnt vmcnt(0)" ::: "memory");
    ATT_BAR();
    if (NT > 2) dma_tile(Kb, Vb, pitch, t0 + 2, shm, SLOT(2), wid, lane);
    SET_CINI(0);
    load_k(kf, shm, SLOT(0), r32, hh);
    mma_qk(a0, a1, kf, qr, cini);
    POST(a0, a1, 0);
#pragma unroll
    for (int r = 0; r < 16; ++r) { a0[r] = __builtin_amdgcn_exp2f(a0[r]); a1[r] = __builtin_amdgcn_exp2f(a1[r]); }
#define STEP(i_, C0, C1, P0, P1) do { \
        asm volatile("s_waitcnt lgkmcnt(0)" ::: "memory"); \
        if ((i_) + 1 < NT) asm volatile("s_waitcnt vmcnt(2)" ::: "memory"); else asm volatile("s_waitcnt vmcnt(0)" ::: "memory"); \
        ATT_BAR(); \
        if ((i_) + 2 < NT) dma_tile(Kb, Vb, pitch, t0 + (i_) + 2, shm, SLOT((i_) + 2), wid, lane); \
        SET_CINI(i_); \
        load_k(kf, shm, SLOT(i_), r32, hh); \
        __builtin_amdgcn_sched_barrier(0); \
        load_v(vf, shm, SLOT((i_) - 1), lane, hh);               \
          \
        C0 = MM(kf[0], qr[0], cini); C1 = MM(kf[1], qr[0], cini); \
        _Pragma("unroll") for (int d_ = 1; d_ < 4; ++d_) { C0 = MM(kf[2 * d_], qr[d_], C0); C1 = MM(kf[2 * d_ + 1], qr[d_], C1); } \
        _Pragma("unroll") for (int r = 0; r < 16; ++r) { ls0 += P0[r]; ls1 += P1[r]; } \
        _Pragma("unroll") for (int e_ = 0; e_ < 4; ++e_) { pw[0][e_] = cvtpk_s(P0[2 * e_], P0[2 * e_ + 1]); pw[1][e_] = cvtpk_s(P0[8 + 2 * e_], P0[9 + 2 * e_]); pw[2][e_] = cvtpk_s(P1[2 * e_], P1[2 * e_ + 1]); pw[3][e_] = cvtpk_s(P1[8 + 2 * e_], P1[9 + 2 * e_]); } \
        _Pragma("unroll") for (int g_ = 0; g_ < 8; ++g_) { SGB(0x008, 1); SGB(0x100, 2); SGB(0x002, 6); } \
        asm volatile("" : "+v"(ls0), "+v"(ls1), "+v"(pw[0]), "+v"(pw[1]), "+v"(pw[2]), "+v"(pw[3]));     \
        __builtin_amdgcn_sched_barrier(0); \
        POST(C0, C1, i_); \
        __builtin_amdgcn_sched_barrier(0); \
          \
        _Pragma("unroll") for (int ks_ = 0; ks_ < 4; ++ks_) _Pragma("unroll") for (int d_ = 0; d_ < 2; ++d_) o[d_] = MM(__builtin_bit_cast(bf16x8, pw[ks_]), vf[2 * ks_ + d_], o[d_]); \
        _Pragma("unroll") for (int r = 0; r < 16; ++r) { C0[r] = __builtin_amdgcn_exp2f(C0[r]); C1[r] = __builtin_amdgcn_exp2f(C1[r]); } \
        _Pragma("unroll") for (int g_ = 0; g_ < 8; ++g_) { SGB(0x008, 1); SGB(0x400, 4); } \
        __builtin_amdgcn_sched_barrier(0); \
        if (!NOMAX) { if (resc) { rescale_o(o, wsf, hh); resc = false; } } \
    } while (0)
    int i = 1;
    for (; i + 1 < NT; i += 2) { STEP(i, b0, b1, a0, a1); STEP(i + 1, a0, a1, b0, b1); }
    if (i < NT) {
        STEP(i, b0, b1, a0, a1);
#pragma unroll
        for (int r = 0; r < 16; ++r) { a0[r] = b0[r]; a1[r] = b1[r]; }
    }
#pragma unroll
    for (int r = 0; r < 16; ++r) { ls0 += a0[r]; ls1 += a1[r]; }
#pragma unroll
    for (int e = 0; e < 4; ++e) { pw[0][e] = cvtpk_s(a0[2 * e], a0[2 * e + 1]); pw[1][e] = cvtpk_s(a0[8 + 2 * e], a0[9 + 2 * e]); pw[2][e] = cvtpk_s(a1[2 * e], a1[2 * e + 1]); pw[3][e] = cvtpk_s(a1[8 + 2 * e], a1[9 + 2 * e]); }
    load_v(vf, shm, SLOT(NT - 1), lane, hh);
    mma_pv(o, pw, vf);
    l += ls0 + ls1;
    asm volatile("s_waitcnt lgkmcnt(0)" ::: "memory");
    ring = SLOT(NT);
#undef STEP
#undef POST
#undef SET_CINI
#undef SLOT
}
#undef MM
#undef SGB
template <bool FIRST>
__device__ __forceinline__ void merge(const f32x16 (&o)[2], float scale, LAS unsigned char* shm, int wid, int r32, int hh) {
    LAS float* wsf = (LAS float*)(shm + L_WS + wid * 256);
    LAS float* stg = (LAS float*)(shm + L_OST + wid * 8192) + r32;
    if (hh == 0) wsf[r32] = scale;
#pragma unroll
    for (int g = 0; g < 4; ++g) { const f32x4 s4 = *(const LAS f32x4*)(wsf + 8 * g + 4 * hh);
#pragma unroll
        for (int j = 0; j < 4; ++j) { LAS float* p = stg + (8 * g + 4 * hh + j) * 64;
            if (FIRST) { p[0] = o[0][4 * g + j] * s4[j]; p[32] = o[1][4 * g + j] * s4[j]; }
            else { p[0] += o[0][4 * g + j] * s4[j]; p[32] += o[1][4 * g + j] * s4[j]; } } }
}
__device__ __forceinline__ void store_o(bf16_t* Ow, LAS unsigned char* shm, int wid, int lane) {
    const LAS float* stg = (const LAS float*)(shm + L_OST + wid * 8192);
#pragma unroll
    for (int i = 0; i < 4; ++i) { const int rowl = i * 8 + (lane >> 3), ch = lane & 7; const f32x4 a = *(const LAS f32x4*)(stg + rowl * 64 + ch * 8), c = *(const LAS f32x4*)(stg + rowl * 64 + ch * 8 + 4);
        u32x4 v; v.x = cvtpk_s(a[0], a[1]); v.y = cvtpk_s(a[2], a[3]); v.z = cvtpk_s(c[0], c[1]); v.w = cvtpk_s(c[2], c[3]); *(GAS u32x4*)(Ow + (size_t)rowl * D + ch * 8) = v; }
}
__device__ __forceinline__ void zero_o(f32x16 (&o)[2]) { o[0] = (f32x16){0.f, 0.f, 0.f, 0.f, 0.f, 0.f, 0.f, 0.f, 0.f, 0.f, 0.f, 0.f, 0.f, 0.f, 0.f, 0.f}; o[1] = o[0]; }
#define ATT_LOADQ(Qrow_) bf16x8 qr[4]; _Pragma("unroll") for (int d0 = 0; d0 < 4; ++d0) qr[d0] = *(const GAS bf16x8*)((Qrow_) + d0 * 16 + hh * 8)

__device__ __forceinline__ void fox_unit(LAS unsigned char* shm, int b, int h, int qb, unsigned char* ws_, size_t off_p, size_t off_cb, size_t off_o, int wid, int& ring) {
    const int lane = lane_id_volatile();
    unsigned char* ws = ws_; asm volatile("" : "+s"(ws)); const bf16_t* P = (const bf16_t*)(ws + off_p); const float* CB = (const float*)(ws + off_cb); bf16_t* O = (bf16_t*)(ws + off_o);
    const int r32 = lane & 31, hh = lane >> 5;
    const int pos = 256 * qb + 32 * wid + r32;
    const size_t row = (size_t)b * T + pos;
    ATT_LOADQ(P + row * FOX_LDP + h * 64);
    const bf16_t* Kb = (const bf16_t*)(ws + off_p + FOX_HM_OFF) + (size_t)(b * NH + h) * T * 64; const bf16_t* Vb = Kb + FOX_HM_STRIDE;
    f32x16 o[2]; zero_o(o); float m = 0.f, l = 0.f;
    asm volatile("s_waitcnt lgkmcnt(0)" ::: "memory"); ATT_BAR();
    { const float* cb = CB + (size_t)(b * NH + h) * T; LAS float* kbl = (LAS float*)(shm + L_KB);
      for (int i = wid * 64 + lane; i < 64 * (4 * qb + 4); i += 512) kbl[i] = cb[i]; }
    sweep<1, false>(o, m, l, qr, Kb, Vb, 64, 0, 4 * qb + 4, 0, pos, 0u, shm, ring, wid, lane);
    const float lt = swap_sum(l); const float inv = lt > 0.f ? 1.0f / lt : 0.f;
    merge<true>(o, inv, shm, wid, r32, hh);
    store_o(O + ((size_t)b * T + 256 * qb + 32 * wid) * D + h * 64, shm, wid, lane);
}
__device__ __forceinline__ void swa_unit(LAS unsigned char* shm, int b, int g, int qt, unsigned char* ws_, size_t off_p, size_t off_o, const float* sinks, int wid, int& ring) {
    const int lane = lane_id_volatile();
    unsigned char* ws = ws_; asm volatile("" : "+s"(ws)); const bf16_t* P = (const bf16_t*)(ws + off_p); bf16_t* O = (bf16_t*)(ws + off_o);
    const int r32 = lane & 31, hh = lane >> 5;
    const int q0 = 32 * qt, pos = q0 + r32, head = 8 * g + wid;
    const size_t row = (size_t)b * T + pos;
    ATT_LOADQ(P + row * SWA_LDP + head * 64);
    const bf16_t* Kb = (const bf16_t*)(ws + off_p + SWA_HM_OFF) + (size_t)(b * 2 + g) * T * 64; const bf16_t* Vb = Kb + SWA_HM_STRIDE;
    f32x16 o[2]; zero_o(o); float m = 0.f, l = 0.f;
    const int tlo = (q0 - 127) > 0 ? ((q0 - 127) >> 6) : 0, thi = (q0 + 31) >> 6;
    sweep<0, true, true>(o, m, l, qr, Kb, Vb, 64, tlo, thi - tlo + 1, pos - 127, pos, 0u, shm, ring, wid, lane);
    const float lt = swap_sum(l) + __builtin_amdgcn_exp2f(sinks[head] * LOG2E - m);
    const float inv = 1.0f / lt;
    merge<true>(o, inv, shm, wid, r32, hh);
    store_o(O + ((size_t)b * T + q0) * D + head * 64, shm, wid, lane);
}
__device__ __forceinline__ void nsa_unit(LAS unsigned char* shm, int b, int g, int qt, unsigned char* ws_, size_t off_p, size_t off_g, size_t off_kc, size_t off_vc, size_t off_o, int wid, int& ring) {
#define NSA_WS() unsigned char* ws = ws_; asm volatile("" : "+s"(ws)); const bf16_t* P = (const bf16_t*)(ws + off_p); const float* G = (const float*)(ws + off_g); const bf16_t* Hb = (const bf16_t*)(ws + off_p + NSA_HM_OFF) + (size_t)(b * 4 + g) * T * 64; (void)G; (void)Hb
    const int hq = 4 * g + (wid >> 1), ph = wid & 1, q0 = 64 * qt;
    LAS unsigned* PSUM = (LAS unsigned*)(shm + L_PSUM); LAS float* IMP = (LAS float*)(shm + L_IMP); LAS unsigned* SEL = (LAS unsigned*)(shm + L_SEL);
#define NSA_LANE() const int lane = lane_id_volatile(); const int r32 = lane & 31, hh = lane >> 5; const int pos = q0 + 32 * ph + r32; const size_t row = (size_t)b * T + pos; (void)hh; (void)row
#define NSA_QROW (P + row * NSA_LDP + hq * 64)
    asm volatile("s_waitcnt lgkmcnt(0)" ::: "memory"); ATT_BAR();
    { const int tid = wid * 64 + lane_id_volatile(); for (int i = tid; i < 8192; i += 512) PSUM[i] = 0u; }
    f32x16 ocmp[2]; float inv_cmp;
    {
        NSA_LANE(); NSA_WS();
        const bf16_t* Kb = (const bf16_t*)(ws + off_kc) + (size_t)(b * 4 + g) * NCP * 64; const bf16_t* Vb = (const bf16_t*)(ws + off_vc) + (size_t)(b * 4 + g) * NCP * 64;
        const int cm = (pos < 31) ? -1 : (((pos - 31) >> 4) < 126 ? ((pos - 31) >> 4) : 126);
        const int ntile = qt >= 16 ? 2 : 1;
        ATT_LOADQ(NSA_QROW);
        f32x16 o[2]; zero_o(o); float m = 0.f, l = 0.f;
        const int ring0 = ring;
        sweep<0, true>(o, m, l, qr, Kb, Vb, 64, 0, ntile, 0, cm, 0u, shm, ring, wid, lane);
        const float lt = swap_sum(l); const float inv = lt > 0.f ? 1.0f / lt : 0.f;
        f32x16 negm;
#pragma unroll
        for (int r = 0; r < 16; ++r) negm[r] = -m;
        for (int tile = 0; tile < ntile; ++tile) {
            const int sl = (ring0 + tile) & (NSLOT - 1);
            f32x16 p0, p1; qkt(p0, p1, shm, sl, qr, negm, r32, hh);
            range_mask(p0, p1, tile * 64 + 4 * hh, 0, cm);
            LAS unsigned* pb = PSUM + (tile * 64 + 4 * hh) * 64 + 32 * ph + r32;
            asm volatile("" : "+v"(pb));
#pragma unroll
            for (int r = 0; r < 16; ++r) {
                const float a = __builtin_amdgcn_exp2f(p0[r]) * inv, c = __builtin_amdgcn_exp2f(p1[r]) * inv;
                __hip_atomic_fetch_add(pb + ((r & 3) + 8 * (r >> 2)) * 64, (unsigned)(a * PFIX + 0.5f), __ATOMIC_RELAXED, __HIP_MEMORY_SCOPE_WORKGROUP);
                __hip_atomic_fetch_add(pb + ((r & 3) + 8 * (r >> 2) + 32) * 64, (unsigned)(c * PFIX + 0.5f), __ATOMIC_RELAXED, __HIP_MEMORY_SCOPE_WORKGROUP);
            }
        }
        ocmp[0] = o[0]; ocmp[1] = o[1]; inv_cmp = inv;
    }
    asm volatile("s_waitcnt lgkmcnt(0)" ::: "memory"); ATT_BAR();
    {
        const int tid = wid * 64 + lane_id_volatile();
        const int rw = tid & 63, ng = tid >> 6;
        LAS unsigned* pb = PSUM + (16 * ng - 1) * 64 + rw;
        LAS float* ib = IMP + (4 * ng) * 64 + rw;
        asm volatile("" : "+v"(pb), "+v"(ib));
        float pc[17];
#pragma unroll
        for (int e = 0; e < 17; ++e) pc[e] = (float)pb[e * 64] * (1.0f / PFIX);
        if (ng == 0) pc[0] = 0.f;
#pragma unroll
        for (int k = 0; k < 4; ++k) ib[k * 64] = pc[4 * k + 1] + pc[4 * k + 2] + pc[4 * k + 3] + 0.5f * (pc[4 * k + 4] + pc[4 * k]);
        const unsigned init = qt < 16 ? ((2u << qt) - 1u) : (1u | (1u << qt) | (1u << (qt - 1)));
        if (tid < 64) SEL[tid] = init;
    }
    asm volatile("s_waitcnt lgkmcnt(0)" ::: "memory"); ATT_BAR();
    if (qt >= 16) {
        const int tid = wid * 64 + lane_id_volatile();
        const int rw = tid & 63, ng = tid >> 6; unsigned bits = 0u;
        LAS float* ib = IMP + rw; asm volatile("" : "+v"(ib));
        float v[4]; int cnt[4] = {0, 0, 0, 0};
#pragma unroll
        for (int k = 0; k < 4; ++k) v[k] = ib[(4 * ng + k) * 64];
        for (int n2 = 1; n2 <= qt - 2; ++n2) { const float v2 = ib[n2 * 64];
#pragma unroll
            for (int k = 0; k < 4; ++k) cnt[k] += (v2 > v[k] || (v2 == v[k] && n2 < 4 * ng + k)) ? 1 : 0; }
#pragma unroll
        for (int k = 0; k < 4; ++k) { const int n = 4 * ng + k; if (n >= 1 && n <= qt - 2 && cnt[k] < 13) bits |= 1u << n; }
        if (bits) __hip_atomic_fetch_or(SEL + rw, bits, __ATOMIC_RELAXED, __HIP_MEMORY_SCOPE_WORKGROUP);
    }
    asm volatile("s_waitcnt lgkmcnt(0)" ::: "memory"); ATT_BAR();
    { NSA_LANE(); NSA_WS(); merge<true>(ocmp, G[row * 48 + hq * 3 + 0] * inv_cmp, shm, wid, r32, hh); }
    {
        NSA_LANE(); NSA_WS();
        const unsigned rowsel = SEL[32 * ph + r32];
        ATT_LOADQ(NSA_QROW);
        f32x16 o[2]; zero_o(o); float m = 0.f, l = 0.f;
        sweep<2, true>(o, m, l, qr, Hb, Hb + NSA_HM_STRIDE, 64, 0, qt + 1, 0, pos, rowsel, shm, ring, wid, lane);
        const float lt = swap_sum(l); const float inv = lt > 0.f ? 1.0f / lt : 0.f;
        merge<false>(o, G[row * 48 + hq * 3 + 1] * inv, shm, wid, r32, hh);
    }
    {
        NSA_LANE(); NSA_WS();
        ATT_LOADQ(NSA_QROW);
        f32x16 o[2]; zero_o(o); float m = 0.f, l = 0.f;
        const int tlo = qt > 8 ? qt - 8 : 0;
        sweep<0, true>(o, m, l, qr, Hb + 2 * NSA_HM_STRIDE, Hb + 3 * NSA_HM_STRIDE, 64, tlo, qt - tlo + 1, pos - 511, pos, 0u, shm, ring, wid, lane);
        const float lt = swap_sum(l); const float inv = lt > 0.f ? 1.0f / lt : 0.f;
        merge<false>(o, G[row * 48 + hq * 3 + 2] * inv, shm, wid, r32, hh);
    }
    { unsigned char* ws = ws_; asm volatile("" : "+s"(ws)); store_o((bf16_t*)(ws + off_o) + ((size_t)b * T + q0 + 32 * ph) * D + hq * 64, shm, wid, lane_id_volatile()); }
#undef NSA_WS
#undef NSA_LANE
#undef NSA_QROW
}
#undef ATT_LOADQ
#undef ATT_BAR
}

constexpr size_t MiB = 1u << 20;
constexpr size_t WS_CTL = 0, CTL_ZERO_BYTES = 1 * MiB;
constexpr size_t WS_WUP = 1 * MiB, WS_WDN = 33 * MiB;
constexpr size_t WS_WNSA = 65 * MiB, WNSA_STRIDE = (size_t)NSA_NP * D * 2;
constexpr size_t WS_WOUT = 76 * MiB;
constexpr size_t WS_WFOX = 84 * MiB;
constexpr size_t WS_WSWA = 84 * MiB + 6656 * 1024;
constexpr size_t WS_WCMP = 93 * MiB;
constexpr size_t WS_ROPEC = 97 * MiB, WS_ROPES = WS_ROPEC + 256 * 1024;
constexpr size_t WS_CMPB = WS_ROPES + 256 * 1024;
constexpr size_t WS_SWAB = WS_CMPB + 64 * 1024;
constexpr size_t WS_RSTD = 98 * MiB;
constexpr size_t WS_XN = 100 * MiB;
constexpr size_t WS_BIG = 164 * MiB;
constexpr size_t WS_O = WS_BIG + 192 * MiB;
constexpr size_t WS_G = 420 * MiB, WS_LF = 426 * MiB, WS_CB = 428 * MiB, WS_KC = 430 * MiB, WS_VC = 431 * MiB, WS_HID = 432 * MiB, WS_M2 = 440 * MiB, WS_END = 504 * MiB;
static_assert(WS_WSWA + (size_t)SWA_NP * D * 2 <= WS_WCMP && WS_WFOX + (size_t)FOX_NP * D * 2 <= WS_WSWA && WS_WNSA + 2 * WNSA_STRIDE <= WS_WOUT && WS_SWAB + 8192 <= WS_XN, "d_ws map");
static_assert((size_t)M * FF * 2 == 256 * MiB && WS_O + (size_t)M * D * 2 == WS_G && (size_t)M * 3072 * 2 == 192 * MiB, "d_ws map");
constexpr int CW_TMO = 0, CW_BAR = 4096;

constexpr int RING_OFF = 0, RING_BYTES = 142336;
constexpr int LDSCTL_OFF = RING_BYTES, MISC_OFF = LDSCTL_OFF + 320;
constexpr int LDS_BYTES = 147456;
static_assert(att::L_END <= RING_BYTES && MISC_OFF + 128 <= LDS_BYTES, "LDS map");
constexpr int NWAVES = 8;
#ifndef L_LO
#define L_LO 0
#endif
#ifndef L_HI
#define L_HI DEPTH
#endif

typedef GAS unsigned gu32;
typedef GAS unsigned long long gu64;
#define RLX_AGENT __ATOMIC_RELAXED, __HIP_MEMORY_SCOPE_AGENT
#define LDS_WAIT() asm volatile("s_waitcnt lgkmcnt(0)" ::: "memory")
#define VM_WAIT() asm volatile("s_waitcnt vmcnt(0)" ::: "memory")
__device__ __forceinline__ unsigned long long rt() { return __builtin_amdgcn_s_memrealtime(); }
__device__ __forceinline__ unsigned f2bf(float f) { unsigned u = __builtin_bit_cast(unsigned, f); return (u + 0x7fffu + ((u >> 16) & 1u)) >> 16; }
__device__ __forceinline__ unsigned pk2(float lo, float hi) { return f2bf(lo) | (f2bf(hi) << 16); }

#define XB_TMO      128
#define XB_XCNT(j)  (256  + 64 * (j))
#define XB_XSUB(j)  (1280 + 64 * (j))
#define XB_XGEN(j)  (2304 + 64 * (j))
#define XB_TOP      3328
#define XB_TOPGEN   3392
#define XCD_BAR_WORDS 3456
#define XB_SPIN_CAP (1u << 18)

__device__ __forceinline__ unsigned xb_ld(unsigned* p)              { return __hip_atomic_load(p, __ATOMIC_RELAXED, __HIP_MEMORY_SCOPE_AGENT); }
__device__ __forceinline__ unsigned xb_add(unsigned* p, unsigned v) { return __hip_atomic_fetch_add(p, v, __ATOMIC_RELAXED, __HIP_MEMORY_SCOPE_AGENT); }
__device__ __forceinline__ unsigned xb_xcc_id() { return (unsigned)__builtin_amdgcn_s_getreg((3 << 11) | 20) & 0xFu; }
#define XB_SPIN(cond, bar) do { unsigned _sp = 0; while (cond) { __builtin_amdgcn_s_sleep(1); \
    if ((++_sp & 255u) == 0u) { if (xb_ld(&(bar)[XB_TMO])) break; if (_sp > XB_SPIN_CAP) { atomicAdd(&(bar)[XB_TMO], 1u); break; } } } } while (0)

struct XcdBarrier {
    unsigned* bar; unsigned x;
    volatile LAS unsigned* st;
};

__device__ __forceinline__ XcdBarrier xcd_barrier_post(unsigned* bar, volatile LAS unsigned* st) {
    XcdBarrier b; b.bar = bar; b.x = xb_xcc_id(); b.st = st;
    if (threadIdx.x == 0) (void)xb_add(&bar[XB_XCNT(b.x)], 1u);
    return b;
}
__device__ __forceinline__ void xcd_barrier_complete(unsigned* bar, unsigned x, unsigned& nloc, unsigned& nx) {
    const unsigned G = gridDim.x * gridDim.y * gridDim.z;
    unsigned sum, cnt, mine, sp = 0u;
    for (;;) {
        sum = 0u; cnt = 0u; mine = 0u;
#pragma unroll
        for (unsigned j = 0; j < 16; ++j) { const unsigned c = xb_ld(&bar[XB_XCNT(j)]); sum += c; cnt += (c > 0u) ? 1u : 0u; mine = (j == x) ? c : mine; }
        if (sum == G) break;
        __builtin_amdgcn_s_sleep(1);
        if ((++sp & 255u) == 0u) { if (xb_ld(&bar[XB_TMO])) break; if (sp > XB_SPIN_CAP) { atomicAdd(&bar[XB_TMO], 1u); break; } }
    }
    nloc = mine > 0u ? mine : 1u; nx = cnt > 0u ? cnt : 1u;
}

__device__ __forceinline__ void xcd_barrier(const XcdBarrier& b) {
    asm volatile("s_waitcnt vmcnt(0)" ::: "memory");
    __syncthreads();
    if (threadIdx.x == 0) {
        unsigned* bar = b.bar;
        __builtin_amdgcn_s_waitcnt(0);
        unsigned nloc = b.st[0], nx = b.st[1];
        if (nloc == 0u) { xcd_barrier_complete(bar, b.x, nloc, nx); b.st[0] = nloc; b.st[1] = nx; }
        const unsigned old = xb_add(&bar[XB_XSUB(b.x)], 1u);
        const unsigned gen = old / nloc;
        if (old + 1u == (gen + 1u) * nloc) {
            __builtin_amdgcn_fence(__ATOMIC_RELEASE, "agent");
            asm volatile("s_waitcnt vmcnt(0)" ::: "memory");
            const unsigned og = xb_add(&bar[XB_TOP], 1u);
            const unsigned tg = og / nx;
            if (og + 1u == (tg + 1u) * nx) xb_add(&bar[XB_TOPGEN], 1u);
            else XB_SPIN(xb_ld(&bar[XB_TOPGEN]) == tg, bar);
            __builtin_amdgcn_fence(__ATOMIC_ACQUIRE, "agent");
            xb_add(&bar[XB_XGEN(b.x)], 1u);
            asm volatile("s_waitcnt vmcnt(0)" ::: "memory");
        } else {
            XB_SPIN(xb_ld(&bar[XB_XGEN(b.x)]) == gen, bar);
            __builtin_amdgcn_fence(__ATOMIC_ACQUIRE, "agent");
            asm volatile("s_waitcnt vmcnt(0)" ::: "memory");
        }
    }
    __syncthreads();
}

__device__ __forceinline__ float wave_sum(float v) {
    v += __builtin_bit_cast(float, __builtin_amdgcn_update_dpp(0, __builtin_bit_cast(int, v), 0xB1, 0xF, 0xF, true));
    v += __builtin_bit_cast(float, __builtin_amdgcn_update_dpp(0, __builtin_bit_cast(int, v), 0x4E, 0xF, 0xF, true));
    v += __builtin_bit_cast(float, __builtin_amdgcn_update_dpp(0, __builtin_bit_cast(int, v), 0x141, 0xF, 0xF, true));
    v += __builtin_bit_cast(float, __builtin_amdgcn_update_dpp(0, __builtin_bit_cast(int, v), 0x140, 0xF, 0xF, true));
    v += __builtin_bit_cast(float, __builtin_amdgcn_ds_swizzle(__builtin_bit_cast(int, v), 0x401F));
    { auto rr = __builtin_amdgcn_permlane32_swap(__float_as_uint(v), __float_as_uint(v), false, false); v = __uint_as_float(rr[0]) + __uint_as_float(rr[1]); }
    return v;
}

__device__ __forceinline__ int il64(int c) { return (c >> 1) + 32 * (c & 1); }
__device__ __forceinline__ int li64(int d) { return 2 * (d & 31) + (d >> 5); }
__device__ __forceinline__ int src_n(int mode, int n) { return (mode == 3 && n < 1152) ? (n & ~63) + il64(n & 63) : n; }
__device__ __forceinline__ int dst_n(int mode, int n) {
    if (mode == 1) { const int reg = n >> 8; const bool rope = reg < 4 || reg == 4 || reg == 6 || reg == 8; return rope ? (n & ~63) + li64(n & 63) : n; }
    if (mode == 3) return n < 1152 ? (n & ~63) + li64(n & 63) : n;
    return n;
}
__device__ __forceinline__ void conv_item(const float* W, int K, int N, bf16_t* WT, int mode, int item, LAS float* scr, int lane) {
    const int nblk = (N + 31) / 32, kb = item / nblk, nb = item % nblk, k0 = 64 * kb, n0 = 32 * nb;
    const int c4 = (lane & 7) * 4; const bool cin = (n0 + c4) < N;
#pragma unroll
    for (int i = 0; i < 8; ++i) { const int kk = (lane >> 3) + 8 * i; const int kd = (mode == 4) ? li64(kk) : kk;
        const f32x4 v = cin ? *(const GAS f32x4*)(W + (size_t)(k0 + kk) * N + n0 + c4) : (f32x4){0.f, 0.f, 0.f, 0.f};
        scr[kd * 33 + c4] = v[0]; scr[kd * 33 + c4 + 1] = v[1]; scr[kd * 33 + c4 + 2] = v[2]; scr[kd * 33 + c4 + 3] = v[3]; }
    LDS_WAIT(); asm volatile("" ::: "memory");
    const int c = lane & 7;
#pragma unroll
    for (int j = 0; j < 4; ++j) { const int n = (lane >> 3) + 8 * j; const LAS float* s = scr + (8 * c) * 33 + n;
        u32x4 o; o.x = pk2(s[0 * 33], s[1 * 33]); o.y = pk2(s[2 * 33], s[3 * 33]); o.z = pk2(s[4 * 33], s[5 * 33]); o.w = pk2(s[6 * 33], s[7 * 33]);
        if (n0 + n < N) *(GAS u32x4*)(WT + (size_t)dst_n(mode, n0 + n) * K + k0 + 8 * c) = o; }
    LDS_WAIT(); asm volatile("" ::: "memory");
}
__device__ __forceinline__ void norm_row(const float* xrow, const float* g, bf16_t* orow, float* rstd_out, int lane) {
    f32x4 v[4]; float s = 0.f;
#pragma unroll
    for (int j = 0; j < 4; ++j) { v[j] = ((const GAS f32x4*)xrow)[lane + 64 * j]; s += (v[j][0] * v[j][0] + v[j][1] * v[j][1]) + (v[j][2] * v[j][2] + v[j][3] * v[j][3]); }
    const float rstd = 1.0f / sqrtf(wave_sum(s) * (1.0f / D) + NORM_EPS);
#pragma unroll
    for (int j = 0; j < 4; ++j) { const f32x4 gg = ((const GAS f32x4*)g)[lane + 64 * j]; u32x2 w; w.x = pk2(v[j][0] * rstd * gg[0], v[j][1] * rstd * gg[1]); w.y = pk2(v[j][2] * rstd * gg[2], v[j][3] * rstd * gg[3]);
        ((GAS u32x2*)orow)[lane + 64 * j] = w; }
    if (lane == 0) *rstd_out = rstd;
}
__device__ __forceinline__ void unpack4(u32x2 w, f32x4& o) { o[0] = __uint_as_float(w.x << 16); o[1] = __uint_as_float(w.x & 0xffff0000u); o[2] = __uint_as_float(w.y << 16); o[3] = __uint_as_float(w.y & 0xffff0000u); }
__device__ __forceinline__ void resnorm_row(const float* xin_f32, bf16_t* xn, float* rstd_io, const float* gcur, const bf16_t* mrow, const float* gpost, const float* gnext, float* xout_f32, int lane) {
    f32x4 xv[4], mv[4]; float s = 0.f;
    if (xin_f32) {
#pragma unroll
        for (int j = 0; j < 4; ++j) xv[j] = ((const GAS f32x4*)xin_f32)[lane + 64 * j];
    } else {
        const float inv_rstd = 1.0f / *rstd_io;
#pragma unroll
        for (int j = 0; j < 4; ++j) { unpack4(((const GAS u32x2*)xn)[lane + 64 * j], xv[j]); const f32x4 gg = ((const GAS f32x4*)gcur)[lane + 64 * j];
#pragma unroll
            for (int e = 0; e < 4; ++e) xv[j][e] = xv[j][e] * inv_rstd / gg[e]; }
    }
#pragma unroll
    for (int j = 0; j < 4; ++j) { unpack4(((const GAS u32x2*)mrow)[lane + 64 * j], mv[j]); s += (mv[j][0] * mv[j][0] + mv[j][1] * mv[j][1]) + (mv[j][2] * mv[j][2] + mv[j][3] * mv[j][3]); }
    const float rstd = 1.0f / sqrtf(wave_sum(s) * (1.0f / D) + NORM_EPS);
    float s2 = 0.f;
#pragma unroll
    for (int j = 0; j < 4; ++j) { const f32x4 gg = ((const GAS f32x4*)gpost)[lane + 64 * j];
#pragma unroll
        for (int e = 0; e < 4; ++e) { xv[j][e] += mv[j][e] * rstd * gg[e]; s2 += xv[j][e] * xv[j][e]; } }
    if (gnext) {
        const float rstd2 = 1.0f / sqrtf(wave_sum(s2) * (1.0f / D) + NORM_EPS);
#pragma unroll
        for (int j = 0; j < 4; ++j) { const f32x4 gg = ((const GAS f32x4*)gnext)[lane + 64 * j]; u32x2 w; w.x = pk2(xv[j][0] * rstd2 * gg[0], xv[j][1] * rstd2 * gg[1]); w.y = pk2(xv[j][2] * rstd2 * gg[2], xv[j][3] * rstd2 * gg[3]);
            ((GAS u32x2*)xn)[lane + 64 * j] = w; }
        if (lane == 0) *rstd_io = rstd2;
    } else {
#pragma unroll
        for (int j = 0; j < 4; ++j) ((GAS f32x4*)xout_f32)[lane + 64 * j] = xv[j];
    }
}

struct Args { const float* in[17]; float* out; unsigned char* ws; };
constexpr int PT_OFF = LDSCTL_OFF;
__device__ __forceinline__ unsigned char* ldptr(LAS unsigned char* lds, int idx) {
    const volatile LAS unsigned* p = (const volatile LAS unsigned*)(lds + PT_OFF + idx * 8);
    const unsigned lo = (unsigned)__builtin_amdgcn_readfirstlane((int)p[0]), hi = (unsigned)__builtin_amdgcn_readfirstlane((int)p[1]);
    return (unsigned char*)(((unsigned long long)hi << 32) | lo);
}
#define INP(i) ((const float*)ldptr(lds, (i)))
#define OUTP ((float*)ldptr(lds, 17))
#define WSP (ldptr(lds, 18))
#define IDS int tid_ = wave_s * 64 + lane_id_volatile(); const int tid = tid_, lane = tid & 63, wave = wave_s; const int G = gridDim.x, bx = blockIdx.x; \
    const int vcu = (G % 8 == 0) ? (bx % 8) * (G / 8) + bx / 8 : bx; const int gw = vcu * NWAVES + wave, NGW = G * NWAVES; (void)lane; (void)gw; (void)NGW; (void)vcu; (void)bx; (void)tid; (void)wave
template <int MODE, int AMODE>
__device__ __forceinline__ void run_gemm(LAS unsigned char* lds, const bf16_t* A, const bf16_t* Bt, int Mr, int N, int K, const pg8::Epi<MODE>& E, int wave_s) {
    pg8::Gemm g{A, Bt, Mr, N, K}; pg8::StaticOrder S; S.init(Mr, N, (int)gridDim.x, (int)blockIdx.x);
#ifndef NO_GEMM
#ifdef ONLY_MODE
    if (MODE == ONLY_MODE)
#endif
    pg8::gemm_phase<pg8::Epi<MODE>, pg8::StaticOrder, AMODE, true, true>(lds, g, S, E, wave_s);
#endif
}

#ifndef REP_GIN
#define REP_GIN 1
#endif
#ifndef REP_CMP
#define REP_CMP 1
#endif
#ifndef REP_SCAN
#define REP_SCAN 1
#endif
#ifndef REP_ATT_NSA
#define REP_ATT_NSA 1
#endif
#ifndef REP_ATT_FOX
#define REP_ATT_FOX 1
#endif
#ifndef REP_ATT_SWA
#define REP_ATT_SWA 1
#endif
#ifndef REP_GOUT
#define REP_GOUT 1
#endif
#ifndef REP_MLP
#define REP_MLP 1
#endif
#ifndef REP_PRO
#define REP_PRO 1
#endif
template <int L>
__device__ __forceinline__ void layer_body(LAS unsigned char* lds, const XcdBarrier& bar, int& aslot, const int wave_s) {
#define GRID_BAR() xcd_barrier(bar)
    constexpr int kind = L % 3, sl = L / 3;
    if (kind == 0) {
        { unsigned char* ws = WSP;
          pg8::Epi<pg8::EM_NSA> E{(bf16_t*)(ws + WS_BIG), NSA_LDP, nullptr, (const float*)(ws + WS_ROPEC), (const float*)(ws + WS_ROPES), (float*)(ws + WS_G), nullptr, (bf16_t*)(ws + WS_BIG + NSA_HM_OFF), NSA_HM_STRIDE};
          run_gemm<pg8::EM_NSA, 0>(lds + RING_OFF, (const bf16_t*)(ws + WS_XN), (const bf16_t*)(ws + WS_WNSA) + (size_t)sl * NSA_NP * D, M, NSA_NP, D, E, wave_s); }
        GRID_BAR();
#if REP_GIN >= 2
        { unsigned char* ws = WSP;
          pg8::Epi<pg8::EM_NSA> E{(bf16_t*)(ws + WS_BIG), NSA_LDP, nullptr, (const float*)(ws + WS_ROPEC), (const float*)(ws + WS_ROPES), (float*)(ws + WS_G), nullptr, (bf16_t*)(ws + WS_BIG + NSA_HM_OFF), NSA_HM_STRIDE};
          run_gemm<pg8::EM_NSA, 0>(lds + RING_OFF, (const bf16_t*)(ws + WS_XN), (const bf16_t*)(ws + WS_WNSA) + (size_t)sl * NSA_NP * D, M, NSA_NP, D, E, wave_s); }
        GRID_BAR();
#endif
        { unsigned char* ws = WSP;
          pg8::Epi<pg8::EM_CMP> E{(bf16_t*)(ws + WS_HID), 256, (const float*)(ws + WS_CMPB) + sl * 512, nullptr, nullptr, nullptr, nullptr, nullptr, 0};
          run_gemm<pg8::EM_CMP, 1>(lds + RING_OFF, (const bf16_t*)(ws + WS_BIG) + 1024, (const bf16_t*)(ws + WS_WCMP) + (size_t)sl * 2 * 256 * 2048, CMP_ROWS, 512, 2048, E, wave_s); }
        GRID_BAR();
#if REP_CMP >= 2
        { unsigned char* ws = WSP;
          pg8::Epi<pg8::EM_CMP> E{(bf16_t*)(ws + WS_HID), 256, (const float*)(ws + WS_CMPB) + sl * 512, nullptr, nullptr, nullptr, nullptr, nullptr, 0};
          run_gemm<pg8::EM_CMP, 1>(lds + RING_OFF, (const bf16_t*)(ws + WS_BIG) + 1024, (const bf16_t*)(ws + WS_WCMP) + (size_t)sl * 2 * 256 * 2048, CMP_ROWS, 512, 2048, E, wave_s); }
        GRID_BAR();
#endif
        { IDS; unsigned char* ws = WSP; const bf16_t* HID = (const bf16_t*)(ws + WS_HID); const float* nsa_w2 = INP(7);
          const int which = bx >> 7, wl = bx & 127;
          LAS float* w2s = (LAS float*)(lds + RING_OFF);
          { const GAS f32x4* w2g = (const GAS f32x4*)(nsa_w2 + (size_t)(sl * 2 + which) * 256 * 64); for (int i = tid; i < 4096; i += 512) ((LAS f32x4*)w2s)[i] = w2g[i]; }
          __syncthreads();
          const int r0 = (wl * 8 + wave) * 8;
          float f[8][4], acc[8];
#pragma unroll
          for (int q = 0; q < 8; ++q) { const u32x2 hw = *(const GAS u32x2*)(HID + ((size_t)which * CMP_ROWS + r0 + q) * 256 + 4 * lane);
              f[q][0] = __uint_as_float(hw.x << 16); f[q][1] = __uint_as_float(hw.x & 0xffff0000u); f[q][2] = __uint_as_float(hw.y << 16); f[q][3] = __uint_as_float(hw.y & 0xffff0000u); acc[q] = 0.f; }
          const LAS float* wcol = w2s + (which ? lane : il64(lane));
          for (int jj = 0; jj < 64; ++jj) {
#pragma unroll
              for (int s = 0; s < 4; ++s) { const float w = wcol[(4 * jj + s) * 64];
#pragma unroll
                  for (int q = 0; q < 8; ++q) acc[q] += __builtin_bit_cast(float, __builtin_amdgcn_readlane(__builtin_bit_cast(int, f[q][s]), jj)) * w; }
          }
          bf16_t* dstb = (bf16_t*)(ws + (which ? WS_VC : WS_KC));
#pragma unroll
          for (int q = 0; q < 8; ++q) { const int r = r0 + q, gg = r & 3, c = (r >> 2) & 127, b = r >> 9;
              dstb[(size_t)((b * 4 + gg) * NCP + c) * 64 + lane] = (bf16_t)f2bf(c == NC ? 0.f : acc[q]); }
          __syncthreads();
        }
        GRID_BAR();
#if REP_CMP >= 2
        { IDS; unsigned char* ws = WSP; const bf16_t* HID = (const bf16_t*)(ws + WS_HID); const float* nsa_w2 = INP(7);
          const int which = bx >> 7, wl = bx & 127;
          LAS float* w2s = (LAS float*)(lds + RING_OFF);
          { const GAS f32x4* w2g = (const GAS f32x4*)(nsa_w2 + (size_t)(sl * 2 + which) * 256 * 64); for (int i = tid; i < 4096; i += 512) ((LAS f32x4*)w2s)[i] = w2g[i]; }
          __syncthreads();
          const int r0 = (wl * 8 + wave) * 8;
          float f[8][4], acc[8];
#pragma unroll
          for (int q = 0; q < 8; ++q) { const u32x2 hw = *(const GAS u32x2*)(HID + ((size_t)which * CMP_ROWS + r0 + q) * 256 + 4 * lane);
              f[q][0] = __uint_as_float(hw.x << 16); f[q][1] = __uint_as_float(hw.x & 0xffff0000u); f[q][2] = __uint_as_float(hw.y << 16); f[q][3] = __uint_as_float(hw.y & 0xffff0000u); acc[q] = 0.f; }
          const LAS float* wcol = w2s + (which ? lane : il64(lane));
          for (int jj = 0; jj < 64; ++jj) {
#pragma unroll
              for (int s = 0; s < 4; ++s) { const float w = wcol[(4 * jj + s) * 64];
#pragma unroll
                  for (int q = 0; q < 8; ++q) acc[q] += __builtin_bit_cast(float, __builtin_amdgcn_readlane(__builtin_bit_cast(int, f[q][s]), jj)) * w; }
          }
          bf16_t* dstb = (bf16_t*)(ws + (which ? WS_VC : WS_KC));
#pragma unroll
          for (int q = 0; q < 8; ++q) { const int r = r0 + q, gg = r & 3, c = (r >> 2) & 127, b = r >> 9;
              dstb[(size_t)((b * 4 + gg) * NCP + c) * 64 + lane] = (bf16_t)f2bf(c == NC ? 0.f : acc[q]); }
          __syncthreads();
        }
        GRID_BAR();
#endif
        { IDS; unsigned char* ws = WSP;
          const int bg = vcu >> 2, sub = vcu & 3, b = bg >> 2, g = bg & 3;
          for (int i = 0; i < 8; ++i) { const int qt = (i & 1) ? (8 * (i >> 1) + 7 - sub) : (8 * (i >> 1) + sub);
#ifndef NO_NSA
              att::nsa_unit(lds + RING_OFF, b, g, qt, ws, WS_BIG, WS_G, WS_KC, WS_VC, WS_O, wave, aslot);
#endif
          } }
#if REP_ATT_NSA >= 2
        GRID_BAR();
        { IDS; unsigned char* ws = WSP;
          const int bg = vcu >> 2, sub = vcu & 3, b = bg >> 2, g = bg & 3;
          for (int i = 0; i < 8; ++i) { const int qt = (i & 1) ? (8 * (i >> 1) + 7 - sub) : (8 * (i >> 1) + sub);
#ifndef NO_NSA
              att::nsa_unit(lds + RING_OFF, b, g, qt, ws, WS_BIG, WS_G, WS_KC, WS_VC, WS_O, wave, aslot);
#endif
          } }
#endif
    } else if (kind == 1) {
        { unsigned char* ws = WSP;
          pg8::Epi<pg8::EM_FOX> E{(bf16_t*)(ws + WS_BIG), FOX_LDP, nullptr, nullptr, nullptr, (float*)(ws + WS_LF), INP(10), (bf16_t*)(ws + WS_BIG + FOX_HM_OFF), FOX_HM_STRIDE};
          run_gemm<pg8::EM_FOX, 0>(lds + RING_OFF, (const bf16_t*)(ws + WS_XN), (const bf16_t*)(ws + WS_WFOX), M, FOX_NP, D, E, wave_s); }
        GRID_BAR();
#if REP_GIN >= 2
        { unsigned char* ws = WSP;
          pg8::Epi<pg8::EM_FOX> E{(bf16_t*)(ws + WS_BIG), FOX_LDP, nullptr, nullptr, nullptr, (float*)(ws + WS_LF), INP(10), (bf16_t*)(ws + WS_BIG + FOX_HM_OFF), FOX_HM_STRIDE};
          run_gemm<pg8::EM_FOX, 0>(lds + RING_OFF, (const bf16_t*)(ws + WS_XN), (const bf16_t*)(ws + WS_WFOX), M, FOX_NP, D, E, wave_s); }
        GRID_BAR();
#endif
        { IDS; unsigned char* ws = WSP; const float* LF = (const float*)(ws + WS_LF); float* CB = (float*)(ws + WS_CB);
          if (wave == 0) for (int bh = bx; bh < BATCH * NH; bh += G) {
            const int b = bh >> 4, h = bh & 15; float v[32]; float run = 0.f;
#pragma unroll
            for (int i = 0; i < 32; ++i) { run += LF[((size_t)b * T + 32 * lane + i) * 16 + h]; v[i] = run; }
            float excl = 0.f;
            for (int k = 0; k < 63; ++k) { const float t = __builtin_bit_cast(float, __builtin_amdgcn_readlane(__builtin_bit_cast(int, run), k)); if (lane > k) excl += t; }
#pragma unroll
            for (int i = 0; i < 32; ++i) CB[(size_t)bh * T + 32 * lane + i] = -(v[i] + excl) * LOG2E;
          } }
        GRID_BAR();
#if REP_SCAN >= 2
        { IDS; unsigned char* ws = WSP; const float* LF = (const float*)(ws + WS_LF); float* CB = (float*)(ws + WS_CB);
          if (wave == 0) for (int bh = bx; bh < BATCH * NH; bh += G) {
            const int b = bh >> 4, h = bh & 15; float v[32]; float run = 0.f;
#pragma unroll
            for (int i = 0; i < 32; ++i) { run += LF[((size_t)b * T + 32 * lane + i) * 16 + h]; v[i] = run; }
            float excl = 0.f;
            for (int k = 0; k < 63; ++k) { const float t = __builtin_bit_cast(float, __builtin_amdgcn_readlane(__builtin_bit_cast(int, run), k)); if (lane > k) excl += t; }
#pragma unroll
            for (int i = 0; i < 32; ++i) CB[(size_t)bh * T + 32 * lane + i] = -(v[i] + excl) * LOG2E;
          } }
        GRID_BAR();
#endif
        { IDS; unsigned char* ws = WSP;
          const int xcd = vcu >> 5, c = vcu & 31, sub = c & 3;
          for (int i = 0; i < 8; ++i) { const int bh = 32 * xcd + 8 * (i >> 1) + (c >> 2); const int qb = (i & 1) ? sub : 7 - sub;
#ifndef NO_FOX
              att::fox_unit(lds + RING_OFF, bh >> 4, bh & 15, qb, ws, WS_BIG, WS_CB, WS_O, wave, aslot);
#endif
          } }
#if REP_ATT_FOX >= 2
        GRID_BAR();
        { IDS; unsigned char* ws = WSP;
          const int xcd = vcu >> 5, c = vcu & 31, sub = c & 3;
          for (int i = 0; i < 8; ++i) { const int bh = 32 * xcd + 8 * (i >> 1) + (c >> 2); const int qb = (i & 1) ? sub : 7 - sub;
#ifndef NO_FOX
              att::fox_unit(lds + RING_OFF, bh >> 4, bh & 15, qb, ws, WS_BIG, WS_CB, WS_O, wave, aslot);
#endif
          } }
#endif
    } else {
        { unsigned char* ws = WSP;
          pg8::Epi<pg8::EM_SWA> E{(bf16_t*)(ws + WS_BIG), SWA_LDP, (const float*)(ws + WS_SWAB), (const float*)(ws + WS_ROPEC), (const float*)(ws + WS_ROPES), nullptr, nullptr, (bf16_t*)(ws + WS_BIG + SWA_HM_OFF), SWA_HM_STRIDE};
          run_gemm<pg8::EM_SWA, 0>(lds + RING_OFF, (const bf16_t*)(ws + WS_XN), (const bf16_t*)(ws + WS_WSWA), M, SWA_NP, D, E, wave_s); }
        GRID_BAR();
#if REP_GIN >= 2
        { unsigned char* ws = WSP;
          pg8::Epi<pg8::EM_SWA> E{(bf16_t*)(ws + WS_BIG), SWA_LDP, (const float*)(ws + WS_SWAB), (const float*)(ws + WS_ROPEC), (const float*)(ws + WS_ROPES), nullptr, nullptr, (bf16_t*)(ws + WS_BIG + SWA_HM_OFF), SWA_HM_STRIDE};
          run_gemm<pg8::EM_SWA, 0>(lds + RING_OFF, (const bf16_t*)(ws + WS_XN), (const bf16_t*)(ws + WS_WSWA), M, SWA_NP, D, E, wave_s); }
        GRID_BAR();
#endif
        { IDS; unsigned char* ws = WSP; const float* sinks = INP(14);
          const int bg = vcu >> 3, sub = vcu & 7;
          for (int i = 0; i < 8; ++i) {
#ifndef NO_SWA
              att::swa_unit(lds + RING_OFF, bg >> 1, bg & 1, 8 * i + sub, ws, WS_BIG, WS_O, sinks, wave, aslot);
#endif
          } }
#if REP_ATT_SWA >= 2
        GRID_BAR();
        { IDS; unsigned char* ws = WSP; const float* sinks = INP(14);
          const int bg = vcu >> 3, sub = vcu & 7;
          for (int i = 0; i < 8; ++i) {
#ifndef NO_SWA
              att::swa_unit(lds + RING_OFF, bg >> 1, bg & 1, 8 * i + sub, ws, WS_BIG, WS_O, sinks, wave, aslot);
#endif
          } }
#endif
    }
    GRID_BAR();
    { unsigned char* ws = WSP;
      pg8::Epi<pg8::EM_PLAIN> E{(bf16_t*)(ws + WS_BIG), D, kind == 2 ? INP(16) : nullptr, nullptr, nullptr, nullptr, nullptr, nullptr, 0};
      run_gemm<pg8::EM_PLAIN, 0>(lds + RING_OFF, (const bf16_t*)(ws + WS_O), (const bf16_t*)(ws + WS_WOUT) + (size_t)L * D * D, M, D, D, E, wave_s); }
    GRID_BAR();
#if REP_GOUT >= 2
    { unsigned char* ws = WSP;
      pg8::Epi<pg8::EM_PLAIN> E{(bf16_t*)(ws + WS_BIG), D, kind == 2 ? INP(16) : nullptr, nullptr, nullptr, nullptr, nullptr, nullptr, 0};
      run_gemm<pg8::EM_PLAIN, 0>(lds + RING_OFF, (const bf16_t*)(ws + WS_O), (const bf16_t*)(ws + WS_WOUT) + (size_t)L * D * D, M, D, D, E, wave_s); }
    GRID_BAR();
#endif
    { IDS; unsigned char* ws = WSP; const float* gL = INP(1) + (size_t)L * 4 * D; const float* xin = (L == 0) ? INP(0) : nullptr;
      const bf16_t* MB = (const bf16_t*)(ws + WS_BIG); bf16_t* XN = (bf16_t*)(ws + WS_XN); float* RSTD = (float*)(ws + WS_RSTD);
      for (int m = gw; m < M; m += NGW) resnorm_row(xin ? xin + (size_t)m * D : nullptr, XN + (size_t)m * D, RSTD + m, gL, MB + (size_t)m * D, gL + D, gL + 2 * D, nullptr, lane); }
    GRID_BAR();
    { unsigned char* ws = WSP;
      pg8::Epi<pg8::EM_RELU2> E{(bf16_t*)(ws + WS_BIG), FF, nullptr, nullptr, nullptr, nullptr, nullptr, nullptr, 0};
      run_gemm<pg8::EM_RELU2, 0>(lds + RING_OFF, (const bf16_t*)(ws + WS_XN), (const bf16_t*)(ws + WS_WUP) + (size_t)L * D * FF, M, FF, D, E, wave_s); }
    GRID_BAR();
#if REP_MLP >= 2
    { unsigned char* ws = WSP;
      pg8::Epi<pg8::EM_RELU2> E{(bf16_t*)(ws + WS_BIG), FF, nullptr, nullptr, nullptr, nullptr, nullptr, nullptr, 0};
      run_gemm<pg8::EM_RELU2, 0>(lds + RING_OFF, (const bf16_t*)(ws + WS_XN), (const bf16_t*)(ws + WS_WUP) + (size_t)L * D * FF, M, FF, D, E, wave_s); }
    GRID_BAR();
#endif
    { unsigned char* ws = WSP;
      pg8::Epi<pg8::EM_PLAIN> E{(bf16_t*)(ws + WS_M2), D, nullptr, nullptr, nullptr, nullptr, nullptr, nullptr, 0};
      run_gemm<pg8::EM_PLAIN, 0>(lds + RING_OFF, (const bf16_t*)(ws + WS_BIG), (const bf16_t*)(ws + WS_WDN) + (size_t)L * D * FF, M, D, FF, E, wave_s); }
    GRID_BAR();
#if REP_MLP >= 2
    { unsigned char* ws = WSP;
      pg8::Epi<pg8::EM_PLAIN> E{(bf16_t*)(ws + WS_M2), D, nullptr, nullptr, nullptr, nullptr, nullptr, nullptr, 0};
      run_gemm<pg8::EM_PLAIN, 0>(lds + RING_OFF, (const bf16_t*)(ws + WS_BIG), (const bf16_t*)(ws + WS_WDN) + (size_t)L * D * FF, M, D, FF, E, wave_s); }
    GRID_BAR();
#endif
    { IDS; unsigned char* ws = WSP; const float* gL = INP(1) + (size_t)L * 4 * D; float* xout = OUTP; bf16_t* XN = (bf16_t*)(ws + WS_XN); const bf16_t* M2 = (const bf16_t*)(ws + WS_M2); float* RSTD = (float*)(ws + WS_RSTD);
      for (int m = gw; m < M; m += NGW) resnorm_row(nullptr, XN + (size_t)m * D, RSTD + m, gL + 2 * D, M2 + (size_t)m * D, gL + 3 * D, (L + 1 < DEPTH) ? gL + 4 * D : nullptr, xout + (size_t)m * D, lane); }
    if (L + 1 < DEPTH) GRID_BAR();
#undef GRID_BAR
}

__global__ void __launch_bounds__(NWAVES * 64, 2) fwd_kernel(Args args) {
    extern __shared__ __attribute__((aligned(16))) unsigned char lds_raw[];
    LAS unsigned char* lds = (LAS unsigned char*)lds_raw;
    const int wave_s = __builtin_amdgcn_readfirstlane((int)threadIdx.x >> 6);
    for (int u = threadIdx.x; u < (LDS_BYTES - LDSCTL_OFF) / 4; u += NWAVES * 64) ((LAS unsigned*)(lds + LDSCTL_OFF))[u] = 0u;
    __syncthreads();
    if (threadIdx.x == 0) {
        LAS unsigned long long* pt = (LAS unsigned long long*)(lds + PT_OFF);
#pragma unroll
        for (int i = 0; i < 17; ++i) pt[i] = (unsigned long long)args.in[i];
        pt[17] = (unsigned long long)args.out; pt[18] = (unsigned long long)args.ws;
    }
    __syncthreads();
    volatile LAS unsigned* MISC = (volatile LAS unsigned*)(lds + MISC_OFF);
    XcdBarrier bar = xcd_barrier_post((unsigned*)(WSP + WS_CTL) + CW_BAR, MISC + 8);

    {
        IDS; unsigned char* ws = WSP;
        const float* x_in = INP(0); const float* norm_g = INP(1); const float* mlp_up = INP(2); const float* mlp_dn = INP(3);
        const float* nsa_w_in = INP(4); const float* nsa_pos = INP(5); const float* nsa_w1 = INP(6); const float* nsa_w_out = INP(8);
        const float* fox_w_in = INP(9); const float* fox_w_out = INP(11); const float* swa_w_in = INP(12); const float* swa_b_in = INP(13); const float* swa_w_out = INP(15);
        bf16_t* W_UP = (bf16_t*)(ws + WS_WUP); bf16_t* W_DN = (bf16_t*)(ws + WS_WDN); bf16_t* W_NSA = (bf16_t*)(ws + WS_WNSA); bf16_t* W_OUT = (bf16_t*)(ws + WS_WOUT);
        bf16_t* W_FOX = (bf16_t*)(ws + WS_WFOX); bf16_t* W_SWA = (bf16_t*)(ws + WS_WSWA); bf16_t* W_CMP = (bf16_t*)(ws + WS_WCMP);
        float* ROPEC = (float*)(ws + WS_ROPEC); float* ROPES = (float*)(ws + WS_ROPES); float* CMPB = (float*)(ws + WS_CMPB); float* SWAB = (float*)(ws + WS_SWAB);
        bf16_t* XN = (bf16_t*)(ws + WS_XN);
        LAS float* scr = (LAS float*)(lds + RING_OFF + wave * 16384);
        constexpr int I_UP = (D / 64) * (FF / 32), I_DN = (FF / 64) * (D / 32), I_NSA = (D / 64) * ((NSA_N + 31) / 32), I_OUT = (D / 64) * (D / 32), I_FOX = (D / 64) * ((FOX_N + 31) / 32), I_SWA = (D / 64) * (SWA_N / 32), I_CMP = (2048 / 64) * (256 / 32);
        constexpr int NITEMS = 4 * I_UP + 4 * I_DN + 2 * I_NSA + 4 * I_OUT + I_FOX + I_SWA + 4 * I_CMP;
        for (int it = gw; it < NITEMS; it += NGW) {
            int r = it;
            if (r < 4 * I_UP) { const int Lw = r / I_UP; conv_item(mlp_up + (size_t)Lw * D * FF, D, FF, W_UP + (size_t)Lw * D * FF, 0, r % I_UP, scr, lane); continue; } r -= 4 * I_UP;
            if (r < 4 * I_DN) { const int Lw = r / I_DN; conv_item(mlp_dn + (size_t)Lw * D * FF, FF, D, W_DN + (size_t)Lw * D * FF, 0, r % I_DN, scr, lane); continue; } r -= 4 * I_DN;
            if (r < 2 * I_NSA) { const int s = r / I_NSA; conv_item(nsa_w_in + (size_t)s * D * NSA_N, D, NSA_N, W_NSA + (size_t)s * NSA_NP * D, 1, r % I_NSA, scr, lane); continue; } r -= 2 * I_NSA;
            if (r < 4 * I_OUT) { const int Lw = r / I_OUT; const float* src = (Lw == 1) ? fox_w_out : (Lw == 2) ? swa_w_out : nsa_w_out + (size_t)(Lw / 3) * D * D;
                conv_item(src, D, D, W_OUT + (size_t)Lw * D * D, 0, r % I_OUT, scr, lane); continue; } r -= 4 * I_OUT;
            if (r < I_FOX) { conv_item(fox_w_in, D, FOX_N, W_FOX, 2, r, scr, lane); continue; } r -= I_FOX;
            if (r < I_SWA) { conv_item(swa_w_in, D, SWA_N, W_SWA, 3, r, scr, lane); continue; } r -= I_SWA;
            { const int sw = r / I_CMP;
                conv_item(nsa_w1 + (size_t)sw * 2048 * 256, 2048, 256, W_CMP + (size_t)sw * 256 * 2048, (sw & 1) ? 0 : 4, r % I_CMP, scr, lane); }
        }
        { constexpr int ZN = (NSA_NP - NSA_N) * D / 8, ZF = (FOX_NP - FOX_N) * D / 8;
          for (int e = bx * 512 + tid; e < 2 * ZN + ZF; e += G * 512) {
              bf16_t* dst = e < ZN ? W_NSA + (size_t)NSA_N * D + (size_t)e * 8 : e < 2 * ZN ? W_NSA + (size_t)NSA_NP * D + (size_t)NSA_N * D + (size_t)(e - ZN) * 8 : W_FOX + (size_t)FOX_N * D + (size_t)(e - 2 * ZN) * 8;
              *(GAS u32x4*)dst = (u32x4){0u, 0u, 0u, 0u}; } }
        for (int e = bx * 512 + tid; e < T * 32; e += G * 512) { const int t = e >> 5, i = e & 31; const float inv = powf(10000.0f, -(float)(2 * i) / 64.0f); const float ang = (float)t * inv;
            ROPEC[e] = cosf(ang); ROPES[e] = sinf(ang); }
        for (int e = bx * 512 + tid; e < SWA_N; e += G * 512) SWAB[e] = swa_b_in[src_n(3, e)];
        for (int task = bx; task < 64; task += G) {
            const int sw = task >> 4, n0 = (task & 15) * 16, kq = tid >> 4, nn = tid & 15;
            const float* pos = nsa_pos + (size_t)sw * 2048; const float* w1 = nsa_w1 + (size_t)sw * 2048 * 256;
            float acc = 0.f;
#pragma unroll 8
            for (int k = kq * 64; k < kq * 64 + 64; ++k) acc += pos[k] * w1[(size_t)k * 256 + n0 + nn];
            LAS float* red = (LAS float*)(lds + RING_OFF);
            __syncthreads();
            red[kq * 16 + nn] = acc;
            __syncthreads();
            if (tid < 16) { float sm = 0.f; for (int q = 0; q < 32; ++q) sm += red[q * 16 + tid]; CMPB[sw * 256 + n0 + tid] = sm; }
            __syncthreads();
        }
        for (int m = gw; m < M; m += NGW) norm_row(x_in + (size_t)m * D, norm_g, XN + (size_t)m * D, (float*)(ws + WS_RSTD) + m, lane);
    }
#if REP_PRO >= 2
    xcd_barrier(bar);
    {
        IDS; unsigned char* ws = WSP;
        const float* x_in = INP(0); const float* norm_g = INP(1); const float* mlp_up = INP(2); const float* mlp_dn = INP(3);
        const float* nsa_w_in = INP(4); const float* nsa_pos = INP(5); const float* nsa_w1 = INP(6); const float* nsa_w_out = INP(8);
        const float* fox_w_in = INP(9); const float* fox_w_out = INP(11); const float* swa_w_in = INP(12); const float* swa_b_in = INP(13); const float* swa_w_out = INP(15);
        bf16_t* W_UP = (bf16_t*)(ws + WS_WUP); bf16_t* W_DN = (bf16_t*)(ws + WS_WDN); bf16_t* W_NSA = (bf16_t*)(ws + WS_WNSA); bf16_t* W_OUT = (bf16_t*)(ws + WS_WOUT);
        bf16_t* W_FOX = (bf16_t*)(ws + WS_WFOX); bf16_t* W_SWA = (bf16_t*)(ws + WS_WSWA); bf16_t* W_CMP = (bf16_t*)(ws + WS_WCMP);
        float* ROPEC = (float*)(ws + WS_ROPEC); float* ROPES = (float*)(ws + WS_ROPES); float* CMPB = (float*)(ws + WS_CMPB); float* SWAB = (float*)(ws + WS_SWAB);
        bf16_t* XN = (bf16_t*)(ws + WS_XN);
        LAS float* scr = (LAS float*)(lds + RING_OFF + wave * 16384);
        constexpr int I_UP = (D / 64) * (FF / 32), I_DN = (FF / 64) * (D / 32), I_NSA = (D / 64) * ((NSA_N + 31) / 32), I_OUT = (D / 64) * (D / 32), I_FOX = (D / 64) * ((FOX_N + 31) / 32), I_SWA = (D / 64) * (SWA_N / 32), I_CMP = (2048 / 64) * (256 / 32);
        constexpr int NITEMS = 4 * I_UP + 4 * I_DN + 2 * I_NSA + 4 * I_OUT + I_FOX + I_SWA + 4 * I_CMP;
        for (int it = gw; it < NITEMS; it += NGW) {
            int r = it;
            if (r < 4 * I_UP) { const int Lw = r / I_UP; conv_item(mlp_up + (size_t)Lw * D * FF, D, FF, W_UP + (size_t)Lw * D * FF, 0, r % I_UP, scr, lane); continue; } r -= 4 * I_UP;
            if (r < 4 * I_DN) { const int Lw = r / I_DN; conv_item(mlp_dn + (size_t)Lw * D * FF, FF, D, W_DN + (size_t)Lw * D * FF, 0, r % I_DN, scr, lane); continue; } r -= 4 * I_DN;
            if (r < 2 * I_NSA) { const int s = r / I_NSA; conv_item(nsa_w_in + (size_t)s * D * NSA_N, D, NSA_N, W_NSA + (size_t)s * NSA_NP * D, 1, r % I_NSA, scr, lane); continue; } r -= 2 * I_NSA;
            if (r < 4 * I_OUT) { const int Lw = r / I_OUT; const float* src = (Lw == 1) ? fox_w_out : (Lw == 2) ? swa_w_out : nsa_w_out + (size_t)(Lw / 3) * D * D;
                conv_item(src, D, D, W_OUT + (size_t)Lw * D * D, 0, r % I_OUT, scr, lane); continue; } r -= 4 * I_OUT;
            if (r < I_FOX) { conv_item(fox_w_in, D, FOX_N, W_FOX, 2, r, scr, lane); continue; } r -= I_FOX;
            if (r < I_SWA) { conv_item(swa_w_in, D, SWA_N, W_SWA, 3, r, scr, lane); continue; } r -= I_SWA;
            { const int sw = r / I_CMP;
                conv_item(nsa_w1 + (size_t)sw * 2048 * 256, 2048, 256, W_CMP + (size_t)sw * 256 * 2048, (sw & 1) ? 0 : 4, r % I_CMP, scr, lane); }
        }
        { constexpr int ZN = (NSA_NP - NSA_N) * D / 8, ZF = (FOX_NP - FOX_N) * D / 8;
          for (int e = bx * 512 + tid; e < 2 * ZN + ZF; e += G * 512) {
              bf16_t* dst = e < ZN ? W_NSA + (size_t)NSA_N * D + (size_t)e * 8 : e < 2 * ZN ? W_NSA + (size_t)NSA_NP * D + (size_t)NSA_N * D + (size_t)(e - ZN) * 8 : W_FOX + (size_t)FOX_N * D + (size_t)(e - 2 * ZN) * 8;
              *(GAS u32x4*)dst = (u32x4){0u, 0u, 0u, 0u}; } }
        for (int e = bx * 512 + tid; e < T * 32; e += G * 512) { const int t = e >> 5, i = e & 31; const float inv = powf(10000.0f, -(float)(2 * i) / 64.0f); const float ang = (float)t * inv;
            ROPEC[e] = cosf(ang); ROPES[e] = sinf(ang); }
        for (int e = bx * 512 + tid; e < SWA_N; e += G * 512) SWAB[e] = swa_b_in[src_n(3, e)];
        for (int task = bx; task < 64; task += G) {
            const int sw = task >> 4, n0 = (task & 15) * 16, kq = tid >> 4, nn = tid & 15;
            const float* pos = nsa_pos + (size_t)sw * 2048; const float* w1 = nsa_w1 + (size_t)sw * 2048 * 256;
            float acc = 0.f;
#pragma unroll 8
            for (int k = kq * 64; k < kq * 64 + 64; ++k) acc += pos[k] * w1[(size_t)k * 256 + n0 + nn];
            LAS float* red = (LAS float*)(lds + RING_OFF);
            __syncthreads();
            red[kq * 16 + nn] = acc;
            __syncthreads();
            if (tid < 16) { float sm = 0.f; for (int q = 0; q < 32; ++q) sm += red[q * 16 + tid]; CMPB[sw * 256 + n0 + tid] = sm; }
            __syncthreads();
        }
        for (int m = gw; m < M; m += NGW) norm_row(x_in + (size_t)m * D, norm_g, XN + (size_t)m * D, (float*)(ws + WS_RSTD) + m, lane);
    }
#endif
    xcd_barrier(bar);

    int aslot = 0;
    if (L_LO <= 0 && 0 < L_HI) layer_body<0>(lds, bar, aslot, wave_s);
    if (L_LO <= 1 && 1 < L_HI) layer_body<1>(lds, bar, aslot, wave_s);
    if (L_LO <= 2 && 2 < L_HI) layer_body<2>(lds, bar, aslot, wave_s);
    if (L_LO <= 3 && 3 < L_HI) layer_body<3>(lds, bar, aslot, wave_s);
}

extern "C" void kernel_launch(void* const* d_in, const int* in_sizes, int n_in, void* d_out, int out_size, void* d_ws, size_t ws_size, hipStream_t stream) {
    static int grid = 0;
    if (grid == 0) {
        if (n_in != 17 || in_sizes[0] != M * D || out_size != M * D || ws_size < WS_END) { fprintf(stderr, "kernel_launch: unexpected problem shape (n_in %d, in0 %d, out %d, ws %zu)\n", n_in, n_in > 0 ? in_sizes[0] : -1, out_size, ws_size); grid = -1; return; }
        int dev = 0, cus = 0, per_cu = 0;
        if (hipGetDevice(&dev) != hipSuccess || hipDeviceGetAttribute(&cus, hipDeviceAttributeMultiprocessorCount, dev) != hipSuccess) { grid = -1; return; }
        if (hipFuncSetAttribute((const void*)fwd_kernel, hipFuncAttributeMaxDynamicSharedMemorySize, LDS_BYTES) != hipSuccess) { fprintf(stderr, "kernel_launch: hipFuncSetAttribute failed\n"); grid = -1; return; }
        if (hipOccupancyMaxActiveBlocksPerMultiprocessor(&per_cu, (const void*)fwd_kernel, NWAVES * 64, LDS_BYTES) != hipSuccess || per_cu < 1) { fprintf(stderr, "kernel_launch: occupancy query reports %d\n", per_cu); }
        (void)hipGetLastError();
        if (cus < 256) { fprintf(stderr, "kernel_launch: needs 256 CUs, device has %d\n", cus); grid = -1; return; }
        grid = 256;
    }
    if (grid < 0) return;
    if (hipMemsetAsync((char*)d_ws + WS_CTL, 0, CTL_ZERO_BYTES, stream) != hipSuccess) return;
    Args a{};
    for (int i = 0; i < 17; ++i) a.in[i] = (const float*)d_in[i];
    a.out = (float*)d_out; a.ws = (unsigned char*)d_ws;
    hipLaunchKernelGGL(fwd_kernel, dim3(grid), dim3(NWAVES * 64), LDS_BYTES, stream, a);
}
```

```cpp
#include <hip/hip_runtime.h>
#include <cstdio>
#include <cstdint>

#define LAS __attribute__((address_space(3)))
#define GAS __attribute__((address_space(1)))
typedef unsigned short bf16_t;
typedef short bf16x8 __attribute__((ext_vector_type(8)));
typedef short s16x4 __attribute__((ext_vector_type(4)));
typedef float f32x2 __attribute__((ext_vector_type(2)));
typedef float f32x4 __attribute__((ext_vector_type(4)));
typedef float f32x16 __attribute__((ext_vector_type(16)));
typedef unsigned u32x2 __attribute__((ext_vector_type(2)));
typedef unsigned u32x4 __attribute__((ext_vector_type(4)));

constexpr int BATCH = 16, T = 2048, D = 1024, NH = 16, HD = 64, FF = 4096, DEPTH = 4;
constexpr int M = BATCH * T;
constexpr int NSA_N = 2608, NSA_NP = 2560, NSA_LDP = 1536;
constexpr int FOX_N = 3088, FOX_NP = 3328, FOX_LDP = 1024;
constexpr int SWA_N = 1280, SWA_NP = 1280, SWA_LDP = 1024;
constexpr int CMP_LDP = NSA_LDP;
constexpr int NC = 127, NCP = 128;
constexpr int CMP_ROWS = BATCH * NCP * 4;
constexpr size_t NSA_HM_OFF = (size_t)96 << 20, NSA_HM_STRIDE = (size_t)8 << 20;
constexpr size_t FOX_HM_OFF = (size_t)64 << 20, FOX_HM_STRIDE = (size_t)32 << 20;
constexpr size_t SWA_HM_OFF = (size_t)64 << 20, SWA_HM_STRIDE = (size_t)4 << 20;
constexpr float LOG2E = 1.4426950408889634f;
constexpr float C2 = 0.125f * LOG2E;
constexpr float NORM_EPS = 1e-6f;

__device__ __forceinline__ unsigned cvt_pk_bf16(float lo, float hi) { unsigned r; asm volatile("v_cvt_pk_bf16_f32 %0, %1, %2" : "=v"(r) : "v"(lo), "v"(hi)); return r; }
__device__ __forceinline__ void store8(bf16_t* p, f32x4 a, f32x4 b) { u32x4 w; w.x = cvt_pk_bf16(a[0], a[1]); w.y = cvt_pk_bf16(a[2], a[3]); w.z = cvt_pk_bf16(b[0], b[1]); w.w = cvt_pk_bf16(b[2], b[3]); *(u32x4*)p = w; }

__device__ __forceinline__ int lane_id_volatile() { int x; asm volatile("v_mbcnt_lo_u32_b32 %0, -1, 0\n\tv_mbcnt_hi_u32_b32 %0, -1, %0" : "=v"(x)); return x; }

namespace pg8 {
#define PG8_LAS __attribute__((address_space(3)))
constexpr int BM = 256, BK = 64, HALF = 128, HTB = HALF * BK * 2  , STAGE_BYTES = 8 * HTB, NXCD = 8, WGM = 8;

__host__ __device__ __forceinline__ int lds_byte(int r, int c) { const int st = (r >> 4) * 2 + (c >> 5), rr = r & 15, cc = c & 31, ob = rr * 64 + cc * 2; return st * 1024 + (ob ^ (((ob >> 9) & 1) << 5)); }
__host__ __device__ __forceinline__ void stage_rc(int b, int& R, int& C) { const int st = b / 1024, sb = b % 1024, swz = sb ^ (((sb >> 9) & 1) << 5); R = (st >> 1) * 16 + swz / 64; C = (st & 1) * 32 + (swz % 64) / 2; }
__host__ __device__ __forceinline__ int perm32(int rho) { const int n = rho >> 4, i = rho & 15; return 8 * (i >> 2) + 4 * n + (i & 3); }

struct Unit { int pm, pn; };
struct Gemm { const bf16_t* A; const bf16_t* Bt; int M, N, K; };

struct StaticOrder {
    int nM, nN, nwg, G, c;
    __host__ __device__ void init(int M_, int N_, int G_, int c_) { nM = M_ / BM; nN = N_ / BM; nwg = nM * nN; G = G_; c = c_; }
    __host__ __device__ bool next(int i, Unit& u) const {
        const long L = (long)i * G + c; if (L >= nwg) return false;
        int wgid = (int)L; { const int q = nwg / NXCD, r = nwg % NXCD, xcd = wgid % NXCD, off = wgid / NXCD; wgid = (xcd < r ? xcd * (q + 1) : r * (q + 1) + (xcd - r) * q) + off; }
        const int nig = WGM * nN, gid = wgid / nig, fm = gid * WGM, gsz = (nM - fm) < WGM ? (nM - fm) : WGM;
        u.pm = fm + ((wgid % nig) % gsz); u.pn = (wgid % nig) / gsz; return true;
    }
    __device__ __forceinline__ void a_ready(const Unit&) const {}
    __device__ __forceinline__ void done(const Unit&) const {}
};

enum EpiMode { EM_PLAIN = 0, EM_RELU2 = 1, EM_NSA = 2, EM_FOX = 3, EM_SWA = 4, EM_CMP = 5, EM_GATE = 6 };

__device__ __forceinline__ void rope4(f32x4& v, float c0, float s0, float c1, float s1) {
    const float a0 = v[0], b0 = v[1], a1 = v[2], b1 = v[3];
    v[0] = a0 * c0 - b0 * s0; v[1] = b0 * c0 + a0 * s0; v[2] = a1 * c1 - b1 * s1; v[3] = b1 * c1 + a1 * s1;
}
__device__ __forceinline__ float sigmoidf_(float x) { return 1.0f / (1.0f + __expf(-x)); }
__device__ __forceinline__ float logsigmoidf_(float x) { return fminf(x, 0.f) - log1pf(expf(-fabsf(x))); }

template <int MODE> struct Epi {
    static constexpr bool PERM = true, AFTER_DRAIN = false;
    bf16_t* O; int ldc; const float* bias; const float* rc; const float* rs; float* aux; const float* auxb;
    bf16_t* hm0; size_t hm_stride;
    __device__ __forceinline__ void operator()(const f32x4 (&acc)[2][2][4][2], const Unit& u, int wr, int wc, int fr, int fq) const {
        const int row0 = u.pm * BM + wr * 64 + fr;
        const int cw = wc * 32 + 8 * fq;
        const int colt = u.pn * BM;
        if (MODE == EM_GATE) {
            if (cw < 48) {
#pragma unroll
                for (int ai = 0; ai < 2; ++ai)
#pragma unroll
                    for (int m = 0; m < 4; ++m) { const size_t row = (size_t)(row0 + ai * HALF + m * 16); f32x4 v0 = acc[ai][0][m][0], v1 = acc[ai][0][m][1];
#pragma unroll
                        for (int j = 0; j < 4; ++j) { v0[j] = sigmoidf_(v0[j]); v1[j] = sigmoidf_(v1[j]); }
                        *(f32x4*)(aux + row * 48 + cw) = v0; *(f32x4*)(aux + row * 48 + cw + 4) = v1; }
            }
            return;
        }
        if (MODE == EM_FOX && u.pn == 12) {
            if (cw < 16) {
                const f32x4 b0 = *(const f32x4*)(auxb + cw), b1 = *(const f32x4*)(auxb + cw + 4);
#pragma unroll
                for (int ai = 0; ai < 2; ++ai)
#pragma unroll
                    for (int m = 0; m < 4; ++m) { const size_t row = (size_t)(row0 + ai * HALF + m * 16); f32x4 v0 = acc[ai][0][m][0] + b0, v1 = acc[ai][0][m][1] + b1;
#pragma unroll
                        for (int j = 0; j < 4; ++j) { v0[j] = logsigmoidf_(v0[j]); v1[j] = logsigmoidf_(v1[j]); }
                        *(f32x4*)(aux + row * 16 + cw) = v0; *(f32x4*)(aux + row * 16 + cw + 4) = v1; }
            }
            return;
        }
        bool rope0 = false, rope1 = false; float sc = 1.f;
        if (MODE == EM_NSA) { if (u.pn < 4) { rope0 = rope1 = true; sc = C2; } else if (!(u.pn & 1)) { rope0 = rope1 = true; } }
        if (MODE == EM_FOX) { if (u.pn < 4) sc = C2; }
        if (MODE == EM_SWA) { if (u.pn < 4) { rope0 = rope1 = true; sc = C2; } else { rope0 = true; } }
        f32x4 bv[2][2];
#pragma unroll
        for (int bj = 0; bj < 2; ++bj)
#pragma unroll
            for (int n = 0; n < 2; ++n) bv[bj][n] = bias ? *(const f32x4*)(bias + colt + bj * HALF + cw + 4 * n) : (f32x4){0.f, 0.f, 0.f, 0.f};
        const int ib = 16 * (wc & 1) + 4 * fq;
        bf16_t* base = O; int colo = colt; size_t rowo = 0;
        if (MODE == EM_CMP) { colo = 0; rowo = (size_t)u.pn * CMP_ROWS; }
        bool hm = false; bf16_t* hb[2] = {nullptr, nullptr}; int hd[2] = {0, 0}; int HG = 1;
        if (MODE == EM_FOX && u.pn >= 4) { hm = true; HG = 16; hb[0] = hb[1] = hm0 + (u.pn >= 8 ? hm_stride : 0); hd[0] = ((u.pn - 4) & 3) * 4 + (wc >> 1); hd[1] = hd[0] + 2; }
        if (MODE == EM_NSA && u.pn >= 6) { hm = true; HG = 4; hb[0] = hb[1] = hm0 + (size_t)(u.pn - 6) * hm_stride; hd[0] = (wc >> 1); hd[1] = hd[0] + 2; }
        if (MODE == EM_SWA && u.pn == 4) { hm = true; HG = 2; hb[0] = hm0; hb[1] = hm0 + hm_stride; hd[0] = hd[1] = (wc >> 1); }
#pragma unroll
        for (int ai = 0; ai < 2; ++ai)
#pragma unroll
            for (int m = 0; m < 4; ++m) {
                const int row = row0 + ai * HALF + m * 16;
                f32x4 cc = {1.f, 1.f, 1.f, 1.f}, ss = {0.f, 0.f, 0.f, 0.f};
                if (MODE == EM_NSA || MODE == EM_SWA) { if (rope0) { const int t = row & (T - 1); cc = *(const f32x4*)(rc + t * 32 + ib); ss = *(const f32x4*)(rs + t * 32 + ib); } }
                bf16_t* rowp = base + (rowo + (size_t)row) * ldc + colo + cw;
#pragma unroll
                for (int bj = 0; bj < 2; ++bj) {
                    f32x4 v0 = acc[ai][bj][m][0] + bv[bj][0], v1 = acc[ai][bj][m][1] + bv[bj][1];
                    if (MODE == EM_NSA || MODE == EM_SWA) { if (bj == 0 ? rope0 : rope1) { rope4(v0, cc[0], ss[0], cc[1], ss[1]); rope4(v1, cc[2], ss[2], cc[3], ss[3]); } }
                    if (MODE == EM_RELU2) {
#pragma unroll
                        for (int j = 0; j < 4; ++j) { const float a = fmaxf(v0[j], 0.f), b = fmaxf(v1[j], 0.f); v0[j] = a * a; v1[j] = b * b; } }
                    if (MODE == EM_CMP) {
#pragma unroll
                        for (int j = 0; j < 4; ++j) { v0[j] = v0[j] * sigmoidf_(v0[j]); v1[j] = v1[j] * sigmoidf_(v1[j]); } }
                    if (MODE == EM_NSA || MODE == EM_FOX || MODE == EM_SWA) { v0 = v0 * sc; v1 = v1 * sc; }
                    if ((MODE == EM_FOX || MODE == EM_NSA || MODE == EM_SWA) && hm) store8(hb[bj] + (((size_t)(row >> 11) * HG + hd[bj]) * T + (row & (T - 1))) * 64 + (cw & 63), v0, v1);
                    else store8(rowp + bj * HALF, v0, v1);
                }
            }
    }
};

template <class Epi, class Sched, int AMODE, bool ALIGN_EPI = false, bool SP2 = false>
__device__ __forceinline__ void gemm_phase(PG8_LAS unsigned char* lds, const Gemm g, const Sched& S, const Epi& E, int wave_id) {
    int tid_; { int x_; asm volatile("v_mbcnt_lo_u32_b32 %0, -1, 0\n\tv_mbcnt_hi_u32_b32 %0, -1, %0" : "=v"(x_)); tid_ = wave_id * 64 + x_; }
    const int tid = tid_, wid = __builtin_amdgcn_readfirstlane(tid >> 6), lane = tid & 63, wr = wid >> 2, wc = wid & 3, fr = lane & 15, fq = lane >> 4;
    const int K = g.K, nt = K / BK;
    unsigned voffA[2], voffB[2];
#pragma unroll
    for (int i = 0; i < 2; ++i) { int R, C; stage_rc(tid * 16 + i * 8192, R, C); const int Rb = Epi::PERM ? ((R & ~31) + perm32(R & 31)) : R;
        voffA[i] = (AMODE == 1) ? (unsigned)((16 * (R >> 2)) * CMP_LDP + (R & 3) * 64 + C) * 2u : (unsigned)(R * K + C) * 2u; voffB[i] = (unsigned)(Rb * K + C) * 2u; }
    const size_t kstepB = (size_t)(BK * 2);
    const size_t hstepB = (size_t)HALF * K * 2;
    const size_t tstepB = 2 * hstepB;
    const size_t kstepA = (AMODE == 1) ? (size_t)CMP_LDP * 2 : kstepB;
    const size_t hstepA = (AMODE == 1) ? (size_t)512 * CMP_LDP * 2 : hstepB;
    const size_t tstepA = 2 * hstepA;
    const size_t pnstepA = (AMODE == 1) ? (size_t)512 : (size_t)0;
    const unsigned ldsw = (unsigned)wid * 1024u;
    const int aoff = lds_byte(wr * 64 + fr, fq * 8), boff = lds_byte(wc * 32 + fr, fq * 8);
#define PG8_SA(b, h) (((b) * 2 + (h)) * HTB)
#define PG8_SB(b, h) ((4 + (b) * 2 + (h)) * HTB)
#define PG8_STAGE(bufoff, gbase, voff) do { _Pragma("unroll") for (int _i = 0; _i < 2; ++_i) \
        __builtin_amdgcn_global_load_lds((const unsigned*)((const char*)(gbase) + (voff)[_i]), (PG8_LAS unsigned*)(lds + (bufoff) + ldsw + _i * 8192), 16, 0, 0); } while (0)
#define PG8_LDA(dst, b, h) do { _Pragma("unroll") for (int m = 0; m < 4; ++m) _Pragma("unroll") for (int k = 0; k < 2; ++k) dst[m][k] = *(const PG8_LAS bf16x8*)(lds + PG8_SA(b, h) + aoff + m * 2048 + k * 1024); } while (0)
#define PG8_LDB(dst, b, h) do { _Pragma("unroll") for (int n = 0; n < 2; ++n) _Pragma("unroll") for (int k = 0; k < 2; ++k) dst[n][k] = *(const PG8_LAS bf16x8*)(lds + PG8_SB(b, h) + boff + n * 2048 + k * 1024); } while (0)
#define PG8_MMA(ai, bj, At, Bt) do { __builtin_amdgcn_s_setprio(1); _Pragma("unroll") for (int m = 0; m < 4; ++m) _Pragma("unroll") for (int n = 0; n < 2; ++n) _Pragma("unroll") for (int k = 0; k < 2; ++k) \
        acc[ai][bj][m][n] = __builtin_amdgcn_mfma_f32_16x16x32_bf16(Bt[n][k], At[m][k], acc[ai][bj][m][n], 0, 0, 0); __builtin_amdgcn_s_setprio(0); } while (0)
#define PG8_WAIT_V(n) asm volatile("s_waitcnt vmcnt(" #n ")" ::: "memory")
#define PG8_WAIT_L(n) asm volatile("s_waitcnt lgkmcnt(" #n ")" ::: "memory")
#define PG8_BAR __builtin_amdgcn_s_barrier()
#define PG8_SCHED __builtin_amdgcn_sched_barrier(0)
    Unit cur, nxt; int ui = 0;
    if (!S.next(0, cur)) return;
    f32x4 acc[2][2][4][2];
#pragma unroll
    for (int a = 0; a < 2; ++a)
#pragma unroll
        for (int b = 0; b < 2; ++b)
#pragma unroll
            for (int m = 0; m < 4; ++m)
#pragma unroll
                for (int n = 0; n < 2; ++n) acc[a][b][m][n] = (f32x4){0.f, 0.f, 0.f, 0.f};
    bf16x8 At[4][2], B0[2][2], B1[2][2];
    const char* cA = (const char*)g.A + (size_t)cur.pm * tstepA + (size_t)cur.pn * pnstepA; const char* cB = (const char*)g.Bt + (size_t)cur.pn * tstepB;
    S.a_ready(cur);
    if constexpr (SP2) {
        PG8_STAGE(PG8_SB(0, 0), cB, voffB); PG8_STAGE(PG8_SB(0, 1), cB + hstepB, voffB); PG8_STAGE(PG8_SA(0, 0), cA, voffA); PG8_STAGE(PG8_SA(0, 1), cA + hstepA, voffA);
        if (wr == 1) PG8_BAR;
        PG8_WAIT_V(2); PG8_BAR;
        PG8_STAGE(PG8_SB(1, 0), cB + kstepB, voffB); PG8_STAGE(PG8_SA(1, 0), cA + kstepA, voffA); PG8_STAGE(PG8_SB(1, 1), cB + hstepB + kstepB, voffB);
        PG8_WAIT_V(6); PG8_BAR;
    } else {
        PG8_STAGE(PG8_SB(0, 0), cB, voffB); PG8_STAGE(PG8_SA(0, 0), cA, voffA); PG8_STAGE(PG8_SB(0, 1), cB + hstepB, voffB); PG8_STAGE(PG8_SA(0, 1), cA + hstepA, voffA);
        if (wr == 1) PG8_BAR;
        PG8_WAIT_V(4); PG8_BAR;
        PG8_STAGE(PG8_SB(1, 0), cB + kstepB, voffB); PG8_STAGE(PG8_SA(1, 0), cA + kstepA, voffA); PG8_STAGE(PG8_SB(1, 1), cB + hstepB + kstepB, voffB);
        PG8_WAIT_V(6); PG8_BAR;
    }
    for (;;) {
        const bool has_next = S.next(ui + 1, nxt);
        const char* nA = has_next ? (const char*)g.A + (size_t)nxt.pm * tstepA + (size_t)nxt.pn * pnstepA : cA; const char* nB = has_next ? (const char*)g.Bt + (size_t)nxt.pn * tstepB : cB;
        for (int t = 0; t < nt; t += 2) {
            const bool last = (t == nt - 2);
            const char* a1 = cA + (size_t)(t + 1) * kstepA;
            const char* a2 = last ? nA : cA + (size_t)(t + 2) * kstepA; const char* b2 = last ? nB : cB + (size_t)(t + 2) * kstepB;
            const char* a3 = a2 + kstepA; const char* b3 = b2 + kstepB;
            if (last && has_next) S.a_ready(nxt);
            if constexpr (SP2) {
            PG8_LDB(B0, 0, 0); PG8_LDB(B1, 0, 1); PG8_SCHED; PG8_LDA(At, 0, 0); PG8_STAGE(PG8_SA(1, 1), a1 + hstepA, voffA);
            PG8_WAIT_V(8); PG8_WAIT_L(0); PG8_BAR; PG8_MMA(0, 0, At, B0); PG8_MMA(0, 1, At, B1); PG8_BAR; PG8_SCHED;
            PG8_LDA(At, 0, 1); PG8_STAGE(PG8_SB(0, 0), b2, voffB); PG8_STAGE(PG8_SB(0, 1), b2 + hstepB, voffB); PG8_STAGE(PG8_SA(0, 0), a2, voffA);
            PG8_WAIT_V(8); PG8_WAIT_L(0); PG8_BAR; PG8_MMA(1, 0, At, B0); PG8_MMA(1, 1, At, B1); PG8_BAR; PG8_SCHED;
            PG8_LDB(B0, 1, 0); PG8_LDB(B1, 1, 1); PG8_SCHED; PG8_LDA(At, 1, 0); PG8_STAGE(PG8_SA(0, 1), a2 + hstepA, voffA);
            PG8_WAIT_V(8); PG8_WAIT_L(0); PG8_BAR; PG8_MMA(0, 0, At, B0); PG8_MMA(0, 1, At, B1); PG8_BAR; PG8_SCHED;
            PG8_LDA(At, 1, 1); PG8_STAGE(PG8_SB(1, 0), b3, voffB); PG8_STAGE(PG8_SB(1, 1), b3 + hstepB, voffB); PG8_STAGE(PG8_SA(1, 0), a3, voffA);
            PG8_WAIT_V(8); PG8_WAIT_L(0); PG8_BAR; PG8_MMA(1, 0, At, B0); PG8_MMA(1, 1, At, B1); PG8_BAR; PG8_SCHED;
            } else {
            PG8_LDB(B0, 0, 0); PG8_SCHED; PG8_LDA(At, 0, 0); PG8_STAGE(PG8_SA(1, 1), a1 + hstepA, voffA);
            PG8_WAIT_L(8); PG8_BAR; PG8_WAIT_L(0); PG8_MMA(0, 0, At, B0); PG8_BAR; PG8_SCHED;
            PG8_LDB(B1, 0, 1); PG8_STAGE(PG8_SB(0, 0), b2, voffB);
            PG8_BAR; PG8_WAIT_L(0); PG8_MMA(0, 1, At, B1); PG8_BAR;
            PG8_LDA(At, 0, 1); PG8_STAGE(PG8_SA(0, 0), a2, voffA);
            PG8_BAR; PG8_WAIT_L(0); PG8_MMA(1, 0, At, B0); PG8_BAR; PG8_SCHED;
            PG8_STAGE(PG8_SB(0, 1), b2 + hstepB, voffB);
            PG8_WAIT_V(6); PG8_BAR; PG8_MMA(1, 1, At, B1); PG8_BAR;
            PG8_LDB(B0, 1, 0); PG8_SCHED; PG8_LDA(At, 1, 0); PG8_STAGE(PG8_SA(0, 1), a2 + hstepA, voffA);
            PG8_WAIT_L(8); PG8_BAR; PG8_WAIT_L(0); PG8_MMA(0, 0, At, B0); PG8_BAR; PG8_SCHED;
            PG8_LDB(B1, 1, 1); PG8_STAGE(PG8_SB(1, 0), b3, voffB);
            PG8_BAR; PG8_WAIT_L(0); PG8_MMA(0, 1, At, B1); PG8_BAR;
            PG8_LDA(At, 1, 1); PG8_STAGE(PG8_SA(1, 0), a3, voffA);
            PG8_BAR; PG8_WAIT_L(0); PG8_MMA(1, 0, At, B0); PG8_BAR; PG8_SCHED;
            PG8_STAGE(PG8_SB(1, 1), b3 + hstepB, voffB);
            PG8_WAIT_V(6); PG8_BAR; PG8_MMA(1, 1, At, B1); PG8_BAR;
            }
        }
        if constexpr (ALIGN_EPI) { if (wr == 0) PG8_BAR; }
        if constexpr (!Epi::AFTER_DRAIN) { E(acc, cur, wr, wc, fr, fq); S.done(cur); }
        if (!has_next) break;
#pragma unroll
        for (int a = 0; a < 2; ++a)
#pragma unroll
            for (int b = 0; b < 2; ++b)
#pragma unroll
                for (int m = 0; m < 4; ++m)
#pragma unroll
                    for (int n = 0; n < 2; ++n) acc[a][b][m][n] = (f32x4){0.f, 0.f, 0.f, 0.f};
        cur = nxt; cA = nA; cB = nB; ++ui;
        if constexpr (ALIGN_EPI) { if (wr == 1) PG8_BAR; }
    }
    PG8_WAIT_V(0);
    if constexpr (!ALIGN_EPI) { if (wr == 0) PG8_BAR; }
    PG8_BAR;
    if constexpr (Epi::AFTER_DRAIN) { E.fused(acc, cur, wr, wc, fr, fq, lds, wid, lane); S.done(cur); }
#undef PG8_SA
#undef PG8_SB
#undef PG8_STAGE
#undef PG8_LDA
#undef PG8_LDB
#undef PG8_MMA
#undef PG8_WAIT_V
#undef PG8_WAIT_L
#undef PG8_BAR
#undef PG8_SCHED
}
}

namespace att {
constexpr int SLOTB = 8192;
constexpr int NSLOT = 4;
constexpr int L_K = 0, L_V = 32768, L_WS = 65536, L_OST = 67584, L_PSUM = L_OST, L_IMP = 133120, L_KB = L_IMP, L_SEL = 141312, L_END = 141568;
constexpr float PFIX = 268435456.0f;
constexpr float THR = 8.0f;

__device__ __forceinline__ int crow(int r, int hh) { return (r & 3) + 8 * (r >> 2) + 4 * hh; }
typedef float f32x2_t __attribute__((ext_vector_type(2))); typedef __bf16 bf16x2_t __attribute__((ext_vector_type(2)));
__device__ __forceinline__ unsigned cvtpk_s(float lo, float hi) { f32x2_t v = {lo, hi}; bf16x2_t b = __builtin_convertvector(v, bf16x2_t); return __builtin_bit_cast(unsigned, b); }
typedef short v4i16_t __attribute__((ext_vector_type(4)));
__device__ __forceinline__ s16x4 vtr(const LAS unsigned char* p) { return __builtin_bit_cast(s16x4, __builtin_amdgcn_ds_read_tr16_b64_v4i16((LAS v4i16_t*)p)); }
__device__ __forceinline__ float swap_sum(float v) { auto rr = __builtin_amdgcn_permlane32_swap(__float_as_uint(v), __float_as_uint(v), false, false); return __uint_as_float(rr[0]) + __uint_as_float(rr[1]); }
__device__ __forceinline__ float swap_max(float v) { auto rr = __builtin_amdgcn_permlane32_swap(__float_as_uint(v), __float_as_uint(v), false, false); return fmaxf(__uint_as_float(rr[0]), __uint_as_float(rr[1])); }
__device__ __forceinline__ bool trailing_half(int wid) { asm volatile("" : "+s"(wid)); return (wid >> 2) != 0; }
#define ATT_BAR() do { __builtin_amdgcn_s_barrier(); asm volatile("" ::: "memory"); } while (0)

__device__ __forceinline__ void dma_tile(const bf16_t* Kb, const bf16_t* Vb, int pitch, int tile, LAS unsigned char* shm, int slot, int wid, int lane) {
    const bf16_t* ks = Kb + (size_t)(tile * 64 + lane) * pitch + wid * 8;
    const bf16_t* vs = Vb + (size_t)(tile * 64 + 16 * (wid & 3) + (lane >> 2)) * pitch + (wid >> 2) * 32 + (lane & 3) * 8;
    __builtin_amdgcn_global_load_lds((const unsigned*)ks, (LAS unsigned*)(shm + L_K + slot * SLOTB + wid * 1024), 16, 0, 0);
    __builtin_amdgcn_global_load_lds((const unsigned*)vs, (LAS unsigned*)(shm + L_V + slot * SLOTB + wid * 1024), 16, 0, 0);
#ifdef PROBE_DMA2
    __builtin_amdgcn_global_load_lds((const unsigned*)ks, (LAS unsigned*)(shm + L_K + slot * SLOTB + wid * 1024), 16, 0, 0);
    __builtin_amdgcn_global_load_lds((const unsigned*)vs, (LAS unsigned*)(shm + L_V + slot * SLOTB + wid * 1024), 16, 0, 0);
#endif
}
#ifdef PROBE_DMA2
#define VMW2 "4"
#define VMW4 "8"
#else
#define VMW2 "2"
#define VMW4 "4"
#endif
__device__ __forceinline__ void qkt(f32x16& p0, f32x16& p1, const LAS unsigned char* shm, int slot, const bf16x8 (&qr)[4], const f32x16& cinit, int r32, int hh) {
    const LAS unsigned char* kb = shm + L_K + slot * SLOTB + hh * 1024 + r32 * 16;
#pragma unroll
    for (int d0 = 0; d0 < 4; ++d0) {
        const bf16x8 b0 = *(const LAS bf16x8*)(kb + d0 * 2048), b1 = *(const LAS bf16x8*)(kb + d0 * 2048 + 512);
        if (d0 == 0) { p0 = __builtin_amdgcn_mfma_f32_32x32x16_bf16(b0, qr[0], cinit, 0, 0, 0); p1 = __builtin_amdgcn_mfma_f32_32x32x16_bf16(b1, qr[0], cinit, 0, 0, 0); }
        else { p0 = __builtin_amdgcn_mfma_f32_32x32x16_bf16(b0, qr[d0], p0, 0, 0, 0); p1 = __builtin_amdgcn_mfma_f32_32x32x16_bf16(b1, qr[d0], p1, 0, 0, 0); }
        if (d0 == 1) asm volatile("" ::: "memory");
    }
}
__device__ __forceinline__ void load_k(bf16x8 (&kf)[8], const LAS unsigned char* shm, int slot, int r32, int hh) {
    const LAS unsigned char* kb = shm + L_K + slot * SLOTB + hh * 1024 + r32 * 16;
#pragma unroll
    for (int d0 = 0; d0 < 4; ++d0) { kf[2 * d0] = *(const LAS bf16x8*)(kb + d0 * 2048); kf[2 * d0 + 1] = *(const LAS bf16x8*)(kb + d0 * 2048 + 512); }
}
__device__ __forceinline__ void mma_qk(f32x16& p0, f32x16& p1, const bf16x8 (&kf)[8], const bf16x8 (&qr)[4], const f32x16& cinit) {
    p0 = __builtin_amdgcn_mfma_f32_32x32x16_bf16(kf[0], qr[0], cinit, 0, 0, 0); p1 = __builtin_amdgcn_mfma_f32_32x32x16_bf16(kf[1], qr[0], cinit, 0, 0, 0);
#pragma unroll
    for (int d0 = 1; d0 < 4; ++d0) { p0 = __builtin_amdgcn_mfma_f32_32x32x16_bf16(kf[2 * d0], qr[d0], p0, 0, 0, 0); p1 = __builtin_amdgcn_mfma_f32_32x32x16_bf16(kf[2 * d0 + 1], qr[d0], p1, 0, 0, 0); }
}
__device__ __forceinline__ void load_v(bf16x8 (&vf)[8], const LAS unsigned char* shm, int slot, int lane, int hh) {
    const LAS unsigned char* vb = shm + L_V + slot * SLOTB + ((lane >> 4) & 1) * 32 + (lane & 3) * 8 + (4 * hh + ((lane & 15) >> 2)) * 64;
#pragma unroll
    for (int ks = 0; ks < 4; ++ks)
#pragma unroll
        for (int d0 = 0; d0 < 2; ++d0) {
            const s16x4 vl = vtr(vb + d0 * 4096 + ks * 1024), vh = vtr(vb + d0 * 4096 + ks * 1024 + 512);
            vf[2 * ks + d0] = (bf16x8){vl[0], vl[1], vl[2], vl[3], vh[0], vh[1], vh[2], vh[3]};
        }
}
__device__ __forceinline__ void mma_pv(f32x16 (&o)[2], const u32x4 (&pw)[4], const bf16x8 (&vf)[8]) {
#pragma unroll
    for (int ks = 0; ks < 4; ++ks)
#pragma unroll
        for (int d0 = 0; d0 < 2; ++d0) o[d0] = __builtin_amdgcn_mfma_f32_32x32x16_bf16(__builtin_bit_cast(bf16x8, pw[ks]), vf[2 * ks + d0], o[d0], 0, 0, 0);
}
__device__ __forceinline__ void pv_seq(f32x16 (&o)[2], const u32x4 (&pw)[4], const LAS unsigned char* shm, int slot, int lane, int hh) {
    const LAS unsigned char* vb = shm + L_V + slot * SLOTB + ((lane >> 4) & 1) * 32 + (lane & 3) * 8 + (4 * hh + ((lane & 15) >> 2)) * 64;
#pragma unroll
    for (int ks = 0; ks < 4; ++ks) {
#pragma unroll
        for (int d0 = 0; d0 < 2; ++d0) {
            const s16x4 vl = vtr(vb + d0 * 4096 + ks * 1024), vh = vtr(vb + d0 * 4096 + ks * 1024 + 512);
            const bf16x8 vf = {vl[0], vl[1], vl[2], vl[3], vh[0], vh[1], vh[2], vh[3]};
            o[d0] = __builtin_amdgcn_mfma_f32_32x32x16_bf16(__builtin_bit_cast(bf16x8, pw[ks]), vf, o[d0], 0, 0, 0);
        }
        if (ks == 1) asm volatile("" ::: "memory");
    }
}
__device__ __forceinline__ void range_mask(f32x16& p0, f32x16& p1, int kb, int lo, int hi) {
#pragma unroll
    for (int r = 0; r < 16; ++r) { const int k = kb + (r & 3) + 8 * (r >> 2); if (k < lo || k > hi) p0[r] = -INFINITY; if (k + 32 < lo || k + 32 > hi) p1[r] = -INFINITY; }
}
__device__ __forceinline__ void mask_hi(f32x16& p0, f32x16& p1, int dh) {
#pragma unroll
    for (int r = 0; r < 16; ++r) { const int c = (r & 3) + 8 * (r >> 2); if (c > dh) p0[r] = -INFINITY; if (c + 32 > dh) p1[r] = -INFINITY; }
}
__device__ __forceinline__ void mask_lo(f32x16& p0, f32x16& p1, int dl) {
#pragma unroll
    for (int r = 0; r < 16; ++r) { const int c = (r & 3) + 8 * (r >> 2); if (c < dl) p0[r] = -INFINITY; if (c + 32 < dl) p1[r] = -INFINITY; }
}
__device__ __forceinline__ void rescale_o(f32x16 (&o)[2], const LAS float* wsf, int hh) {
#pragma unroll
    for (int g = 0; g < 4; ++g) { const f32x4 a4 = *(const LAS f32x4*)(wsf + 8 * g + 4 * hh);
#pragma unroll
        for (int j = 0; j < 4; ++j) { o[0][4 * g + j] *= a4[j]; o[1][4 * g + j] *= a4[j]; } }
}

__device__ __forceinline__ float max3f(float a, float b, float c) { float r; asm("v_max3_f32 %0, %1, %2, %3" : "=v"(r) : "v"(a), "v"(b), "v"(c)); return r; }
#define MM(a, b, c) __builtin_amdgcn_mfma_f32_32x32x16_bf16(a, b, c, 0, 0, 0)
#define SGB(mask, n) __builtin_amdgcn_sched_group_barrier(mask, n, 0)
template <int MODE, bool NOMAX, bool LEAN = false>
__device__ __forceinline__ void sweep(f32x16 (&o)[2], float& mhat, float& l, const bf16x8 (&qr)[4], const bf16_t* Kb, const bf16_t* Vb, int pitch, int t0, int NT, int lo, int hi,
                                      unsigned rowsel, LAS unsigned char* shm, int& ring, int wid, int lane) {
    static_assert(!(MODE == 1 && NOMAX), "the FoX key bias grows without bound: it needs the running max");
    asm volatile("" : "+v"(lane));
    const int r32 = lane & 31, hh = lane >> 5;
    LAS float* wsf = (LAS float*)(shm + L_WS + wid * 256);
    const int lo_max = __builtin_amdgcn_readlane(lo, 31), hi_min = __builtin_amdgcn_readfirstlane(hi);
    const int ring0 = ring;
#define SLOT(i_) ((ring0 + (i_)) & (NSLOT - 1))
    dma_tile(Kb, Vb, pitch, t0, shm, SLOT(0), wid, lane);
    if (NT > 1) dma_tile(Kb, Vb, pitch, t0 + 1, shm, SLOT(1), wid, lane);
    f32x16 a0, a1, b0, b1, cini; u32x4 pw[4]; bf16x8 kf[8], vf[8]; float ls0 = 0.f, ls1 = 0.f; bool resc = false;
#pragma unroll
    for (int r = 0; r < 16; ++r) cini[r] = 0.f;
#define SET_CINI(i_) do { if (MODE == 2) { const float c_ = ((rowsel >> (t0 + (i_))) & 1u) ? 0.f : -INFINITY; _Pragma("unroll") for (int r = 0; r < 16; ++r) cini[r] = c_; } } while (0)
#define POST(C0, C1, i_) do { const int tile_ = t0 + (i_); \
        if (MODE == 1) { const LAS float* kb_ = (const LAS float*)(shm + L_KB) + tile_ * 64 + 4 * hh; \
            _Pragma("unroll") for (int k_ = 0; k_ < 4; ++k_) { const f32x4 x0_ = *(const LAS f32x4*)(kb_ + 8 * k_), x1_ = *(const LAS f32x4*)(kb_ + 32 + 8 * k_); \
                _Pragma("unroll") for (int e_ = 0; e_ < 4; ++e_) { C0[4 * k_ + e_] += x0_[e_]; C1[4 * k_ + e_] += x1_[e_]; } } } \
        if (tile_ * 64 < lo_max || tile_ * 64 + 63 > hi_min) range_mask(C0, C1, tile_ * 64 + 4 * hh, lo, hi); \
        if (!NOMAX) { \
            float ra_ = max3f(C0[0], C0[1], C1[0]), rb_ = max3f(C0[2], C0[3], C1[1]); ra_ = max3f(ra_, C1[2], C1[3]); \
            _Pragma("unroll") for (int r = 4; r < 16; r += 4) { ra_ = max3f(ra_, C0[r], C0[r + 1]); rb_ = max3f(rb_, C0[r + 2], C0[r + 3]); ra_ = max3f(ra_, C1[r], C1[r + 1]); rb_ = max3f(rb_, C1[r + 2], C1[r + 3]); } \
            const float rm_ = swap_max(fmaxf(ra_, rb_)); const bool first_ = ((i_) == 0); \
            if (first_ || __any(rm_ > THR)) { \
                float dl_ = first_ ? rm_ : fmaxf(rm_, 0.f); if (dl_ == -INFINITY) dl_ = 0.f; \
                mhat += dl_; \
                _Pragma("unroll") for (int r = 0; r < 16; ++r) { C0[r] -= dl_; C1[r] -= dl_; cini[r] = -mhat; } \
                if (!first_) { const float al_ = __builtin_amdgcn_exp2f(-dl_); l *= al_; ls0 *= al_; ls1 *= al_; if (hh == 0) wsf[r32] = al_; resc = true; } } } \
    } while (0)
    asm volatile("s_waitcnt lgkmcnt(0)" ::: "memory");
    if (NT > 1) asm volatile("s_waitcnt vmcnt(2)" ::: "memory"); else asm volatile("s_waitcnt vmcnt(0)" ::: "memory");
    ATT_BAR();
    if (NT > 2) dma_tile(Kb, Vb, pitch, t0 + 2, shm, SLOT(2), wid, lane);
    SET_CINI(0);
    load_k(kf, shm, SLOT(0), r32, hh);
    mma_qk(a0, a1, kf, qr, cini);
    POST(a0, a1, 0);
#pragma unroll
    for (int r = 0; r < 16; ++r) { a0[r] = __builtin_amdgcn_exp2f(a0[r]); a1[r] = __builtin_amdgcn_exp2f(a1[r]); }
#define STEP(i_, C0, C1, P0, P1) do { \
        asm volatile("s_waitcnt lgkmcnt(0)" ::: "memory"); \
        if ((i_) + 1 < NT) asm volatile("s_waitcnt vmcnt(2)" ::: "memory"); else asm volatile("s_waitcnt vmcnt(0)" ::: "memory"); \
        ATT_BAR(); \
        if ((i_) + 2 < NT) dma_tile(Kb, Vb, pitch, t0 + (i_) + 2, shm, SLOT((i_) + 2), wid, lane); \
        SET_CINI(i_); \
        load_k(kf, shm, SLOT(i_), r32, hh); \
        __builtin_amdgcn_sched_barrier(0); \
        load_v(vf, shm, SLOT((i_) - 1), lane, hh);               \
          \
        C0 = MM(kf[0], qr[0], cini); C1 = MM(kf[1], qr[0], cini); \
        _Pragma("unroll") for (int d_ = 1; d_ < 4; ++d_) { C0 = MM(kf[2 * d_], qr[d_], C0); C1 = MM(kf[2 * d_ + 1], qr[d_], C1); } \
        _Pragma("unroll") for (int r = 0; r < 16; ++r) { ls0 += P0[r]; ls1 += P1[r]; } \
        _Pragma("unroll") for (int e_ = 0; e_ < 4; ++e_) { pw[0][e_] = cvtpk_s(P0[2 * e_], P0[2 * e_ + 1]); pw[1][e_] = cvtpk_s(P0[8 + 2 * e_], P0[9 + 2 * e_]); pw[2][e_] = cvtpk_s(P1[2 * e_], P1[2 * e_ + 1]); pw[3][e_] = cvtpk_s(P1[8 + 2 * e_], P1[9 + 2 * e_]); } \
        _Pragma("unroll") for (int g_ = 0; g_ < 8; ++g_) { SGB(0x008, 1); SGB(0x100, 2); SGB(0x002, 6); } \
        asm volatile("" : "+v"(ls0), "+v"(ls1), "+v"(pw[0]), "+v"(pw[1]), "+v"(pw[2]), "+v"(pw[3]));     \
        __builtin_amdgcn_sched_barrier(0); \
        POST(C0, C1, i_); \
        __builtin_amdgcn_sched_barrier(0); \
          \
        _Pragma("unroll") for (int ks_ = 0; ks_ < 4; ++ks_) _Pragma("unroll") for (int d_ = 0; d_ < 2; ++d_) o[d_] = MM(__builtin_bit_cast(bf16x8, pw[ks_]), vf[2 * ks_ + d_], o[d_]); \
        _Pragma("unroll") for (int r = 0; r < 16; ++r) { C0[r] = __builtin_amdgcn_exp2f(C0[r]); C1[r] = __builtin_amdgcn_exp2f(C1[r]); } \
        _Pragma("unroll") for (int g_ = 0; g_ < 8; ++g_) { SGB(0x008, 1); SGB(0x400, 4); } \
        __builtin_amdgcn_sched_barrier(0); \
        if (!NOMAX) { if (resc) { rescale_o(o, wsf, hh); resc = false; } } \
    } while (0)
    int i = 1;
    for (; i + 1 < NT; i += 2) { STEP(i, b0, b1, a0, a1); STEP(i + 1, a0, a1, b0, b1); }
    if (i < NT) {
        STEP(i, b0, b1, a0, a1);
#pragma unroll
        for (int r = 0; r < 16; ++r) { a0[r] = b0[r]; a1[r] = b1[r]; }
    }
#pragma unroll
    for (int r = 0; r < 16; ++r) { ls0 += a0[r]; ls1 += a1[r]; }
#pragma unroll
    for (int e = 0; e < 4; ++e) { pw[0][e] = cvtpk_s(a0[2 * e], a0[2 * e + 1]); pw[1][e] = cvtpk_s(a0[8 + 2 * e], a0[9 + 2 * e]); pw[2][e] = cvtpk_s(a1[2 * e], a1[2 * e + 1]); pw[3][e] = cvtpk_s(a1[8 + 2 * e], a1[9 + 2 * e]); }
    load_v(vf, shm, SLOT(NT - 1), lane, hh);
    mma_pv(o, pw, vf);
    l += ls0 + ls1;
    asm volatile("s_waitcnt lgkmcnt(0)" ::: "memory");
    ring = SLOT(NT);
#undef STEP
#undef POST
#undef SET_CINI
#undef SLOT
}
#undef MM
#undef SGB
template <bool FIRST>
__device__ __forceinline__ void merge(const f32x16 (&o)[2], float scale, LAS unsigned char* shm, int wid, int r32, int hh) {
    LAS float* wsf = (LAS float*)(shm + L_WS + wid * 256);
    LAS float* stg = (LAS float*)(shm + L_OST + wid * 8192) + r32;
    if (hh == 0) wsf[r32] = scale;
#pragma unroll
    for (int g = 0; g < 4; ++g) { const f32x4 s4 = *(const LAS f32x4*)(wsf + 8 * g + 4 * hh);
#pragma unroll
        for (int j = 0; j < 4; ++j) { LAS float* p = stg + (8 * g + 4 * hh + j) * 64;
            if (FIRST) { p[0] = o[0][4 * g + j] * s4[j]; p[32] = o[1][4 * g + j] * s4[j]; }
            else { p[0] += o[0][4 * g + j] * s4[j]; p[32] += o[1][4 * g + j] * s4[j]; } } }
}
__device__ __forceinline__ void store_o(bf16_t* Ow, LAS unsigned char* shm, int wid, int lane) {
    const LAS float* stg = (const LAS float*)(shm + L_OST + wid * 8192);
#pragma unroll
    for (int i = 0; i < 4; ++i) { const int rowl = i * 8 + (lane >> 3), ch = lane & 7; const f32x4 a = *(const LAS f32x4*)(stg + rowl * 64 + ch * 8), c = *(const LAS f32x4*)(stg + rowl * 64 + ch * 8 + 4);
        u32x4 v; v.x = cvtpk_s(a[0], a[1]); v.y = cvtpk_s(a[2], a[3]); v.z = cvtpk_s(c[0], c[1]); v.w = cvtpk_s(c[2], c[3]); *(GAS u32x4*)(Ow + (size_t)rowl * D + ch * 8) = v; }
}
__device__ __forceinline__ void zero_o(f32x16 (&o)[2]) { o[0] = (f32x16){0.f, 0.f, 0.f, 0.f, 0.f, 0.f, 0.f, 0.f, 0.f, 0.f, 0.f, 0.f, 0.f, 0.f, 0.f, 0.f}; o[1] = o[0]; }
#define ATT_LOADQ(Qrow_) bf16x8 qr[4]; _Pragma("unroll") for (int d0 = 0; d0 < 4; ++d0) qr[d0] = *(const GAS bf16x8*)((Qrow_) + d0 * 16 + hh * 8)

__device__ __forceinline__ void fox_unit(LAS unsigned char* shm, int b, int h, int qb, unsigned char* ws_, size_t off_p, size_t off_cb, size_t off_o, int wid, int& ring) {
    const int lane = lane_id_volatile();
    unsigned char* ws = ws_; asm volatile("" : "+s"(ws)); const bf16_t* P = (const bf16_t*)(ws + off_p); const float* CB = (const float*)(ws + off_cb); bf16_t* O = (bf16_t*)(ws + off_o);
    const int r32 = lane & 31, hh = lane >> 5;
    const int pos = 256 * qb + 32 * wid + r32;
    const size_t row = (size_t)b * T + pos;
    ATT_LOADQ(P + row * FOX_LDP + h * 64);
    const bf16_t* Kb = (const bf16_t*)(ws + off_p + FOX_HM_OFF) + (size_t)(b * NH + h) * T * 64; const bf16_t* Vb = Kb + FOX_HM_STRIDE;
    f32x16 o[2]; zero_o(o); float m = 0.f, l = 0.f;
    asm volatile("s_waitcnt lgkmcnt(0)" ::: "memory"); ATT_BAR();
    { const float* cb = CB + (size_t)(b * NH + h) * T; LAS float* kbl = (LAS float*)(shm + L_KB);
      for (int i = wid * 64 + lane; i < 64 * (4 * qb + 4); i += 512) kbl[i] = cb[i]; }
    sweep<1, false>(o, m, l, qr, Kb, Vb, 64, 0, 4 * qb + 4, 0, pos, 0u, shm, ring, wid, lane);
    const float lt = swap_sum(l); const float inv = lt > 0.f ? 1.0f / lt : 0.f;
    merge<true>(o, inv, shm, wid, r32, hh);
    store_o(O + ((size_t)b * T + 256 * qb + 32 * wid) * D + h * 64, shm, wid, lane);
}
__device__ __forceinline__ void swa_unit(LAS unsigned char* shm, int b, int g, int qt, unsigned char* ws_, size_t off_p, size_t off_o, const float* sinks, int wid, int& ring) {
    const int lane = lane_id_volatile();
    unsigned char* ws = ws_; asm volatile("" : "+s"(ws)); const bf16_t* P = (const bf16_t*)(ws + off_p); bf16_t* O = (bf16_t*)(ws + off_o);
    const int r32 = lane & 31, hh = lane >> 5;
    const int q0 = 32 * qt, pos = q0 + r32, head = 8 * g + wid;
    const size_t row = (size_t)b * T + pos;
    ATT_LOADQ(P + row * SWA_LDP + head * 64);
    const bf16_t* Kb = (const bf16_t*)(ws + off_p + SWA_HM_OFF) + (size_t)(b * 2 + g) * T * 64; const bf16_t* Vb = Kb + SWA_HM_STRIDE;
    f32x16 o[2]; zero_o(o); float m = 0.f, l = 0.f;
    const int tlo = (q0 - 127) > 0 ? ((q0 - 127) >> 6) : 0, thi = (q0 + 31) >> 6;
    sweep<0, true, true>(o, m, l, qr, Kb, Vb, 64, tlo, thi - tlo + 1, pos - 127, pos, 0u, shm, ring, wid, lane);
    const float lt = swap_sum(l) + __builtin_amdgcn_exp2f(sinks[head] * LOG2E - m);
    const float inv = 1.0f / lt;
    merge<true>(o, inv, shm, wid, r32, hh);
    store_o(O + ((size_t)b * T + q0) * D + head * 64, shm, wid, lane);
}
__device__ __forceinline__ void nsa_unit(LAS unsigned char* shm, int b, int g, int qt, unsigned char* ws_, size_t off_p, size_t off_g, size_t off_kc, size_t off_vc, size_t off_o, int wid, int& ring) {
#define NSA_WS() unsigned char* ws = ws_; asm volatile("" : "+s"(ws)); const bf16_t* P = (const bf16_t*)(ws + off_p); const float* G = (const float*)(ws + off_g); const bf16_t* Hb = (const bf16_t*)(ws + off_p + NSA_HM_OFF) + (size_t)(b * 4 + g) * T * 64; (void)G; (void)Hb
    const int hq = 4 * g + (wid >> 1), ph = wid & 1, q0 = 64 * qt;
    LAS unsigned* PSUM = (LAS unsigned*)(shm + L_PSUM); LAS float* IMP = (LAS float*)(shm + L_IMP); LAS unsigned* SEL = (LAS unsigned*)(shm + L_SEL);
#define NSA_LANE() const int lane = lane_id_volatile(); const int r32 = lane & 31, hh = lane >> 5; const int pos = q0 + 32 * ph + r32; const size_t row = (size_t)b * T + pos; (void)hh; (void)row
#define NSA_QROW (P + row * NSA_LDP + hq * 64)
    asm volatile("s_waitcnt lgkmcnt(0)" ::: "memory"); ATT_BAR();
    { const int tid = wid * 64 + lane_id_volatile(); for (int i = tid; i < 8192; i += 512) PSUM[i] = 0u; }
    f32x16 ocmp[2]; float inv_cmp;
    {
        NSA_LANE(); NSA_WS();
        const bf16_t* Kb = (const bf16_t*)(ws + off_kc) + (size_t)(b * 4 + g) * NCP * 64; const bf16_t* Vb = (const bf16_t*)(ws + off_vc) + (size_t)(b * 4 + g) * NCP * 64;
        const int cm = (pos < 31) ? -1 : (((pos - 31) >> 4) < 126 ? ((pos - 31) >> 4) : 126);
        const int ntile = qt >= 16 ? 2 : 1;
        ATT_LOADQ(NSA_QROW);
        f32x16 o[2]; zero_o(o); float m = 0.f, l = 0.f;
        const int ring0 = ring;
        sweep<0, true>(o, m, l, qr, Kb, Vb, 64, 0, ntile, 0, cm, 0u, shm, ring, wid, lane);
        const float lt = swap_sum(l); const float inv = lt > 0.f ? 1.0f / lt : 0.f;
        f32x16 negm;
#pragma unroll
        for (int r = 0; r < 16; ++r) negm[r] = -m;
        for (int tile = 0; tile < ntile; ++tile) {
            const int sl = (ring0 + tile) & (NSLOT - 1);
            f32x16 p0, p1; qkt(p0, p1, shm, sl, qr, negm, r32, hh);
            range_mask(p0, p1, tile * 64 + 4 * hh, 0, cm);
            LAS unsigned* pb = PSUM + (tile * 64 + 4 * hh) * 64 + 32 * ph + r32;
            asm volatile("" : "+v"(pb));
#pragma unroll
            for (int r = 0; r < 16; ++r) {
                const float a = __builtin_amdgcn_exp2f(p0[r]) * inv, c = __builtin_amdgcn_exp2f(p1[r]) * inv;
                __hip_atomic_fetch_add(pb + ((r & 3) + 8 * (r >> 2)) * 64, (unsigned)(a * PFIX + 0.5f), __ATOMIC_RELAXED, __HIP_MEMORY_SCOPE_WORKGROUP);
                __hip_atomic_fetch_add(pb + ((r & 3) + 8 * (r >> 2) + 32) * 64, (unsigned)(c * PFIX + 0.5f), __ATOMIC_RELAXED, __HIP_MEMORY_SCOPE_WORKGROUP);
            }
        }
        ocmp[0] = o[0]; ocmp[1] = o[1]; inv_cmp = inv;
    }
    asm volatile("s_waitcnt lgkmcnt(0)" ::: "memory"); ATT_BAR();
    {
        const int tid = wid * 64 + lane_id_volatile();
        const int rw = tid & 63, ng = tid >> 6;
        LAS unsigned* pb = PSUM + (16 * ng - 1) * 64 + rw;
        LAS float* ib = IMP + (4 * ng) * 64 + rw;
        asm volatile("" : "+v"(pb), "+v"(ib));
        float pc[17];
#pragma unroll
        for (int e = 0; e < 17; ++e) pc[e] = (float)pb[e * 64] * (1.0f / PFIX);
        if (ng == 0) pc[0] = 0.f;
#pragma unroll
        for (int k = 0; k < 4; ++k) ib[k * 64] = pc[4 * k + 1] + pc[4 * k + 2] + pc[4 * k + 3] + 0.5f * (pc[4 * k + 4] + pc[4 * k]);
        const unsigned init = qt < 16 ? ((2u << qt) - 1u) : (1u | (1u << qt) | (1u << (qt - 1)));
        if (tid < 64) SEL[tid] = init;
    }
    asm volatile("s_waitcnt lgkmcnt(0)" ::: "memory"); ATT_BAR();
    if (qt >= 16) {
        const int tid = wid * 64 + lane_id_volatile();
        const int rw = tid & 63, ng = tid >> 6; unsigned bits = 0u;
        LAS float* ib = IMP + rw; asm volatile("" : "+v"(ib));
        float v[4]; int cnt[4] = {0, 0, 0, 0};
#pragma unroll
        for (int k = 0; k < 4; ++k) v[k] = ib[(4 * ng + k) * 64];
        for (int n2 = 1; n2 <= qt - 2; ++n2) { const float v2 = ib[n2 * 64];
#pragma unroll
            for (int k = 0; k < 4; ++k) cnt[k] += (v2 > v[k] || (v2 == v[k] && n2 < 4 * ng + k)) ? 1 : 0; }
#pragma unroll
        for (int k = 0; k < 4; ++k) { const int n = 4 * ng + k; if (n >= 1 && n <= qt - 2 && cnt[k] < 13) bits |= 1u << n; }
        if (bits) __hip_atomic_fetch_or(SEL + rw, bits, __ATOMIC_RELAXED, __HIP_MEMORY_SCOPE_WORKGROUP);
    }
    asm volatile("s_waitcnt lgkmcnt(0)" ::: "memory"); ATT_BAR();
    { NSA_LANE(); NSA_WS(); merge<true>(ocmp, G[row * 48 + hq * 3 + 0] * inv_cmp, shm, wid, r32, hh); }
    {
        NSA_LANE(); NSA_WS();
        const unsigned rowsel = SEL[32 * ph + r32];
        ATT_LOADQ(NSA_QROW);
        f32x16 o[2]; zero_o(o); float m = 0.f, l = 0.f;
        sweep<2, true>(o, m, l, qr, Hb, Hb + NSA_HM_STRIDE, 64, 0, qt + 1, 0, pos, rowsel, shm, ring, wid, lane);
        const float lt = swap_sum(l); const float inv = lt > 0.f ? 1.0f / lt : 0.f;
        merge<false>(o, G[row * 48 + hq * 3 + 1] * inv, shm, wid, r32, hh);
    }
    {
        NSA_LANE(); NSA_WS();
        ATT_LOADQ(NSA_QROW);
        f32x16 o[2]; zero_o(o); float m = 0.f, l = 0.f;
        const int tlo = qt > 8 ? qt - 8 : 0;
        sweep<0, true>(o, m, l, qr, Hb + 2 * NSA_HM_STRIDE, Hb + 3 * NSA_HM_STRIDE, 64, tlo, qt - tlo + 1, pos - 511, pos, 0u, shm, ring, wid, lane);
        const float lt = swap_sum(l); const float inv = lt > 0.f ? 1.0f / lt : 0.f;
        merge<false>(o, G[row * 48 + hq * 3 + 2] * inv, shm, wid, r32, hh);
    }
    { unsigned char* ws = ws_; asm volatile("" : "+s"(ws)); store_o((bf16_t*)(ws + off_o) + ((size_t)b * T + q0 + 32 * ph) * D + hq * 64, shm, wid, lane_id_volatile()); }
#undef NSA_WS
#undef NSA_LANE
#undef NSA_QROW
}
#undef ATT_LOADQ
#undef ATT_BAR
}

constexpr size_t MiB = 1u << 20;
constexpr size_t WS_CTL = 0, CTL_ZERO_BYTES = 1 * MiB;
constexpr size_t WS_WUP = 1 * MiB, WS_WDN = 33 * MiB;
constexpr size_t WS_WNSA = 65 * MiB, WNSA_STRIDE = (size_t)NSA_NP * D * 2;
constexpr size_t WS_WOUT = 76 * MiB;
constexpr size_t WS_WFOX = 84 * MiB;
constexpr size_t WS_WSWA = 84 * MiB + 6656 * 1024;
constexpr size_t WS_WCMP = 93 * MiB;
constexpr size_t WS_ROPEC = 97 * MiB, WS_ROPES = WS_ROPEC + 256 * 1024;
constexpr size_t WS_CMPB = WS_ROPES + 256 * 1024;
constexpr size_t WS_SWAB = WS_CMPB + 64 * 1024;
constexpr size_t WS_WGATE = 99 * MiB;
constexpr size_t WS_RSTD = 98 * MiB;
constexpr size_t WS_XN = 100 * MiB;
constexpr size_t WS_BIG = 164 * MiB;
constexpr size_t WS_O = WS_BIG + 192 * MiB;
constexpr size_t WS_G = 420 * MiB, WS_LF = 426 * MiB, WS_CB = 428 * MiB, WS_KC = 430 * MiB, WS_VC = 431 * MiB, WS_HID = 432 * MiB, WS_M2 = 440 * MiB, WS_END = 504 * MiB;
static_assert(WS_WSWA + (size_t)SWA_NP * D * 2 <= WS_WCMP && WS_WFOX + (size_t)FOX_NP * D * 2 <= WS_WSWA && WS_WNSA + 2 * WNSA_STRIDE <= WS_WOUT && WS_SWAB + 8192 <= WS_XN, "d_ws map");
static_assert((size_t)M * FF * 2 == 256 * MiB && WS_O + (size_t)M * D * 2 == WS_G && (size_t)M * 3072 * 2 == 192 * MiB, "d_ws map");
constexpr int CW_TMO = 0, CW_BAR = 4096;

constexpr int RING_OFF = 0, RING_BYTES = 142336;
constexpr int LDSCTL_OFF = RING_BYTES, MISC_OFF = LDSCTL_OFF + 320;
constexpr int LDS_BYTES = 147456;
static_assert(att::L_END <= RING_BYTES && MISC_OFF + 128 <= LDS_BYTES, "LDS map");
constexpr int NWAVES = 8;
#ifndef L_LO
#define L_LO 0
#endif
#ifndef L_HI
#define L_HI DEPTH
#endif

typedef GAS unsigned gu32;
typedef GAS unsigned long long gu64;
#define RLX_AGENT __ATOMIC_RELAXED, __HIP_MEMORY_SCOPE_AGENT
#define LDS_WAIT() asm volatile("s_waitcnt lgkmcnt(0)" ::: "memory")
#define VM_WAIT() asm volatile("s_waitcnt vmcnt(0)" ::: "memory")
__device__ __forceinline__ unsigned long long rt() { return __builtin_amdgcn_s_memrealtime(); }
__device__ __forceinline__ unsigned f2bf(float f) { unsigned u = __builtin_bit_cast(unsigned, f); return (u + 0x7fffu + ((u >> 16) & 1u)) >> 16; }
__device__ __forceinline__ unsigned pk2(float lo, float hi) { return f2bf(lo) | (f2bf(hi) << 16); }

#define XB_TMO      128
#define XB_XCNT(j)  (256  + 64 * (j))
#define XB_XSUB(j)  (1280 + 64 * (j))
#define XB_XGEN(j)  (2304 + 64 * (j))
#define XB_TOP      3328
#define XB_TOPGEN   3392
#define XCD_BAR_WORDS 3456
#define XB_SPIN_CAP (1u << 18)

__device__ __forceinline__ unsigned xb_ld(unsigned* p)              { return __hip_atomic_load(p, __ATOMIC_RELAXED, __HIP_MEMORY_SCOPE_AGENT); }
__device__ __forceinline__ unsigned xb_add(unsigned* p, unsigned v) { return __hip_atomic_fetch_add(p, v, __ATOMIC_RELAXED, __HIP_MEMORY_SCOPE_AGENT); }
__device__ __forceinline__ unsigned xb_xcc_id() { return (unsigned)__builtin_amdgcn_s_getreg((3 << 11) | 20) & 0xFu; }
#define XB_SPIN(cond, bar) do { unsigned _sp = 0; while (cond) { __builtin_amdgcn_s_sleep(1); \
    if ((++_sp & 255u) == 0u) { if (xb_ld(&(bar)[XB_TMO])) break; if (_sp > XB_SPIN_CAP) { atomicAdd(&(bar)[XB_TMO], 1u); break; } } } } while (0)

struct XcdBarrier {
    unsigned* bar; unsigned x;
    volatile LAS unsigned* st;
};

__device__ __forceinline__ XcdBarrier xcd_barrier_post(unsigned* bar, volatile LAS unsigned* st) {
    XcdBarrier b; b.bar = bar; b.x = xb_xcc_id(); b.st = st;
    if (threadIdx.x == 0) (void)xb_add(&bar[XB_XCNT(b.x)], 1u);
    return b;
}
__device__ __forceinline__ void xcd_barrier_complete(unsigned* bar, unsigned x, unsigned& nloc, unsigned& nx) {
    const unsigned G = gridDim.x * gridDim.y * gridDim.z;
    unsigned sum, cnt, mine, sp = 0u;
    for (;;) {
        sum = 0u; cnt = 0u; mine = 0u;
#pragma unroll
        for (unsigned j = 0; j < 16; ++j) { const unsigned c = xb_ld(&bar[XB_XCNT(j)]); sum += c; cnt += (c > 0u) ? 1u : 0u; mine = (j == x) ? c : mine; }
        if (sum == G) break;
        __builtin_amdgcn_s_sleep(1);
        if ((++sp & 255u) == 0u) { if (xb_ld(&bar[XB_TMO])) break; if (sp > XB_SPIN_CAP) { atomicAdd(&bar[XB_TMO], 1u); break; } }
    }
    nloc = mine > 0u ? mine : 1u; nx = cnt > 0u ? cnt : 1u;
}

__device__ __forceinline__ void xcd_barrier(const XcdBarrier& b) {
    asm volatile("s_waitcnt vmcnt(0)" ::: "memory");
    __syncthreads();
    if (threadIdx.x == 0) {
        unsigned* bar = b.bar;
        __builtin_amdgcn_s_waitcnt(0);
        unsigned nloc = b.st[0], nx = b.st[1];
        if (nloc == 0u) { xcd_barrier_complete(bar, b.x, nloc, nx); b.st[0] = nloc; b.st[1] = nx; }
        const unsigned old = xb_add(&bar[XB_XSUB(b.x)], 1u);
        const unsigned gen = old / nloc;
        if (old + 1u == (gen + 1u) * nloc) {
            __builtin_amdgcn_fence(__ATOMIC_RELEASE, "agent");
            asm volatile("s_waitcnt vmcnt(0)" ::: "memory");
            const unsigned og = xb_add(&bar[XB_TOP], 1u);
            const unsigned tg = og / nx;
            if (og + 1u == (tg + 1u) * nx) xb_add(&bar[XB_TOPGEN], 1u);
            else XB_SPIN(xb_ld(&bar[XB_TOPGEN]) == tg, bar);
            __builtin_amdgcn_fence(__ATOMIC_ACQUIRE, "agent");
            xb_add(&bar[XB_XGEN(b.x)], 1u);
            asm volatile("s_waitcnt vmcnt(0)" ::: "memory");
        } else {
            XB_SPIN(xb_ld(&bar[XB_XGEN(b.x)]) == gen, bar);
            __builtin_amdgcn_fence(__ATOMIC_ACQUIRE, "agent");
            asm volatile("s_waitcnt vmcnt(0)" ::: "memory");
        }
    }
    __syncthreads();
}

__device__ __forceinline__ float wave_sum(float v) {
    v += __builtin_bit_cast(float, __builtin_amdgcn_update_dpp(0, __builtin_bit_cast(int, v), 0xB1, 0xF, 0xF, true));
    v += __builtin_bit_cast(float, __builtin_amdgcn_update_dpp(0, __builtin_bit_cast(int, v), 0x4E, 0xF, 0xF, true));
    v += __builtin_bit_cast(float, __builtin_amdgcn_update_dpp(0, __builtin_bit_cast(int, v), 0x141, 0xF, 0xF, true));
    v += __builtin_bit_cast(float, __builtin_amdgcn_update_dpp(0, __builtin_bit_cast(int, v), 0x140, 0xF, 0xF, true));
    v += __builtin_bit_cast(float, __builtin_amdgcn_ds_swizzle(__builtin_bit_cast(int, v), 0x401F));
    { auto rr = __builtin_amdgcn_permlane32_swap(__float_as_uint(v), __float_as_uint(v), false, false); v = __uint_as_float(rr[0]) + __uint_as_float(rr[1]); }
    return v;
}

__device__ __forceinline__ int il64(int c) { return (c >> 1) + 32 * (c & 1); }
__device__ __forceinline__ int li64(int d) { return 2 * (d & 31) + (d >> 5); }
__device__ __forceinline__ int src_n(int mode, int n) { return (mode == 3 && n < 1152) ? (n & ~63) + il64(n & 63) : n; }
__device__ __forceinline__ int dst_n(int mode, int n) {
    if (mode == 1) { const int reg = n >> 8; const bool rope = reg < 4 || reg == 4 || reg == 6 || reg == 8; return rope ? (n & ~63) + li64(n & 63) : n; }
    if (mode == 3) return n < 1152 ? (n & ~63) + li64(n & 63) : n;
    return n;
}
__device__ __forceinline__ void conv_item(const float* W, int K, int N, bf16_t* WT, int mode, int item, LAS float* scr, int lane, int ld = 0) {
    if (ld == 0) ld = N;
    const int nblk = (N + 31) / 32, kb = item / nblk, nb = item % nblk, k0 = 64 * kb, n0 = 32 * nb;
    const int c4 = (lane & 7) * 4; const bool cin = (n0 + c4) < N;
#pragma unroll
    for (int i = 0; i < 8; ++i) { const int kk = (lane >> 3) + 8 * i; const int kd = (mode == 4) ? li64(kk) : kk;
        const f32x4 v = cin ? *(const GAS f32x4*)(W + (size_t)(k0 + kk) * ld + n0 + c4) : (f32x4){0.f, 0.f, 0.f, 0.f};
        scr[kd * 33 + c4] = v[0]; scr[kd * 33 + c4 + 1] = v[1]; scr[kd * 33 + c4 + 2] = v[2]; scr[kd * 33 + c4 + 3] = v[3]; }
    LDS_WAIT(); asm volatile("" ::: "memory");
    const int c = lane & 7;
#pragma unroll
    for (int j = 0; j < 4; ++j) { const int n = (lane >> 3) + 8 * j; const LAS float* s = scr + (8 * c) * 33 + n;
        u32x4 o; o.x = pk2(s[0 * 33], s[1 * 33]); o.y = pk2(s[2 * 33], s[3 * 33]); o.z = pk2(s[4 * 33], s[5 * 33]); o.w = pk2(s[6 * 33], s[7 * 33]);
        if (n0 + n < N) *(GAS u32x4*)(WT + (size_t)dst_n(mode, n0 + n) * K + k0 + 8 * c) = o; }
    LDS_WAIT(); asm volatile("" ::: "memory");
}
__device__ __forceinline__ void norm_row(const float* xrow, const float* g, bf16_t* orow, float* rstd_out, int lane) {
    f32x4 v[4]; float s = 0.f;
#pragma unroll
    for (int j = 0; j < 4; ++j) { v[j] = ((const GAS f32x4*)xrow)[lane + 64 * j]; s += (v[j][0] * v[j][0] + v[j][1] * v[j][1]) + (v[j][2] * v[j][2] + v[j][3] * v[j][3]); }
    const float rstd = 1.0f / sqrtf(wave_sum(s) * (1.0f / D) + NORM_EPS);
#pragma unroll
    for (int j = 0; j < 4; ++j) { const f32x4 gg = ((const GAS f32x4*)g)[lane + 64 * j]; u32x2 w; w.x = pk2(v[j][0] * rstd * gg[0], v[j][1] * rstd * gg[1]); w.y = pk2(v[j][2] * rstd * gg[2], v[j][3] * rstd * gg[3]);
        ((GAS u32x2*)orow)[lane + 64 * j] = w; }
    if (lane == 0) *rstd_out = rstd;
}
__device__ __forceinline__ void unpack4(u32x2 w, f32x4& o) { o[0] = __uint_as_float(w.x << 16); o[1] = __uint_as_float(w.x & 0xffff0000u); o[2] = __uint_as_float(w.y << 16); o[3] = __uint_as_float(w.y & 0xffff0000u); }
struct RowIn { f32x4 xv[4]; u32x2 mw[4]; float inv_rstd; };
__device__ __forceinline__ void resnorm_load(RowIn& R, const float* xin_f32, const bf16_t* xn, const float* rstd_io, const bf16_t* mrow, int lane) {
    if (xin_f32) {
#pragma unroll
        for (int j = 0; j < 4; ++j) R.xv[j] = ((const GAS f32x4*)xin_f32)[lane + 64 * j];
        R.inv_rstd = 1.f;
    } else {
#pragma unroll
        for (int j = 0; j < 4; ++j) { const u32x2 w = ((const GAS u32x2*)xn)[lane + 64 * j]; R.xv[j][0] = __uint_as_float(w.x); R.xv[j][1] = __uint_as_float(w.y); }
        R.inv_rstd = 1.0f / *(const GAS float*)rstd_io;
    }
#pragma unroll
    for (int j = 0; j < 4; ++j) R.mw[j] = ((const GAS u32x2*)mrow)[lane + 64 * j];
}
__device__ __forceinline__ void resnorm_finish(RowIn& R, bool from_f32, bf16_t* xn, float* rstd_io, const float* gcur, const float* gpost, const float* gnext, float* xout_f32, int lane) {
    f32x4 xv[4], mv[4]; float s = 0.f;
    if (from_f32) {
#pragma unroll
        for (int j = 0; j < 4; ++j) xv[j] = R.xv[j];
    } else {
#pragma unroll
        for (int j = 0; j < 4; ++j) { u32x2 w; w.x = __float_as_uint(R.xv[j][0]); w.y = __float_as_uint(R.xv[j][1]); unpack4(w, xv[j]); const f32x4 gg = ((const GAS f32x4*)gcur)[lane + 64 * j];
#pragma unroll
            for (int e = 0; e < 4; ++e) xv[j][e] = xv[j][e] * R.inv_rstd / gg[e]; }
    }
#pragma unroll
    for (int j = 0; j < 4; ++j) { unpack4(R.mw[j], mv[j]); s += (mv[j][0] * mv[j][0] + mv[j][1] * mv[j][1]) + (mv[j][2] * mv[j][2] + mv[j][3] * mv[j][3]); }
    const float rstd = 1.0f / sqrtf(wave_sum(s) * (1.0f / D) + NORM_EPS);
    float s2 = 0.f;
#pragma unroll
    for (int j = 0; j < 4; ++j) { const f32x4 gg = ((const GAS f32x4*)gpost)[lane + 64 * j];
#pragma unroll
        for (int e = 0; e < 4; ++e) { xv[j][e] += mv[j][e] * rstd * gg[e]; s2 += xv[j][e] * xv[j][e]; } }
    if (gnext) {
        const float rstd2 = 1.0f / sqrtf(wave_sum(s2) * (1.0f / D) + NORM_EPS);
#pragma unroll
        for (int j = 0; j < 4; ++j) { const f32x4 gg = ((const GAS f32x4*)gnext)[lane + 64 * j]; u32x2 w; w.x = pk2(xv[j][0] * rstd2 * gg[0], xv[j][1] * rstd2 * gg[1]); w.y = pk2(xv[j][2] * rstd2 * gg[2], xv[j][3] * rstd2 * gg[3]);
            ((GAS u32x2*)xn)[lane + 64 * j] = w; }
        if (lane == 0) *rstd_io = rstd2;
    } else {
#pragma unroll
        for (int j = 0; j < 4; ++j) ((GAS f32x4*)xout_f32)[lane + 64 * j] = xv[j];
    }
}
__device__ __forceinline__ void resnorm_rows2(int m0, int m1, const float* xin_f32, bf16_t* XN, float* RSTD, const float* gcur, const bf16_t* MB, const float* gpost, const float* gnext, float* xout_f32, int lane) {
    RowIn A, B;
    resnorm_load(A, xin_f32 ? xin_f32 + (size_t)m0 * D : nullptr, XN + (size_t)m0 * D, RSTD + m0, MB + (size_t)m0 * D, lane);
    resnorm_load(B, xin_f32 ? xin_f32 + (size_t)m1 * D : nullptr, XN + (size_t)m1 * D, RSTD + m1, MB + (size_t)m1 * D, lane);
    resnorm_finish(A, xin_f32 != nullptr, XN + (size_t)m0 * D, RSTD + m0, gcur, gpost, gnext, xout_f32 ? xout_f32 + (size_t)m0 * D : nullptr, lane);
    resnorm_finish(B, xin_f32 != nullptr, XN + (size_t)m1 * D, RSTD + m1, gcur, gpost, gnext, xout_f32 ? xout_f32 + (size_t)m1 * D : nullptr, lane);
}

struct Args { const float* in[17]; float* out; unsigned char* ws; };
constexpr int PT_OFF = LDSCTL_OFF;
__device__ __forceinline__ unsigned char* ldptr(LAS unsigned char* lds, int idx) {
    const volatile LAS unsigned* p = (const volatile LAS unsigned*)(lds + PT_OFF + idx * 8);
    const unsigned lo = (unsigned)__builtin_amdgcn_readfirstlane((int)p[0]), hi = (unsigned)__builtin_amdgcn_readfirstlane((int)p[1]);
    return (unsigned char*)(((unsigned long long)hi << 32) | lo);
}
#define INP(i) ((const float*)ldptr(lds, (i)))
#define OUTP ((float*)ldptr(lds, 17))
#define WSP (ldptr(lds, 18))
#define IDS int tid_ = wave_s * 64 + lane_id_volatile(); const int tid = tid_, lane = tid & 63, wave = wave_s; const int G = gridDim.x, bx = blockIdx.x; \
    const int vcu = (G % 8 == 0) ? (bx % 8) * (G / 8) + bx / 8 : bx; const int gw = vcu * NWAVES + wave, NGW = G * NWAVES; (void)lane; (void)gw; (void)NGW; (void)vcu; (void)bx; (void)tid; (void)wave
template <int MODE, int AMODE>
__device__ __forceinline__ void run_gemm(LAS unsigned char* lds, const bf16_t* A, const bf16_t* Bt, int Mr, int N, int K, const pg8::Epi<MODE>& E, int wave_s, int ord_g = 0, int ord_c = 0) {
    pg8::Gemm g{A, Bt, Mr, N, K}; pg8::StaticOrder S; if (ord_g) S.init(Mr, N, ord_g, ord_c); else S.init(Mr, N, (int)gridDim.x, (int)blockIdx.x);
#ifndef NO_GEMM
#ifdef ONLY_MODE
    if (MODE == ONLY_MODE)
#endif
    pg8::gemm_phase<pg8::Epi<MODE>, pg8::StaticOrder, AMODE, true, true>(lds, g, S, E, wave_s);
#endif
}

#ifndef REP_GIN
#define REP_GIN 1
#endif
#ifndef REP_CMP
#define REP_CMP 1
#endif
#ifndef REP_SCAN
#define REP_SCAN 1
#endif
#ifndef REP_ATT_NSA
#define REP_ATT_NSA 1
#endif
#ifndef REP_ATT_FOX
#define REP_ATT_FOX 1
#endif
#ifndef REP_ATT_SWA
#define REP_ATT_SWA 1
#endif
#ifndef REP_GOUT
#define REP_GOUT 1
#endif
#ifndef REP_MLP
#define REP_MLP 1
#endif
#ifndef REP_PRO
#define REP_PRO 1
#endif
template <int L>
__device__ __forceinline__ void layer_body(LAS unsigned char* lds, const XcdBarrier& bar, int& aslot, const int wave_s) {
#define GRID_BAR() xcd_barrier(bar)
    constexpr int kind = L % 3, sl = L / 3;
    if (kind == 0) {
        { unsigned char* ws = WSP;
          pg8::Epi<pg8::EM_NSA> E{(bf16_t*)(ws + WS_BIG), NSA_LDP, nullptr, (const float*)(ws + WS_ROPEC), (const float*)(ws + WS_ROPES), (float*)(ws + WS_G), nullptr, (bf16_t*)(ws + WS_BIG + NSA_HM_OFF), NSA_HM_STRIDE};
          run_gemm<pg8::EM_NSA, 0>(lds + RING_OFF, (const bf16_t*)(ws + WS_XN), (const bf16_t*)(ws + WS_WNSA) + (size_t)sl * NSA_NP * D, M, NSA_NP, D, E, wave_s); }
        GRID_BAR();
#if REP_GIN >= 2
        { unsigned char* ws = WSP;
          pg8::Epi<pg8::EM_NSA> E{(bf16_t*)(ws + WS_BIG), NSA_LDP, nullptr, (const float*)(ws + WS_ROPEC), (const float*)(ws + WS_ROPES), (float*)(ws + WS_G), nullptr, (bf16_t*)(ws + WS_BIG + NSA_HM_OFF), NSA_HM_STRIDE};
          run_gemm<pg8::EM_NSA, 0>(lds + RING_OFF, (const bf16_t*)(ws + WS_XN), (const bf16_t*)(ws + WS_WNSA) + (size_t)sl * NSA_NP * D, M, NSA_NP, D, E, wave_s); }
        GRID_BAR();
#endif
        if ((int)blockIdx.x < 64) { unsigned char* ws = WSP;
          pg8::Epi<pg8::EM_CMP> E{(bf16_t*)(ws + WS_HID), 256, (const float*)(ws + WS_CMPB) + sl * 512, nullptr, nullptr, nullptr, nullptr, nullptr, 0};
          run_gemm<pg8::EM_CMP, 1>(lds + RING_OFF, (const bf16_t*)(ws + WS_BIG) + 1024, (const bf16_t*)(ws + WS_WCMP) + (size_t)sl * 2 * 256 * 2048, CMP_ROWS, 512, 2048, E, wave_s); }
        else { unsigned char* ws = WSP;
          pg8::Epi<pg8::EM_GATE> E{nullptr, 0, nullptr, nullptr, nullptr, (float*)(ws + WS_G), nullptr, nullptr, 0};
          run_gemm<pg8::EM_GATE, 0>(lds + RING_OFF, (const bf16_t*)(ws + WS_XN), (const bf16_t*)(ws + WS_WGATE) + (size_t)sl * 256 * D, M, 256, D, E, wave_s, 192, (int)blockIdx.x - 64); }
        GRID_BAR();
#if REP_CMP >= 2
        if ((int)blockIdx.x < 64) { unsigned char* ws = WSP;
          pg8::Epi<pg8::EM_CMP> E{(bf16_t*)(ws + WS_HID), 256, (const float*)(ws + WS_CMPB) + sl * 512, nullptr, nullptr, nullptr, nullptr, nullptr, 0};
          run_gemm<pg8::EM_CMP, 1>(lds + RING_OFF, (const bf16_t*)(ws + WS_BIG) + 1024, (const bf16_t*)(ws + WS_WCMP) + (size_t)sl * 2 * 256 * 2048, CMP_ROWS, 512, 2048, E, wave_s); }
        else { unsigned char* ws = WSP;
          pg8::Epi<pg8::EM_GATE> E{nullptr, 0, nullptr, nullptr, nullptr, (float*)(ws + WS_G), nullptr, nullptr, 0};
          run_gemm<pg8::EM_GATE, 0>(lds + RING_OFF, (const bf16_t*)(ws + WS_XN), (const bf16_t*)(ws + WS_WGATE) + (size_t)sl * 256 * D, M, 256, D, E, wave_s, 192, (int)blockIdx.x - 64); }
        GRID_BAR();
#endif
        { IDS; unsigned char* ws = WSP; const bf16_t* HID = (const bf16_t*)(ws + WS_HID); const float* nsa_w2 = INP(7);
          const int which = bx >> 7, wl = bx & 127;
          LAS float* w2s = (LAS float*)(lds + RING_OFF);
          { const GAS f32x4* w2g = (const GAS f32x4*)(nsa_w2 + (size_t)(sl * 2 + which) * 256 * 64); for (int i = tid; i < 4096; i += 512) ((LAS f32x4*)w2s)[i] = w2g[i]; }
          __syncthreads();
          const int r0 = (wl * 8 + wave) * 8;
          float f[8][4], acc[8];
#pragma unroll
          for (int q = 0; q < 8; ++q) { const u32x2 hw = *(const GAS u32x2*)(HID + ((size_t)which * CMP_ROWS + r0 + q) * 256 + 4 * lane);
              f[q][0] = __uint_as_float(hw.x << 16); f[q][1] = __uint_as_float(hw.x & 0xffff0000u); f[q][2] = __uint_as_float(hw.y << 16); f[q][3] = __uint_as_float(hw.y & 0xffff0000u); acc[q] = 0.f; }
          const LAS float* wcol = w2s + (which ? lane : il64(lane));
          for (int jj = 0; jj < 64; ++jj) {
#pragma unroll
              for (int s = 0; s < 4; ++s) { const float w = wcol[(4 * jj + s) * 64];
#pragma unroll
                  for (int q = 0; q < 8; ++q) acc[q] += __builtin_bit_cast(float, __builtin_amdgcn_readlane(__builtin_bit_cast(int, f[q][s]), jj)) * w; }
          }
          bf16_t* dstb = (bf16_t*)(ws + (which ? WS_VC : WS_KC));
#pragma unroll
          for (int q = 0; q < 8; ++q) { const int r = r0 + q, gg = r & 3, c = (r >> 2) & 127, b = r >> 9;
              dstb[(size_t)((b * 4 + gg) * NCP + c) * 64 + lane] = (bf16_t)f2bf(c == NC ? 0.f : acc[q]); }
          __syncthreads();
        }
        GRID_BAR();
#if REP_CMP >= 2
        { IDS; unsigned char* ws = WSP; const bf16_t* HID = (const bf16_t*)(ws + WS_HID); const float* nsa_w2 = INP(7);
          const int which = bx >> 7, wl = bx & 127;
          LAS float* w2s = (LAS float*)(lds + RING_OFF);
          { const GAS f32x4* w2g = (const GAS f32x4*)(nsa_w2 + (size_t)(sl * 2 + which) * 256 * 64); for (int i = tid; i < 4096; i += 512) ((LAS f32x4*)w2s)[i] = w2g[i]; }
          __syncthreads();
          const int r0 = (wl * 8 + wave) * 8;
          float f[8][4], acc[8];
#pragma unroll
          for (int q = 0; q < 8; ++q) { const u32x2 hw = *(const GAS u32x2*)(HID + ((size_t)which * CMP_ROWS + r0 + q) * 256 + 4 * lane);
              f[q][0] = __uint_as_float(hw.x << 16); f[q][1] = __uint_as_float(hw.x & 0xffff0000u); f[q][2] = __uint_as_float(hw.y << 16); f[q][3] = __uint_as_float(hw.y & 0xffff0000u); acc[q] = 0.f; }
          const LAS float* wcol = w2s + (which ? lane : il64(lane));
          for (int jj = 0; jj < 64; ++jj) {
#pragma unroll
              for (int s = 0; s < 4; ++s) { const float w = wcol[(4 * jj + s) * 64];
#pragma unroll
                  for (int q = 0; q < 8; ++q) acc[q] += __builtin_bit_cast(float, __builtin_amdgcn_readlane(__builtin_bit_cast(int, f[q][s]), jj)) * w; }
          }
          bf16_t* dstb = (bf16_t*)(ws + (which ? WS_VC : WS_KC));
#pragma unroll
          for (int q = 0; q < 8; ++q) { const int r = r0 + q, gg = r & 3, c = (r >> 2) & 127, b = r >> 9;
              dstb[(size_t)((b * 4 + gg) * NCP + c) * 64 + lane] = (bf16_t)f2bf(c == NC ? 0.f : acc[q]); }
          __syncthreads();
        }
        GRID_BAR();
#endif
        { IDS; unsigned char* ws = WSP;
          const int bg = vcu >> 2, sub = vcu & 3, b = bg >> 2, g = bg & 3;
          for (int i = 0; i < 8; ++i) { const int qt = (i & 1) ? (8 * (i >> 1) + 7 - sub) : (8 * (i >> 1) + sub);
#ifndef NO_NSA
              att::nsa_unit(lds + RING_OFF, b, g, qt, ws, WS_BIG, WS_G, WS_KC, WS_VC, WS_O, wave, aslot);
#endif
          } }
#if REP_ATT_NSA >= 2
        GRID_BAR();
        { IDS; unsigned char* ws = WSP;
          const int bg = vcu >> 2, sub = vcu & 3, b = bg >> 2, g = bg & 3;
          for (int i = 0; i < 8; ++i) { const int qt = (i & 1) ? (8 * (i >> 1) + 7 - sub) : (8 * (i >> 1) + sub);
#ifndef NO_NSA
              att::nsa_unit(lds + RING_OFF, b, g, qt, ws, WS_BIG, WS_G, WS_KC, WS_VC, WS_O, wave, aslot);
#endif
          } }
#endif
    } else if (kind == 1) {
        { unsigned char* ws = WSP;
          pg8::Epi<pg8::EM_FOX> E{(bf16_t*)(ws + WS_BIG), FOX_LDP, nullptr, nullptr, nullptr, (float*)(ws + WS_LF), INP(10), (bf16_t*)(ws + WS_BIG + FOX_HM_OFF), FOX_HM_STRIDE};
          run_gemm<pg8::EM_FOX, 0>(lds + RING_OFF, (const bf16_t*)(ws + WS_XN), (const bf16_t*)(ws + WS_WFOX), M, FOX_NP, D, E, wave_s); }
        GRID_BAR();
#if REP_GIN >= 2
        { unsigned char* ws = WSP;
          pg8::Epi<pg8::EM_FOX> E{(bf16_t*)(ws + WS_BIG), FOX_LDP, nullptr, nullptr, nullptr, (float*)(ws + WS_LF), INP(10), (bf16_t*)(ws + WS_BIG + FOX_HM_OFF), FOX_HM_STRIDE};
          run_gemm<pg8::EM_FOX, 0>(lds + RING_OFF, (const bf16_t*)(ws + WS_XN), (const bf16_t*)(ws + WS_WFOX), M, FOX_NP, D, E, wave_s); }
        GRID_BAR();
#endif
        { IDS; unsigned char* ws = WSP; const float* LF = (const float*)(ws + WS_LF); float* CB = (float*)(ws + WS_CB);
          if (wave == 0) for (int bh = bx; bh < BATCH * NH; bh += G) {
            const int b = bh >> 4, h = bh & 15; float v[32]; float run = 0.f;
#pragma unroll
            for (int i = 0; i < 32; ++i) { run += LF[((size_t)b * T + 32 * lane + i) * 16 + h]; v[i] = run; }
            float excl = 0.f;
            for (int k = 0; k < 63; ++k) { const float t = __builtin_bit_cast(float, __builtin_amdgcn_readlane(__builtin_bit_cast(int, run), k)); if (lane > k) excl += t; }
#pragma unroll
            for (int i = 0; i < 32; ++i) CB[(size_t)bh * T + 32 * lane + i] = -(v[i] + excl) * LOG2E;
          } }
        GRID_BAR();
#if REP_SCAN >= 2
        { IDS; unsigned char* ws = WSP; const float* LF = (const float*)(ws + WS_LF); float* CB = (float*)(ws + WS_CB);
          if (wave == 0) for (int bh = bx; bh < BATCH * NH; bh += G) {
            const int b = bh >> 4, h = bh & 15; float v[32]; float run = 0.f;
#pragma unroll
            for (int i = 0; i < 32; ++i) { run += LF[((size_t)b * T + 32 * lane + i) * 16 + h]; v[i] = run; }
            float excl = 0.f;
            for (int k = 0; k < 63; ++k) { const float t = __builtin_bit_cast(float, __builtin_amdgcn_readlane(__builtin_bit_cast(int, run), k)); if (lane > k) excl += t; }
#pragma unroll
            for (int i = 0; i < 32; ++i) CB[(size_t)bh * T + 32 * lane + i] = -(v[i] + excl) * LOG2E;
          } }
        GRID_BAR();
#endif
        { IDS; unsigned char* ws = WSP;
          const int xcd = vcu >> 5, c = vcu & 31, sub = c & 3;
          for (int i = 0; i < 8; ++i) { const int bh = 32 * xcd + 8 * (i >> 1) + (c >> 2); const int qb = (i & 1) ? sub : 7 - sub;
#ifndef NO_FOX
              att::fox_unit(lds + RING_OFF, bh >> 4, bh & 15, qb, ws, WS_BIG, WS_CB, WS_O, wave, aslot);
#endif
          } }
#if REP_ATT_FOX >= 2
        GRID_BAR();
        { IDS; unsigned char* ws = WSP;
          const int xcd = vcu >> 5, c = vcu & 31, sub = c & 3;
          for (int i = 0; i < 8; ++i) { const int bh = 32 * xcd + 8 * (i >> 1) + (c >> 2); const int qb = (i & 1) ? sub : 7 - sub;
#ifndef NO_FOX
              att::fox_unit(lds + RING_OFF, bh >> 4, bh & 15, qb, ws, WS_BIG, WS_CB, WS_O, wave, aslot);
#endif
          } }
#endif
    } else {
        { unsigned char* ws = WSP;
          pg8::Epi<pg8::EM_SWA> E{(bf16_t*)(ws + WS_BIG), SWA_LDP, (const float*)(ws + WS_SWAB), (const float*)(ws + WS_ROPEC), (const float*)(ws + WS_ROPES), nullptr, nullptr, (bf16_t*)(ws + WS_BIG + SWA_HM_OFF), SWA_HM_STRIDE};
          run_gemm<pg8::EM_SWA, 0>(lds + RING_OFF, (const bf16_t*)(ws + WS_XN), (const bf16_t*)(ws + WS_WSWA), M, SWA_NP, D, E, wave_s); }
        GRID_BAR();
#if REP_GIN >= 2
        { unsigned char* ws = WSP;
          pg8::Epi<pg8::EM_SWA> E{(bf16_t*)(ws + WS_BIG), SWA_LDP, (const float*)(ws + WS_SWAB), (const float*)(ws + WS_ROPEC), (const float*)(ws + WS_ROPES), nullptr, nullptr, (bf16_t*)(ws + WS_BIG + SWA_HM_OFF), SWA_HM_STRIDE};
          run_gemm<pg8::EM_SWA, 0>(lds + RING_OFF, (const bf16_t*)(ws + WS_XN), (const bf16_t*)(ws + WS_WSWA), M, SWA_NP, D, E, wave_s); }
        GRID_BAR();
#endif
        { IDS; unsigned char* ws = WSP; const float* sinks = INP(14);
          const int bg = vcu >> 3, sub = vcu & 7;
          for (int i = 0; i < 8; ++i) {
#ifndef NO_SWA
              att::swa_unit(lds + RING_OFF, bg >> 1, bg & 1, 8 * i + sub, ws, WS_BIG, WS_O, sinks, wave, aslot);
#endif
          } }
#if REP_ATT_SWA >= 2
        GRID_BAR();
        { IDS; unsigned char* ws = WSP; const float* sinks = INP(14);
          const int bg = vcu >> 3, sub = vcu & 7;
          for (int i = 0; i < 8; ++i) {
#ifndef NO_SWA
              att::swa_unit(lds + RING_OFF, bg >> 1, bg & 1, 8 * i + sub, ws, WS_BIG, WS_O, sinks, wave, aslot);
#endif
          } }
#endif
    }
    GRID_BAR();
    { unsigned char* ws = WSP;
      pg8::Epi<pg8::EM_PLAIN> E{(bf16_t*)(ws + WS_BIG), D, kind == 2 ? INP(16) : nullptr, nullptr, nullptr, nullptr, nullptr, nullptr, 0};
      run_gemm<pg8::EM_PLAIN, 0>(lds + RING_OFF, (const bf16_t*)(ws + WS_O), (const bf16_t*)(ws + WS_WOUT) + (size_t)L * D * D, M, D, D, E, wave_s); }
    GRID_BAR();
#if REP_GOUT >= 2
    { unsigned char* ws = WSP;
      pg8::Epi<pg8::EM_PLAIN> E{(bf16_t*)(ws + WS_BIG), D, kind == 2 ? INP(16) : nullptr, nullptr, nullptr, nullptr, nullptr, nullptr, 0};
      run_gemm<pg8::EM_PLAIN, 0>(lds + RING_OFF, (const bf16_t*)(ws + WS_O), (const bf16_t*)(ws + WS_WOUT) + (size_t)L * D * D, M, D, D, E, wave_s); }
    GRID_BAR();
#endif
    { IDS; unsigned char* ws = WSP; const float* gL = INP(1) + (size_t)L * 4 * D; const float* xin = (L == 0) ? INP(0) : nullptr;
      const bf16_t* MB = (const bf16_t*)(ws + WS_BIG); bf16_t* XN = (bf16_t*)(ws + WS_XN); float* RSTD = (float*)(ws + WS_RSTD);
      for (int m = gw; m < M; m += 2 * NGW) resnorm_rows2(m, m + NGW, xin, XN, RSTD, gL, MB, gL + D, gL + 2 * D, nullptr, lane); }
    GRID_BAR();
    { unsigned char* ws = WSP;
      pg8::Epi<pg8::EM_RELU2> E{(bf16_t*)(ws + WS_BIG), FF, nullptr, nullptr, nullptr, nullptr, nullptr, nullptr, 0};
      run_gemm<pg8::EM_RELU2, 0>(lds + RING_OFF, (const bf16_t*)(ws + WS_XN), (const bf16_t*)(ws + WS_WUP) + (size_t)L * D * FF, M, FF, D, E, wave_s); }
    GRID_BAR();
#if REP_MLP >= 2
    { unsigned char* ws = WSP;
      pg8::Epi<pg8::EM_RELU2> E{(bf16_t*)(ws + WS_BIG), FF, nullptr, nullptr, nullptr, nullptr, nullptr, nullptr, 0};
      run_gemm<pg8::EM_RELU2, 0>(lds + RING_OFF, (const bf16_t*)(ws + WS_XN), (const bf16_t*)(ws + WS_WUP) + (size_t)L * D * FF, M, FF, D, E, wave_s); }
    GRID_BAR();
#endif
    { unsigned char* ws = WSP;
      pg8::Epi<pg8::EM_PLAIN> E{(bf16_t*)(ws + WS_M2), D, nullptr, nullptr, nullptr, nullptr, nullptr, nullptr, 0};
      run_gemm<pg8::EM_PLAIN, 0>(lds + RING_OFF, (const bf16_t*)(ws + WS_BIG), (const bf16_t*)(ws + WS_WDN) + (size_t)L * D * FF, M, D, FF, E, wave_s); }
    GRID_BAR();
#if REP_MLP >= 2
    { unsigned char* ws = WSP;
      pg8::Epi<pg8::EM_PLAIN> E{(bf16_t*)(ws + WS_M2), D, nullptr, nullptr, nullptr, nullptr, nullptr, nullptr, 0};
      run_gemm<pg8::EM_PLAIN, 0>(lds + RING_OFF, (const bf16_t*)(ws + WS_BIG), (const bf16_t*)(ws + WS_WDN) + (size_t)L * D * FF, M, D, FF, E, wave_s); }
    GRID_BAR();
#endif
    { IDS; unsigned char* ws = WSP; const float* gL = INP(1) + (size_t)L * 4 * D; float* xout = OUTP; bf16_t* XN = (bf16_t*)(ws + WS_XN); const bf16_t* M2 = (const bf16_t*)(ws + WS_M2); float* RSTD = (float*)(ws + WS_RSTD);
      for (int m = gw; m < M; m += 2 * NGW) resnorm_rows2(m, m + NGW, nullptr, XN, RSTD, gL + 2 * D, M2, gL + 3 * D, (L + 1 < DEPTH) ? gL + 4 * D : nullptr, (L + 1 < DEPTH) ? nullptr : xout, lane); }
    if (L + 1 < DEPTH) GRID_BAR();
#undef GRID_BAR
}

__global__ void __launch_bounds__(NWAVES * 64, 2) fwd_kernel(Args args) {
    extern __shared__ __attribute__((aligned(16))) unsigned char lds_raw[];
    LAS unsigned char* lds = (LAS unsigned char*)lds_raw;
    const int wave_s = __builtin_amdgcn_readfirstlane((int)threadIdx.x >> 6);
    for (int u = threadIdx.x; u < (LDS_BYTES - LDSCTL_OFF) / 4; u += NWAVES * 64) ((LAS unsigned*)(lds + LDSCTL_OFF))[u] = 0u;
    __syncthreads();
    if (threadIdx.x == 0) {
        LAS unsigned long long* pt = (LAS unsigned long long*)(lds + PT_OFF);
#pragma unroll
        for (int i = 0; i < 17; ++i) pt[i] = (unsigned long long)args.in[i];
        pt[17] = (unsigned long long)args.out; pt[18] = (unsigned long long)args.ws;
    }
    __syncthreads();
    volatile LAS unsigned* MISC = (volatile LAS unsigned*)(lds + MISC_OFF);
    XcdBarrier bar = xcd_barrier_post((unsigned*)(WSP + WS_CTL) + CW_BAR, MISC + 8);

    {
        IDS; unsigned char* ws = WSP;
        const float* x_in = INP(0); const float* norm_g = INP(1); const float* mlp_up = INP(2); const float* mlp_dn = INP(3);
        const float* nsa_w_in = INP(4); const float* nsa_pos = INP(5); const float* nsa_w1 = INP(6); const float* nsa_w_out = INP(8);
        const float* fox_w_in = INP(9); const float* fox_w_out = INP(11); const float* swa_w_in = INP(12); const float* swa_b_in = INP(13); const float* swa_w_out = INP(15);
        bf16_t* W_UP = (bf16_t*)(ws + WS_WUP); bf16_t* W_DN = (bf16_t*)(ws + WS_WDN); bf16_t* W_NSA = (bf16_t*)(ws + WS_WNSA); bf16_t* W_OUT = (bf16_t*)(ws + WS_WOUT);
        bf16_t* W_FOX = (bf16_t*)(ws + WS_WFOX); bf16_t* W_SWA = (bf16_t*)(ws + WS_WSWA); bf16_t* W_CMP = (bf16_t*)(ws + WS_WCMP);
        float* ROPEC = (float*)(ws + WS_ROPEC); float* ROPES = (float*)(ws + WS_ROPES); float* CMPB = (float*)(ws + WS_CMPB); float* SWAB = (float*)(ws + WS_SWAB);
        bf16_t* XN = (bf16_t*)(ws + WS_XN);
        LAS float* scr = (LAS float*)(lds + RING_OFF + wave * 16384);
        constexpr int I_UP = (D / 64) * (FF / 32), I_DN = (FF / 64) * (D / 32), I_NSA = (D / 64) * (NSA_NP / 32), I_GATE = (D / 64) * 2, I_OUT = (D / 64) * (D / 32), I_FOX = (D / 64) * ((FOX_N + 31) / 32), I_SWA = (D / 64) * (SWA_N / 32), I_CMP = (2048 / 64) * (256 / 32);
        constexpr int NITEMS = 4 * I_UP + 4 * I_DN + 2 * I_NSA + 2 * I_GATE + 4 * I_OUT + I_FOX + I_SWA + 4 * I_CMP;
        for (int it = gw; it < NITEMS; it += NGW) {
            int r = it;
            if (r < 4 * I_UP) { const int Lw = r / I_UP; conv_item(mlp_up + (size_t)Lw * D * FF, D, FF, W_UP + (size_t)Lw * D * FF, 0, r % I_UP, scr, lane); continue; } r -= 4 * I_UP;
            if (r < 4 * I_DN) { const int Lw = r / I_DN; conv_item(mlp_dn + (size_t)Lw * D * FF, FF, D, W_DN + (size_t)Lw * D * FF, 0, r % I_DN, scr, lane); continue; } r -= 4 * I_DN;
            if (r < 2 * I_NSA) { const int s = r / I_NSA; conv_item(nsa_w_in + (size_t)s * D * NSA_N, D, NSA_NP, W_NSA + (size_t)s * NSA_NP * D, 1, r % I_NSA, scr, lane, NSA_N); continue; } r -= 2 * I_NSA;
            if (r < 2 * I_GATE) { const int s = r / I_GATE; conv_item(nsa_w_in + (size_t)s * D * NSA_N + NSA_NP, D, 48, (bf16_t*)(ws + WS_WGATE) + (size_t)s * 256 * D, 0, r % I_GATE, scr, lane, NSA_N); continue; } r -= 2 * I_GATE;
            if (r < 4 * I_OUT) { const int Lw = r / I_OUT; const float* src = (Lw == 1) ? fox_w_out : (Lw == 2) ? swa_w_out : nsa_w_out + (size_t)(Lw / 3) * D * D;
                conv_item(src, D, D, W_OUT + (size_t)Lw * D * D, 0, r % I_OUT, scr, lane); continue; } r -= 4 * I_OUT;
            if (r < I_FOX) { conv_item(fox_w_in, D, FOX_N, W_FOX, 2, r, scr, lane); continue; } r -= I_FOX;
            if (r < I_SWA) { conv_item(swa_w_in, D, SWA_N, W_SWA, 3, r, scr, lane); continue; } r -= I_SWA;
            { const int sw = r / I_CMP;
                conv_item(nsa_w1 + (size_t)sw * 2048 * 256, 2048, 256, W_CMP + (size_t)sw * 256 * 2048, (sw & 1) ? 0 : 4, r % I_CMP, scr, lane); }
        }
        { constexpr int ZG = 208 * D / 8, ZF = (FOX_NP - FOX_N) * D / 8;
          for (int e = bx * 512 + tid; e < 2 * ZG + ZF; e += G * 512) {
              bf16_t* dst = e < ZG ? (bf16_t*)(ws + WS_WGATE) + (size_t)48 * D + (size_t)e * 8 : e < 2 * ZG ? (bf16_t*)(ws + WS_WGATE) + (size_t)256 * D + (size_t)48 * D + (size_t)(e - ZG) * 8 : W_FOX + (size_t)FOX_N * D + (size_t)(e - 2 * ZG) * 8;
              *(GAS u32x4*)dst = (u32x4){0u, 0u, 0u, 0u}; } }
        for (int e = bx * 512 + tid; e < T * 32; e += G * 512) { const int t = e >> 5, i = e & 31; const float inv = powf(10000.0f, -(float)(2 * i) / 64.0f); const float ang = (float)t * inv;
            ROPEC[e] = cosf(ang); ROPES[e] = sinf(ang); }
        for (int e = bx * 512 + tid; e < SWA_N; e += G * 512) SWAB[e] = swa_b_in[src_n(3, e)];
        for (int task = bx; task < 64; task += G) {
            const int sw = task >> 4, n0 = (task & 15) * 16, kq = tid >> 4, nn = tid & 15;
            const float* pos = nsa_pos + (size_t)sw * 2048; const float* w1 = nsa_w1 + (size_t)sw * 2048 * 256;
            float acc = 0.f;
#pragma unroll 8
            for (int k = kq * 64; k < kq * 64 + 64; ++k) acc += pos[k] * w1[(size_t)k * 256 + n0 + nn];
            LAS float* red = (LAS float*)(lds + RING_OFF);
            __syncthreads();
            red[kq * 16 + nn] = acc;
            __syncthreads();
            if (tid < 16) { float sm = 0.f; for (int q = 0; q < 32; ++q) sm += red[q * 16 + tid]; CMPB[sw * 256 + n0 + tid] = sm; }
            __syncthreads();
        }
        for (int m = gw; m < M; m += NGW) norm_row(x_in + (size_t)m * D, norm_g, XN + (size_t)m * D, (float*)(ws + WS_RSTD) + m, lane);
    }
#if REP_PRO >= 2
    xcd_barrier(bar);
    {
        IDS; unsigned char* ws = WSP;
        const float* x_in = INP(0); const float* norm_g = INP(1); const float* mlp_up = INP(2); const float* mlp_dn = INP(3);
        const float* nsa_w_in = INP(4); const float* nsa_pos = INP(5); const float* nsa_w1 = INP(6); const float* nsa_w_out = INP(8);
        const float* fox_w_in = INP(9); const float* fox_w_out = INP(11); const float* swa_w_in = INP(12); const float* swa_b_in = INP(13); const float* swa_w_out = INP(15);
        bf16_t* W_UP = (bf16_t*)(ws + WS_WUP); bf16_t* W_DN = (bf16_t*)(ws + WS_WDN); bf16_t* W_NSA = (bf16_t*)(ws + WS_WNSA); bf16_t* W_OUT = (bf16_t*)(ws + WS_WOUT);
        bf16_t* W_FOX = (bf16_t*)(ws + WS_WFOX); bf16_t* W_SWA = (bf16_t*)(ws + WS_WSWA); bf16_t* W_CMP = (bf16_t*)(ws + WS_WCMP);
        float* ROPEC = (float*)(ws + WS_ROPEC); float* ROPES = (float*)(ws + WS_ROPES); float* CMPB = (float*)(ws + WS_CMPB); float* SWAB = (float*)(ws + WS_SWAB);
        bf16_t* XN = (bf16_t*)(ws + WS_XN);
        LAS float* scr = (LAS float*)(lds + RING_OFF + wave * 16384);
        constexpr int I_UP = (D / 64) * (FF / 32), I_DN = (FF / 64) * (D / 32), I_NSA = (D / 64) * (NSA_NP / 32), I_GATE = (D / 64) * 2, I_OUT = (D / 64) * (D / 32), I_FOX = (D / 64) * ((FOX_N + 31) / 32), I_SWA = (D / 64) * (SWA_N / 32), I_CMP = (2048 / 64) * (256 / 32);
        constexpr int NITEMS = 4 * I_UP + 4 * I_DN + 2 * I_NSA + 2 * I_GATE + 4 * I_OUT + I_FOX + I_SWA + 4 * I_CMP;
        for (int it = gw; it < NITEMS; it += NGW) {
            int r = it;
            if (r < 4 * I_UP) { const int Lw = r / I_UP; conv_item(mlp_up + (size_t)Lw * D * FF, D, FF, W_UP + (size_t)Lw * D * FF, 0, r % I_UP, scr, lane); continue; } r -= 4 * I_UP;
            if (r < 4 * I_DN) { const int Lw = r / I_DN; conv_item(mlp_dn + (size_t)Lw * D * FF, FF, D, W_DN + (size_t)Lw * D * FF, 0, r % I_DN, scr, lane); continue; } r -= 4 * I_DN;
            if (r < 2 * I_NSA) { const int s = r / I_NSA; conv_item(nsa_w_in + (size_t)s * D * NSA_N, D, NSA_NP, W_NSA + (size_t)s * NSA_NP * D, 1, r % I_NSA, scr, lane, NSA_N); continue; } r -= 2 * I_NSA;
            if (r < 2 * I_GATE) { const int s = r / I_GATE; conv_item(nsa_w_in + (size_t)s * D * NSA_N + NSA_NP, D, 48, (bf16_t*)(ws + WS_WGATE) + (size_t)s * 256 * D, 0, r % I_GATE, scr, lane, NSA_N); continue; } r -= 2 * I_GATE;
            if (r < 4 * I_OUT) { const int Lw = r / I_OUT; const float* src = (Lw == 1) ? fox_w_out : (Lw == 2) ? swa_w_out : nsa_w_out + (size_t)(Lw / 3) * D * D;
                conv_item(src, D, D, W_OUT + (size_t)Lw * D * D, 0, r % I_OUT, scr, lane); continue; } r -= 4 * I_OUT;
            if (r < I_FOX) { conv_item(fox_w_in, D, FOX_N, W_FOX, 2, r, scr, lane); continue; } r -= I_FOX;
            if (r < I_SWA) { conv_item(swa_w_in, D, SWA_N, W_SWA, 3, r, scr, lane); continue; } r -= I_SWA;
            { const int sw = r / I_CMP;
                conv_item(nsa_w1 + (size_t)sw * 2048 * 256, 2048, 256, W_CMP + (size_t)sw * 256 * 2048, (sw & 1) ? 0 : 4, r % I_CMP, scr, lane); }
        }
        { constexpr int ZG = 208 * D / 8, ZF = (FOX_NP - FOX_N) * D / 8;
          for (int e = bx * 512 + tid; e < 2 * ZG + ZF; e += G * 512) {
              bf16_t* dst = e < ZG ? (bf16_t*)(ws + WS_WGATE) + (size_t)48 * D + (size_t)e * 8 : e < 2 * ZG ? (bf16_t*)(ws + WS_WGATE) + (size_t)256 * D + (size_t)48 * D + (size_t)(e - ZG) * 8 : W_FOX + (size_t)FOX_N * D + (size_t)(e - 2 * ZG) * 8;
              *(GAS u32x4*)dst = (u32x4){0u, 0u, 0u, 0u}; } }
        for (int e = bx * 512 + tid; e < T * 32; e += G * 512) { const int t = e >> 5, i = e & 31; const float inv = powf(10000.0f, -(float)(2 * i) / 64.0f); const float ang = (float)t * inv;
            ROPEC[e] = cosf(ang); ROPES[e] = sinf(ang); }
        for (int e = bx * 512 + tid; e < SWA_N; e += G * 512) SWAB[e] = swa_b_in[src_n(3, e)];
        for (int task = bx; task < 64; task += G) {
            const int sw = task >> 4, n0 = (task & 15) * 16, kq = tid >> 4, nn = tid & 15;
            const float* pos = nsa_pos + (size_t)sw * 2048; const float* w1 = nsa_w1 + (size_t)sw * 2048 * 256;
            float acc = 0.f;
#pragma unroll 8
            for (int k = kq * 64; k < kq * 64 + 64; ++k) acc += pos[k] * w1[(size_t)k * 256 + n0 + nn];
            LAS float* red = (LAS float*)(lds + RING_OFF);
            __syncthreads();
            red[kq * 16 + nn] = acc;
            __syncthreads();
            if (tid < 16) { float sm = 0.f; for (int q = 0; q < 32; ++q) sm += red[q * 16 + tid]; CMPB[sw * 256 + n0 + tid] = sm; }
            __syncthreads();
        }
        for (int m = gw; m < M; m += NGW) norm_row(x_in + (size_t)m * D, norm_g, XN + (size_t)m * D, (float*)(ws + WS_RSTD) + m, lane);
    }
#endif
    xcd_barrier(bar);

    int aslot = 0;
    if (L_LO <= 0 && 0 < L_HI) layer_body<0>(lds, bar, aslot, wave_s);
    if (L_LO <= 1 && 1 < L_HI) layer_body<1>(lds, bar, aslot, wave_s);
    if (L_LO <= 2 && 2 < L_HI) layer_body<2>(lds, bar, aslot, wave_s);
    if (L_LO <= 3 && 3 < L_HI) layer_body<3>(lds, bar, aslot, wave_s);
}

extern "C" void kernel_launch(void* const* d_in, const int* in_sizes, int n_in, void* d_out, int out_size, void* d_ws, size_t ws_size, hipStream_t stream) {
    static int grid = 0;
    if (grid == 0) {
        if (n_in != 17 || in_sizes[0] != M * D || out_size != M * D || ws_size < WS_END) { fprintf(stderr, "kernel_launch: unexpected problem shape (n_in %d, in0 %d, out %d, ws %zu)\n", n_in, n_in > 0 ? in_sizes[0] : -1, out_size, ws_size); grid = -1; return; }
        int dev = 0, cus = 0, per_cu = 0;
        if (hipGetDevice(&dev) != hipSuccess || hipDeviceGetAttribute(&cus, hipDeviceAttributeMultiprocessorCount, dev) != hipSuccess) { grid = -1; return; }
        if (hipFuncSetAttribute((const void*)fwd_kernel, hipFuncAttributeMaxDynamicSharedMemorySize, LDS_BYTES) != hipSuccess) { fprintf(stderr, "kernel_launch: hipFuncSetAttribute failed\n"); grid = -1; return; }
        if (hipOccupancyMaxActiveBlocksPerMultiprocessor(&per_cu, (const void*)fwd_kernel, NWAVES * 64, LDS_BYTES) != hipSuccess || per_cu < 1) { fprintf(stderr, "kernel_launch: occupancy query reports %d\n", per_cu); }
        (void)hipGetLastError();
        if (cus < 256) { fprintf(stderr, "kernel_launch: needs 256 CUs, device has %d\n", cus); grid = -1; return; }
        grid = 256;
    }
    if (grid < 0) return;
    if (hipMemsetAsync((char*)d_ws + WS_CTL, 0, CTL_ZERO_BYTES, stream) != hipSuccess) return;
    Args a{};
    for (int i = 0; i < 17; ++i) a.in[i] = (const float*)d_in[i];
    a.out = (float*)d_out; a.ws = (unsigned char*)d_ws;
    hipLaunchKernelGGL(fwd_kernel, dim3(grid), dim3(NWAVES * 64), LDS_BYTES, stream, a);
}
```

```cpp
#include <hip/hip_runtime.h>
#include <cstdio>
#include <cstdint>

#define LAS __attribute__((address_space(3)))
#define GAS __attribute__((address_space(1)))
typedef unsigned short bf16_t;
typedef short bf16x8 __attribute__((ext_vector_type(8)));
typedef short s16x4 __attribute__((ext_vector_type(4)));
typedef float f32x2 __attribute__((ext_vector_type(2)));
typedef float f32x4 __attribute__((ext_vector_type(4)));
typedef float f32x16 __attribute__((ext_vector_type(16)));
typedef unsigned u32x2 __attribute__((ext_vector_type(2)));
typedef unsigned u32x4 __attribute__((ext_vector_type(4)));

constexpr int BATCH = 16, T = 2048, D = 1024, NH = 16, HD = 64, FF = 4096, DEPTH = 4;
constexpr int M = BATCH * T;
constexpr int NSA_N = 2608, NSA_NP = 2560, NSA_LDP = 1536;
constexpr int FOX_N = 3088, FOX_NP = 3328, FOX_LDP = 1024;
constexpr int SWA_N = 1280, SWA_NP = 1280, SWA_LDP = 1024;
constexpr int CMP_LDP = NSA_LDP;
constexpr int NC = 127, NCP = 128;
constexpr int CMP_ROWS = BATCH * NCP * 4;
constexpr size_t NSA_HM_OFF = (size_t)96 << 20, NSA_HM_STRIDE = (size_t)8 << 20;
constexpr size_t FOX_HM_OFF = (size_t)64 << 20, FOX_HM_STRIDE = (size_t)32 << 20;
constexpr size_t SWA_HM_OFF = (size_t)64 << 20, SWA_HM_STRIDE = (size_t)4 << 20;
constexpr float LOG2E = 1.4426950408889634f;
constexpr float C2 = 0.125f * LOG2E;
constexpr float NORM_EPS = 1e-6f;

__device__ __forceinline__ unsigned cvt_pk_bf16(float lo, float hi) { unsigned r; asm volatile("v_cvt_pk_bf16_f32 %0, %1, %2" : "=v"(r) : "v"(lo), "v"(hi)); return r; }
__device__ __forceinline__ void store8(bf16_t* p, f32x4 a, f32x4 b) { u32x4 w; w.x = cvt_pk_bf16(a[0], a[1]); w.y = cvt_pk_bf16(a[2], a[3]); w.z = cvt_pk_bf16(b[0], b[1]); w.w = cvt_pk_bf16(b[2], b[3]); *(GAS u32x4*)p = w; }

__device__ __forceinline__ int lane_id_volatile() { int x; asm volatile("v_mbcnt_lo_u32_b32 %0, -1, 0\n\tv_mbcnt_hi_u32_b32 %0, -1, %0" : "=v"(x)); return x; }

namespace pg8 {
#define PG8_LAS __attribute__((address_space(3)))
constexpr int BM = 256, BK = 64, HALF = 128, HTB = HALF * BK * 2  , STAGE_BYTES = 8 * HTB, NXCD = 8, WGM = 8;

__host__ __device__ __forceinline__ int lds_byte(int r, int c) { const int st = (r >> 4) * 2 + (c >> 5), rr = r & 15, cc = c & 31, ob = rr * 64 + cc * 2; return st * 1024 + (ob ^ (((ob >> 9) & 1) << 5)); }
__host__ __device__ __forceinline__ void stage_rc(int b, int& R, int& C) { const int st = b / 1024, sb = b % 1024, swz = sb ^ (((sb >> 9) & 1) << 5); R = (st >> 1) * 16 + swz / 64; C = (st & 1) * 32 + (swz % 64) / 2; }
__host__ __device__ __forceinline__ int perm32(int rho) { const int n = rho >> 4, i = rho & 15; return 8 * (i >> 2) + 4 * n + (i & 3); }

struct Unit { int pm, pn; };
struct Gemm { const bf16_t* A; const bf16_t* Bt; int M, N, K; };

struct StaticOrder {
    int nM, nN, nwg, G, c;
    __host__ __device__ void init(int M_, int N_, int G_, int c_) { nM = M_ / BM; nN = N_ / BM; nwg = nM * nN; G = G_; c = c_; }
    __host__ __device__ bool next(int i, Unit& u) const {
        const long L = (long)i * G + c; if (L >= nwg) return false;
        int wgid = (int)L; { const int q = nwg / NXCD, r = nwg % NXCD, xcd = wgid % NXCD, off = wgid / NXCD; wgid = (xcd < r ? xcd * (q + 1) : r * (q + 1) + (xcd - r) * q) + off; }
        const int nig = WGM * nN, gid = wgid / nig, fm = gid * WGM, gsz = (nM - fm) < WGM ? (nM - fm) : WGM;
        u.pm = fm + ((wgid % nig) % gsz); u.pn = (wgid % nig) / gsz; return true;
    }
    __device__ __forceinline__ void a_ready(const Unit&) const {}
    __device__ __forceinline__ void done(const Unit&) const {}
};

enum EpiMode { EM_PLAIN = 0, EM_RELU2 = 1, EM_NSA = 2, EM_FOX = 3, EM_SWA = 4, EM_CMP = 5, EM_GATE = 6 };

__device__ __forceinline__ void rope4(f32x4& v, float c0, float s0, float c1, float s1) {
    const float a0 = v[0], b0 = v[1], a1 = v[2], b1 = v[3];
    v[0] = a0 * c0 - b0 * s0; v[1] = b0 * c0 + a0 * s0; v[2] = a1 * c1 - b1 * s1; v[3] = b1 * c1 + a1 * s1;
}
__device__ __forceinline__ float sigmoidf_(float x) { return 1.0f / (1.0f + __expf(-x)); }
__device__ __forceinline__ float logsigmoidf_(float x) { return fminf(x, 0.f) - log1pf(expf(-fabsf(x))); }

template <int MODE> struct Epi {
    static constexpr bool PERM = true, AFTER_DRAIN = false;
    bf16_t* O; int ldc; const float* bias; const float* rc; const float* rs; float* aux; const float* auxb;
    bf16_t* hm0; size_t hm_stride;
    __device__ __forceinline__ void operator()(const f32x4 (&acc)[2][2][4][2], const Unit& u, int wr, int wc, int fr, int fq) const {
        const int row0 = u.pm * BM + wr * 64 + fr;
        const int cw = wc * 32 + 8 * fq;
        const int colt = u.pn * BM;
        if (MODE == EM_GATE) {
            if (cw < 48) {
#pragma unroll
                for (int ai = 0; ai < 2; ++ai)
#pragma unroll
                    for (int m = 0; m < 4; ++m) { const size_t row = (size_t)(row0 + ai * HALF + m * 16); f32x4 v0 = acc[ai][0][m][0], v1 = acc[ai][0][m][1];
#pragma unroll
                        for (int j = 0; j < 4; ++j) { v0[j] = sigmoidf_(v0[j]); v1[j] = sigmoidf_(v1[j]); }
                        *(GAS f32x4*)(aux + row * 48 + cw) = v0; *(GAS f32x4*)(aux + row * 48 + cw + 4) = v1; }
            }
            return;
        }
        if (MODE == EM_FOX && u.pn == 12) {
            if (cw < 16) {
                const f32x4 b0 = *(const GAS f32x4*)(auxb + cw), b1 = *(const GAS f32x4*)(auxb + cw + 4);
#pragma unroll
                for (int ai = 0; ai < 2; ++ai)
#pragma unroll
                    for (int m = 0; m < 4; ++m) { const size_t row = (size_t)(row0 + ai * HALF + m * 16); f32x4 v0 = acc[ai][0][m][0] + b0, v1 = acc[ai][0][m][1] + b1;
#pragma unroll
                        for (int j = 0; j < 4; ++j) { v0[j] = logsigmoidf_(v0[j]); v1[j] = logsigmoidf_(v1[j]); }
                        *(GAS f32x4*)(aux + row * 16 + cw) = v0; *(GAS f32x4*)(aux + row * 16 + cw + 4) = v1; }
            }
            return;
        }
        bool rope0 = false, rope1 = false; float sc = 1.f;
        if (MODE == EM_NSA) { if (u.pn < 4) { rope0 = rope1 = true; sc = C2; } else if (!(u.pn & 1)) { rope0 = rope1 = true; } }
        if (MODE == EM_FOX) { if (u.pn < 4) sc = C2; }
        if (MODE == EM_SWA) { if (u.pn < 4) { rope0 = rope1 = true; sc = C2; } else { rope0 = true; } }
        f32x4 bv[2][2];
#pragma unroll
        for (int bj = 0; bj < 2; ++bj)
#pragma unroll
            for (int n = 0; n < 2; ++n) bv[bj][n] = bias ? *(const GAS f32x4*)(bias + colt + bj * HALF + cw + 4 * n) : (f32x4){0.f, 0.f, 0.f, 0.f};
        const int ib = 16 * (wc & 1) + 4 * fq;
        bf16_t* base = O; int colo = colt; size_t rowo = 0;
        if (MODE == EM_CMP) { colo = 0; rowo = (size_t)u.pn * CMP_ROWS; }
        bool hm = false; bf16_t* hb[2] = {nullptr, nullptr}; int hd[2] = {0, 0}; int HG = 1;
        if (MODE == EM_FOX && u.pn >= 4) { hm = true; HG = 16; hb[0] = hb[1] = hm0 + (u.pn >= 8 ? hm_stride : 0); hd[0] = ((u.pn - 4) & 3) * 4 + (wc >> 1); hd[1] = hd[0] + 2; }
        if (MODE == EM_NSA && u.pn >= 6) { hm = true; HG = 4; hb[0] = hb[1] = hm0 + (size_t)(u.pn - 6) * hm_stride; hd[0] = (wc >> 1); hd[1] = hd[0] + 2; }
        if (MODE == EM_SWA && u.pn == 4) { hm = true; HG = 2; hb[0] = hm0; hb[1] = hm0 + hm_stride; hd[0] = hd[1] = (wc >> 1); }
#pragma unroll
        for (int ai = 0; ai < 2; ++ai)
#pragma unroll
            for (int m = 0; m < 4; ++m) {
                const int row = row0 + ai * HALF + m * 16;
                f32x4 cc = {1.f, 1.f, 1.f, 1.f}, ss = {0.f, 0.f, 0.f, 0.f};
                if (MODE == EM_NSA || MODE == EM_SWA) { if (rope0) { const int t = row & (T - 1); cc = *(const GAS f32x4*)(rc + t * 32 + ib); ss = *(const GAS f32x4*)(rs + t * 32 + ib); } }
                bf16_t* rowp = base + (rowo + (size_t)row) * ldc + colo + cw;
#pragma unroll
                for (int bj = 0; bj < 2; ++bj) {
                    f32x4 v0 = acc[ai][bj][m][0] + bv[bj][0], v1 = acc[ai][bj][m][1] + bv[bj][1];
                    if (MODE == EM_NSA || MODE == EM_SWA) { if (bj == 0 ? rope0 : rope1) { rope4(v0, cc[0], ss[0], cc[1], ss[1]); rope4(v1, cc[2], ss[2], cc[3], ss[3]); } }
                    if (MODE == EM_RELU2) {
#pragma unroll
                        for (int j = 0; j < 4; ++j) { const float a = fmaxf(v0[j], 0.f), b = fmaxf(v1[j], 0.f); v0[j] = a * a; v1[j] = b * b; } }
                    if (MODE == EM_CMP) {
#pragma unroll
                        for (int j = 0; j < 4; ++j) { v0[j] = v0[j] * sigmoidf_(v0[j]); v1[j] = v1[j] * sigmoidf_(v1[j]); } }
                    if (MODE == EM_NSA || MODE == EM_FOX || MODE == EM_SWA) { v0 = v0 * sc; v1 = v1 * sc; }
                    if ((MODE == EM_FOX || MODE == EM_NSA || MODE == EM_SWA) && hm) store8(hb[bj] + (((size_t)(row >> 11) * HG + hd[bj]) * T + (row & (T - 1))) * 64 + (cw & 63), v0, v1);
                    else store8(rowp + bj * HALF, v0, v1);
                }
            }
    }
};

template <class Epi, class Sched, int AMODE, bool ALIGN_EPI = false, bool SP2 = false>
__device__ __forceinline__ void gemm_phase(PG8_LAS unsigned char* lds, const Gemm g, const Sched& S, const Epi& E, int wave_id) {
    int tid_; { int x_; asm volatile("v_mbcnt_lo_u32_b32 %0, -1, 0\n\tv_mbcnt_hi_u32_b32 %0, -1, %0" : "=v"(x_)); tid_ = wave_id * 64 + x_; }
    const int tid = tid_, wid = __builtin_amdgcn_readfirstlane(tid >> 6), lane = tid & 63, wr = wid >> 2, wc = wid & 3, fr = lane & 15, fq = lane >> 4;
    const int K = g.K, nt = K / BK;
    unsigned voffA[2], voffB[2];
#pragma unroll
    for (int i = 0; i < 2; ++i) { int R, C; stage_rc(tid * 16 + i * 8192, R, C); const int Rb = Epi::PERM ? ((R & ~31) + perm32(R & 31)) : R;
        voffA[i] = (AMODE == 1) ? (unsigned)((16 * (R >> 2)) * CMP_LDP + (R & 3) * 64 + C) * 2u : (unsigned)(R * K + C) * 2u; voffB[i] = (unsigned)(Rb * K + C) * 2u; }
    const size_t kstepB = (size_t)(BK * 2);
    const size_t hstepB = (size_t)HALF * K * 2;
    const size_t tstepB = 2 * hstepB;
    const size_t kstepA = (AMODE == 1) ? (size_t)CMP_LDP * 2 : kstepB;
    const size_t hstepA = (AMODE == 1) ? (size_t)512 * CMP_LDP * 2 : hstepB;
    const size_t tstepA = 2 * hstepA;
    const size_t pnstepA = (AMODE == 1) ? (size_t)512 : (size_t)0;
    const unsigned ldsw = (unsigned)wid * 1024u;
    const int aoff = lds_byte(wr * 64 + fr, fq * 8), boff = lds_byte(wc * 32 + fr, fq * 8);
#define PG8_SA(b, h) (((b) * 2 + (h)) * HTB)
#define PG8_SB(b, h) ((4 + (b) * 2 + (h)) * HTB)
#define PG8_STAGE(bufoff, gbase, voff) do { _Pragma("unroll") for (int _i = 0; _i < 2; ++_i) \
        __builtin_amdgcn_global_load_lds((const unsigned*)((const char*)(gbase) + (voff)[_i]), (PG8_LAS unsigned*)(lds + (bufoff) + ldsw + _i * 8192), 16, 0, 0); } while (0)
#define PG8_LDA(dst, b, h) do { _Pragma("unroll") for (int m = 0; m < 4; ++m) _Pragma("unroll") for (int k = 0; k < 2; ++k) dst[m][k] = *(const PG8_LAS bf16x8*)(lds + PG8_SA(b, h) + aoff + m * 2048 + k * 1024); } while (0)
#define PG8_LDB(dst, b, h) do { _Pragma("unroll") for (int n = 0; n < 2; ++n) _Pragma("unroll") for (int k = 0; k < 2; ++k) dst[n][k] = *(const PG8_LAS bf16x8*)(lds + PG8_SB(b, h) + boff + n * 2048 + k * 1024); } while (0)
#define PG8_MMA(ai, bj, At, Bt) do { __builtin_amdgcn_s_setprio(1); _Pragma("unroll") for (int m = 0; m < 4; ++m) _Pragma("unroll") for (int n = 0; n < 2; ++n) _Pragma("unroll") for (int k = 0; k < 2; ++k) \
        acc[ai][bj][m][n] = __builtin_amdgcn_mfma_f32_16x16x32_bf16(Bt[n][k], At[m][k], acc[ai][bj][m][n], 0, 0, 0); __builtin_amdgcn_s_setprio(0); } while (0)
#define PG8_WAIT_V(n) asm volatile("s_waitcnt vmcnt(" #n ")" ::: "memory")
#define PG8_WAIT_L(n) asm volatile("s_waitcnt lgkmcnt(" #n ")" ::: "memory")
#define PG8_BAR __builtin_amdgcn_s_barrier()
#define PG8_SCHED __builtin_amdgcn_sched_barrier(0)
    Unit cur, nxt; int ui = 0;
    if (!S.next(0, cur)) return;
    f32x4 acc[2][2][4][2];
#pragma unroll
    for (int a = 0; a < 2; ++a)
#pragma unroll
        for (int b = 0; b < 2; ++b)
#pragma unroll
            for (int m = 0; m < 4; ++m)
#pragma unroll
                for (int n = 0; n < 2; ++n) acc[a][b][m][n] = (f32x4){0.f, 0.f, 0.f, 0.f};
    bf16x8 At[4][2], B0[2][2], B1[2][2];
    const char* cA = (const char*)g.A + (size_t)cur.pm * tstepA + (size_t)cur.pn * pnstepA; const char* cB = (const char*)g.Bt + (size_t)cur.pn * tstepB;
    S.a_ready(cur);
    if constexpr (SP2) {
        PG8_STAGE(PG8_SB(0, 0), cB, voffB); PG8_STAGE(PG8_SB(0, 1), cB + hstepB, voffB); PG8_STAGE(PG8_SA(0, 0), cA, voffA); PG8_STAGE(PG8_SA(0, 1), cA + hstepA, voffA);
        if (wr == 1) PG8_BAR;
        PG8_WAIT_V(2); PG8_BAR;
        PG8_STAGE(PG8_SB(1, 0), cB + kstepB, voffB); PG8_STAGE(PG8_SA(1, 0), cA + kstepA, voffA); PG8_STAGE(PG8_SB(1, 1), cB + hstepB + kstepB, voffB);
        PG8_WAIT_V(6); PG8_BAR;
    } else {
        PG8_STAGE(PG8_SB(0, 0), cB, voffB); PG8_STAGE(PG8_SA(0, 0), cA, voffA); PG8_STAGE(PG8_SB(0, 1), cB + hstepB, voffB); PG8_STAGE(PG8_SA(0, 1), cA + hstepA, voffA);
        if (wr == 1) PG8_BAR;
        PG8_WAIT_V(4); PG8_BAR;
        PG8_STAGE(PG8_SB(1, 0), cB + kstepB, voffB); PG8_STAGE(PG8_SA(1, 0), cA + kstepA, voffA); PG8_STAGE(PG8_SB(1, 1), cB + hstepB + kstepB, voffB);
        PG8_WAIT_V(6); PG8_BAR;
    }
    for (;;) {
        const bool has_next = S.next(ui + 1, nxt);
        const char* nA = has_next ? (const char*)g.A + (size_t)nxt.pm * tstepA + (size_t)nxt.pn * pnstepA : cA; const char* nB = has_next ? (const char*)g.Bt + (size_t)nxt.pn * tstepB : cB;
        for (int t = 0; t < nt; t += 2) {
            const bool last = (t == nt - 2);
            const char* a1 = cA + (size_t)(t + 1) * kstepA;
            const char* a2 = last ? nA : cA + (size_t)(t + 2) * kstepA; const char* b2 = last ? nB : cB + (size_t)(t + 2) * kstepB;
            const char* a3 = a2 + kstepA; const char* b3 = b2 + kstepB;
            if (last && has_next) S.a_ready(nxt);
            if constexpr (SP2) {
            PG8_LDB(B0, 0, 0); PG8_LDB(B1, 0, 1); PG8_SCHED; PG8_LDA(At, 0, 0); PG8_STAGE(PG8_SA(1, 1), a1 + hstepA, voffA);
            PG8_WAIT_V(8); PG8_WAIT_L(0); PG8_BAR; PG8_MMA(0, 0, At, B0); PG8_MMA(0, 1, At, B1); PG8_BAR; PG8_SCHED;
            PG8_LDA(At, 0, 1); PG8_STAGE(PG8_SB(0, 0), b2, voffB); PG8_STAGE(PG8_SB(0, 1), b2 + hstepB, voffB); PG8_STAGE(PG8_SA(0, 0), a2, voffA);
            PG8_WAIT_V(8); PG8_WAIT_L(0); PG8_BAR; PG8_MMA(1, 0, At, B0); PG8_MMA(1, 1, At, B1); PG8_BAR; PG8_SCHED;
            PG8_LDB(B0, 1, 0); PG8_LDB(B1, 1, 1); PG8_SCHED; PG8_LDA(At, 1, 0); PG8_STAGE(PG8_SA(0, 1), a2 + hstepA, voffA);
            PG8_WAIT_V(8); PG8_WAIT_L(0); PG8_BAR; PG8_MMA(0, 0, At, B0); PG8_MMA(0, 1, At, B1); PG8_BAR; PG8_SCHED;
            PG8_LDA(At, 1, 1); PG8_STAGE(PG8_SB(1, 0), b3, voffB); PG8_STAGE(PG8_SB(1, 1), b3 + hstepB, voffB); PG8_STAGE(PG8_SA(1, 0), a3, voffA);
            PG8_WAIT_V(8); PG8_WAIT_L(0); PG8_BAR; PG8_MMA(1, 0, At, B0); PG8_MMA(1, 1, At, B1); PG8_BAR; PG8_SCHED;
            } else {
            PG8_LDB(B0, 0, 0); PG8_SCHED; PG8_LDA(At, 0, 0); PG8_STAGE(PG8_SA(1, 1), a1 + hstepA, voffA);
            PG8_WAIT_L(8); PG8_BAR; PG8_WAIT_L(0); PG8_MMA(0, 0, At, B0); PG8_BAR; PG8_SCHED;
            PG8_LDB(B1, 0, 1); PG8_STAGE(PG8_SB(0, 0), b2, voffB);
            PG8_BAR; PG8_WAIT_L(0); PG8_MMA(0, 1, At, B1); PG8_BAR;
            PG8_LDA(At, 0, 1); PG8_STAGE(PG8_SA(0, 0), a2, voffA);
            PG8_BAR; PG8_WAIT_L(0); PG8_MMA(1, 0, At, B0); PG8_BAR; PG8_SCHED;
            PG8_STAGE(PG8_SB(0, 1), b2 + hstepB, voffB);
            PG8_WAIT_V(6); PG8_BAR; PG8_MMA(1, 1, At, B1); PG8_BAR;
            PG8_LDB(B0, 1, 0); PG8_SCHED; PG8_LDA(At, 1, 0); PG8_STAGE(PG8_SA(0, 1), a2 + hstepA, voffA);
            PG8_WAIT_L(8); PG8_BAR; PG8_WAIT_L(0); PG8_MMA(0, 0, At, B0); PG8_BAR; PG8_SCHED;
            PG8_LDB(B1, 1, 1); PG8_STAGE(PG8_SB(1, 0), b3, voffB);
            PG8_BAR; PG8_WAIT_L(0); PG8_MMA(0, 1, At, B1); PG8_BAR;
            PG8_LDA(At, 1, 1); PG8_STAGE(PG8_SA(1, 0), a3, voffA);
            PG8_BAR; PG8_WAIT_L(0); PG8_MMA(1, 0, At, B0); PG8_BAR; PG8_SCHED;
            PG8_STAGE(PG8_SB(1, 1), b3 + hstepB, voffB);
            PG8_WAIT_V(6); PG8_BAR; PG8_MMA(1, 1, At, B1); PG8_BAR;
            }
        }
        if constexpr (ALIGN_EPI) { if (wr == 0) PG8_BAR; }
        if constexpr (!Epi::AFTER_DRAIN) { E(acc, cur, wr, wc, fr, fq); S.done(cur); }
        if (!has_next) break;
#pragma unroll
        for (int a = 0; a < 2; ++a)
#pragma unroll
            for (int b = 0; b < 2; ++b)
#pragma unroll
                for (int m = 0; m < 4; ++m)
#pragma unroll
                    for (int n = 0; n < 2; ++n) acc[a][b][m][n] = (f32x4){0.f, 0.f, 0.f, 0.f};
        cur = nxt; cA = nA; cB = nB; ++ui;
        if constexpr (ALIGN_EPI) { if (wr == 1) PG8_BAR; }
    }
    PG8_WAIT_V(0);
    if constexpr (!ALIGN_EPI) { if (wr == 0) PG8_BAR; }
    PG8_BAR;
    if constexpr (Epi::AFTER_DRAIN) { E.fused(acc, cur, wr, wc, fr, fq, lds, wid, lane); S.done(cur); }
#undef PG8_SA
#undef PG8_SB
#undef PG8_STAGE
#undef PG8_LDA
#undef PG8_LDB
#undef PG8_MMA
#undef PG8_WAIT_V
#undef PG8_WAIT_L
#undef PG8_BAR
#undef PG8_SCHED
}
}

namespace att {
constexpr int SLOTB = 8192;
constexpr int NSLOT = 4;
constexpr int L_K = 0, L_V = 32768, L_WS = 65536, L_OST = 67584, L_PSUM = L_OST, L_IMP = 133120, L_KB = L_IMP, L_SEL = 141312, L_END = 141568;
constexpr float PFIX = 268435456.0f;
constexpr float THR = 8.0f;

__device__ __forceinline__ int crow(int r, int hh) { return (r & 3) + 8 * (r >> 2) + 4 * hh; }
typedef float f32x2_t __attribute__((ext_vector_type(2))); typedef __bf16 bf16x2_t __attribute__((ext_vector_type(2)));
__device__ __forceinline__ unsigned cvtpk_s(float lo, float hi) { f32x2_t v = {lo, hi}; bf16x2_t b = __builtin_convertvector(v, bf16x2_t); return __builtin_bit_cast(unsigned, b); }
typedef short v4i16_t __attribute__((ext_vector_type(4)));
__device__ __forceinline__ s16x4 vtr(const LAS unsigned char* p) { return __builtin_bit_cast(s16x4, __builtin_amdgcn_ds_read_tr16_b64_v4i16((LAS v4i16_t*)p)); }
__device__ __forceinline__ float swap_sum(float v) { auto rr = __builtin_amdgcn_permlane32_swap(__float_as_uint(v), __float_as_uint(v), false, false); return __uint_as_float(rr[0]) + __uint_as_float(rr[1]); }
__device__ __forceinline__ float swap_max(float v) { auto rr = __builtin_amdgcn_permlane32_swap(__float_as_uint(v), __float_as_uint(v), false, false); return fmaxf(__uint_as_float(rr[0]), __uint_as_float(rr[1])); }
__device__ __forceinline__ bool trailing_half(int wid) { asm volatile("" : "+s"(wid)); return (wid >> 2) != 0; }
#define ATT_BAR() do { __builtin_amdgcn_s_barrier(); asm volatile("" ::: "memory"); } while (0)

__device__ __forceinline__ void dma_tile(const bf16_t* Kb, const bf16_t* Vb, int pitch, int tile, LAS unsigned char* shm, int slot, int wid, int lane) {
    const bf16_t* ks = Kb + (size_t)(tile * 64 + lane) * pitch + wid * 8;
    const bf16_t* vs = Vb + (size_t)(tile * 64 + 16 * (wid & 3) + (lane >> 2)) * pitch + (wid >> 2) * 32 + (lane & 3) * 8;
    __builtin_amdgcn_global_load_lds((const unsigned*)ks, (LAS unsigned*)(shm + L_K + slot * SLOTB + wid * 1024), 16, 0, 0);
    __builtin_amdgcn_global_load_lds((const unsigned*)vs, (LAS unsigned*)(shm + L_V + slot * SLOTB + wid * 1024), 16, 0, 0);
#ifdef PROBE_DMA2
    __builtin_amdgcn_global_load_lds((const unsigned*)ks, (LAS unsigned*)(shm + L_K + slot * SLOTB + wid * 1024), 16, 0, 0);
    __builtin_amdgcn_global_load_lds((const unsigned*)vs, (LAS unsigned*)(shm + L_V + slot * SLOTB + wid * 1024), 16, 0, 0);
#endif
}
#ifdef PROBE_DMA2
#define VMW2 "4"
#define VMW4 "8"
#else
#define VMW2 "2"
#define VMW4 "4"
#endif
__device__ __forceinline__ void qkt(f32x16& p0, f32x16& p1, const LAS unsigned char* shm, int slot, const bf16x8 (&qr)[4], const f32x16& cinit, int r32, int hh) {
    const LAS unsigned char* kb = shm + L_K + slot * SLOTB + hh * 1024 + r32 * 16;
#pragma unroll
    for (int d0 = 0; d0 < 4; ++d0) {
        const bf16x8 b0 = *(const LAS bf16x8*)(kb + d0 * 2048), b1 = *(const LAS bf16x8*)(kb + d0 * 2048 + 512);
        if (d0 == 0) { p0 = __builtin_amdgcn_mfma_f32_32x32x16_bf16(b0, qr[0], cinit, 0, 0, 0); p1 = __builtin_amdgcn_mfma_f32_32x32x16_bf16(b1, qr[0], cinit, 0, 0, 0); }
        else { p0 = __builtin_amdgcn_mfma_f32_32x32x16_bf16(b0, qr[d0], p0, 0, 0, 0); p1 = __builtin_amdgcn_mfma_f32_32x32x16_bf16(b1, qr[d0], p1, 0, 0, 0); }
        if (d0 == 1) asm volatile("" ::: "memory");
    }
}
__device__ __forceinline__ void load_k(bf16x8 (&kf)[8], const LAS unsigned char* shm, int slot, int r32, int hh) {
    const LAS unsigned char* kb = shm + L_K + slot * SLOTB + hh * 1024 + r32 * 16;
#pragma unroll
    for (int d0 = 0; d0 < 4; ++d0) { kf[2 * d0] = *(const LAS bf16x8*)(kb + d0 * 2048); kf[2 * d0 + 1] = *(const LAS bf16x8*)(kb + d0 * 2048 + 512); }
}
__device__ __forceinline__ void mma_qk(f32x16& p0, f32x16& p1, const bf16x8 (&kf)[8], const bf16x8 (&qr)[4], const f32x16& cinit) {
    p0 = __builtin_amdgcn_mfma_f32_32x32x16_bf16(kf[0], qr[0], cinit, 0, 0, 0); p1 = __builtin_amdgcn_mfma_f32_32x32x16_bf16(kf[1], qr[0], cinit, 0, 0, 0);
#pragma unroll
    for (int d0 = 1; d0 < 4; ++d0) { p0 = __builtin_amdgcn_mfma_f32_32x32x16_bf16(kf[2 * d0], qr[d0], p0, 0, 0, 0); p1 = __builtin_amdgcn_mfma_f32_32x32x16_bf16(kf[2 * d0 + 1], qr[d0], p1, 0, 0, 0); }
}
__device__ __forceinline__ void load_v(bf16x8 (&vf)[8], const LAS unsigned char* shm, int slot, int lane, int hh) {
    const LAS unsigned char* vb = shm + L_V + slot * SLOTB + ((lane >> 4) & 1) * 32 + (lane & 3) * 8 + (4 * hh + ((lane & 15) >> 2)) * 64;
#pragma unroll
    for (int ks = 0; ks < 4; ++ks)
#pragma unroll
        for (int d0 = 0; d0 < 2; ++d0) {
            const s16x4 vl = vtr(vb + d0 * 4096 + ks * 1024), vh = vtr(vb + d0 * 4096 + ks * 1024 + 512);
            vf[2 * ks + d0] = (bf16x8){vl[0], vl[1], vl[2], vl[3], vh[0], vh[1], vh[2], vh[3]};
        }
}
__device__ __forceinline__ void mma_pv(f32x16 (&o)[2], const u32x4 (&pw)[4], const bf16x8 (&vf)[8]) {
#pragma unroll
    for (int ks = 0; ks < 4; ++ks)
#pragma unroll
        for (int d0 = 0; d0 < 2; ++d0) o[d0] = __builtin_amdgcn_mfma_f32_32x32x16_bf16(__builtin_bit_cast(bf16x8, pw[ks]), vf[2 * ks + d0], o[d0], 0, 0, 0);
}
__device__ __forceinline__ void pv_seq(f32x16 (&o)[2], const u32x4 (&pw)[4], const LAS unsigned char* shm, int slot, int lane, int hh) {
    const LAS unsigned char* vb = shm + L_V + slot * SLOTB + ((lane >> 4) & 1) * 32 + (lane & 3) * 8 + (4 * hh + ((lane & 15) >> 2)) * 64;
#pragma unroll
    for (int ks = 0; ks < 4; ++ks) {
#pragma unroll
        for (int d0 = 0; d0 < 2; ++d0) {
            const s16x4 vl = vtr(vb + d0 * 4096 + ks * 1024), vh = vtr(vb + d0 * 4096 + ks * 1024 + 512);
            const bf16x8 vf = {vl[0], vl[1], vl[2], vl[3], vh[0], vh[1], vh[2], vh[3]};
            o[d0] = __builtin_amdgcn_mfma_f32_32x32x16_bf16(__builtin_bit_cast(bf16x8, pw[ks]), vf, o[d0], 0, 0, 0);
        }
        if (ks == 1) asm volatile("" ::: "memory");
    }
}
__device__ __forceinline__ void range_mask(f32x16& p0, f32x16& p1, int kb, int lo, int hi) {
#pragma unroll
    for (int r = 0; r < 16; ++r) { const int k = kb + (r & 3) + 8 * (r >> 2); if (k < lo || k > hi) p0[r] = -INFINITY; if (k + 32 < lo || k + 32 > hi) p1[r] = -INFINITY; }
}
__device__ __forceinline__ void mask_hi(f32x16& p0, f32x16& p1, int dh) {
#pragma unroll
    for (int r = 0; r < 16; ++r) { const int c = (r & 3) + 8 * (r >> 2); if (c > dh) p0[r] = -INFINITY; if (c + 32 > dh) p1[r] = -INFINITY; }
}
__device__ __forceinline__ void mask_lo(f32x16& p0, f32x16& p1, int dl) {
#pragma unroll
    for (int r = 0; r < 16; ++r) { const int c = (r & 3) + 8 * (r >> 2); if (c < dl) p0[r] = -INFINITY; if (c + 32 < dl) p1[r] = -INFINITY; }
}
__device__ __forceinline__ void rescale_o(f32x16 (&o)[2], const LAS float* wsf, int hh) {
#pragma unroll
    for (int g = 0; g < 4; ++g) { const f32x4 a4 = *(const LAS f32x4*)(wsf + 8 * g + 4 * hh);
#pragma unroll
        for (int j = 0; j < 4; ++j) { o[0][4 * g + j] *= a4[j]; o[1][4 * g + j] *= a4[j]; } }
}

__device__ __forceinline__ float max3f(float a, float b, float c) { float r; asm("v_max3_f32 %0, %1, %2, %3" : "=v"(r) : "v"(a), "v"(b), "v"(c)); return r; }
#define MM(a, b, c) __builtin_amdgcn_mfma_f32_32x32x16_bf16(a, b, c, 0, 0, 0)
#define SGB(mask, n) __builtin_amdgcn_sched_group_barrier(mask, n, 0)
template <int MODE, bool NOMAX, bool LEAN = false>
__device__ __forceinline__ void sweep(f32x16 (&o)[2], float& mhat, float& l, const bf16x8 (&qr)[4], const bf16_t* Kb, const bf16_t* Vb, int pitch, int t0, int NT, int lo, int hi,
                                      unsigned rowsel, LAS unsigned char* shm, int& ring, int wid, int lane) {
    static_assert(!(MODE == 1 && NOMAX), "the FoX key bias grows without bound: it needs the running max");
    asm volatile("" : "+v"(lane));
    const int r32 = lane & 31, hh = lane >> 5;
    LAS float* wsf = (LAS float*)(shm + L_WS + wid * 256);
    const int lo_max = __builtin_amdgcn_readlane(lo, 31), hi_min = __builtin_amdgcn_readfirstlane(hi);
    const int ring0 = ring;
#define SLOT(i_) ((ring0 + (i_)) & (NSLOT - 1))
    dma_tile(Kb, Vb, pitch, t0, shm, SLOT(0), wid, lane);
    if (NT > 1) dma_tile(Kb, Vb, pitch, t0 + 1, shm, SLOT(1), wid, lane);
    f32x16 a0, a1, b0, b1, cini; u32x4 pw[4]; bf16x8 kf[8], vf[8]; float ls0 = 0.f, ls1 = 0.f; bool resc = false;
#pragma unroll
    for (int r = 0; r < 16; ++r) cini[r] = 0.f;
#define SET_CINI(i_) do { if (MODE == 2) { const float c_ = ((rowsel >> (t0 + (i_))) & 1u) ? 0.f : -INFINITY; _Pragma("unroll") for (int r = 0; r < 16; ++r) cini[r] = c_; } } while (0)
#define POST(C0, C1, i_) do { const int tile_ = t0 + (i_); \
        if (MODE == 1) { const LAS float* kb_ = (const LAS float*)(shm + L_KB) + tile_ * 64 + 4 * hh; \
            _Pragma("unroll") for (int k_ = 0; k_ < 4; ++k_) { const f32x4 x0_ = *(const LAS f32x4*)(kb_ + 8 * k_), x1_ = *(const LAS f32x4*)(kb_ + 32 + 8 * k_); \
                _Pragma("unroll") for (int e_ = 0; e_ < 4; ++e_) { C0[4 * k_ + e_] += x0_[e_]; C1[4 * k_ + e_] += x1_[e_]; } } } \
        if (tile_ * 64 < lo_max || tile_ * 64 + 63 > hi_min) range_mask(C0, C1, tile_ * 64 + 4 * hh, lo, hi); \
        if (!NOMAX) { \
            float ra_ = max3f(C0[0], C0[1], C1[0]), rb_ = max3f(C0[2], C0[3], C1[1]); ra_ = max3f(ra_, C1[2], C1[3]); \
            _Pragma("unroll") for (int r = 4; r < 16; r += 4) { ra_ = max3f(ra_, C0[r], C0[r + 1]); rb_ = max3f(rb_, C0[r + 2], C0[r + 3]); ra_ = max3f(ra_, C1[r], C1[r + 1]); rb_ = max3f(rb_, C1[r + 2], C1[r + 3]); } \
            const float rm_ = swap_max(fmaxf(ra_, rb_)); const bool first_ = ((i_) == 0); \
            if (first_ || __any(rm_ > THR)) { \
                float dl_ = first_ ? rm_ : fmaxf(rm_, 0.f); if (dl_ == -INFINITY) dl_ = 0.f; \
                mhat += dl_; \
                _Pragma("unroll") for (int r = 0; r < 16; ++r) { C0[r] -= dl_; C1[r] -= dl_; cini[r] = -mhat; } \
                if (!first_) { const float al_ = __builtin_amdgcn_exp2f(-dl_); l *= al_; ls0 *= al_; ls1 *= al_; if (hh == 0) wsf[r32] = al_; resc = true; } } } \
    } while (0)
    asm volatile("s_waitcnt lgkmcnt(0)" ::: "memory");
    if (NT > 1) asm volatile("s_waitcnt vmcnt(2)" ::: "memory"); else asm volatile("s_waitcnt vmcnt(0)" ::: "memory");
    ATT_BAR();
    if (NT > 2) dma_tile(Kb, Vb, pitch, t0 + 2, shm, SLOT(2), wid, lane);
    SET_CINI(0);
    load_k(kf, shm, SLOT(0), r32, hh);
    mma_qk(a0, a1, kf, qr, cini);
    POST(a0, a1, 0);
#pragma unroll
    for (int r = 0; r < 16; ++r) { a0[r] = __builtin_amdgcn_exp2f(a0[r]); a1[r] = __builtin_amdgcn_exp2f(a1[r]); }
#define STEP(i_, C0, C1, P0, P1) do { \
        asm volatile("s_waitcnt lgkmcnt(0)" ::: "memory"); \
        if ((i_) + 1 < NT) asm volatile("s_waitcnt vmcnt(2)" ::: "memory"); else asm volatile("s_waitcnt vmcnt(0)" ::: "memory"); \
        ATT_BAR(); \
        if ((i_) + 2 < NT) dma_tile(Kb, Vb, pitch, t0 + (i_) + 2, shm, SLOT((i_) + 2), wid, lane); \
        SET_CINI(i_); \
        load_k(kf, shm, SLOT(i_), r32, hh); \
        __builtin_amdgcn_sched_barrier(0); \
        load_v(vf, shm, SLOT((i_) - 1), lane, hh);               \
          \
        C0 = MM(kf[0], qr[0], cini); C1 = MM(kf[1], qr[0], cini); \
        _Pragma("unroll") for (int d_ = 1; d_ < 4; ++d_) { C0 = MM(kf[2 * d_], qr[d_], C0); C1 = MM(kf[2 * d_ + 1], qr[d_], C1); } \
        _Pragma("unroll") for (int r = 0; r < 16; ++r) { ls0 += P0[r]; ls1 += P1[r]; } \
        _Pragma("unroll") for (int e_ = 0; e_ < 4; ++e_) { pw[0][e_] = cvtpk_s(P0[2 * e_], P0[2 * e_ + 1]); pw[1][e_] = cvtpk_s(P0[8 + 2 * e_], P0[9 + 2 * e_]); pw[2][e_] = cvtpk_s(P1[2 * e_], P1[2 * e_ + 1]); pw[3][e_] = cvtpk_s(P1[8 + 2 * e_], P1[9 + 2 * e_]); } \
        _Pragma("unroll") for (int g_ = 0; g_ < 8; ++g_) { SGB(0x008, 1); SGB(0x100, 2); SGB(0x002, 6); } \
        asm volatile("" : "+v"(ls0), "+v"(ls1), "+v"(pw[0]), "+v"(pw[1]), "+v"(pw[2]), "+v"(pw[3]));     \
        __builtin_amdgcn_sched_barrier(0); \
        POST(C0, C1, i_); \
        __builtin_amdgcn_sched_barrier(0); \
          \
        _Pragma("unroll") for (int ks_ = 0; ks_ < 4; ++ks_) _Pragma("unroll") for (int d_ = 0; d_ < 2; ++d_) o[d_] = MM(__builtin_bit_cast(bf16x8, pw[ks_]), vf[2 * ks_ + d_], o[d_]); \
        _Pragma("unroll") for (int r = 0; r < 16; ++r) { C0[r] = __builtin_amdgcn_exp2f(C0[r]); C1[r] = __builtin_amdgcn_exp2f(C1[r]); } \
        _Pragma("unroll") for (int g_ = 0; g_ < 8; ++g_) { SGB(0x008, 1); SGB(0x400, 4); } \
        __builtin_amdgcn_sched_barrier(0); \
        if (!NOMAX) { if (resc) { rescale_o(o, wsf, hh); resc = false; } } \
    } while (0)
    int i = 1;
    for (; i + 1 < NT; i += 2) { STEP(i, b0, b1, a0, a1); STEP(i + 1, a0, a1, b0, b1); }
    if (i < NT) {
        STEP(i, b0, b1, a0, a1);
#pragma unroll
        for (int r = 0; r < 16; ++r) { a0[r] = b0[r]; a1[r] = b1[r]; }
    }
#pragma unroll
    for (int r = 0; r < 16; ++r) { ls0 += a0[r]; ls1 += a1[r]; }
#pragma unroll
    for (int e = 0; e < 4; ++e) { pw[0][e] = cvtpk_s(a0[2 * e], a0[2 * e + 1]); pw[1][e] = cvtpk_s(a0[8 + 2 * e], a0[9 + 2 * e]); pw[2][e] = cvtpk_s(a1[2 * e], a1[2 * e + 1]); pw[3][e] = cvtpk_s(a1[8 + 2 * e], a1[9 + 2 * e]); }
    load_v(vf, shm, SLOT(NT - 1), lane, hh);
    mma_pv(o, pw, vf);
    l += ls0 + ls1;
    asm volatile("s_waitcnt lgkmcnt(0)" ::: "memory");
    ring = SLOT(NT);
#undef STEP
#undef POST
#undef SET_CINI
#undef SLOT
}
#undef MM
#undef SGB
template <bool FIRST>
__device__ __forceinline__ void merge(const f32x16 (&o)[2], float scale, LAS unsigned char* shm, int wid, int r32, int hh) {
    LAS float* wsf = (LAS float*)(shm + L_WS + wid * 256);
    LAS float* stg = (LAS float*)(shm + L_OST + wid * 8192) + r32;
    if (hh == 0) wsf[r32] = scale;
#pragma unroll
    for (int g = 0; g < 4; ++g) { const f32x4 s4 = *(const LAS f32x4*)(wsf + 8 * g + 4 * hh);
#pragma unroll
        for (int j = 0; j < 4; ++j) { LAS float* p = stg + (8 * g + 4 * hh + j) * 64;
            if (FIRST) { p[0] = o[0][4 * g + j] * s4[j]; p[32] = o[1][4 * g + j] * s4[j]; }
            else { p[0] += o[0][4 * g + j] * s4[j]; p[32] += o[1][4 * g + j] * s4[j]; } } }
}
__device__ __forceinline__ void store_o(bf16_t* Ow, LAS unsigned char* shm, int wid, int lane) {
    const LAS float* stg = (const LAS float*)(shm + L_OST + wid * 8192);
#pragma unroll
    for (int i = 0; i < 4; ++i) { const int rowl = i * 8 + (lane >> 3), ch = lane & 7; const f32x4 a = *(const LAS f32x4*)(stg + rowl * 64 + ch * 8), c = *(const LAS f32x4*)(stg + rowl * 64 + ch * 8 + 4);
        u32x4 v; v.x = cvtpk_s(a[0], a[1]); v.y = cvtpk_s(a[2], a[3]); v.z = cvtpk_s(c[0], c[1]); v.w = cvtpk_s(c[2], c[3]); *(GAS u32x4*)(Ow + (size_t)rowl * D + ch * 8) = v; }
}
__device__ __forceinline__ void zero_o(f32x16 (&o)[2]) { o[0] = (f32x16){0.f, 0.f, 0.f, 0.f, 0.f, 0.f, 0.f, 0.f, 0.f, 0.f, 0.f, 0.f, 0.f, 0.f, 0.f, 0.f}; o[1] = o[0]; }
#define ATT_LOADQ(Qrow_) bf16x8 qr[4]; _Pragma("unroll") for (int d0 = 0; d0 < 4; ++d0) qr[d0] = *(const GAS bf16x8*)((Qrow_) + d0 * 16 + hh * 8)

__device__ __forceinline__ void fox_unit(LAS unsigned char* shm, int b, int h, int qb, unsigned char* ws_, size_t off_p, size_t off_cb, size_t off_o, int wid, int& ring) {
    const int lane = lane_id_volatile();
    unsigned char* ws = ws_; asm volatile("" : "+s"(ws)); const bf16_t* P = (const bf16_t*)(ws + off_p); const float* CB = (const float*)(ws + off_cb); bf16_t* O = (bf16_t*)(ws + off_o);
    const int r32 = lane & 31, hh = lane >> 5;
    const int pos = 256 * qb + 32 * wid + r32;
    const size_t row = (size_t)b * T + pos;
    ATT_LOADQ(P + row * FOX_LDP + h * 64);
    const bf16_t* Kb = (const bf16_t*)(ws + off_p + FOX_HM_OFF) + (size_t)(b * NH + h) * T * 64; const bf16_t* Vb = Kb + FOX_HM_STRIDE;
    f32x16 o[2]; zero_o(o); float m = 0.f, l = 0.f;
    asm volatile("s_waitcnt lgkmcnt(0)" ::: "memory"); ATT_BAR();
    { const float* cb = CB + (size_t)(b * NH + h) * T; LAS float* kbl = (LAS float*)(shm + L_KB);
      for (int i = wid * 64 + lane; i < 64 * (4 * qb + 4); i += 512) kbl[i] = ((const GAS float*)cb)[i]; }
    sweep<1, false>(o, m, l, qr, Kb, Vb, 64, 0, 4 * qb + 4, 0, pos, 0u, shm, ring, wid, lane);
    const float lt = swap_sum(l); const float inv = lt > 0.f ? 1.0f / lt : 0.f;
    merge<true>(o, inv, shm, wid, r32, hh);
    store_o(O + ((size_t)b * T + 256 * qb + 32 * wid) * D + h * 64, shm, wid, lane);
}
__device__ __forceinline__ void swa_unit(LAS unsigned char* shm, int b, int g, int qt, unsigned char* ws_, size_t off_p, size_t off_o, const float* sinks, int wid, int& ring) {
    const int lane = lane_id_volatile();
    unsigned char* ws = ws_; asm volatile("" : "+s"(ws)); const bf16_t* P = (const bf16_t*)(ws + off_p); bf16_t* O = (bf16_t*)(ws + off_o);
    const int r32 = lane & 31, hh = lane >> 5;
    const int q0 = 32 * qt, pos = q0 + r32, head = 8 * g + wid;
    const size_t row = (size_t)b * T + pos;
    ATT_LOADQ(P + row * SWA_LDP + head * 64);
    const bf16_t* Kb = (const bf16_t*)(ws + off_p + SWA_HM_OFF) + (size_t)(b * 2 + g) * T * 64; const bf16_t* Vb = Kb + SWA_HM_STRIDE;
    f32x16 o[2]; zero_o(o); float m = 0.f, l = 0.f;
    const int tlo = (q0 - 127) > 0 ? ((q0 - 127) >> 6) : 0, thi = (q0 + 31) >> 6;
    sweep<0, true, true>(o, m, l, qr, Kb, Vb, 64, tlo, thi - tlo + 1, pos - 127, pos, 0u, shm, ring, wid, lane);
    const float lt = swap_sum(l) + __builtin_amdgcn_exp2f(((const GAS float*)sinks)[head] * LOG2E - m);
    const float inv = 1.0f / lt;
    merge<true>(o, inv, shm, wid, r32, hh);
    store_o(O + ((size_t)b * T + q0) * D + head * 64, shm, wid, lane);
}
__device__ __forceinline__ void nsa_unit(LAS unsigned char* shm, int b, int g, int qt, unsigned char* ws_, size_t off_p, size_t off_g, size_t off_kc, size_t off_vc, size_t off_o, int wid, int& ring) {
#define NSA_WS() unsigned char* ws = ws_; asm volatile("" : "+s"(ws)); const bf16_t* P = (const bf16_t*)(ws + off_p); const float* G = (const float*)(ws + off_g); const bf16_t* Hb = (const bf16_t*)(ws + off_p + NSA_HM_OFF) + (size_t)(b * 4 + g) * T * 64; (void)G; (void)Hb
    const int hq = 4 * g + (wid >> 1), ph = wid & 1, q0 = 64 * qt;
    LAS unsigned* PSUM = (LAS unsigned*)(shm + L_PSUM); LAS float* IMP = (LAS float*)(shm + L_IMP); LAS unsigned* SEL = (LAS unsigned*)(shm + L_SEL);
#define NSA_LANE() const int lane = lane_id_volatile(); const int r32 = lane & 31, hh = lane >> 5; const int pos = q0 + 32 * ph + r32; const size_t row = (size_t)b * T + pos; (void)hh; (void)row
#define NSA_QROW (P + row * NSA_LDP + hq * 64)
    asm volatile("s_waitcnt lgkmcnt(0)" ::: "memory"); ATT_BAR();
    { const int tid = wid * 64 + lane_id_volatile(); for (int i = tid; i < 8192; i += 512) PSUM[i] = 0u; }
    f32x16 ocmp[2]; float inv_cmp;
    {
        NSA_LANE(); NSA_WS();
        const bf16_t* Kb = (const bf16_t*)(ws + off_kc) + (size_t)(b * 4 + g) * NCP * 64; const bf16_t* Vb = (const bf16_t*)(ws + off_vc) + (size_t)(b * 4 + g) * NCP * 64;
        const int cm = (pos < 31) ? -1 : (((pos - 31) >> 4) < 126 ? ((pos - 31) >> 4) : 126);
        const int ntile = qt >= 16 ? 2 : 1;
        ATT_LOADQ(NSA_QROW);
        f32x16 o[2]; zero_o(o); float m = 0.f, l = 0.f;
        const int ring0 = ring;
        sweep<0, true>(o, m, l, qr, Kb, Vb, 64, 0, ntile, 0, cm, 0u, shm, ring, wid, lane);
        const float lt = swap_sum(l); const float inv = lt > 0.f ? 1.0f / lt : 0.f;
        f32x16 negm;
#pragma unroll
        for (int r = 0; r < 16; ++r) negm[r] = -m;
        for (int tile = 0; tile < ntile; ++tile) {
            const int sl = (ring0 + tile) & (NSLOT - 1);
            f32x16 p0, p1; qkt(p0, p1, shm, sl, qr, negm, r32, hh);
            range_mask(p0, p1, tile * 64 + 4 * hh, 0, cm);
            LAS unsigned* pb = PSUM + (tile * 64 + 4 * hh) * 64 + 32 * ph + r32;
            asm volatile("" : "+v"(pb));
#pragma unroll
            for (int r = 0; r < 16; ++r) {
                const float a = __builtin_amdgcn_exp2f(p0[r]) * inv, c = __builtin_amdgcn_exp2f(p1[r]) * inv;
                __hip_atomic_fetch_add(pb + ((r & 3) + 8 * (r >> 2)) * 64, (unsigned)(a * PFIX + 0.5f), __ATOMIC_RELAXED, __HIP_MEMORY_SCOPE_WORKGROUP);
                __hip_atomic_fetch_add(pb + ((r & 3) + 8 * (r >> 2) + 32) * 64, (unsigned)(c * PFIX + 0.5f), __ATOMIC_RELAXED, __HIP_MEMORY_SCOPE_WORKGROUP);
            }
        }
        ocmp[0] = o[0]; ocmp[1] = o[1]; inv_cmp = inv;
    }
    asm volatile("s_waitcnt lgkmcnt(0)" ::: "memory"); ATT_BAR();
    {
        const int tid = wid * 64 + lane_id_volatile();
        const int rw = tid & 63, ng = tid >> 6;
        LAS unsigned* pb = PSUM + (16 * ng - 1) * 64 + rw;
        LAS float* ib = IMP + (4 * ng) * 64 + rw;
        asm volatile("" : "+v"(pb), "+v"(ib));
        float pc[17];
#pragma unroll
        for (int e = 0; e < 17; ++e) pc[e] = (float)pb[e * 64] * (1.0f / PFIX);
        if (ng == 0) pc[0] = 0.f;
#pragma unroll
        for (int k = 0; k < 4; ++k) ib[k * 64] = pc[4 * k + 1] + pc[4 * k + 2] + pc[4 * k + 3] + 0.5f * (pc[4 * k + 4] + pc[4 * k]);
        const unsigned init = qt < 16 ? ((2u << qt) - 1u) : (1u | (1u << qt) | (1u << (qt - 1)));
        if (tid < 64) SEL[tid] = init;
    }
    asm volatile("s_waitcnt lgkmcnt(0)" ::: "memory"); ATT_BAR();
    if (qt >= 16) {
        const int tid = wid * 64 + lane_id_volatile();
        const int rw = tid & 63, ng = tid >> 6; unsigned bits = 0u;
        LAS float* ib = IMP + rw; asm volatile("" : "+v"(ib));
        float v[4]; int cnt[4] = {0, 0, 0, 0};
#pragma unroll
        for (int k = 0; k < 4; ++k) v[k] = ib[(4 * ng + k) * 64];
        for (int n2 = 1; n2 <= qt - 2; ++n2) { const float v2 = ib[n2 * 64];
#pragma unroll
            for (int k = 0; k < 4; ++k) cnt[k] += (v2 > v[k] || (v2 == v[k] && n2 < 4 * ng + k)) ? 1 : 0; }
#pragma unroll
        for (int k = 0; k < 4; ++k) { const int n = 4 * ng + k; if (n >= 1 && n <= qt - 2 && cnt[k] < 13) bits |= 1u << n; }
        if (bits) __hip_atomic_fetch_or(SEL + rw, bits, __ATOMIC_RELAXED, __HIP_MEMORY_SCOPE_WORKGROUP);
    }
    asm volatile("s_waitcnt lgkmcnt(0)" ::: "memory"); ATT_BAR();
    { NSA_LANE(); NSA_WS(); merge<true>(ocmp, ((const GAS float*)G)[row * 48 + hq * 3 + 0] * inv_cmp, shm, wid, r32, hh); }
    {
        NSA_LANE(); NSA_WS();
        const unsigned rowsel = SEL[32 * ph + r32];
        ATT_LOADQ(NSA_QROW);
        f32x16 o[2]; zero_o(o); float m = 0.f, l = 0.f;
        sweep<2, true>(o, m, l, qr, Hb, Hb + NSA_HM_STRIDE, 64, 0, qt + 1, 0, pos, rowsel, shm, ring, wid, lane);
        const float lt = swap_sum(l); const float inv = lt > 0.f ? 1.0f / lt : 0.f;
        merge<false>(o, ((const GAS float*)G)[row * 48 + hq * 3 + 1] * inv, shm, wid, r32, hh);
    }
    {
        NSA_LANE(); NSA_WS();
        ATT_LOADQ(NSA_QROW);
        f32x16 o[2]; zero_o(o); float m = 0.f, l = 0.f;
        const int tlo = qt > 8 ? qt - 8 : 0;
        sweep<0, true>(o, m, l, qr, Hb + 2 * NSA_HM_STRIDE, Hb + 3 * NSA_HM_STRIDE, 64, tlo, qt - tlo + 1, pos - 511, pos, 0u, shm, ring, wid, lane);
        const float lt = swap_sum(l); const float inv = lt > 0.f ? 1.0f / lt : 0.f;
        merge<false>(o, ((const GAS float*)G)[row * 48 + hq * 3 + 2] * inv, shm, wid, r32, hh);
    }
    { unsigned char* ws = ws_; asm volatile("" : "+s"(ws)); store_o((bf16_t*)(ws + off_o) + ((size_t)b * T + q0 + 32 * ph) * D + hq * 64, shm, wid, lane_id_volatile()); }
#undef NSA_WS
#undef NSA_LANE
#undef NSA_QROW
}
#undef ATT_LOADQ
#undef ATT_BAR
}

constexpr size_t MiB = 1u << 20;
constexpr size_t WS_CTL = 0, CTL_ZERO_BYTES = 1 * MiB;
constexpr size_t WS_WUP = 1 * MiB, WS_WDN = 33 * MiB;
constexpr size_t WS_WNSA = 65 * MiB, WNSA_STRIDE = (size_t)NSA_NP * D * 2;
constexpr size_t WS_WOUT = 76 * MiB;
constexpr size_t WS_WFOX = 84 * MiB;
constexpr size_t WS_WSWA = 84 * MiB + 6656 * 1024;
constexpr size_t WS_WCMP = 93 * MiB;
constexpr size_t WS_ROPEC = 97 * MiB, WS_ROPES = WS_ROPEC + 256 * 1024;
constexpr size_t WS_CMPB = WS_ROPES + 256 * 1024;
constexpr size_t WS_SWAB = WS_CMPB + 64 * 1024;
constexpr size_t WS_WGATE = 99 * MiB;
constexpr size_t WS_RSTD = 98 * MiB;
constexpr size_t WS_XN = 100 * MiB;
constexpr size_t WS_BIG = 164 * MiB;
constexpr size_t WS_O = WS_BIG + 192 * MiB;
constexpr size_t WS_G = 420 * MiB, WS_LF = 426 * MiB, WS_CB = 428 * MiB, WS_KC = 430 * MiB, WS_VC = 431 * MiB, WS_HID = 432 * MiB, WS_M2 = 440 * MiB, WS_END = 504 * MiB;
static_assert(WS_WSWA + (size_t)SWA_NP * D * 2 <= WS_WCMP && WS_WFOX + (size_t)FOX_NP * D * 2 <= WS_WSWA && WS_WNSA + 2 * WNSA_STRIDE <= WS_WOUT && WS_SWAB + 8192 <= WS_XN, "d_ws map");
static_assert((size_t)M * FF * 2 == 256 * MiB && WS_O + (size_t)M * D * 2 == WS_G && (size_t)M * 3072 * 2 == 192 * MiB, "d_ws map");
constexpr int CW_TMO = 0, CW_BAR = 4096;

constexpr int RING_OFF = 0, RING_BYTES = 142336;
constexpr int LDSCTL_OFF = RING_BYTES, MISC_OFF = LDSCTL_OFF + 320;
constexpr int LDS_BYTES = 147456;
static_assert(att::L_END <= RING_BYTES && MISC_OFF + 128 <= LDS_BYTES, "LDS map");
constexpr int NWAVES = 8;
#ifndef L_LO
#define L_LO 0
#endif
#ifndef L_HI
#define L_HI DEPTH
#endif

typedef GAS unsigned gu32;
typedef GAS unsigned long long gu64;
#define RLX_AGENT __ATOMIC_RELAXED, __HIP_MEMORY_SCOPE_AGENT
#define LDS_WAIT() asm volatile("s_waitcnt lgkmcnt(0)" ::: "memory")
#define VM_WAIT() asm volatile("s_waitcnt vmcnt(0)" ::: "memory")
__device__ __forceinline__ unsigned long long rt() { return __builtin_amdgcn_s_memrealtime(); }
__device__ __forceinline__ unsigned f2bf(float f) { unsigned u = __builtin_bit_cast(unsigned, f); return (u + 0x7fffu + ((u >> 16) & 1u)) >> 16; }
__device__ __forceinline__ unsigned pk2(float lo, float hi) { return f2bf(lo) | (f2bf(hi) << 16); }

#define XB_TMO      128
#define XB_XCNT(j)  (256  + 64 * (j))
#define XB_XSUB(j)  (1280 + 64 * (j))
#define XB_XGEN(j)  (2304 + 64 * (j))
#define XB_TOP      3328
#define XB_TOPGEN   3392
#define XCD_BAR_WORDS 3456
#define XB_SPIN_CAP (1u << 18)

__device__ __forceinline__ unsigned xb_ld(unsigned* p)              { return __hip_atomic_load(p, __ATOMIC_RELAXED, __HIP_MEMORY_SCOPE_AGENT); }
__device__ __forceinline__ unsigned xb_add(unsigned* p, unsigned v) { return __hip_atomic_fetch_add(p, v, __ATOMIC_RELAXED, __HIP_MEMORY_SCOPE_AGENT); }
__device__ __forceinline__ unsigned xb_xcc_id() { return (unsigned)__builtin_amdgcn_s_getreg((3 << 11) | 20) & 0xFu; }
#define XB_SPIN(cond, bar) do { unsigned _sp = 0; while (cond) { __builtin_amdgcn_s_sleep(1); \
    if ((++_sp & 255u) == 0u) { if (xb_ld(&(bar)[XB_TMO])) break; if (_sp > XB_SPIN_CAP) { atomicAdd(&(bar)[XB_TMO], 1u); break; } } } } while (0)

struct XcdBarrier {
    unsigned* bar; unsigned x;
    volatile LAS unsigned* st;
};

__device__ __forceinline__ XcdBarrier xcd_barrier_post(unsigned* bar, volatile LAS unsigned* st) {
    XcdBarrier b; b.bar = bar; b.x = xb_xcc_id(); b.st = st;
    if (threadIdx.x == 0) (void)xb_add(&bar[XB_XCNT(b.x)], 1u);
    return b;
}
__device__ __forceinline__ void xcd_barrier_complete(unsigned* bar, unsigned x, unsigned& nloc, unsigned& nx) {
    const unsigned G = gridDim.x * gridDim.y * gridDim.z;
    unsigned sum, cnt, mine, sp = 0u;
    for (;;) {
        sum = 0u; cnt = 0u; mine = 0u;
#pragma unroll
        for (unsigned j = 0; j < 16; ++j) { const unsigned c = xb_ld(&bar[XB_XCNT(j)]); sum += c; cnt += (c > 0u) ? 1u : 0u; mine = (j == x) ? c : mine; }
        if (sum == G) break;
        __builtin_amdgcn_s_sleep(1);
        if ((++sp & 255u) == 0u) { if (xb_ld(&bar[XB_TMO])) break; if (sp > XB_SPIN_CAP) { atomicAdd(&bar[XB_TMO], 1u); break; } }
    }
    nloc = mine > 0u ? mine : 1u; nx = cnt > 0u ? cnt : 1u;
}

__device__ __forceinline__ void xcd_barrier(const XcdBarrier& b) {
    asm volatile("s_waitcnt vmcnt(0)" ::: "memory");
    __syncthreads();
    if (threadIdx.x == 0) {
        unsigned* bar = b.bar;
        __builtin_amdgcn_s_waitcnt(0);
        unsigned nloc = b.st[0], nx = b.st[1];
        if (nloc == 0u) { xcd_barrier_complete(bar, b.x, nloc, nx); b.st[0] = nloc; b.st[1] = nx; }
        const unsigned old = xb_add(&bar[XB_XSUB(b.x)], 1u);
        const unsigned gen = old / nloc;
        if (old + 1u == (gen + 1u) * nloc) {
            __builtin_amdgcn_fence(__ATOMIC_RELEASE, "agent");
            asm volatile("s_waitcnt vmcnt(0)" ::: "memory");
            const unsigned og = xb_add(&bar[XB_TOP], 1u);
            const unsigned tg = og / nx;
            if (og + 1u == (tg + 1u) * nx) xb_add(&bar[XB_TOPGEN], 1u);
            else XB_SPIN(xb_ld(&bar[XB_TOPGEN]) == tg, bar);
            __builtin_amdgcn_fence(__ATOMIC_ACQUIRE, "agent");
            xb_add(&bar[XB_XGEN(b.x)], 1u);
            asm volatile("s_waitcnt vmcnt(0)" ::: "memory");
        } else {
            XB_SPIN(xb_ld(&bar[XB_XGEN(b.x)]) == gen, bar);
            __builtin_amdgcn_fence(__ATOMIC_ACQUIRE, "agent");
            asm volatile("s_waitcnt vmcnt(0)" ::: "memory");
        }
    }
    __syncthreads();
}

__device__ __forceinline__ float wave_sum(float v) {
    v += __builtin_bit_cast(float, __builtin_amdgcn_update_dpp(0, __builtin_bit_cast(int, v), 0xB1, 0xF, 0xF, true));
    v += __builtin_bit_cast(float, __builtin_amdgcn_update_dpp(0, __builtin_bit_cast(int, v), 0x4E, 0xF, 0xF, true));
    v += __builtin_bit_cast(float, __builtin_amdgcn_update_dpp(0, __builtin_bit_cast(int, v), 0x141, 0xF, 0xF, true));
    v += __builtin_bit_cast(float, __builtin_amdgcn_update_dpp(0, __builtin_bit_cast(int, v), 0x140, 0xF, 0xF, true));
    v += __builtin_bit_cast(float, __builtin_amdgcn_ds_swizzle(__builtin_bit_cast(int, v), 0x401F));
    { auto rr = __builtin_amdgcn_permlane32_swap(__float_as_uint(v), __float_as_uint(v), false, false); v = __uint_as_float(rr[0]) + __uint_as_float(rr[1]); }
    return v;
}

__device__ __forceinline__ int il64(int c) { return (c >> 1) + 32 * (c & 1); }
__device__ __forceinline__ int li64(int d) { return 2 * (d & 31) + (d >> 5); }
__device__ __forceinline__ int src_n(int mode, int n) { return (mode == 3 && n < 1152) ? (n & ~63) + il64(n & 63) : n; }
__device__ __forceinline__ int dst_n(int mode, int n) {
    if (mode == 1) { const int reg = n >> 8; const bool rope = reg < 4 || reg == 4 || reg == 6 || reg == 8; return rope ? (n & ~63) + li64(n & 63) : n; }
    if (mode == 3) return n < 1152 ? (n & ~63) + li64(n & 63) : n;
    return n;
}
__device__ __forceinline__ void conv_item(const float* W, int K, int N, bf16_t* WT, int mode, int item, LAS float* scr, int lane, int ld = 0) {
    if (ld == 0) ld = N;
    const int nblk = (N + 31) / 32, kb = item / nblk, nb = item % nblk, k0 = 64 * kb, n0 = 32 * nb;
    const int c4 = (lane & 7) * 4; const bool cin = (n0 + c4) < N;
#pragma unroll
    for (int i = 0; i < 8; ++i) { const int kk = (lane >> 3) + 8 * i; const int kd = (mode == 4) ? li64(kk) : kk;
        const f32x4 v = cin ? *(const GAS f32x4*)(W + (size_t)(k0 + kk) * ld + n0 + c4) : (f32x4){0.f, 0.f, 0.f, 0.f};
        scr[kd * 33 + c4] = v[0]; scr[kd * 33 + c4 + 1] = v[1]; scr[kd * 33 + c4 + 2] = v[2]; scr[kd * 33 + c4 + 3] = v[3]; }
    LDS_WAIT(); asm volatile("" ::: "memory");
    const int c = lane & 7;
#pragma unroll
    for (int j = 0; j < 4; ++j) { const int n = (lane >> 3) + 8 * j; const LAS float* s = scr + (8 * c) * 33 + n;
        u32x4 o; o.x = pk2(s[0 * 33], s[1 * 33]); o.y = pk2(s[2 * 33], s[3 * 33]); o.z = pk2(s[4 * 33], s[5 * 33]); o.w = pk2(s[6 * 33], s[7 * 33]);
        if (n0 + n < N) *(GAS u32x4*)(WT + (size_t)dst_n(mode, n0 + n) * K + k0 + 8 * c) = o; }
    LDS_WAIT(); asm volatile("" ::: "memory");
}
__device__ __forceinline__ void norm_row(const float* xrow, const float* g, bf16_t* orow, float* rstd_out, int lane) {
    f32x4 v[4]; float s = 0.f;
#pragma unroll
    for (int j = 0; j < 4; ++j) { v[j] = ((const GAS f32x4*)xrow)[lane + 64 * j]; s += (v[j][0] * v[j][0] + v[j][1] * v[j][1]) + (v[j][2] * v[j][2] + v[j][3] * v[j][3]); }
    const float rstd = 1.0f / sqrtf(wave_sum(s) * (1.0f / D) + NORM_EPS);
#pragma unroll
    for (int j = 0; j < 4; ++j) { const f32x4 gg = ((const GAS f32x4*)g)[lane + 64 * j]; u32x2 w; w.x = pk2(v[j][0] * rstd * gg[0], v[j][1] * rstd * gg[1]); w.y = pk2(v[j][2] * rstd * gg[2], v[j][3] * rstd * gg[3]);
        ((GAS u32x2*)orow)[lane + 64 * j] = w; }
    if (lane == 0) *rstd_out = rstd;
}
__device__ __forceinline__ void unpack4(u32x2 w, f32x4& o) { o[0] = __uint_as_float(w.x << 16); o[1] = __uint_as_float(w.x & 0xffff0000u); o[2] = __uint_as_float(w.y << 16); o[3] = __uint_as_float(w.y & 0xffff0000u); }
struct RowIn { f32x4 xv[4]; u32x2 mw[4]; float inv_rstd; };
__device__ __forceinline__ void resnorm_load(RowIn& R, const float* xin_f32, const bf16_t* xn, const float* rstd_io, const bf16_t* mrow, int lane) {
    if (xin_f32) {
#pragma unroll
        for (int j = 0; j < 4; ++j) R.xv[j] = ((const GAS f32x4*)xin_f32)[lane + 64 * j];
        R.inv_rstd = 1.f;
    } else {
#pragma unroll
        for (int j = 0; j < 4; ++j) { const u32x2 w = ((const GAS u32x2*)xn)[lane + 64 * j]; R.xv[j][0] = __uint_as_float(w.x); R.xv[j][1] = __uint_as_float(w.y); }
        R.inv_rstd = 1.0f / *(const GAS float*)rstd_io;
    }
#pragma unroll
    for (int j = 0; j < 4; ++j) R.mw[j] = ((const GAS u32x2*)mrow)[lane + 64 * j];
}
__device__ __forceinline__ void resnorm_finish(RowIn& R, bool from_f32, bf16_t* xn, float* rstd_io, const float* gcur, const float* gpost, const float* gnext, float* xout_f32, int lane) {
    f32x4 xv[4], mv[4]; float s = 0.f;
    if (from_f32) {
#pragma unroll
        for (int j = 0; j < 4; ++j) xv[j] = R.xv[j];
    } else {
#pragma unroll
        for (int j = 0; j < 4; ++j) { u32x2 w; w.x = __float_as_uint(R.xv[j][0]); w.y = __float_as_uint(R.xv[j][1]); unpack4(w, xv[j]); const f32x4 gg = ((const GAS f32x4*)gcur)[lane + 64 * j];
#pragma unroll
            for (int e = 0; e < 4; ++e) xv[j][e] = xv[j][e] * R.inv_rstd / gg[e]; }
    }
#pragma unroll
    for (int j = 0; j < 4; ++j) { unpack4(R.mw[j], mv[j]); s += (mv[j][0] * mv[j][0] + mv[j][1] * mv[j][1]) + (mv[j][2] * mv[j][2] + mv[j][3] * mv[j][3]); }
    const float rstd = 1.0f / sqrtf(wave_sum(s) * (1.0f / D) + NORM_EPS);
    float s2 = 0.f;
#pragma unroll
    for (int j = 0; j < 4; ++j) { const f32x4 gg = ((const GAS f32x4*)gpost)[lane + 64 * j];
#pragma unroll
        for (int e = 0; e < 4; ++e) { xv[j][e] += mv[j][e] * rstd * gg[e]; s2 += xv[j][e] * xv[j][e]; } }
    if (gnext) {
        const float rstd2 = 1.0f / sqrtf(wave_sum(s2) * (1.0f / D) + NORM_EPS);
#pragma unroll
        for (int j = 0; j < 4; ++j) { const f32x4 gg = ((const GAS f32x4*)gnext)[lane + 64 * j]; u32x2 w; w.x = pk2(xv[j][0] * rstd2 * gg[0], xv[j][1] * rstd2 * gg[1]); w.y = pk2(xv[j][2] * rstd2 * gg[2], xv[j][3] * rstd2 * gg[3]);
            ((GAS u32x2*)xn)[lane + 64 * j] = w; }
        if (lane == 0) *rstd_io = rstd2;
    } else {
#pragma unroll
        for (int j = 0; j < 4; ++j) ((GAS f32x4*)xout_f32)[lane + 64 * j] = xv[j];
    }
}
__device__ __forceinline__ void resnorm_rows2(int m0, int m1, const float* xin_f32, bf16_t* XN, float* RSTD, const float* gcur, const bf16_t* MB, const float* gpost, const float* gnext, float* xout_f32, int lane) {
    RowIn A, B;
    resnorm_load(A, xin_f32 ? xin_f32 + (size_t)m0 * D : nullptr, XN + (size_t)m0 * D, RSTD + m0, MB + (size_t)m0 * D, lane);
    resnorm_load(B, xin_f32 ? xin_f32 + (size_t)m1 * D : nullptr, XN + (size_t)m1 * D, RSTD + m1, MB + (size_t)m1 * D, lane);
    resnorm_finish(A, xin_f32 != nullptr, XN + (size_t)m0 * D, RSTD + m0, gcur, gpost, gnext, xout_f32 ? xout_f32 + (size_t)m0 * D : nullptr, lane);
    resnorm_finish(B, xin_f32 != nullptr, XN + (size_t)m1 * D, RSTD + m1, gcur, gpost, gnext, xout_f32 ? xout_f32 + (size_t)m1 * D : nullptr, lane);
}

struct Args { const float* in[17]; float* out; unsigned char* ws; };
constexpr int PT_OFF = LDSCTL_OFF;
__device__ __forceinline__ unsigned char* ldptr(LAS unsigned char* lds, int idx) {
    const volatile LAS unsigned* p = (const volatile LAS unsigned*)(lds + PT_OFF + idx * 8);
    const unsigned lo = (unsigned)__builtin_amdgcn_readfirstlane((int)p[0]), hi = (unsigned)__builtin_amdgcn_readfirstlane((int)p[1]);
    return (unsigned char*)(((unsigned long long)hi << 32) | lo);
}
#define INP(i) ((const float*)ldptr(lds, (i)))
#define OUTP ((float*)ldptr(lds, 17))
#define WSP (ldptr(lds, 18))
#define IDS int tid_ = wave_s * 64 + lane_id_volatile(); const int tid = tid_, lane = tid & 63, wave = wave_s; const int G = gridDim.x, bx = blockIdx.x; \
    const int vcu = (G % 8 == 0) ? (bx % 8) * (G / 8) + bx / 8 : bx; const int gw = vcu * NWAVES + wave, NGW = G * NWAVES; (void)lane; (void)gw; (void)NGW; (void)vcu; (void)bx; (void)tid; (void)wave
template <int MODE, int AMODE>
__device__ __forceinline__ void run_gemm(LAS unsigned char* lds, const bf16_t* A, const bf16_t* Bt, int Mr, int N, int K, const pg8::Epi<MODE>& E, int wave_s, int ord_g = 0, int ord_c = 0) {
    pg8::Gemm g{A, Bt, Mr, N, K}; pg8::StaticOrder S; if (ord_g) S.init(Mr, N, ord_g, ord_c); else S.init(Mr, N, (int)gridDim.x, (int)blockIdx.x);
#ifndef NO_GEMM
#ifdef ONLY_MODE
    if (MODE == ONLY_MODE)
#endif
    pg8::gemm_phase<pg8::Epi<MODE>, pg8::StaticOrder, AMODE, true, true>(lds, g, S, E, wave_s);
#endif
}

#ifndef REP_GIN
#define REP_GIN 1
#endif
#ifndef REP_CMP
#define REP_CMP 1
#endif
#ifndef REP_SCAN
#define REP_SCAN 1
#endif
#ifndef REP_ATT_NSA
#define REP_ATT_NSA 1
#endif
#ifndef REP_ATT_FOX
#define REP_ATT_FOX 1
#endif
#ifndef REP_ATT_SWA
#define REP_ATT_SWA 1
#endif
#ifndef REP_GOUT
#define REP_GOUT 1
#endif
#ifndef REP_MLP
#define REP_MLP 1
#endif
#ifndef REP_PRO
#define REP_PRO 1
#endif
template <int L>
__device__ __forceinline__ void layer_body(LAS unsigned char* lds, const XcdBarrier& bar, int& aslot, const int wave_s) {
#define GRID_BAR() xcd_barrier(bar)
    constexpr int kind = L % 3, sl = L / 3;
    if (kind == 0) {
        { unsigned char* ws = WSP;
          pg8::Epi<pg8::EM_NSA> E{(bf16_t*)(ws + WS_BIG), NSA_LDP, nullptr, (const float*)(ws + WS_ROPEC), (const float*)(ws + WS_ROPES), (float*)(ws + WS_G), nullptr, (bf16_t*)(ws + WS_BIG + NSA_HM_OFF), NSA_HM_STRIDE};
          run_gemm<pg8::EM_NSA, 0>(lds + RING_OFF, (const bf16_t*)(ws + WS_XN), (const bf16_t*)(ws + WS_WNSA) + (size_t)sl * NSA_NP * D, M, NSA_NP, D, E, wave_s); }
        GRID_BAR();
#if REP_GIN >= 2
        { unsigned char* ws = WSP;
          pg8::Epi<pg8::EM_NSA> E{(bf16_t*)(ws + WS_BIG), NSA_LDP, nullptr, (const float*)(ws + WS_ROPEC), (const float*)(ws + WS_ROPES), (float*)(ws + WS_G), nullptr, (bf16_t*)(ws + WS_BIG + NSA_HM_OFF), NSA_HM_STRIDE};
          run_gemm<pg8::EM_NSA, 0>(lds + RING_OFF, (const bf16_t*)(ws + WS_XN), (const bf16_t*)(ws + WS_WNSA) + (size_t)sl * NSA_NP * D, M, NSA_NP, D, E, wave_s); }
        GRID_BAR();
#endif
        if ((int)blockIdx.x < 64) { unsigned char* ws = WSP;
          pg8::Epi<pg8::EM_CMP> E{(bf16_t*)(ws + WS_HID), 256, (const float*)(ws + WS_CMPB) + sl * 512, nullptr, nullptr, nullptr, nullptr, nullptr, 0};
          run_gemm<pg8::EM_CMP, 1>(lds + RING_OFF, (const bf16_t*)(ws + WS_BIG) + 1024, (const bf16_t*)(ws + WS_WCMP) + (size_t)sl * 2 * 256 * 2048, CMP_ROWS, 512, 2048, E, wave_s); }
        else { unsigned char* ws = WSP;
          pg8::Epi<pg8::EM_GATE> E{nullptr, 0, nullptr, nullptr, nullptr, (float*)(ws + WS_G), nullptr, nullptr, 0};
          run_gemm<pg8::EM_GATE, 0>(lds + RING_OFF, (const bf16_t*)(ws + WS_XN), (const bf16_t*)(ws + WS_WGATE) + (size_t)sl * 256 * D, M, 256, D, E, wave_s, 192, (int)blockIdx.x - 64); }
        GRID_BAR();
#if REP_CMP >= 2
        if ((int)blockIdx.x < 64) { unsigned char* ws = WSP;
          pg8::Epi<pg8::EM_CMP> E{(bf16_t*)(ws + WS_HID), 256, (const float*)(ws + WS_CMPB) + sl * 512, nullptr, nullptr, nullptr, nullptr, nullptr, 0};
          run_gemm<pg8::EM_CMP, 1>(lds + RING_OFF, (const bf16_t*)(ws + WS_BIG) + 1024, (const bf16_t*)(ws + WS_WCMP) + (size_t)sl * 2 * 256 * 2048, CMP_ROWS, 512, 2048, E, wave_s); }
        else { unsigned char* ws = WSP;
          pg8::Epi<pg8::EM_GATE> E{nullptr, 0, nullptr, nullptr, nullptr, (float*)(ws + WS_G), nullptr, nullptr, 0};
          run_gemm<pg8::EM_GATE, 0>(lds + RING_OFF, (const bf16_t*)(ws + WS_XN), (const bf16_t*)(ws + WS_WGATE) + (size_t)sl * 256 * D, M, 256, D, E, wave_s, 192, (int)blockIdx.x - 64); }
        GRID_BAR();
#endif
        { IDS; unsigned char* ws = WSP; const bf16_t* HID = (const bf16_t*)(ws + WS_HID); const float* nsa_w2 = INP(7);
          const int which = bx >> 7, wl = bx & 127;
          LAS float* w2s = (LAS float*)(lds + RING_OFF);
          { const GAS f32x4* w2g = (const GAS f32x4*)(nsa_w2 + (size_t)(sl * 2 + which) * 256 * 64); for (int i = tid; i < 4096; i += 512) ((LAS f32x4*)w2s)[i] = w2g[i]; }
          __syncthreads();
          const int r0 = (wl * 8 + wave) * 8;
          float f[8][4], acc[8];
#pragma unroll
          for (int q = 0; q < 8; ++q) { const u32x2 hw = *(const GAS u32x2*)(HID + ((size_t)which * CMP_ROWS + r0 + q) * 256 + 4 * lane);
              f[q][0] = __uint_as_float(hw.x << 16); f[q][1] = __uint_as_float(hw.x & 0xffff0000u); f[q][2] = __uint_as_float(hw.y << 16); f[q][3] = __uint_as_float(hw.y & 0xffff0000u); acc[q] = 0.f; }
          const LAS float* wcol = w2s + (which ? lane : il64(lane));
          for (int jj = 0; jj < 64; ++jj) {
#pragma unroll
              for (int s = 0; s < 4; ++s) { const float w = wcol[(4 * jj + s) * 64];
#pragma unroll
                  for (int q = 0; q < 8; ++q) acc[q] += __builtin_bit_cast(float, __builtin_amdgcn_readlane(__builtin_bit_cast(int, f[q][s]), jj)) * w; }
          }
          bf16_t* dstb = (bf16_t*)(ws + (which ? WS_VC : WS_KC));
#pragma unroll
          for (int q = 0; q < 8; ++q) { const int r = r0 + q, gg = r & 3, c = (r >> 2) & 127, b = r >> 9;
              dstb[(size_t)((b * 4 + gg) * NCP + c) * 64 + lane] = (bf16_t)f2bf(c == NC ? 0.f : acc[q]); }
          __syncthreads();
        }
        GRID_BAR();
#if REP_CMP >= 2
        { IDS; unsigned char* ws = WSP; const bf16_t* HID = (const bf16_t*)(ws + WS_HID); const float* nsa_w2 = INP(7);
          const int which = bx >> 7, wl = bx & 127;
          LAS float* w2s = (LAS float*)(lds + RING_OFF);
          { const GAS f32x4* w2g = (const GAS f32x4*)(nsa_w2 + (size_t)(sl * 2 + which) * 256 * 64); for (int i = tid; i < 4096; i += 512) ((LAS f32x4*)w2s)[i] = w2g[i]; }
          __syncthreads();
          const int r0 = (wl * 8 + wave) * 8;
          float f[8][4], acc[8];
#pragma unroll
          for (int q = 0; q < 8; ++q) { const u32x2 hw = *(const GAS u32x2*)(HID + ((size_t)which * CMP_ROWS + r0 + q) * 256 + 4 * lane);
              f[q][0] = __uint_as_float(hw.x << 16); f[q][1] = __uint_as_float(hw.x & 0xffff0000u); f[q][2] = __uint_as_float(hw.y << 16); f[q][3] = __uint_as_float(hw.y & 0xffff0000u); acc[q] = 0.f; }
          const LAS float* wcol = w2s + (which ? lane : il64(lane));
          for (int jj = 0; jj < 64; ++jj) {
#pragma unroll
              for (int s = 0; s < 4; ++s) { const float w = wcol[(4 * jj + s) * 64];
#pragma unroll
                  for (int q = 0; q < 8; ++q) acc[q] += __builtin_bit_cast(float, __builtin_amdgcn_readlane(__builtin_bit_cast(int, f[q][s]), jj)) * w; }
          }
          bf16_t* dstb = (bf16_t*)(ws + (which ? WS_VC : WS_KC));
#pragma unroll
          for (int q = 0; q < 8; ++q) { const int r = r0 + q, gg = r & 3, c = (r >> 2) & 127, b = r >> 9;
              dstb[(size_t)((b * 4 + gg) * NCP + c) * 64 + lane] = (bf16_t)f2bf(c == NC ? 0.f : acc[q]); }
          __syncthreads();
        }
        GRID_BAR();
#endif
        { IDS; unsigned char* ws = WSP;
          const int bg = vcu >> 2, sub = vcu & 3, b = bg >> 2, g = bg & 3;
          for (int i = 0; i < 8; ++i) { const int qt = (i & 1) ? (8 * (i >> 1) + 7 - sub) : (8 * (i >> 1) + sub);
#ifndef NO_NSA
              att::nsa_unit(lds + RING_OFF, b, g, qt, ws, WS_BIG, WS_G, WS_KC, WS_VC, WS_O, wave, aslot);
#endif
          } }
#if REP_ATT_NSA >= 2
        GRID_BAR();
        { IDS; unsigned char* ws = WSP;
          const int bg = vcu >> 2, sub = vcu & 3, b = bg >> 2, g = bg & 3;
          for (int i = 0; i < 8; ++i) { const int qt = (i & 1) ? (8 * (i >> 1) + 7 - sub) : (8 * (i >> 1) + sub);
#ifndef NO_NSA
              att::nsa_unit(lds + RING_OFF, b, g, qt, ws, WS_BIG, WS_G, WS_KC, WS_VC, WS_O, wave, aslot);
#endif
          } }
#endif
    } else if (kind == 1) {
        { unsigned char* ws = WSP;
          pg8::Epi<pg8::EM_FOX> E{(bf16_t*)(ws + WS_BIG), FOX_LDP, nullptr, nullptr, nullptr, (float*)(ws + WS_LF), INP(10), (bf16_t*)(ws + WS_BIG + FOX_HM_OFF), FOX_HM_STRIDE};
          run_gemm<pg8::EM_FOX, 0>(lds + RING_OFF, (const bf16_t*)(ws + WS_XN), (const bf16_t*)(ws + WS_WFOX), M, FOX_NP, D, E, wave_s); }
        GRID_BAR();
#if REP_GIN >= 2
        { unsigned char* ws = WSP;
          pg8::Epi<pg8::EM_FOX> E{(bf16_t*)(ws + WS_BIG), FOX_LDP, nullptr, nullptr, nullptr, (float*)(ws + WS_LF), INP(10), (bf16_t*)(ws + WS_BIG + FOX_HM_OFF), FOX_HM_STRIDE};
          run_gemm<pg8::EM_FOX, 0>(lds + RING_OFF, (const bf16_t*)(ws + WS_XN), (const bf16_t*)(ws + WS_WFOX), M, FOX_NP, D, E, wave_s); }
        GRID_BAR();
#endif
        { IDS; unsigned char* ws = WSP; const float* LF = (const float*)(ws + WS_LF); float* CB = (float*)(ws + WS_CB);
          if (wave == 0) for (int bh = bx; bh < BATCH * NH; bh += G) {
            const int b = bh >> 4, h = bh & 15; float v[32]; float run = 0.f;
#pragma unroll
            for (int i = 0; i < 32; ++i) { run += LF[((size_t)b * T + 32 * lane + i) * 16 + h]; v[i] = run; }
            float excl = 0.f;
            for (int k = 0; k < 63; ++k) { const float t = __builtin_bit_cast(float, __builtin_amdgcn_readlane(__builtin_bit_cast(int, run), k)); if (lane > k) excl += t; }
#pragma unroll
            for (int i = 0; i < 32; ++i) CB[(size_t)bh * T + 32 * lane + i] = -(v[i] + excl) * LOG2E;
          } }
        GRID_BAR();
#if REP_SCAN >= 2
        { IDS; unsigned char* ws = WSP; const float* LF = (const float*)(ws + WS_LF); float* CB = (float*)(ws + WS_CB);
          if (wave == 0) for (int bh = bx; bh < BATCH * NH; bh += G) {
            const int b = bh >> 4, h = bh & 15; float v[32]; float run = 0.f;
#pragma unroll
            for (int i = 0; i < 32; ++i) { run += LF[((size_t)b * T + 32 * lane + i) * 16 + h]; v[i] = run; }
            float excl = 0.f;
            for (int k = 0; k < 63; ++k) { const float t = __builtin_bit_cast(float, __builtin_amdgcn_readlane(__builtin_bit_cast(int, run), k)); if (lane > k) excl += t; }
#pragma unroll
            for (int i = 0; i < 32; ++i) CB[(size_t)bh * T + 32 * lane + i] = -(v[i] + excl) * LOG2E;
          } }
        GRID_BAR();
#endif
        { IDS; unsigned char* ws = WSP;
          const int xcd = vcu >> 5, c = vcu & 31, sub = c & 3;
          for (int i = 0; i < 8; ++i) { const int bh = 32 * xcd + 8 * (i >> 1) + (c >> 2); const int qb = (i & 1) ? sub : 7 - sub;
#ifndef NO_FOX
              att::fox_unit(lds + RING_OFF, bh >> 4, bh & 15, qb, ws, WS_BIG, WS_CB, WS_O, wave, aslot);
#endif
          } }
#if REP_ATT_FOX >= 2
        GRID_BAR();
        { IDS; unsigned char* ws = WSP;
          const int xcd = vcu >> 5, c = vcu & 31, sub = c & 3;
          for (int i = 0; i < 8; ++i) { const int bh = 32 * xcd + 8 * (i >> 1) + (c >> 2); const int qb = (i & 1) ? sub : 7 - sub;
#ifndef NO_FOX
              att::fox_unit(lds + RING_OFF, bh >> 4, bh & 15, qb, ws, WS_BIG, WS_CB, WS_O, wave, aslot);
#endif
          } }
#endif
    } else {
        { unsigned char* ws = WSP;
          pg8::Epi<pg8::EM_SWA> E{(bf16_t*)(ws + WS_BIG), SWA_LDP, (const float*)(ws + WS_SWAB), (const float*)(ws + WS_ROPEC), (const float*)(ws + WS_ROPES), nullptr, nullptr, (bf16_t*)(ws + WS_BIG + SWA_HM_OFF), SWA_HM_STRIDE};
          run_gemm<pg8::EM_SWA, 0>(lds + RING_OFF, (const bf16_t*)(ws + WS_XN), (const bf16_t*)(ws + WS_WSWA), M, SWA_NP, D, E, wave_s); }
        GRID_BAR();
#if REP_GIN >= 2
        { unsigned char* ws = WSP;
          pg8::Epi<pg8::EM_SWA> E{(bf16_t*)(ws + WS_BIG), SWA_LDP, (const float*)(ws + WS_SWAB), (const float*)(ws + WS_ROPEC), (const float*)(ws + WS_ROPES), nullptr, nullptr, (bf16_t*)(ws + WS_BIG + SWA_HM_OFF), SWA_HM_STRIDE};
          run_gemm<pg8::EM_SWA, 0>(lds + RING_OFF, (const bf16_t*)(ws + WS_XN), (const bf16_t*)(ws + WS_WSWA), M, SWA_NP, D, E, wave_s); }
        GRID_BAR();
#endif
        { IDS; unsigned char* ws = WSP; const float* sinks = INP(14);
          const int bg = vcu >> 3, sub = vcu & 7;
          for (int i = 0; i < 8; ++i) {
#ifndef NO_SWA
              att::swa_unit(lds + RING_OFF, bg >> 1, bg & 1, 8 * i + sub, ws, WS_BIG, WS_O, sinks, wave, aslot);
#endif
          } }
#if REP_ATT_SWA >= 2
        GRID_BAR();
        { IDS; unsigned char* ws = WSP; const float* sinks = INP(14);
          const int bg = vcu >> 3, sub = vcu & 7;
          for (int i = 0; i < 8; ++i) {
#ifndef NO_SWA
              att::swa_unit(lds + RING_OFF, bg >> 1, bg & 1, 8 * i + sub, ws, WS_BIG, WS_O, sinks, wave, aslot);
#endif
          } }
#endif
    }
    GRID_BAR();
    { unsigned char* ws = WSP;
      pg8::Epi<pg8::EM_PLAIN> E{(bf16_t*)(ws + WS_BIG), D, kind == 2 ? INP(16) : nullptr, nullptr, nullptr, nullptr, nullptr, nullptr, 0};
      run_gemm<pg8::EM_PLAIN, 0>(lds + RING_OFF, (const bf16_t*)(ws + WS_O), (const bf16_t*)(ws + WS_WOUT) + (size_t)L * D * D, M, D, D, E, wave_s); }
    GRID_BAR();
#if REP_GOUT >= 2
    { unsigned char* ws = WSP;
      pg8::Epi<pg8::EM_PLAIN> E{(bf16_t*)(ws + WS_BIG), D, kind == 2 ? INP(16) : nullptr, nullptr, nullptr, nullptr, nullptr, nullptr, 0};
      run_gemm<pg8::EM_PLAIN, 0>(lds + RING_OFF, (const bf16_t*)(ws + WS_O), (const bf16_t*)(ws + WS_WOUT) + (size_t)L * D * D, M, D, D, E, wave_s); }
    GRID_BAR();
#endif
    { IDS; unsigned char* ws = WSP; const float* gL = INP(1) + (size_t)L * 4 * D; const float* xin = (L == 0) ? INP(0) : nullptr;
      const bf16_t* MB = (const bf16_t*)(ws + WS_BIG); bf16_t* XN = (bf16_t*)(ws + WS_XN); float* RSTD = (float*)(ws + WS_RSTD);
      for (int m = gw; m < M; m += 2 * NGW) resnorm_rows2(m, m + NGW, xin, XN, RSTD, gL, MB, gL + D, gL + 2 * D, nullptr, lane); }
    GRID_BAR();
    { unsigned char* ws = WSP;
      pg8::Epi<pg8::EM_RELU2> E{(bf16_t*)(ws + WS_BIG), FF, nullptr, nullptr, nullptr, nullptr, nullptr, nullptr, 0};
      run_gemm<pg8::EM_RELU2, 0>(lds + RING_OFF, (const bf16_t*)(ws + WS_XN), (const bf16_t*)(ws + WS_WUP) + (size_t)L * D * FF, M, FF, D, E, wave_s); }
    GRID_BAR();
#if REP_MLP >= 2
    { unsigned char* ws = WSP;
      pg8::Epi<pg8::EM_RELU2> E{(bf16_t*)(ws + WS_BIG), FF, nullptr, nullptr, nullptr, nullptr, nullptr, nullptr, 0};
      run_gemm<pg8::EM_RELU2, 0>(lds + RING_OFF, (const bf16_t*)(ws + WS_XN), (const bf16_t*)(ws + WS_WUP) + (size_t)L * D * FF, M, FF, D, E, wave_s); }
    GRID_BAR();
#endif
    { unsigned char* ws = WSP;
      pg8::Epi<pg8::EM_PLAIN> E{(bf16_t*)(ws + WS_M2), D, nullptr, nullptr, nullptr, nullptr, nullptr, nullptr, 0};
      run_gemm<pg8::EM_PLAIN, 0>(lds + RING_OFF, (const bf16_t*)(ws + WS_BIG), (const bf16_t*)(ws + WS_WDN) + (size_t)L * D * FF, M, D, FF, E, wave_s); }
    GRID_BAR();
#if REP_MLP >= 2
    { unsigned char* ws = WSP;
      pg8::Epi<pg8::EM_PLAIN> E{(bf16_t*)(ws + WS_M2), D, nullptr, nullptr, nullptr, nullptr, nullptr, nullptr, 0};
      run_gemm<pg8::EM_PLAIN, 0>(lds + RING_OFF, (const bf16_t*)(ws + WS_BIG), (const bf16_t*)(ws + WS_WDN) + (size_t)L * D * FF, M, D, FF, E, wave_s); }
    GRID_BAR();
#endif
    { IDS; unsigned char* ws = WSP; const float* gL = INP(1) + (size_t)L * 4 * D; float* xout = OUTP; bf16_t* XN = (bf16_t*)(ws + WS_XN); const bf16_t* M2 = (const bf16_t*)(ws + WS_M2); float* RSTD = (float*)(ws + WS_RSTD);
      for (int m = gw; m < M; m += 2 * NGW) resnorm_rows2(m, m + NGW, nullptr, XN, RSTD, gL + 2 * D, M2, gL + 3 * D, (L + 1 < DEPTH) ? gL + 4 * D : nullptr, (L + 1 < DEPTH) ? nullptr : xout, lane); }
    if (L + 1 < DEPTH) GRID_BAR();
#undef GRID_BAR
}

__global__ void __launch_bounds__(NWAVES * 64, 2) fwd_kernel(Args args) {
    extern __shared__ __attribute__((aligned(16))) unsigned char lds_raw[];
    LAS unsigned char* lds = (LAS unsigned char*)lds_raw;
    const int wave_s = __builtin_amdgcn_readfirstlane((int)threadIdx.x >> 6);
    for (int u = threadIdx.x; u < (LDS_BYTES - LDSCTL_OFF) / 4; u += NWAVES * 64) ((LAS unsigned*)(lds + LDSCTL_OFF))[u] = 0u;
    __syncthreads();
    if (threadIdx.x == 0) {
        LAS unsigned long long* pt = (LAS unsigned long long*)(lds + PT_OFF);
#pragma unroll
        for (int i = 0; i < 17; ++i) pt[i] = (unsigned long long)args.in[i];
        pt[17] = (unsigned long long)args.out; pt[18] = (unsigned long long)args.ws;
    }
    __syncthreads();
    volatile LAS unsigned* MISC = (volatile LAS unsigned*)(lds + MISC_OFF);
    XcdBarrier bar = xcd_barrier_post((unsigned*)(WSP + WS_CTL) + CW_BAR, MISC + 8);

    {
        IDS; unsigned char* ws = WSP;
        const float* x_in = INP(0); const float* norm_g = INP(1); const float* mlp_up = INP(2); const float* mlp_dn = INP(3);
        const float* nsa_w_in = INP(4); const float* nsa_pos = INP(5); const float* nsa_w1 = INP(6); const float* nsa_w_out = INP(8);
        const float* fox_w_in = INP(9); const float* fox_w_out = INP(11); const float* swa_w_in = INP(12); const float* swa_b_in = INP(13); const float* swa_w_out = INP(15);
        bf16_t* W_UP = (bf16_t*)(ws + WS_WUP); bf16_t* W_DN = (bf16_t*)(ws + WS_WDN); bf16_t* W_NSA = (bf16_t*)(ws + WS_WNSA); bf16_t* W_OUT = (bf16_t*)(ws + WS_WOUT);
        bf16_t* W_FOX = (bf16_t*)(ws + WS_WFOX); bf16_t* W_SWA = (bf16_t*)(ws + WS_WSWA); bf16_t* W_CMP = (bf16_t*)(ws + WS_WCMP);
        float* ROPEC = (float*)(ws + WS_ROPEC); float* ROPES = (float*)(ws + WS_ROPES); float* CMPB = (float*)(ws + WS_CMPB); float* SWAB = (float*)(ws + WS_SWAB);
        bf16_t* XN = (bf16_t*)(ws + WS_XN);
        LAS float* scr = (LAS float*)(lds + RING_OFF + wave * 16384);
        constexpr int I_UP = (D / 64) * (FF / 32), I_DN = (FF / 64) * (D / 32), I_NSA = (D / 64) * (NSA_NP / 32), I_GATE = (D / 64) * 2, I_OUT = (D / 64) * (D / 32), I_FOX = (D / 64) * ((FOX_N + 31) / 32), I_SWA = (D / 64) * (SWA_N / 32), I_CMP = (2048 / 64) * (256 / 32);
        constexpr int NITEMS = 4 * I_UP + 4 * I_DN + 2 * I_NSA + 2 * I_GATE + 4 * I_OUT + I_FOX + I_SWA + 4 * I_CMP;
        for (int it = gw; it < NITEMS; it += NGW) {
            int r = it;
            if (r < 4 * I_UP) { const int Lw = r / I_UP; conv_item(mlp_up + (size_t)Lw * D * FF, D, FF, W_UP + (size_t)Lw * D * FF, 0, r % I_UP, scr, lane); continue; } r -= 4 * I_UP;
            if (r < 4 * I_DN) { const int Lw = r / I_DN; conv_item(mlp_dn + (size_t)Lw * D * FF, FF, D, W_DN + (size_t)Lw * D * FF, 0, r % I_DN, scr, lane); continue; } r -= 4 * I_DN;
            if (r < 2 * I_NSA) { const int s = r / I_NSA; conv_item(nsa_w_in + (size_t)s * D * NSA_N, D, NSA_NP, W_NSA + (size_t)s * NSA_NP * D, 1, r % I_NSA, scr, lane, NSA_N); continue; } r -= 2 * I_NSA;
            if (r < 2 * I_GATE) { const int s = r / I_GATE; conv_item(nsa_w_in + (size_t)s * D * NSA_N + NSA_NP, D, 48, (bf16_t*)(ws + WS_WGATE) + (size_t)s * 256 * D, 0, r % I_GATE, scr, lane, NSA_N); continue; } r -= 2 * I_GATE;
            if (r < 4 * I_OUT) { const int Lw = r / I_OUT; const float* src = (Lw == 1) ? fox_w_out : (Lw == 2) ? swa_w_out : nsa_w_out + (size_t)(Lw / 3) * D * D;
                conv_item(src, D, D, W_OUT + (size_t)Lw * D * D, 0, r % I_OUT, scr, lane); continue; } r -= 4 * I_OUT;
            if (r < I_FOX) { conv_item(fox_w_in, D, FOX_N, W_FOX, 2, r, scr, lane); continue; } r -= I_FOX;
            if (r < I_SWA) { conv_item(swa_w_in, D, SWA_N, W_SWA, 3, r, scr, lane); continue; } r -= I_SWA;
            { const int sw = r / I_CMP;
                conv_item(nsa_w1 + (size_t)sw * 2048 * 256, 2048, 256, W_CMP + (size_t)sw * 256 * 2048, (sw & 1) ? 0 : 4, r % I_CMP, scr, lane); }
        }
        { constexpr int ZG = 208 * D / 8, ZF = (FOX_NP - FOX_N) * D / 8;
          for (int e = bx * 512 + tid; e < 2 * ZG + ZF; e += G * 512) {
              bf16_t* dst = e < ZG ? (bf16_t*)(ws + WS_WGATE) + (size_t)48 * D + (size_t)e * 8 : e < 2 * ZG ? (bf16_t*)(ws + WS_WGATE) + (size_t)256 * D + (size_t)48 * D + (size_t)(e - ZG) * 8 : W_FOX + (size_t)FOX_N * D + (size_t)(e - 2 * ZG) * 8;
              *(GAS u32x4*)dst = (u32x4){0u, 0u, 0u, 0u}; } }
        for (int e = bx * 512 + tid; e < T * 32; e += G * 512) { const int t = e >> 5, i = e & 31; const float inv = powf(10000.0f, -(float)(2 * i) / 64.0f); const float ang = (float)t * inv;
            ROPEC[e] = cosf(ang); ROPES[e] = sinf(ang); }
        for (int e = bx * 512 + tid; e < SWA_N; e += G * 512) SWAB[e] = swa_b_in[src_n(3, e)];
        for (int task = bx; task < 64; task += G) {
            const int sw = task >> 4, n0 = (task & 15) * 16, kq = tid >> 4, nn = tid & 15;
            const float* pos = nsa_pos + (size_t)sw * 2048; const float* w1 = nsa_w1 + (size_t)sw * 2048 * 256;
            float acc = 0.f;
#pragma unroll 8
            for (int k = kq * 64; k < kq * 64 + 64; ++k) acc += pos[k] * w1[(size_t)k * 256 + n0 + nn];
            LAS float* red = (LAS float*)(lds + RING_OFF);
            __syncthreads();
            red[kq * 16 + nn] = acc;
            __syncthreads();
            if (tid < 16) { float sm = 0.f; for (int q = 0; q < 32; ++q) sm += red[q * 16 + tid]; CMPB[sw * 256 + n0 + tid] = sm; }
            __syncthreads();
        }
        for (int m = gw; m < M; m += NGW) norm_row(x_in + (size_t)m * D, norm_g, XN + (size_t)m * D, (float*)(ws + WS_RSTD) + m, lane);
    }
#if REP_PRO >= 2
    xcd_barrier(bar);
    {
        IDS; unsigned char* ws = WSP;
        const float* x_in = INP(0); const float* norm_g = INP(1); const float* mlp_up = INP(2); const float* mlp_dn = INP(3);
        const float* nsa_w_in = INP(4); const float* nsa_pos = INP(5); const float* nsa_w1 = INP(6); const float* nsa_w_out = INP(8);
        const float* fox_w_in = INP(9); const float* fox_w_out = INP(11); const float* swa_w_in = INP(12); const float* swa_b_in = INP(13); const float* swa_w_out = INP(15);
        bf16_t* W_UP = (bf16_t*)(ws + WS_WUP); bf16_t* W_DN = (bf16_t*)(ws + WS_WDN); bf16_t* W_NSA = (bf16_t*)(ws + WS_WNSA); bf16_t* W_OUT = (bf16_t*)(ws + WS_WOUT);
        bf16_t* W_FOX = (bf16_t*)(ws + WS_WFOX); bf16_t* W_SWA = (bf16_t*)(ws + WS_WSWA); bf16_t* W_CMP = (bf16_t*)(ws + WS_WCMP);
        float* ROPEC = (float*)(ws + WS_ROPEC); float* ROPES = (float*)(ws + WS_ROPES); float* CMPB = (float*)(ws + WS_CMPB); float* SWAB = (float*)(ws + WS_SWAB);
        bf16_t* XN = (bf16_t*)(ws + WS_XN);
        LAS float* scr = (LAS float*)(lds + RING_OFF + wave * 16384);
        constexpr int I_UP = (D / 64) * (FF / 32), I_DN = (FF / 64) * (D / 32), I_NSA = (D / 64) * (NSA_NP / 32), I_GATE = (D / 64) * 2, I_OUT = (D / 64) * (D / 32), I_FOX = (D / 64) * ((FOX_N + 31) / 32), I_SWA = (D / 64) * (SWA_N / 32), I_CMP = (2048 / 64) * (256 / 32);
        constexpr int NITEMS = 4 * I_UP + 4 * I_DN + 2 * I_NSA + 2 * I_GATE + 4 * I_OUT + I_FOX + I_SWA + 4 * I_CMP;
        for (int it = gw; it < NITEMS; it += NGW) {
            int r = it;
            if (r < 4 * I_UP) { const int Lw = r / I_UP; conv_item(mlp_up + (size_t)Lw * D * FF, D, FF, W_UP + (size_t)Lw * D * FF, 0, r % I_UP, scr, lane); continue; } r -= 4 * I_UP;
            if (r < 4 * I_DN) { const int Lw = r / I_DN; conv_item(mlp_dn + (size_t)Lw * D * FF, FF, D, W_DN + (size_t)Lw * D * FF, 0, r % I_DN, scr, lane); continue; } r -= 4 * I_DN;
            if (r < 2 * I_NSA) { const int s = r / I_NSA; conv_item(nsa_w_in + (size_t)s * D * NSA_N, D, NSA_NP, W_NSA + (size_t)s * NSA_NP * D, 1, r % I_NSA, scr, lane, NSA_N); continue; } r -= 2 * I_NSA;
            if (r < 2 * I_GATE) { const int s = r / I_GATE; conv_item(nsa_w_in + (size_t)s * D * NSA_N + NSA_NP, D, 48, (bf16_t*)(ws + WS_WGATE) + (size_t)s * 256 * D, 0, r % I_GATE, scr, lane, NSA_N); continue; } r -= 2 * I_GATE;
            if (r < 4 * I_OUT) { const int Lw = r / I_OUT; const float* src = (Lw == 1) ? fox_w_out : (Lw == 2) ? swa_w_out : nsa_w_out + (size_t)(Lw / 3) * D * D;
                conv_item(src, D, D, W_OUT + (size_t)Lw * D * D, 0, r % I_OUT, scr, lane); continue; } r -= 4 * I_OUT;
            if (r < I_FOX) { conv_item(fox_w_in, D, FOX_N, W_FOX, 2, r, scr, lane); continue; } r -= I_FOX;
            if (r < I_SWA) { conv_item(swa_w_in, D, SWA_N, W_SWA, 3, r, scr, lane); continue; } r -= I_SWA;
            { const int sw = r / I_CMP;
                conv_item(nsa_w1 + (size_t)sw * 2048 * 256, 2048, 256, W_CMP + (size_t)sw * 256 * 2048, (sw & 1) ? 0 : 4, r % I_CMP, scr, lane); }
        }
        { constexpr int ZG = 208 * D / 8, ZF = (FOX_NP - FOX_N) * D / 8;
          for (int e = bx * 512 + tid; e < 2 * ZG + ZF; e += G * 512) {
              bf16_t* dst = e < ZG ? (bf16_t*)(ws + WS_WGATE) + (size_t)48 * D + (size_t)e * 8 : e < 2 * ZG ? (bf16_t*)(ws + WS_WGATE) + (size_t)256 * D + (size_t)48 * D + (size_t)(e - ZG) * 8 : W_FOX + (size_t)FOX_N * D + (size_t)(e - 2 * ZG) * 8;
              *(GAS u32x4*)dst = (u32x4){0u, 0u, 0u, 0u}; } }
        for (int e = bx * 512 + tid; e < T * 32; e += G * 512) { const int t = e >> 5, i = e & 31; const float inv = powf(10000.0f, -(float)(2 * i) / 64.0f); const float ang = (float)t * inv;
            ROPEC[e] = cosf(ang); ROPES[e] = sinf(ang); }
        for (int e = bx * 512 + tid; e < SWA_N; e += G * 512) SWAB[e] = swa_b_in[src_n(3, e)];
        for (int task = bx; task < 64; task += G) {
            const int sw = task >> 4, n0 = (task & 15) * 16, kq = tid >> 4, nn = tid & 15;
            const float* pos = nsa_pos + (size_t)sw * 2048; const float* w1 = nsa_w1 + (size_t)sw * 2048 * 256;
            float acc = 0.f;
#pragma unroll 8
            for (int k = kq * 64; k < kq * 64 + 64; ++k) acc += pos[k] * w1[(size_t)k * 256 + n0 + nn];
            LAS float* red = (LAS float*)(lds + RING_OFF);
            __syncthreads();
            red[kq * 16 + nn] = acc;
            __syncthreads();
            if (tid < 16) { float sm = 0.f; for (int q = 0; q < 32; ++q) sm += red[q * 16 + tid]; CMPB[sw * 256 + n0 + tid] = sm; }
            __syncthreads();
        }
        for (int m = gw; m < M; m += NGW) norm_row(x_in + (size_t)m * D, norm_g, XN + (size_t)m * D, (float*)(ws + WS_RSTD) + m, lane);
    }
#endif
    xcd_barrier(bar);

    int aslot = 0;
    if (L_LO <= 0 && 0 < L_HI) layer_body<0>(lds, bar, aslot, wave_s);
    if (L_LO <= 1 && 1 < L_HI) layer_body<1>(lds, bar, aslot, wave_s);
    if (L_LO <= 2 && 2 < L_HI) layer_body<2>(lds, bar, aslot, wave_s);
    if (L_LO <= 3 && 3 < L_HI) layer_body<3>(lds, bar, aslot, wave_s);
}

extern "C" void kernel_launch(void* const* d_in, const int* in_sizes, int n_in, void* d_out, int out_size, void* d_ws, size_t ws_size, hipStream_t stream) {
    static int grid = 0;
    if (grid == 0) {
        if (n_in != 17 || in_sizes[0] != M * D || out_size != M * D || ws_size < WS_END) { fprintf(stderr, "kernel_launch: unexpected problem shape (n_in %d, in0 %d, out %d, ws %zu)\n", n_in, n_in > 0 ? in_sizes[0] : -1, out_size, ws_size); grid = -1; return; }
        int dev = 0, cus = 0, per_cu = 0;
        if (hipGetDevice(&dev) != hipSuccess || hipDeviceGetAttribute(&cus, hipDeviceAttributeMultiprocessorCount, dev) != hipSuccess) { grid = -1; return; }
        if (hipFuncSetAttribute((const void*)fwd_kernel, hipFuncAttributeMaxDynamicSharedMemorySize, LDS_BYTES) != hipSuccess) { fprintf(stderr, "kernel_launch: hipFuncSetAttribute failed\n"); grid = -1; return; }
        if (hipOccupancyMaxActiveBlocksPerMultiprocessor(&per_cu, (const void*)fwd_kernel, NWAVES * 64, LDS_BYTES) != hipSuccess || per_cu < 1) { fprintf(stderr, "kernel_launch: occupancy query reports %d\n", per_cu); }
        (void)hipGetLastError();
        if (cus < 256) { fprintf(stderr, "kernel_launch: needs 256 CUs, device has %d\n", cus); grid = -1; return; }
        grid = 256;
    }
    if (grid < 0) return;
    if (hipMemsetAsync((char*)d_ws + WS_CTL, 0, CTL_ZERO_BYTES, stream) != hipSuccess) return;
    Args a{};
    for (int i = 0; i < 17; ++i) a.in[i] = (const float*)d_in[i];
    a.out = (float*)d_out; a.ws = (unsigned char*)d_ws;
    hipLaunchKernelGGL(fwd_kernel, dim3(grid), dim3(NWAVES * 64), LDS_BYTES, stream, a);
}
```

```cpp
#include <hip/hip_runtime.h>
#include <cstdio>
#include <cstdint>

#define LAS __attribute__((address_space(3)))
#define GAS __attribute__((address_space(1)))
typedef unsigned short bf16_t;
typedef short bf16x8 __attribute__((ext_vector_type(8)));
typedef short s16x4 __attribute__((ext_vector_type(4)));
typedef float f32x2 __attribute__((ext_vector_type(2)));
typedef float f32x4 __attribute__((ext_vector_type(4)));
typedef float f32x16 __attribute__((ext_vector_type(16)));
typedef unsigned u32x2 __attribute__((ext_vector_type(2)));
typedef unsigned u32x4 __attribute__((ext_vector_type(4)));

constexpr int BATCH = 16, T = 2048, D = 1024, NH = 16, HD = 64, FF = 4096, DEPTH = 4;
constexpr int M = BATCH * T;
constexpr int NSA_N = 2608, NSA_NP = 2560, NSA_LDP = 1536;
constexpr int FOX_N = 3088, FOX_NP = 3328, FOX_LDP = 1024;
constexpr int SWA_N = 1280, SWA_NP = 1280, SWA_LDP = 1024;
constexpr int CMP_LDP = NSA_LDP;
constexpr int NC = 127, NCP = 128;
constexpr int CMP_ROWS = BATCH * NCP * 4;
constexpr size_t NSA_HM_OFF = (size_t)96 << 20, NSA_HM_STRIDE = (size_t)8 << 20;
constexpr size_t FOX_HM_OFF = (size_t)64 << 20, FOX_HM_STRIDE = (size_t)32 << 20;
constexpr size_t SWA_HM_OFF = (size_t)64 << 20, SWA_HM_STRIDE = (size_t)4 << 20;
constexpr float LOG2E = 1.4426950408889634f;
constexpr float C2 = 0.125f * LOG2E;
constexpr float NORM_EPS = 1e-6f;

__device__ __forceinline__ unsigned cvt_pk_bf16(float lo, float hi) { unsigned r; asm volatile("v_cvt_pk_bf16_f32 %0, %1, %2" : "=v"(r) : "v"(lo), "v"(hi)); return r; }
__device__ __forceinline__ void store8(bf16_t* p, f32x4 a, f32x4 b) { u32x4 w; w.x = cvt_pk_bf16(a[0], a[1]); w.y = cvt_pk_bf16(a[2], a[3]); w.z = cvt_pk_bf16(b[0], b[1]); w.w = cvt_pk_bf16(b[2], b[3]); *(GAS u32x4*)p = w; }

__device__ __forceinline__ int lane_id_volatile() { int x; asm volatile("v_mbcnt_lo_u32_b32 %0, -1, 0\n\tv_mbcnt_hi_u32_b32 %0, -1, %0" : "=v"(x)); return x; }

namespace pg8 {
#define PG8_LAS __attribute__((address_space(3)))
constexpr int BM = 256, BK = 64, HALF = 128, HTB = HALF * BK * 2  , STAGE_BYTES = 8 * HTB, NXCD = 8, WGM = 8;

__host__ __device__ __forceinline__ int lds_byte(int r, int c) { const int st = (r >> 4) * 2 + (c >> 5), rr = r & 15, cc = c & 31, ob = rr * 64 + cc * 2; return st * 1024 + (ob ^ (((ob >> 9) & 1) << 5)); }
__host__ __device__ __forceinline__ void stage_rc(int b, int& R, int& C) { const int st = b / 1024, sb = b % 1024, swz = sb ^ (((sb >> 9) & 1) << 5); R = (st >> 1) * 16 + swz / 64; C = (st & 1) * 32 + (swz % 64) / 2; }
__host__ __device__ __forceinline__ int perm32(int rho) { const int n = rho >> 4, i = rho & 15; return 8 * (i >> 2) + 4 * n + (i & 3); }

struct Unit { int pm, pn; };
struct Gemm { const bf16_t* A; const bf16_t* Bt; int M, N, K; };

struct StaticOrder {
    int nM, nN, nwg, G, c;
    __host__ __device__ void init(int M_, int N_, int G_, int c_) { nM = M_ / BM; nN = N_ / BM; nwg = nM * nN; G = G_; c = c_; }
    __host__ __device__ bool next(int i, Unit& u) const {
        const long L = (long)i * G + c; if (L >= nwg) return false;
        int wgid = (int)L; { const int q = nwg / NXCD, r = nwg % NXCD, xcd = wgid % NXCD, off = wgid / NXCD; wgid = (xcd < r ? xcd * (q + 1) : r * (q + 1) + (xcd - r) * q) + off; }
        const int nig = WGM * nN, gid = wgid / nig, fm = gid * WGM, gsz = (nM - fm) < WGM ? (nM - fm) : WGM;
        u.pm = fm + ((wgid % nig) % gsz); u.pn = (wgid % nig) / gsz; return true;
    }
    __device__ __forceinline__ void a_ready(const Unit&) const {}
    __device__ __forceinline__ void done(const Unit&) const {}
};

enum EpiMode { EM_PLAIN = 0, EM_RELU2 = 1, EM_NSA = 2, EM_FOX = 3, EM_SWA = 4, EM_CMP = 5, EM_GATE = 6 };

__device__ __forceinline__ void rope4(f32x4& v, float c0, float s0, float c1, float s1) {
    const float a0 = v[0], b0 = v[1], a1 = v[2], b1 = v[3];
    v[0] = a0 * c0 - b0 * s0; v[1] = b0 * c0 + a0 * s0; v[2] = a1 * c1 - b1 * s1; v[3] = b1 * c1 + a1 * s1;
}
__device__ __forceinline__ float sigmoidf_(float x) { return 1.0f / (1.0f + __expf(-x)); }
__device__ __forceinline__ float logsigmoidf_(float x) { return fminf(x, 0.f) - log1pf(expf(-fabsf(x))); }

template <int MODE> struct Epi {
    static constexpr bool PERM = true, AFTER_DRAIN = false;
    bf16_t* O; int ldc; const float* bias; const float* rc; const float* rs; float* aux; const float* auxb;
    bf16_t* hm0; size_t hm_stride;
    __device__ __forceinline__ void operator()(const f32x4 (&acc)[2][2][4][2], const Unit& u, int wr, int wc, int fr, int fq) const {
        const int row0 = u.pm * BM + wr * 64 + fr;
        const int cw = wc * 32 + 8 * fq;
        const int colt = u.pn * BM;
        if (MODE == EM_GATE) {
            if (cw < 48) {
#pragma unroll
                for (int ai = 0; ai < 2; ++ai)
#pragma unroll
                    for (int m = 0; m < 4; ++m) { const size_t row = (size_t)(row0 + ai * HALF + m * 16); f32x4 v0 = acc[ai][0][m][0], v1 = acc[ai][0][m][1];
#pragma unroll
                        for (int j = 0; j < 4; ++j) { v0[j] = sigmoidf_(v0[j]); v1[j] = sigmoidf_(v1[j]); }
                        *(GAS f32x4*)(aux + row * 48 + cw) = v0; *(GAS f32x4*)(aux + row * 48 + cw + 4) = v1; }
            }
            return;
        }
        if (MODE == EM_FOX && u.pn == 12) {
            if (cw < 16) {
                const f32x4 b0 = *(const GAS f32x4*)(auxb + cw), b1 = *(const GAS f32x4*)(auxb + cw + 4);
#pragma unroll
                for (int ai = 0; ai < 2; ++ai)
#pragma unroll
                    for (int m = 0; m < 4; ++m) { const size_t row = (size_t)(row0 + ai * HALF + m * 16); f32x4 v0 = acc[ai][0][m][0] + b0, v1 = acc[ai][0][m][1] + b1;
#pragma unroll
                        for (int j = 0; j < 4; ++j) { v0[j] = logsigmoidf_(v0[j]); v1[j] = logsigmoidf_(v1[j]); }
                        *(GAS f32x4*)(aux + row * 16 + cw) = v0; *(GAS f32x4*)(aux + row * 16 + cw + 4) = v1; }
            }
            return;
        }
        bool rope0 = false, rope1 = false; float sc = 1.f;
        if (MODE == EM_NSA) { if (u.pn < 4) { rope0 = rope1 = true; sc = C2; } else if (!(u.pn & 1)) { rope0 = rope1 = true; } }
        if (MODE == EM_FOX) { if (u.pn < 4) sc = C2; }
        if (MODE == EM_SWA) { if (u.pn < 4) { rope0 = rope1 = true; sc = C2; } else { rope0 = true; } }
        f32x4 bv[2][2];
#pragma unroll
        for (int bj = 0; bj < 2; ++bj)
#pragma unroll
            for (int n = 0; n < 2; ++n) bv[bj][n] = bias ? *(const GAS f32x4*)(bias + colt + bj * HALF + cw + 4 * n) : (f32x4){0.f, 0.f, 0.f, 0.f};
        const int ib = 16 * (wc & 1) + 4 * fq;
        bf16_t* base = O; int colo = colt; size_t rowo = 0;
        if (MODE == EM_CMP) { colo = 0; rowo = (size_t)u.pn * CMP_ROWS; }
        bool hm = false; bf16_t* hb[2] = {nullptr, nullptr}; int hd[2] = {0, 0}; int HG = 1;
        if (MODE == EM_FOX && u.pn >= 4) { hm = true; HG = 16; hb[0] = hb[1] = hm0 + (u.pn >= 8 ? hm_stride : 0); hd[0] = ((u.pn - 4) & 3) * 4 + (wc >> 1); hd[1] = hd[0] + 2; }
        if (MODE == EM_NSA && u.pn >= 6) { hm = true; HG = 4; hb[0] = hb[1] = hm0 + (size_t)(u.pn - 6) * hm_stride; hd[0] = (wc >> 1); hd[1] = hd[0] + 2; }
        if (MODE == EM_SWA && u.pn == 4) { hm = true; HG = 2; hb[0] = hm0; hb[1] = hm0 + hm_stride; hd[0] = hd[1] = (wc >> 1); }
#pragma unroll
        for (int ai = 0; ai < 2; ++ai)
#pragma unroll
            for (int m = 0; m < 4; ++m) {
                const int row = row0 + ai * HALF + m * 16;
                f32x4 cc = {1.f, 1.f, 1.f, 1.f}, ss = {0.f, 0.f, 0.f, 0.f};
                if (MODE == EM_NSA || MODE == EM_SWA) { if (rope0) { const int t = row & (T - 1); cc = *(const GAS f32x4*)(rc + t * 32 + ib); ss = *(const GAS f32x4*)(rs + t * 32 + ib); } }
                bf16_t* rowp = base + (rowo + (size_t)row) * ldc + colo + cw;
#pragma unroll
                for (int bj = 0; bj < 2; ++bj) {
                    f32x4 v0 = acc[ai][bj][m][0] + bv[bj][0], v1 = acc[ai][bj][m][1] + bv[bj][1];
                    if (MODE == EM_NSA || MODE == EM_SWA) { if (bj == 0 ? rope0 : rope1) { rope4(v0, cc[0], ss[0], cc[1], ss[1]); rope4(v1, cc[2], ss[2], cc[3], ss[3]); } }
                    if (MODE == EM_RELU2) {
#pragma unroll
                        for (int j = 0; j < 4; ++j) { const float a = fmaxf(v0[j], 0.f), b = fmaxf(v1[j], 0.f); v0[j] = a * a; v1[j] = b * b; } }
                    if (MODE == EM_CMP) {
#pragma unroll
                        for (int j = 0; j < 4; ++j) { v0[j] = v0[j] * sigmoidf_(v0[j]); v1[j] = v1[j] * sigmoidf_(v1[j]); } }
                    if (MODE == EM_NSA || MODE == EM_FOX || MODE == EM_SWA) { v0 = v0 * sc; v1 = v1 * sc; }
                    if ((MODE == EM_FOX || MODE == EM_NSA || MODE == EM_SWA) && hm) store8(hb[bj] + (((size_t)(row >> 11) * HG + hd[bj]) * T + (row & (T - 1))) * 64 + (cw & 63), v0, v1);
                    else store8(rowp + bj * HALF, v0, v1);
                }
            }
    }
};

template <class Epi, class Sched, int AMODE, bool ALIGN_EPI = false, bool SP2 = false>
__device__ __forceinline__ void gemm_phase(PG8_LAS unsigned char* lds, const Gemm g, const Sched& S, const Epi& E, int wave_id) {
    int tid_; { int x_; asm volatile("v_mbcnt_lo_u32_b32 %0, -1, 0\n\tv_mbcnt_hi_u32_b32 %0, -1, %0" : "=v"(x_)); tid_ = wave_id * 64 + x_; }
    const int tid = tid_, wid = __builtin_amdgcn_readfirstlane(tid >> 6), lane = tid & 63, wr = wid >> 2, wc = wid & 3, fr = lane & 15, fq = lane >> 4;
    const int K = g.K, nt = K / BK;
    unsigned voffA[2], voffB[2];
#pragma unroll
    for (int i = 0; i < 2; ++i) { int R, C; stage_rc(tid * 16 + i * 8192, R, C); const int Rb = Epi::PERM ? ((R & ~31) + perm32(R & 31)) : R;
        voffA[i] = (AMODE == 1) ? (unsigned)((16 * (R >> 2)) * CMP_LDP + (R & 3) * 64 + C) * 2u : (unsigned)(R * K + C) * 2u; voffB[i] = (unsigned)(Rb * K + C) * 2u; }
    const size_t kstepB = (size_t)(BK * 2);
    const size_t hstepB = (size_t)HALF * K * 2;
    const size_t tstepB = 2 * hstepB;
    const size_t kstepA = (AMODE == 1) ? (size_t)CMP_LDP * 2 : kstepB;
    const size_t hstepA = (AMODE == 1) ? (size_t)512 * CMP_LDP * 2 : hstepB;
    const size_t tstepA = 2 * hstepA;
    const size_t pnstepA = (AMODE == 1) ? (size_t)512 : (size_t)0;
    const unsigned ldsw = (unsigned)wid * 1024u;
    const int aoff = lds_byte(wr * 64 + fr, fq * 8), boff = lds_byte(wc * 32 + fr, fq * 8);
#define PG8_SA(b, h) (((b) * 2 + (h)) * HTB)
#define PG8_SB(b, h) ((4 + (b) * 2 + (h)) * HTB)
#define PG8_STAGE(bufoff, gbase, voff) do { _Pragma("unroll") for (int _i = 0; _i < 2; ++_i) \
        __builtin_amdgcn_global_load_lds((const unsigned*)((const char*)(gbase) + (voff)[_i]), (PG8_LAS unsigned*)(lds + (bufoff) + ldsw + _i * 8192), 16, 0, 0); } while (0)
#define PG8_LDA(dst, b, h) do { _Pragma("unroll") for (int m = 0; m < 4; ++m) _Pragma("unroll") for (int k = 0; k < 2; ++k) dst[m][k] = *(const PG8_LAS bf16x8*)(lds + PG8_SA(b, h) + aoff + m * 2048 + k * 1024); } while (0)
#define PG8_LDB(dst, b, h) do { _Pragma("unroll") for (int n = 0; n < 2; ++n) _Pragma("unroll") for (int k = 0; k < 2; ++k) dst[n][k] = *(const PG8_LAS bf16x8*)(lds + PG8_SB(b, h) + boff + n * 2048 + k * 1024); } while (0)
#define PG8_MMA(ai, bj, At, Bt) do { __builtin_amdgcn_s_setprio(1); _Pragma("unroll") for (int m = 0; m < 4; ++m) _Pragma("unroll") for (int n = 0; n < 2; ++n) _Pragma("unroll") for (int k = 0; k < 2; ++k) \
        acc[ai][bj][m][n] = __builtin_amdgcn_mfma_f32_16x16x32_bf16(Bt[n][k], At[m][k], acc[ai][bj][m][n], 0, 0, 0); __builtin_amdgcn_s_setprio(0); } while (0)
#define PG8_WAIT_V(n) asm volatile("s_waitcnt vmcnt(" #n ")" ::: "memory")
#define PG8_WAIT_L(n) asm volatile("s_waitcnt lgkmcnt(" #n ")" ::: "memory")
#define PG8_BAR __builtin_amdgcn_s_barrier()
#define PG8_SCHED __builtin_amdgcn_sched_barrier(0)
    Unit cur, nxt; int ui = 0;
    if (!S.next(0, cur)) return;
    f32x4 acc[2][2][4][2];
#pragma unroll
    for (int a = 0; a < 2; ++a)
#pragma unroll
        for (int b = 0; b < 2; ++b)
#pragma unroll
            for (int m = 0; m < 4; ++m)
#pragma unroll
                for (int n = 0; n < 2; ++n) acc[a][b][m][n] = (f32x4){0.f, 0.f, 0.f, 0.f};
    bf16x8 At[4][2], B0[2][2], B1[2][2];
    const char* cA = (const char*)g.A + (size_t)cur.pm * tstepA + (size_t)cur.pn * pnstepA; const char* cB = (const char*)g.Bt + (size_t)cur.pn * tstepB;
    S.a_ready(cur);
    if constexpr (SP2) {
        PG8_STAGE(PG8_SB(0, 0), cB, voffB); PG8_STAGE(PG8_SB(0, 1), cB + hstepB, voffB); PG8_STAGE(PG8_SA(0, 0), cA, voffA); PG8_STAGE(PG8_SA(0, 1), cA + hstepA, voffA);
        if (wr == 1) PG8_BAR;
        PG8_WAIT_V(2); PG8_BAR;
        PG8_STAGE(PG8_SB(1, 0), cB + kstepB, voffB); PG8_STAGE(PG8_SA(1, 0), cA + kstepA, voffA); PG8_STAGE(PG8_SB(1, 1), cB + hstepB + kstepB, voffB);
        PG8_WAIT_V(6); PG8_BAR;
    } else {
        PG8_STAGE(PG8_SB(0, 0), cB, voffB); PG8_STAGE(PG8_SA(0, 0), cA, voffA); PG8_STAGE(PG8_SB(0, 1), cB + hstepB, voffB); PG8_STAGE(PG8_SA(0, 1), cA + hstepA, voffA);
        if (wr == 1) PG8_BAR;
        PG8_WAIT_V(4); PG8_BAR;
        PG8_STAGE(PG8_SB(1, 0), cB + kstepB, voffB); PG8_STAGE(PG8_SA(1, 0), cA + kstepA, voffA); PG8_STAGE(PG8_SB(1, 1), cB + hstepB + kstepB, voffB);
        PG8_WAIT_V(6); PG8_BAR;
    }
    for (;;) {
        const bool has_next = S.next(ui + 1, nxt);
        const char* nA = has_next ? (const char*)g.A + (size_t)nxt.pm * tstepA + (size_t)nxt.pn * pnstepA : cA; const char* nB = has_next ? (const char*)g.Bt + (size_t)nxt.pn * tstepB : cB;
        for (int t = 0; t < nt; t += 2) {
            const bool last = (t == nt - 2);
            const char* a1 = cA + (size_t)(t + 1) * kstepA;
            const char* a2 = last ? nA : cA + (size_t)(t + 2) * kstepA; const char* b2 = last ? nB : cB + (size_t)(t + 2) * kstepB;
            const char* a3 = a2 + kstepA; const char* b3 = b2 + kstepB;
            if (last && has_next) S.a_ready(nxt);
            if constexpr (SP2) {
            PG8_LDB(B0, 0, 0); PG8_LDB(B1, 0, 1); PG8_SCHED; PG8_LDA(At, 0, 0); PG8_STAGE(PG8_SA(1, 1), a1 + hstepA, voffA);
            PG8_WAIT_V(8); PG8_WAIT_L(0); PG8_BAR; PG8_MMA(0, 0, At, B0); PG8_MMA(0, 1, At, B1); PG8_BAR; PG8_SCHED;
            PG8_LDA(At, 0, 1); PG8_STAGE(PG8_SB(0, 0), b2, voffB); PG8_STAGE(PG8_SB(0, 1), b2 + hstepB, voffB); PG8_STAGE(PG8_SA(0, 0), a2, voffA);
            PG8_WAIT_V(8); PG8_WAIT_L(0); PG8_BAR; PG8_MMA(1, 0, At, B0); PG8_MMA(1, 1, At, B1); PG8_BAR; PG8_SCHED;
            PG8_LDB(B0, 1, 0); PG8_LDB(B1, 1, 1); PG8_SCHED; PG8_LDA(At, 1, 0); PG8_STAGE(PG8_SA(0, 1), a2 + hstepA, voffA);
            PG8_WAIT_V(8); PG8_WAIT_L(0); PG8_BAR; PG8_MMA(0, 0, At, B0); PG8_MMA(0, 1, At, B1); PG8_BAR; PG8_SCHED;
            PG8_LDA(At, 1, 1); PG8_STAGE(PG8_SB(1, 0), b3, voffB); PG8_STAGE(PG8_SB(1, 1), b3 + hstepB, voffB); PG8_STAGE(PG8_SA(1, 0), a3, voffA);
            PG8_WAIT_V(8); PG8_WAIT_L(0); PG8_BAR; PG8_MMA(1, 0, At, B0); PG8_MMA(1, 1, At, B1); PG8_BAR; PG8_SCHED;
            } else {
            PG8_LDB(B0, 0, 0); PG8_SCHED; PG8_LDA(At, 0, 0); PG8_STAGE(PG8_SA(1, 1), a1 + hstepA, voffA);
            PG8_WAIT_L(8); PG8_BAR; PG8_WAIT_L(0); PG8_MMA(0, 0, At, B0); PG8_BAR; PG8_SCHED;
            PG8_LDB(B1, 0, 1); PG8_STAGE(PG8_SB(0, 0), b2, voffB);
            PG8_BAR; PG8_WAIT_L(0); PG8_MMA(0, 1, At, B1); PG8_BAR;
            PG8_LDA(At, 0, 1); PG8_STAGE(PG8_SA(0, 0), a2, voffA);
            PG8_BAR; PG8_WAIT_L(0); PG8_MMA(1, 0, At, B0); PG8_BAR; PG8_SCHED;
            PG8_STAGE(PG8_SB(0, 1), b2 + hstepB, voffB);
            PG8_WAIT_V(6); PG8_BAR; PG8_MMA(1, 1, At, B1); PG8_BAR;
            PG8_LDB(B0, 1, 0); PG8_SCHED; PG8_LDA(At, 1, 0); PG8_STAGE(PG8_SA(0, 1), a2 + hstepA, voffA);
            PG8_WAIT_L(8); PG8_BAR; PG8_WAIT_L(0); PG8_MMA(0, 0, At, B0); PG8_BAR; PG8_SCHED;
            PG8_LDB(B1, 1, 1); PG8_STAGE(PG8_SB(1, 0), b3, voffB);
            PG8_BAR; PG8_WAIT_L(0); PG8_MMA(0, 1, At, B1); PG8_BAR;
            PG8_LDA(At, 1, 1); PG8_STAGE(PG8_SA(1, 0), a3, voffA);
            PG8_BAR; PG8_WAIT_L(0); PG8_MMA(1, 0, At, B0); PG8_BAR; PG8_SCHED;
            PG8_STAGE(PG8_SB(1, 1), b3 + hstepB, voffB);
            PG8_WAIT_V(6); PG8_BAR; PG8_MMA(1, 1, At, B1); PG8_BAR;
            }
        }
        if constexpr (ALIGN_EPI) { if (wr == 0) PG8_BAR; }
        if constexpr (!Epi::AFTER_DRAIN) { E(acc, cur, wr, wc, fr, fq); S.done(cur); }
        if (!has_next) break;
#pragma unroll
        for (int a = 0; a < 2; ++a)
#pragma unroll
            for (int b = 0; b < 2; ++b)
#pragma unroll
                for (int m = 0; m < 4; ++m)
#pragma unroll
                    for (int n = 0; n < 2; ++n) acc[a][b][m][n] = (f32x4){0.f, 0.f, 0.f, 0.f};
        cur = nxt; cA = nA; cB = nB; ++ui;
        if constexpr (ALIGN_EPI) { if (wr == 1) PG8_BAR; }
    }
    PG8_WAIT_V(0);
    if constexpr (!ALIGN_EPI) { if (wr == 0) PG8_BAR; }
    PG8_BAR;
    if constexpr (Epi::AFTER_DRAIN) { E.fused(acc, cur, wr, wc, fr, fq, lds, wid, lane); S.done(cur); }
#undef PG8_SA
#undef PG8_SB
#undef PG8_STAGE
#undef PG8_LDA
#undef PG8_LDB
#undef PG8_MMA
#undef PG8_WAIT_V
#undef PG8_WAIT_L
#undef PG8_BAR
#undef PG8_SCHED
}
}

namespace att {
constexpr int SLOTB = 8192;
constexpr int NSLOT = 4;
constexpr int L_K = 0, L_V = 32768, L_WS = 65536, L_OST = 67584, L_PSUM = L_OST, L_IMP = 133120, L_KB = L_IMP, L_SEL = 141312, L_END = 141568;
constexpr float PFIX = 268435456.0f;
constexpr float THR = 8.0f;

__device__ __forceinline__ int crow(int r, int hh) { return (r & 3) + 8 * (r >> 2) + 4 * hh; }
typedef float f32x2_t __attribute__((ext_vector_type(2))); typedef __bf16 bf16x2_t __attribute__((ext_vector_type(2)));
__device__ __forceinline__ unsigned cvtpk_s(float lo, float hi) { f32x2_t v = {lo, hi}; bf16x2_t b = __builtin_convertvector(v, bf16x2_t); return __builtin_bit_cast(unsigned, b); }
typedef short v4i16_t __attribute__((ext_vector_type(4)));
__device__ __forceinline__ s16x4 vtr(const LAS unsigned char* p) { return __builtin_bit_cast(s16x4, __builtin_amdgcn_ds_read_tr16_b64_v4i16((LAS v4i16_t*)p)); }
__device__ __forceinline__ float swap_sum(float v) { auto rr = __builtin_amdgcn_permlane32_swap(__float_as_uint(v), __float_as_uint(v), false, false); return __uint_as_float(rr[0]) + __uint_as_float(rr[1]); }
__device__ __forceinline__ float swap_max(float v) { auto rr = __builtin_amdgcn_permlane32_swap(__float_as_uint(v), __float_as_uint(v), false, false); return fmaxf(__uint_as_float(rr[0]), __uint_as_float(rr[1])); }
__device__ __forceinline__ bool trailing_half(int wid) { asm volatile("" : "+s"(wid)); return (wid >> 2) != 0; }
#define ATT_BAR() do { __builtin_amdgcn_s_barrier(); asm volatile("" ::: "memory"); } while (0)

__device__ __forceinline__ void dma_tile(const bf16_t* Kb, const bf16_t* Vb, int pitch, int tile, LAS unsigned char* shm, int slot, int wid, int lane) {
    const bf16_t* ks = Kb + (size_t)(tile * 64 + lane) * pitch + wid * 8;
    const bf16_t* vs = Vb + (size_t)(tile * 64 + 16 * (wid & 3) + (lane >> 2)) * pitch + (wid >> 2) * 32 + (lane & 3) * 8;
    __builtin_amdgcn_global_load_lds((const unsigned*)ks, (LAS unsigned*)(shm + L_K + slot * SLOTB + wid * 1024), 16, 0, 0);
    __builtin_amdgcn_global_load_lds((const unsigned*)vs, (LAS unsigned*)(shm + L_V + slot * SLOTB + wid * 1024), 16, 0, 0);
#ifdef PROBE_DMA2
    __builtin_amdgcn_global_load_lds((const unsigned*)ks, (LAS unsigned*)(shm + L_K + slot * SLOTB + wid * 1024), 16, 0, 0);
    __builtin_amdgcn_global_load_lds((const unsigned*)vs, (LAS unsigned*)(shm + L_V + slot * SLOTB + wid * 1024), 16, 0, 0);
#endif
}
#ifdef PROBE_DMA2
#define VMW2 "4"
#define VMW4 "8"
#else
#define VMW2 "2"
#define VMW4 "4"
#endif
__device__ __forceinline__ void qkt(f32x16& p0, f32x16& p1, const LAS unsigned char* shm, int slot, const bf16x8 (&qr)[4], const f32x16& cinit, int r32, int hh) {
    const LAS unsigned char* kb = shm + L_K + slot * SLOTB + hh * 1024 + r32 * 16;
#pragma unroll
    for (int d0 = 0; d0 < 4; ++d0) {
        const bf16x8 b0 = *(const LAS bf16x8*)(kb + d0 * 2048), b1 = *(const LAS bf16x8*)(kb + d0 * 2048 + 512);
        if (d0 == 0) { p0 = __builtin_amdgcn_mfma_f32_32x32x16_bf16(b0, qr[0], cinit, 0, 0, 0); p1 = __builtin_amdgcn_mfma_f32_32x32x16_bf16(b1, qr[0], cinit, 0, 0, 0); }
        else { p0 = __builtin_amdgcn_mfma_f32_32x32x16_bf16(b0, qr[d0], p0, 0, 0, 0); p1 = __builtin_amdgcn_mfma_f32_32x32x16_bf16(b1, qr[d0], p1, 0, 0, 0); }
        if (d0 == 1) asm volatile("" ::: "memory");
    }
}
__device__ __forceinline__ void load_k(bf16x8 (&kf)[8], const LAS unsigned char* shm, int slot, int r32, int hh) {
    const LAS unsigned char* kb = shm + L_K + slot * SLOTB + hh * 1024 + r32 * 16;
#pragma unroll
    for (int d0 = 0; d0 < 4; ++d0) { kf[2 * d0] = *(const LAS bf16x8*)(kb + d0 * 2048); kf[2 * d0 + 1] = *(const LAS bf16x8*)(kb + d0 * 2048 + 512); }
}
__device__ __forceinline__ void mma_qk(f32x16& p0, f32x16& p1, const bf16x8 (&kf)[8], const bf16x8 (&qr)[4], const f32x16& cinit) {
    p0 = __builtin_amdgcn_mfma_f32_32x32x16_bf16(kf[0], qr[0], cinit, 0, 0, 0); p1 = __builtin_amdgcn_mfma_f32_32x32x16_bf16(kf[1], qr[0], cinit, 0, 0, 0);
#pragma unroll
    for (int d0 = 1; d0 < 4; ++d0) { p0 = __builtin_amdgcn_mfma_f32_32x32x16_bf16(kf[2 * d0], qr[d0], p0, 0, 0, 0); p1 = __builtin_amdgcn_mfma_f32_32x32x16_bf16(kf[2 * d0 + 1], qr[d0], p1, 0, 0, 0); }
}
__device__ __forceinline__ void load_v(bf16x8 (&vf)[8], const LAS unsigned char* shm, int slot, int lane, int hh) {
    const LAS unsigned char* vb = shm + L_V + slot * SLOTB + ((lane >> 4) & 1) * 32 + (lane & 3) * 8 + (4 * hh + ((lane & 15) >> 2)) * 64;
#pragma unroll
    for (int ks = 0; ks < 4; ++ks)
#pragma unroll
        for (int d0 = 0; d0 < 2; ++d0) {
            const s16x4 vl = vtr(vb + d0 * 4096 + ks * 1024), vh = vtr(vb + d0 * 4096 + ks * 1024 + 512);
            vf[2 * ks + d0] = (bf16x8){vl[0], vl[1], vl[2], vl[3], vh[0], vh[1], vh[2], vh[3]};
        }
}
__device__ __forceinline__ void mma_pv(f32x16 (&o)[2], const u32x4 (&pw)[4], const bf16x8 (&vf)[8]) {
#pragma unroll
    for (int ks = 0; ks < 4; ++ks)
#pragma unroll
        for (int d0 = 0; d0 < 2; ++d0) o[d0] = __builtin_amdgcn_mfma_f32_32x32x16_bf16(__builtin_bit_cast(bf16x8, pw[ks]), vf[2 * ks + d0], o[d0], 0, 0, 0);
}
__device__ __forceinline__ void pv_seq(f32x16 (&o)[2], const u32x4 (&pw)[4], const LAS unsigned char* shm, int slot, int lane, int hh) {
    const LAS unsigned char* vb = shm + L_V + slot * SLOTB + ((lane >> 4) & 1) * 32 + (lane & 3) * 8 + (4 * hh + ((lane & 15) >> 2)) * 64;
#pragma unroll
    for (int ks = 0; ks < 4; ++ks) {
#pragma unroll
        for (int d0 = 0; d0 < 2; ++d0) {
            const s16x4 vl = vtr(vb + d0 * 4096 + ks * 1024), vh = vtr(vb + d0 * 4096 + ks * 1024 + 512);
            const bf16x8 vf = {vl[0], vl[1], vl[2], vl[3], vh[0], vh[1], vh[2], vh[3]};
            o[d0] = __builtin_amdgcn_mfma_f32_32x32x16_bf16(__builtin_bit_cast(bf16x8, pw[ks]), vf, o[d0], 0, 0, 0);
        }
        if (ks == 1) asm volatile("" ::: "memory");
    }
}
__device__ __forceinline__ void range_mask(f32x16& p0, f32x16& p1, int kb, int lo, int hi) {
#pragma unroll
    for (int r = 0; r < 16; ++r) { const int k = kb + (r & 3) + 8 * (r >> 2); if (k < lo || k > hi) p0[r] = -INFINITY; if (k + 32 < lo || k + 32 > hi) p1[r] = -INFINITY; }
}
__device__ __forceinline__ void mask_hi(f32x16& p0, f32x16& p1, int dh) {
#pragma unroll
    for (int r = 0; r < 16; ++r) { const int c = (r & 3) + 8 * (r >> 2); if (c > dh) p0[r] = -INFINITY; if (c + 32 > dh) p1[r] = -INFINITY; }
}
__device__ __forceinline__ void mask_lo(f32x16& p0, f32x16& p1, int dl) {
#pragma unroll
    for (int r = 0; r < 16; ++r) { const int c = (r & 3) + 8 * (r >> 2); if (c < dl) p0[r] = -INFINITY; if (c + 32 < dl) p1[r] = -INFINITY; }
}
__device__ __forceinline__ void rescale_o(f32x16 (&o)[2], const LAS float* wsf, int hh) {
#pragma unroll
    for (int g = 0; g < 4; ++g) { const f32x4 a4 = *(const LAS f32x4*)(wsf + 8 * g + 4 * hh);
#pragma unroll
        for (int j = 0; j < 4; ++j) { o[0][4 * g + j] *= a4[j]; o[1][4 * g + j] *= a4[j]; } }
}

__device__ __forceinline__ float max3f(float a, float b, float c) { float r; asm("v_max3_f32 %0, %1, %2, %3" : "=v"(r) : "v"(a), "v"(b), "v"(c)); return r; }
#define MM(a, b, c) __builtin_amdgcn_mfma_f32_32x32x16_bf16(a, b, c, 0, 0, 0)
#define SGB(mask, n) __builtin_amdgcn_sched_group_barrier(mask, n, 0)
template <int MODE, bool NOMAX, bool LEAN = false>
__device__ __forceinline__ void sweep(f32x16 (&o)[2], float& mhat, float& l, const bf16x8 (&qr)[4], const bf16_t* Kb, const bf16_t* Vb, int pitch, int t0, int NT, int lo, int hi,
                                      unsigned rowsel, LAS unsigned char* shm, int& ring, int wid, int lane) {
    static_assert(!(MODE == 1 && NOMAX), "the FoX key bias grows without bound: it needs the running max");
    asm volatile("" : "+v"(lane));
    const int r32 = lane & 31, hh = lane >> 5;
    LAS float* wsf = (LAS float*)(shm + L_WS + wid * 256);
    const int lo_max = __builtin_amdgcn_readlane(lo, 31), hi_min = __builtin_amdgcn_readfirstlane(hi);
    const int ring0 = ring;
#define SLOT(i_) ((ring0 + (i_)) & (NSLOT - 1))
    dma_tile(Kb, Vb, pitch, t0, shm, SLOT(0), wid, lane);
    if (NT > 1) dma_tile(Kb, Vb, pitch, t0 + 1, shm, SLOT(1), wid, lane);
    f32x16 a0, a1, b0, b1, cini; u32x4 pw[4]; bf16x8 kf[8], vf[8]; float ls0 = 0.f, ls1 = 0.f; bool resc = false;
#pragma unroll
    for (int r = 0; r < 16; ++r) cini[r] = 0.f;
#define SET_CINI(i_) do { if (MODE == 2) { const float c_ = ((rowsel >> (t0 + (i_))) & 1u) ? 0.f : -INFINITY; _Pragma("unroll") for (int r = 0; r < 16; ++r) cini[r] = c_; } } while (0)
#define POST(C0, C1, i_) do { const int tile_ = t0 + (i_); \
        if (MODE == 1) { const LAS float* kb_ = (const LAS float*)(shm + L_KB) + tile_ * 64 + 4 * hh; \
            _Pragma("unroll") for (int k_ = 0; k_ < 4; ++k_) { const f32x4 x0_ = *(const LAS f32x4*)(kb_ + 8 * k_), x1_ = *(const LAS f32x4*)(kb_ + 32 + 8 * k_); \
                _Pragma("unroll") for (int e_ = 0; e_ < 4; ++e_) { C0[4 * k_ + e_] += x0_[e_]; C1[4 * k_ + e_] += x1_[e_]; } } } \
        if (tile_ * 64 < lo_max || tile_ * 64 + 63 > hi_min) range_mask(C0, C1, tile_ * 64 + 4 * hh, lo, hi); \
        if (!NOMAX) { \
            float ra_ = max3f(C0[0], C0[1], C1[0]), rb_ = max3f(C0[2], C0[3], C1[1]); ra_ = max3f(ra_, C1[2], C1[3]); \
            _Pragma("unroll") for (int r = 4; r < 16; r += 4) { ra_ = max3f(ra_, C0[r], C0[r + 1]); rb_ = max3f(rb_, C0[r + 2], C0[r + 3]); ra_ = max3f(ra_, C1[r], C1[r + 1]); rb_ = max3f(rb_, C1[r + 2], C1[r + 3]); } \
            const float rm_ = swap_max(fmaxf(ra_, rb_)); const bool first_ = ((i_) == 0); \
            if (first_ || __any(rm_ > THR)) { \
                float dl_ = first_ ? rm_ : fmaxf(rm_, 0.f); if (dl_ == -INFINITY) dl_ = 0.f; \
                mhat += dl_; \
                _Pragma("unroll") for (int r = 0; r < 16; ++r) { C0[r] -= dl_; C1[r] -= dl_; cini[r] = -mhat; } \
                if (!first_) { const float al_ = __builtin_amdgcn_exp2f(-dl_); l *= al_; ls0 *= al_; ls1 *= al_; if (hh == 0) wsf[r32] = al_; resc = true; } } } \
    } while (0)
    asm volatile("s_waitcnt lgkmcnt(0)" ::: "memory");
    if (NT > 1) asm volatile("s_waitcnt vmcnt(2)" ::: "memory"); else asm volatile("s_waitcnt vmcnt(0)" ::: "memory");
    ATT_BAR();
    if (NT > 2) dma_tile(Kb, Vb, pitch, t0 + 2, shm, SLOT(2), wid, lane);
    SET_CINI(0);
    load_k(kf, shm, SLOT(0), r32, hh);
    mma_qk(a0, a1, kf, qr, cini);
    POST(a0, a1, 0);
#pragma unroll
    for (int r = 0; r < 16; ++r) { a0[r] = __builtin_amdgcn_exp2f(a0[r]); a1[r] = __builtin_amdgcn_exp2f(a1[r]); }
#define STEP(i_, C0, C1, P0, P1) do { \
        asm volatile("s_waitcnt lgkmcnt(0)" ::: "memory"); \
        if ((i_) + 1 < NT) asm volatile("s_waitcnt vmcnt(2)" ::: "memory"); else asm volatile("s_waitcnt vmcnt(0)" ::: "memory"); \
        ATT_BAR(); \
        SET_CINI(i_); \
        load_k(kf, shm, SLOT(i_), r32, hh); \
        __builtin_amdgcn_sched_barrier(0); \
        load_v(vf, shm, SLOT((i_) - 1), lane, hh);               \
          \
        C0 = MM(kf[0], qr[0], cini); C1 = MM(kf[1], qr[0], cini); \
        _Pragma("unroll") for (int d_ = 1; d_ < 4; ++d_) { C0 = MM(kf[2 * d_], qr[d_], C0); C1 = MM(kf[2 * d_ + 1], qr[d_], C1); } \
        _Pragma("unroll") for (int r = 0; r < 16; ++r) { ls0 += P0[r]; ls1 += P1[r]; } \
        _Pragma("unroll") for (int e_ = 0; e_ < 4; ++e_) { pw[0][e_] = cvtpk_s(P0[2 * e_], P0[2 * e_ + 1]); pw[1][e_] = cvtpk_s(P0[8 + 2 * e_], P0[9 + 2 * e_]); pw[2][e_] = cvtpk_s(P1[2 * e_], P1[2 * e_ + 1]); pw[3][e_] = cvtpk_s(P1[8 + 2 * e_], P1[9 + 2 * e_]); } \
        _Pragma("unroll") for (int g_ = 0; g_ < 8; ++g_) { SGB(0x008, 1); SGB(0x100, 2); SGB(0x002, 6); } \
        asm volatile("" : "+v"(ls0), "+v"(ls1), "+v"(pw[0]), "+v"(pw[1]), "+v"(pw[2]), "+v"(pw[3]));     \
        __builtin_amdgcn_sched_barrier(0); \
        POST(C0, C1, i_); \
        __builtin_amdgcn_sched_barrier(0); \
          \
        if ((i_) + 2 < NT) dma_tile(Kb, Vb, pitch, t0 + (i_) + 2, shm, SLOT((i_) + 2), wid, lane); \
        _Pragma("unroll") for (int ks_ = 0; ks_ < 4; ++ks_) _Pragma("unroll") for (int d_ = 0; d_ < 2; ++d_) o[d_] = MM(__builtin_bit_cast(bf16x8, pw[ks_]), vf[2 * ks_ + d_], o[d_]); \
        _Pragma("unroll") for (int r = 0; r < 16; ++r) { C0[r] = __builtin_amdgcn_exp2f(C0[r]); C1[r] = __builtin_amdgcn_exp2f(C1[r]); } \
        SGB(0x008, 1); SGB(0x020, 1); SGB(0x400, 4); SGB(0x008, 1); SGB(0x020, 1); SGB(0x400, 4); \
        _Pragma("unroll") for (int g_ = 0; g_ < 6; ++g_) { SGB(0x008, 1); SGB(0x400, 4); } \
        __builtin_amdgcn_sched_barrier(0); \
        if (!NOMAX) { if (resc) { rescale_o(o, wsf, hh); resc = false; } } \
    } while (0)
    int i = 1;
    for (; i + 1 < NT; i += 2) { STEP(i, b0, b1, a0, a1); STEP(i + 1, a0, a1, b0, b1); }
    if (i < NT) {
        STEP(i, b0, b1, a0, a1);
#pragma unroll
        for (int r = 0; r < 16; ++r) { a0[r] = b0[r]; a1[r] = b1[r]; }
    }
#pragma unroll
    for (int r = 0; r < 16; ++r) { ls0 += a0[r]; ls1 += a1[r]; }
#pragma unroll
    for (int e = 0; e < 4; ++e) { pw[0][e] = cvtpk_s(a0[2 * e], a0[2 * e + 1]); pw[1][e] = cvtpk_s(a0[8 + 2 * e], a0[9 + 2 * e]); pw[2][e] = cvtpk_s(a1[2 * e], a1[2 * e + 1]); pw[3][e] = cvtpk_s(a1[8 + 2 * e], a1[9 + 2 * e]); }
    load_v(vf, shm, SLOT(NT - 1), lane, hh);
    mma_pv(o, pw, vf);
    l += ls0 + ls1;
    asm volatile("s_waitcnt lgkmcnt(0)" ::: "memory");
    ring = SLOT(NT);
#undef STEP
#undef POST
#undef SET_CINI
#undef SLOT
}
#undef MM
#undef SGB
template <bool FIRST>
__device__ __forceinline__ void merge(const f32x16 (&o)[2], float scale, LAS unsigned char* shm, int wid, int r32, int hh) {
    LAS float* wsf = (LAS float*)(shm + L_WS + wid * 256);
    LAS float* stg = (LAS float*)(shm + L_OST + wid * 8192) + r32;
    if (hh == 0) wsf[r32] = scale;
#pragma unroll
    for (int g = 0; g < 4; ++g) { const f32x4 s4 = *(const LAS f32x4*)(wsf + 8 * g + 4 * hh);
#pragma unroll
        for (int j = 0; j < 4; ++j) { LAS float* p = stg + (8 * g + 4 * hh + j) * 64;
            if (FIRST) { p[0] = o[0][4 * g + j] * s4[j]; p[32] = o[1][4 * g + j] * s4[j]; }
            else { p[0] += o[0][4 * g + j] * s4[j]; p[32] += o[1][4 * g + j] * s4[j]; } } }
}
__device__ __forceinline__ void store_o(bf16_t* Ow, LAS unsigned char* shm, int wid, int lane) {
    const LAS float* stg = (const LAS float*)(shm + L_OST + wid * 8192);
#pragma unroll
    for (int i = 0; i < 4; ++i) { const int rowl = i * 8 + (lane >> 3), ch = lane & 7; const f32x4 a = *(const LAS f32x4*)(stg + rowl * 64 + ch * 8), c = *(const LAS f32x4*)(stg + rowl * 64 + ch * 8 + 4);
        u32x4 v; v.x = cvtpk_s(a[0], a[1]); v.y = cvtpk_s(a[2], a[3]); v.z = cvtpk_s(c[0], c[1]); v.w = cvtpk_s(c[2], c[3]); *(GAS u32x4*)(Ow + (size_t)rowl * D + ch * 8) = v; }
}
__device__ __forceinline__ void zero_o(f32x16 (&o)[2]) { o[0] = (f32x16){0.f, 0.f, 0.f, 0.f, 0.f, 0.f, 0.f, 0.f, 0.f, 0.f, 0.f, 0.f, 0.f, 0.f, 0.f, 0.f}; o[1] = o[0]; }
#define ATT_LOADQ(Qrow_) bf16x8 qr[4]; _Pragma("unroll") for (int d0 = 0; d0 < 4; ++d0) qr[d0] = *(const GAS bf16x8*)((Qrow_) + d0 * 16 + hh * 8)

__device__ __forceinline__ void fox_unit(LAS unsigned char* shm, int b, int h, int qb, unsigned char* ws_, size_t off_p, size_t off_cb, size_t off_o, int wid, int& ring) {
    const int lane = lane_id_volatile();
    unsigned char* ws = ws_; asm volatile("" : "+s"(ws)); const bf16_t* P = (const bf16_t*)(ws + off_p); const float* CB = (const float*)(ws + off_cb); bf16_t* O = (bf16_t*)(ws + off_o);
    const int r32 = lane & 31, hh = lane >> 5;
    const int pos = 256 * qb + 32 * wid + r32;
    const size_t row = (size_t)b * T + pos;
    ATT_LOADQ(P + row * FOX_LDP + h * 64);
    const bf16_t* Kb = (const bf16_t*)(ws + off_p + FOX_HM_OFF) + (size_t)(b * NH + h) * T * 64; const bf16_t* Vb = Kb + FOX_HM_STRIDE;
    f32x16 o[2]; zero_o(o); float m = 0.f, l = 0.f;
    asm volatile("s_waitcnt lgkmcnt(0)" ::: "memory"); ATT_BAR();
    { const float* cb = CB + (size_t)(b * NH + h) * T; LAS float* kbl = (LAS float*)(shm + L_KB);
      for (int i = wid * 64 + lane; i < 64 * (4 * qb + 4); i += 512) kbl[i] = ((const GAS float*)cb)[i]; }
    sweep<1, false>(o, m, l, qr, Kb, Vb, 64, 0, 4 * qb + 4, 0, pos, 0u, shm, ring, wid, lane);
    const float lt = swap_sum(l); const float inv = lt > 0.f ? 1.0f / lt : 0.f;
    merge<true>(o, inv, shm, wid, r32, hh);
    store_o(O + ((size_t)b * T + 256 * qb + 32 * wid) * D + h * 64, shm, wid, lane);
}
__device__ __forceinline__ void swa_unit(LAS unsigned char* shm, int b, int g, int qt, unsigned char* ws_, size_t off_p, size_t off_o, const float* sinks, int wid, int& ring) {
    const int lane = lane_id_volatile();
    unsigned char* ws = ws_; asm volatile("" : "+s"(ws)); const bf16_t* P = (const bf16_t*)(ws + off_p); bf16_t* O = (bf16_t*)(ws + off_o);
    const int r32 = lane & 31, hh = lane >> 5;
    const int q0 = 32 * qt, pos = q0 + r32, head = 8 * g + wid;
    const size_t row = (size_t)b * T + pos;
    ATT_LOADQ(P + row * SWA_LDP + head * 64);
    const bf16_t* Kb = (const bf16_t*)(ws + off_p + SWA_HM_OFF) + (size_t)(b * 2 + g) * T * 64; const bf16_t* Vb = Kb + SWA_HM_STRIDE;
    f32x16 o[2]; zero_o(o); float m = 0.f, l = 0.f;
    const int tlo = (q0 - 127) > 0 ? ((q0 - 127) >> 6) : 0, thi = (q0 + 31) >> 6;
    sweep<0, true, true>(o, m, l, qr, Kb, Vb, 64, tlo, thi - tlo + 1, pos - 127, pos, 0u, shm, ring, wid, lane);
    const float lt = swap_sum(l) + __builtin_amdgcn_exp2f(((const GAS float*)sinks)[head] * LOG2E - m);
    const float inv = 1.0f / lt;
    merge<true>(o, inv, shm, wid, r32, hh);
    store_o(O + ((size_t)b * T + q0) * D + head * 64, shm, wid, lane);
}
__device__ __forceinline__ void nsa_unit(LAS unsigned char* shm, int b, int g, int qt, unsigned char* ws_, size_t off_p, size_t off_g, size_t off_kc, size_t off_vc, size_t off_o, int wid, int& ring) {
#define NSA_WS() unsigned char* ws = ws_; asm volatile("" : "+s"(ws)); const bf16_t* P = (const bf16_t*)(ws + off_p); const float* G = (const float*)(ws + off_g); const bf16_t* Hb = (const bf16_t*)(ws + off_p + NSA_HM_OFF) + (size_t)(b * 4 + g) * T * 64; (void)G; (void)Hb
    const int hq = 4 * g + (wid >> 1), ph = wid & 1, q0 = 64 * qt;
    LAS unsigned* PSUM = (LAS unsigned*)(shm + L_PSUM); LAS float* IMP = (LAS float*)(shm + L_IMP); LAS unsigned* SEL = (LAS unsigned*)(shm + L_SEL);
#define NSA_LANE() const int lane = lane_id_volatile(); const int r32 = lane & 31, hh = lane >> 5; const int pos = q0 + 32 * ph + r32; const size_t row = (size_t)b * T + pos; (void)hh; (void)row
#define NSA_QROW (P + row * NSA_LDP + hq * 64)
    asm volatile("s_waitcnt lgkmcnt(0)" ::: "memory"); ATT_BAR();
    { const int tid = wid * 64 + lane_id_volatile(); for (int i = tid; i < 8192; i += 512) PSUM[i] = 0u; }
    f32x16 ocmp[2]; float inv_cmp;
    {
        NSA_LANE(); NSA_WS();
        const bf16_t* Kb = (const bf16_t*)(ws + off_kc) + (size_t)(b * 4 + g) * NCP * 64; const bf16_t* Vb = (const bf16_t*)(ws + off_vc) + (size_t)(b * 4 + g) * NCP * 64;
        const int cm = (pos < 31) ? -1 : (((pos - 31) >> 4) < 126 ? ((pos - 31) >> 4) : 126);
        const int ntile = qt >= 16 ? 2 : 1;
        ATT_LOADQ(NSA_QROW);
        f32x16 o[2]; zero_o(o); float m = 0.f, l = 0.f;
        const int ring0 = ring;
        sweep<0, true>(o, m, l, qr, Kb, Vb, 64, 0, ntile, 0, cm, 0u, shm, ring, wid, lane);
        const float lt = swap_sum(l); const float inv = lt > 0.f ? 1.0f / lt : 0.f;
        f32x16 negm;
#pragma unroll
        for (int r = 0; r < 16; ++r) negm[r] = -m;
        for (int tile = 0; tile < ntile; ++tile) {
            const int sl = (ring0 + tile) & (NSLOT - 1);
            f32x16 p0, p1; qkt(p0, p1, shm, sl, qr, negm, r32, hh);
            range_mask(p0, p1, tile * 64 + 4 * hh, 0, cm);
            LAS unsigned* pb = PSUM + (tile * 64 + 4 * hh) * 64 + 32 * ph + r32;
            asm volatile("" : "+v"(pb));
#pragma unroll
            for (int r = 0; r < 16; ++r) {
                const float a = __builtin_amdgcn_exp2f(p0[r]) * inv, c = __builtin_amdgcn_exp2f(p1[r]) * inv;
                __hip_atomic_fetch_add(pb + ((r & 3) + 8 * (r >> 2)) * 64, (unsigned)(a * PFIX + 0.5f), __ATOMIC_RELAXED, __HIP_MEMORY_SCOPE_WORKGROUP);
                __hip_atomic_fetch_add(pb + ((r & 3) + 8 * (r >> 2) + 32) * 64, (unsigned)(c * PFIX + 0.5f), __ATOMIC_RELAXED, __HIP_MEMORY_SCOPE_WORKGROUP);
            }
        }
        ocmp[0] = o[0]; ocmp[1] = o[1]; inv_cmp = inv;
    }
    asm volatile("s_waitcnt lgkmcnt(0)" ::: "memory"); ATT_BAR();
    {
        const int tid = wid * 64 + lane_id_volatile();
        const int rw = tid & 63, ng = tid >> 6;
        LAS unsigned* pb = PSUM + (16 * ng - 1) * 64 + rw;
        LAS float* ib = IMP + (4 * ng) * 64 + rw;
        asm volatile("" : "+v"(pb), "+v"(ib));
        float pc[17];
#pragma unroll
        for (int e = 0; e < 17; ++e) pc[e] = (float)pb[e * 64] * (1.0f / PFIX);
        if (ng == 0) pc[0] = 0.f;
#pragma unroll
        for (int k = 0; k < 4; ++k) ib[k * 64] = pc[4 * k + 1] + pc[4 * k + 2] + pc[4 * k + 3] + 0.5f * (pc[4 * k + 4] + pc[4 * k]);
        const unsigned init = qt < 16 ? ((2u << qt) - 1u) : (1u | (1u << qt) | (1u << (qt - 1)));
        if (tid < 64) SEL[tid] = init;
    }
    asm volatile("s_waitcnt lgkmcnt(0)" ::: "memory"); ATT_BAR();
    if (qt >= 16) {
        const int tid = wid * 64 + lane_id_volatile();
        const int rw = tid & 63, ng = tid >> 6; unsigned bits = 0u;
        LAS float* ib = IMP + rw; asm volatile("" : "+v"(ib));
        float v[4]; int cnt[4] = {0, 0, 0, 0};
#pragma unroll
        for (int k = 0; k < 4; ++k) v[k] = ib[(4 * ng + k) * 64];
        for (int n2 = 1; n2 <= qt - 2; ++n2) { const float v2 = ib[n2 * 64];
#pragma unroll
            for (int k = 0; k < 4; ++k) cnt[k] += (v2 > v[k] || (v2 == v[k] && n2 < 4 * ng + k)) ? 1 : 0; }
#pragma unroll
        for (int k = 0; k < 4; ++k) { const int n = 4 * ng + k; if (n >= 1 && n <= qt - 2 && cnt[k] < 13) bits |= 1u << n; }
        if (bits) __hip_atomic_fetch_or(SEL + rw, bits, __ATOMIC_RELAXED, __HIP_MEMORY_SCOPE_WORKGROUP);
    }
    asm volatile("s_waitcnt lgkmcnt(0)" ::: "memory"); ATT_BAR();
    { NSA_LANE(); NSA_WS(); merge<true>(ocmp, ((const GAS float*)G)[row * 48 + hq * 3 + 0] * inv_cmp, shm, wid, r32, hh); }
    {
        NSA_LANE(); NSA_WS();
        const unsigned rowsel = SEL[32 * ph + r32];
        ATT_LOADQ(NSA_QROW);
        f32x16 o[2]; zero_o(o); float m = 0.f, l = 0.f;
        sweep<2, true>(o, m, l, qr, Hb, Hb + NSA_HM_STRIDE, 64, 0, qt + 1, 0, pos, rowsel, shm, ring, wid, lane);
        const float lt = swap_sum(l); const float inv = lt > 0.f ? 1.0f / lt : 0.f;
        merge<false>(o, ((const GAS float*)G)[row * 48 + hq * 3 + 1] * inv, shm, wid, r32, hh);
    }
    {
        NSA_LANE(); NSA_WS();
        ATT_LOADQ(NSA_QROW);
        f32x16 o[2]; zero_o(o); float m = 0.f, l = 0.f;
        const int tlo = qt > 8 ? qt - 8 : 0;
        sweep<0, true>(o, m, l, qr, Hb + 2 * NSA_HM_STRIDE, Hb + 3 * NSA_HM_STRIDE, 64, tlo, qt - tlo + 1, pos - 511, pos, 0u, shm, ring, wid, lane);
        const float lt = swap_sum(l); const float inv = lt > 0.f ? 1.0f / lt : 0.f;
        merge<false>(o, ((const GAS float*)G)[row * 48 + hq * 3 + 2] * inv, shm, wid, r32, hh);
    }
    { unsigned char* ws = ws_; asm volatile("" : "+s"(ws)); store_o((bf16_t*)(ws + off_o) + ((size_t)b * T + q0 + 32 * ph) * D + hq * 64, shm, wid, lane_id_volatile()); }
#undef NSA_WS
#undef NSA_LANE
#undef NSA_QROW
}
#undef ATT_LOADQ
#undef ATT_BAR
}

constexpr size_t MiB = 1u << 20;
constexpr size_t WS_CTL = 0, CTL_ZERO_BYTES = 1 * MiB;
constexpr size_t WS_WUP = 1 * MiB, WS_WDN = 33 * MiB;
constexpr size_t WS_WNSA = 65 * MiB, WNSA_STRIDE = (size_t)NSA_NP * D * 2;
constexpr size_t WS_WOUT = 76 * MiB;
constexpr size_t WS_WFOX = 84 * MiB;
constexpr size_t WS_WSWA = 84 * MiB + 6656 * 1024;
constexpr size_t WS_WCMP = 93 * MiB;
constexpr size_t WS_ROPEC = 97 * MiB, WS_ROPES = WS_ROPEC + 256 * 1024;
constexpr size_t WS_CMPB = WS_ROPES + 256 * 1024;
constexpr size_t WS_SWAB = WS_CMPB + 64 * 1024;
constexpr size_t WS_WGATE = 99 * MiB;
constexpr size_t WS_RSTD = 98 * MiB;
constexpr size_t WS_XN = 100 * MiB;
constexpr size_t WS_BIG = 164 * MiB;
constexpr size_t WS_O = WS_BIG + 192 * MiB;
constexpr size_t WS_G = 420 * MiB, WS_LF = 426 * MiB, WS_CB = 428 * MiB, WS_KC = 430 * MiB, WS_VC = 431 * MiB, WS_HID = 432 * MiB, WS_M2 = 440 * MiB, WS_END = 504 * MiB;
static_assert(WS_WSWA + (size_t)SWA_NP * D * 2 <= WS_WCMP && WS_WFOX + (size_t)FOX_NP * D * 2 <= WS_WSWA && WS_WNSA + 2 * WNSA_STRIDE <= WS_WOUT && WS_SWAB + 8192 <= WS_XN, "d_ws map");
static_assert((size_t)M * FF * 2 == 256 * MiB && WS_O + (size_t)M * D * 2 == WS_G && (size_t)M * 3072 * 2 == 192 * MiB, "d_ws map");
constexpr int CW_TMO = 0, CW_BAR = 4096;

constexpr int RING_OFF = 0, RING_BYTES = 142336;
constexpr int LDSCTL_OFF = RING_BYTES, MISC_OFF = LDSCTL_OFF + 320;
constexpr int LDS_BYTES = 147456;
static_assert(att::L_END <= RING_BYTES && MISC_OFF + 128 <= LDS_BYTES, "LDS map");
constexpr int NWAVES = 8;
#ifndef L_LO
#define L_LO 0
#endif
#ifndef L_HI
#define L_HI DEPTH
#endif

typedef GAS unsigned gu32;
typedef GAS unsigned long long gu64;
#define RLX_AGENT __ATOMIC_RELAXED, __HIP_MEMORY_SCOPE_AGENT
#define LDS_WAIT() asm volatile("s_waitcnt lgkmcnt(0)" ::: "memory")
#define VM_WAIT() asm volatile("s_waitcnt vmcnt(0)" ::: "memory")
__device__ __forceinline__ unsigned long long rt() { return __builtin_amdgcn_s_memrealtime(); }
__device__ __forceinline__ unsigned f2bf(float f) { unsigned u = __builtin_bit_cast(unsigned, f); return (u + 0x7fffu + ((u >> 16) & 1u)) >> 16; }
__device__ __forceinline__ unsigned pk2(float lo, float hi) { return f2bf(lo) | (f2bf(hi) << 16); }

#define XB_TMO      128
#define XB_XCNT(j)  (256  + 64 * (j))
#define XB_XSUB(j)  (1280 + 64 * (j))
#define XB_XGEN(j)  (2304 + 64 * (j))
#define XB_TOP      3328
#define XB_TOPGEN   3392
#define XCD_BAR_WORDS 3456
#define XB_SPIN_CAP (1u << 18)

__device__ __forceinline__ unsigned xb_ld(unsigned* p)              { return __hip_atomic_load(p, __ATOMIC_RELAXED, __HIP_MEMORY_SCOPE_AGENT); }
__device__ __forceinline__ unsigned xb_add(unsigned* p, unsigned v) { return __hip_atomic_fetch_add(p, v, __ATOMIC_RELAXED, __HIP_MEMORY_SCOPE_AGENT); }
__device__ __forceinline__ unsigned xb_xcc_id() { return (unsigned)__builtin_amdgcn_s_getreg((3 << 11) | 20) & 0xFu; }
#define XB_SPIN(cond, bar) do { unsigned _sp = 0; while (cond) { __builtin_amdgcn_s_sleep(1); \
    if ((++_sp & 255u) == 0u) { if (xb_ld(&(bar)[XB_TMO])) break; if (_sp > XB_SPIN_CAP) { atomicAdd(&(bar)[XB_TMO], 1u); break; } } } } while (0)

struct XcdBarrier {
    unsigned* bar; unsigned x;
    volatile LAS unsigned* st;
};

__device__ __forceinline__ XcdBarrier xcd_barrier_post(unsigned* bar, volatile LAS unsigned* st) {
    XcdBarrier b; b.bar = bar; b.x = xb_xcc_id(); b.st = st;
    if (threadIdx.x == 0) (void)xb_add(&bar[XB_XCNT(b.x)], 1u);
    return b;
}
__device__ __forceinline__ void xcd_barrier_complete(unsigned* bar, unsigned x, unsigned& nloc, unsigned& nx) {
    const unsigned G = gridDim.x * gridDim.y * gridDim.z;
    unsigned sum, cnt, mine, sp = 0u;
    for (;;) {
        sum = 0u; cnt = 0u; mine = 0u;
#pragma unroll
        for (unsigned j = 0; j < 16; ++j) { const unsigned c = xb_ld(&bar[XB_XCNT(j)]); sum += c; cnt += (c > 0u) ? 1u : 0u; mine = (j == x) ? c : mine; }
        if (sum == G) break;
        __builtin_amdgcn_s_sleep(1);
        if ((++sp & 255u) == 0u) { if (xb_ld(&bar[XB_TMO])) break; if (sp > XB_SPIN_CAP) { atomicAdd(&bar[XB_TMO], 1u); break; } }
    }
    nloc = mine > 0u ? mine : 1u; nx = cnt > 0u ? cnt : 1u;
}

__device__ __forceinline__ void xcd_barrier(const XcdBarrier& b) {
    asm volatile("s_waitcnt vmcnt(0)" ::: "memory");
    __syncthreads();
    if (threadIdx.x == 0) {
        unsigned* bar = b.bar;
        __builtin_amdgcn_s_waitcnt(0);
        unsigned nloc = b.st[0], nx = b.st[1];
        if (nloc == 0u) { xcd_barrier_complete(bar, b.x, nloc, nx); b.st[0] = nloc; b.st[1] = nx; }
        const unsigned old = xb_add(&bar[XB_XSUB(b.x)], 1u);
        const unsigned gen = old / nloc;
        if (old + 1u == (gen + 1u) * nloc) {
            __builtin_amdgcn_fence(__ATOMIC_RELEASE, "agent");
            asm volatile("s_waitcnt vmcnt(0)" ::: "memory");
            const unsigned og = xb_add(&bar[XB_TOP], 1u);
            const unsigned tg = og / nx;
            if (og + 1u == (tg + 1u) * nx) xb_add(&bar[XB_TOPGEN], 1u);
            else XB_SPIN(xb_ld(&bar[XB_TOPGEN]) == tg, bar);
            __builtin_amdgcn_fence(__ATOMIC_ACQUIRE, "agent");
            xb_add(&bar[XB_XGEN(b.x)], 1u);
            asm volatile("s_waitcnt vmcnt(0)" ::: "memory");
        } else {
            XB_SPIN(xb_ld(&bar[XB_XGEN(b.x)]) == gen, bar);
            __builtin_amdgcn_fence(__ATOMIC_ACQUIRE, "agent");
            asm volatile("s_waitcnt vmcnt(0)" ::: "memory");
        }
    }
    __syncthreads();
}

__device__ __forceinline__ float wave_sum(float v) {
    v += __builtin_bit_cast(float, __builtin_amdgcn_update_dpp(0, __builtin_bit_cast(int, v), 0xB1, 0xF, 0xF, true));
    v += __builtin_bit_cast(float, __builtin_amdgcn_update_dpp(0, __builtin_bit_cast(int, v), 0x4E, 0xF, 0xF, true));
    v += __builtin_bit_cast(float, __builtin_amdgcn_update_dpp(0, __builtin_bit_cast(int, v), 0x141, 0xF, 0xF, true));
    v += __builtin_bit_cast(float, __builtin_amdgcn_update_dpp(0, __builtin_bit_cast(int, v), 0x140, 0xF, 0xF, true));
    v += __builtin_bit_cast(float, __builtin_amdgcn_ds_swizzle(__builtin_bit_cast(int, v), 0x401F));
    { auto rr = __builtin_amdgcn_permlane32_swap(__float_as_uint(v), __float_as_uint(v), false, false); v = __uint_as_float(rr[0]) + __uint_as_float(rr[1]); }
    return v;
}

__device__ __forceinline__ int il64(int c) { return (c >> 1) + 32 * (c & 1); }
__device__ __forceinline__ int li64(int d) { return 2 * (d & 31) + (d >> 5); }
__device__ __forceinline__ int src_n(int mode, int n) { return (mode == 3 && n < 1152) ? (n & ~63) + il64(n & 63) : n; }
__device__ __forceinline__ int dst_n(int mode, int n) {
    if (mode == 1) { const int reg = n >> 8; const bool rope = reg < 4 || reg == 4 || reg == 6 || reg == 8; return rope ? (n & ~63) + li64(n & 63) : n; }
    if (mode == 3) return n < 1152 ? (n & ~63) + li64(n & 63) : n;
    return n;
}
__device__ __forceinline__ void conv_item(const float* W, int K, int N, bf16_t* WT, int mode, int item, LAS float* scr, int lane, int ld = 0) {
    if (ld == 0) ld = N;
    const int nblk = (N + 31) / 32, kb = item / nblk, nb = item % nblk, k0 = 64 * kb, n0 = 32 * nb;
    const int c4 = (lane & 7) * 4; const bool cin = (n0 + c4) < N;
#pragma unroll
    for (int i = 0; i < 8; ++i) { const int kk = (lane >> 3) + 8 * i; const int kd = (mode == 4) ? li64(kk) : kk;
        const f32x4 v = cin ? *(const GAS f32x4*)(W + (size_t)(k0 + kk) * ld + n0 + c4) : (f32x4){0.f, 0.f, 0.f, 0.f};
        scr[kd * 33 + c4] = v[0]; scr[kd * 33 + c4 + 1] = v[1]; scr[kd * 33 + c4 + 2] = v[2]; scr[kd * 33 + c4 + 3] = v[3]; }
    LDS_WAIT(); asm volatile("" ::: "memory");
    const int c = lane & 7;
#pragma unroll
    for (int j = 0; j < 4; ++j) { const int n = (lane >> 3) + 8 * j; const LAS float* s = scr + (8 * c) * 33 + n;
        u32x4 o; o.x = pk2(s[0 * 33], s[1 * 33]); o.y = pk2(s[2 * 33], s[3 * 33]); o.z = pk2(s[4 * 33], s[5 * 33]); o.w = pk2(s[6 * 33], s[7 * 33]);
        if (n0 + n < N) *(GAS u32x4*)(WT + (size_t)dst_n(mode, n0 + n) * K + k0 + 8 * c) = o; }
    LDS_WAIT(); asm volatile("" ::: "memory");
}
__device__ __forceinline__ void norm_row(const float* xrow, const float* g, bf16_t* orow, float* rstd_out, int lane) {
    f32x4 v[4]; float s = 0.f;
#pragma unroll
    for (int j = 0; j < 4; ++j) { v[j] = ((const GAS f32x4*)xrow)[lane + 64 * j]; s += (v[j][0] * v[j][0] + v[j][1] * v[j][1]) + (v[j][2] * v[j][2] + v[j][3] * v[j][3]); }
    const float rstd = 1.0f / sqrtf(wave_sum(s) * (1.0f / D) + NORM_EPS);
#pragma unroll
    for (int j = 0; j < 4; ++j) { const f32x4 gg = ((const GAS f32x4*)g)[lane + 64 * j]; u32x2 w; w.x = pk2(v[j][0] * rstd * gg[0], v[j][1] * rstd * gg[1]); w.y = pk2(v[j][2] * rstd * gg[2], v[j][3] * rstd * gg[3]);
        ((GAS u32x2*)orow)[lane + 64 * j] = w; }
    if (lane == 0) *rstd_out = rstd;
}
__device__ __forceinline__ void unpack4(u32x2 w, f32x4& o) { o[0] = __uint_as_float(w.x << 16); o[1] = __uint_as_float(w.x & 0xffff0000u); o[2] = __uint_as_float(w.y << 16); o[3] = __uint_as_float(w.y & 0xffff0000u); }
struct RowIn { f32x4 xv[4]; u32x2 mw[4]; float inv_rstd; };
__device__ __forceinline__ void resnorm_load(RowIn& R, const float* xin_f32, const bf16_t* xn, const float* rstd_io, const bf16_t* mrow, int lane) {
    if (xin_f32) {
#pragma unroll
        for (int j = 0; j < 4; ++j) R.xv[j] = ((const GAS f32x4*)xin_f32)[lane + 64 * j];
        R.inv_rstd = 1.f;
    } else {
#pragma unroll
        for (int j = 0; j < 4; ++j) { const u32x2 w = ((const GAS u32x2*)xn)[lane + 64 * j]; R.xv[j][0] = __uint_as_float(w.x); R.xv[j][1] = __uint_as_float(w.y); }
        R.inv_rstd = 1.0f / *(const GAS float*)rstd_io;
    }
#pragma unroll
    for (int j = 0; j < 4; ++j) R.mw[j] = ((const GAS u32x2*)mrow)[lane + 64 * j];
}
__device__ __forceinline__ void resnorm_finish(RowIn& R, bool from_f32, bf16_t* xn, float* rstd_io, const float* gcur, const float* gpost, const float* gnext, float* xout_f32, int lane) {
    f32x4 xv[4], mv[4]; float s = 0.f;
    if (from_f32) {
#pragma unroll
        for (int j = 0; j < 4; ++j) xv[j] = R.xv[j];
    } else {
#pragma unroll
        for (int j = 0; j < 4; ++j) { u32x2 w; w.x = __float_as_uint(R.xv[j][0]); w.y = __float_as_uint(R.xv[j][1]); unpack4(w, xv[j]); const f32x4 gg = ((const GAS f32x4*)gcur)[lane + 64 * j];
#pragma unroll
            for (int e = 0; e < 4; ++e) xv[j][e] = xv[j][e] * R.inv_rstd / gg[e]; }
    }
#pragma unroll
    for (int j = 0; j < 4; ++j) { unpack4(R.mw[j], mv[j]); s += (mv[j][0] * mv[j][0] + mv[j][1] * mv[j][1]) + (mv[j][2] * mv[j][2] + mv[j][3] * mv[j][3]); }
    const float rstd = 1.0f / sqrtf(wave_sum(s) * (1.0f / D) + NORM_EPS);
    float s2 = 0.f;
#pragma unroll
    for (int j = 0; j < 4; ++j) { const f32x4 gg = ((const GAS f32x4*)gpost)[lane + 64 * j];
#pragma unroll
        for (int e = 0; e < 4; ++e) { xv[j][e] += mv[j][e] * rstd * gg[e]; s2 += xv[j][e] * xv[j][e]; } }
    if (gnext) {
        const float rstd2 = 1.0f / sqrtf(wave_sum(s2) * (1.0f / D) + NORM_EPS);
#pragma unroll
        for (int j = 0; j < 4; ++j) { const f32x4 gg = ((const GAS f32x4*)gnext)[lane + 64 * j]; u32x2 w; w.x = pk2(xv[j][0] * rstd2 * gg[0], xv[j][1] * rstd2 * gg[1]); w.y = pk2(xv[j][2] * rstd2 * gg[2], xv[j][3] * rstd2 * gg[3]);
            ((GAS u32x2*)xn)[lane + 64 * j] = w; }
        if (lane == 0) *rstd_io = rstd2;
    } else {
#pragma unroll
        for (int j = 0; j < 4; ++j) ((GAS f32x4*)xout_f32)[lane + 64 * j] = xv[j];
    }
}
__device__ __forceinline__ void resnorm_rows2(int m0, int m1, const float* xin_f32, bf16_t* XN, float* RSTD, const float* gcur, const bf16_t* MB, const float* gpost, const float* gnext, float* xout_f32, int lane) {
    RowIn A, B;
    resnorm_load(A, xin_f32 ? xin_f32 + (size_t)m0 * D : nullptr, XN + (size_t)m0 * D, RSTD + m0, MB + (size_t)m0 * D, lane);
    resnorm_load(B, xin_f32 ? xin_f32 + (size_t)m1 * D : nullptr, XN + (size_t)m1 * D, RSTD + m1, MB + (size_t)m1 * D, lane);
    resnorm_finish(A, xin_f32 != nullptr, XN + (size_t)m0 * D, RSTD + m0, gcur, gpost, gnext, xout_f32 ? xout_f32 + (size_t)m0 * D : nullptr, lane);
    resnorm_finish(B, xin_f32 != nullptr, XN + (size_t)m1 * D, RSTD + m1, gcur, gpost, gnext, xout_f32 ? xout_f32 + (size_t)m1 * D : nullptr, lane);
}

struct Args { const float* in[17]; float* out; unsigned char* ws; };
constexpr int PT_OFF = LDSCTL_OFF;
__device__ __forceinline__ unsigned char* ldptr(LAS unsigned char* lds, int idx) {
    const volatile LAS unsigned* p = (const volatile LAS unsigned*)(lds + PT_OFF + idx * 8);
    const unsigned lo = (unsigned)__builtin_amdgcn_readfirstlane((int)p[0]), hi = (unsigned)__builtin_amdgcn_readfirstlane((int)p[1]);
    return (unsigned char*)(((unsigned long long)hi << 32) | lo);
}
#define INP(i) ((const float*)ldptr(lds, (i)))
#define OUTP ((float*)ldptr(lds, 17))
#define WSP (ldptr(lds, 18))
#define IDS int tid_ = wave_s * 64 + lane_id_volatile(); const int tid = tid_, lane = tid & 63, wave = wave_s; const int G = gridDim.x, bx = blockIdx.x; \
    const int vcu = (G % 8 == 0) ? (bx % 8) * (G / 8) + bx / 8 : bx; const int gw = vcu * NWAVES + wave, NGW = G * NWAVES; (void)lane; (void)gw; (void)NGW; (void)vcu; (void)bx; (void)tid; (void)wave
template <int MODE, int AMODE>
__device__ __forceinline__ void run_gemm(LAS unsigned char* lds, const bf16_t* A, const bf16_t* Bt, int Mr, int N, int K, const pg8::Epi<MODE>& E, int wave_s, int ord_g = 0, int ord_c = 0) {
    pg8::Gemm g{A, Bt, Mr, N, K}; pg8::StaticOrder S; if (ord_g) S.init(Mr, N, ord_g, ord_c); else S.init(Mr, N, (int)gridDim.x, (int)blockIdx.x);
#ifndef NO_GEMM
#ifdef ONLY_MODE
    if (MODE == ONLY_MODE)
#endif
    pg8::gemm_phase<pg8::Epi<MODE>, pg8::StaticOrder, AMODE, true, true>(lds, g, S, E, wave_s);
#endif
}

#ifndef REP_GIN
#define REP_GIN 1
#endif
#ifndef REP_CMP
#define REP_CMP 1
#endif
#ifndef REP_SCAN
#define REP_SCAN 1
#endif
#ifndef REP_ATT_NSA
#define REP_ATT_NSA 1
#endif
#ifndef REP_ATT_FOX
#define REP_ATT_FOX 1
#endif
#ifndef REP_ATT_SWA
#define REP_ATT_SWA 1
#endif
#ifndef REP_GOUT
#define REP_GOUT 1
#endif
#ifndef REP_MLP
#define REP_MLP 1
#endif
#ifndef REP_PRO
#define REP_PRO 1
#endif
template <int L>
__device__ __forceinline__ void layer_body(LAS unsigned char* lds, const XcdBarrier& bar, int& aslot, const int wave_s) {
#define GRID_BAR() xcd_barrier(bar)
    constexpr int kind = L % 3, sl = L / 3;
    if (kind == 0) {
        { unsigned char* ws = WSP;
          pg8::Epi<pg8::EM_NSA> E{(bf16_t*)(ws + WS_BIG), NSA_LDP, nullptr, (const float*)(ws + WS_ROPEC), (const float*)(ws + WS_ROPES), (float*)(ws + WS_G), nullptr, (bf16_t*)(ws + WS_BIG + NSA_HM_OFF), NSA_HM_STRIDE};
          run_gemm<pg8::EM_NSA, 0>(lds + RING_OFF, (const bf16_t*)(ws + WS_XN), (const bf16_t*)(ws + WS_WNSA) + (size_t)sl * NSA_NP * D, M, NSA_NP, D, E, wave_s); }
        GRID_BAR();
#if REP_GIN >= 2
        { unsigned char* ws = WSP;
          pg8::Epi<pg8::EM_NSA> E{(bf16_t*)(ws + WS_BIG), NSA_LDP, nullptr, (const float*)(ws + WS_ROPEC), (const float*)(ws + WS_ROPES), (float*)(ws + WS_G), nullptr, (bf16_t*)(ws + WS_BIG + NSA_HM_OFF), NSA_HM_STRIDE};
          run_gemm<pg8::EM_NSA, 0>(lds + RING_OFF, (const bf16_t*)(ws + WS_XN), (const bf16_t*)(ws + WS_WNSA) + (size_t)sl * NSA_NP * D, M, NSA_NP, D, E, wave_s); }
        GRID_BAR();
#endif
        if ((int)blockIdx.x < 64) { unsigned char* ws = WSP;
          pg8::Epi<pg8::EM_CMP> E{(bf16_t*)(ws + WS_HID), 256, (const float*)(ws + WS_CMPB) + sl * 512, nullptr, nullptr, nullptr, nullptr, nullptr, 0};
          run_gemm<pg8::EM_CMP, 1>(lds + RING_OFF, (const bf16_t*)(ws + WS_BIG) + 1024, (const bf16_t*)(ws + WS_WCMP) + (size_t)sl * 2 * 256 * 2048, CMP_ROWS, 512, 2048, E, wave_s); }
        else { unsigned char* ws = WSP;
          pg8::Epi<pg8::EM_GATE> E{nullptr, 0, nullptr, nullptr, nullptr, (float*)(ws + WS_G), nullptr, nullptr, 0};
          run_gemm<pg8::EM_GATE, 0>(lds + RING_OFF, (const bf16_t*)(ws + WS_XN), (const bf16_t*)(ws + WS_WGATE) + (size_t)sl * 256 * D, M, 256, D, E, wave_s, 192, (int)blockIdx.x - 64); }
        GRID_BAR();
#if REP_CMP >= 2
        if ((int)blockIdx.x < 64) { unsigned char* ws = WSP;
          pg8::Epi<pg8::EM_CMP> E{(bf16_t*)(ws + WS_HID), 256, (const float*)(ws + WS_CMPB) + sl * 512, nullptr, nullptr, nullptr, nullptr, nullptr, 0};
          run_gemm<pg8::EM_CMP, 1>(lds + RING_OFF, (const bf16_t*)(ws + WS_BIG) + 1024, (const bf16_t*)(ws + WS_WCMP) + (size_t)sl * 2 * 256 * 2048, CMP_ROWS, 512, 2048, E, wave_s); }
        else { unsigned char* ws = WSP;
          pg8::Epi<pg8::EM_GATE> E{nullptr, 0, nullptr, nullptr, nullptr, (float*)(ws + WS_G), nullptr, nullptr, 0};
          run_gemm<pg8::EM_GATE, 0>(lds + RING_OFF, (const bf16_t*)(ws + WS_XN), (const bf16_t*)(ws + WS_WGATE) + (size_t)sl * 256 * D, M, 256, D, E, wave_s, 192, (int)blockIdx.x - 64); }
        GRID_BAR();
#endif
        { IDS; unsigned char* ws = WSP; const bf16_t* HID = (const bf16_t*)(ws + WS_HID); const float* nsa_w2 = INP(7);
          const int which = bx >> 7, wl = bx & 127;
          LAS float* w2s = (LAS float*)(lds + RING_OFF);
          { const GAS f32x4* w2g = (const GAS f32x4*)(nsa_w2 + (size_t)(sl * 2 + which) * 256 * 64); for (int i = tid; i < 4096; i += 512) ((LAS f32x4*)w2s)[i] = w2g[i]; }
          __syncthreads();
          const int r0 = (wl * 8 + wave) * 8;
          float f[8][4], acc[8];
#pragma unroll
          for (int q = 0; q < 8; ++q) { const u32x2 hw = *(const GAS u32x2*)(HID + ((size_t)which * CMP_ROWS + r0 + q) * 256 + 4 * lane);
              f[q][0] = __uint_as_float(hw.x << 16); f[q][1] = __uint_as_float(hw.x & 0xffff0000u); f[q][2] = __uint_as_float(hw.y << 16); f[q][3] = __uint_as_float(hw.y & 0xffff0000u); acc[q] = 0.f; }
          const LAS float* wcol = w2s + (which ? lane : il64(lane));
          for (int jj = 0; jj < 64; ++jj) {
#pragma unroll
              for (int s = 0; s < 4; ++s) { const float w = wcol[(4 * jj + s) * 64];
#pragma unroll
                  for (int q = 0; q < 8; ++q) acc[q] += __builtin_bit_cast(float, __builtin_amdgcn_readlane(__builtin_bit_cast(int, f[q][s]), jj)) * w; }
          }
          bf16_t* dstb = (bf16_t*)(ws + (which ? WS_VC : WS_KC));
#pragma unroll
          for (int q = 0; q < 8; ++q) { const int r = r0 + q, gg = r & 3, c = (r >> 2) & 127, b = r >> 9;
              dstb[(size_t)((b * 4 + gg) * NCP + c) * 64 + lane] = (bf16_t)f2bf(c == NC ? 0.f : acc[q]); }
          __syncthreads();
        }
        GRID_BAR();
#if REP_CMP >= 2
        { IDS; unsigned char* ws = WSP; const bf16_t* HID = (const bf16_t*)(ws + WS_HID); const float* nsa_w2 = INP(7);
          const int which = bx >> 7, wl = bx & 127;
          LAS float* w2s = (LAS float*)(lds + RING_OFF);
          { const GAS f32x4* w2g = (const GAS f32x4*)(nsa_w2 + (size_t)(sl * 2 + which) * 256 * 64); for (int i = tid; i < 4096; i += 512) ((LAS f32x4*)w2s)[i] = w2g[i]; }
          __syncthreads();
          const int r0 = (wl * 8 + wave) * 8;
          float f[8][4], acc[8];
#pragma unroll
          for (int q = 0; q < 8; ++q) { const u32x2 hw = *(const GAS u32x2*)(HID + ((size_t)which * CMP_ROWS + r0 + q) * 256 + 4 * lane);
              f[q][0] = __uint_as_float(hw.x << 16); f[q][1] = __uint_as_float(hw.x & 0xffff0000u); f[q][2] = __uint_as_float(hw.y << 16); f[q][3] = __uint_as_float(hw.y & 0xffff0000u); acc[q] = 0.f; }
          const LAS float* wcol = w2s + (which ? lane : il64(lane));
          for (int jj = 0; jj < 64; ++jj) {
#pragma unroll
              for (int s = 0; s < 4; ++s) { const float w = wcol[(4 * jj + s) * 64];
#pragma unroll
                  for (int q = 0; q < 8; ++q) acc[q] += __builtin_bit_cast(float, __builtin_amdgcn_readlane(__builtin_bit_cast(int, f[q][s]), jj)) * w; }
          }
          bf16_t* dstb = (bf16_t*)(ws + (which ? WS_VC : WS_KC));
#pragma unroll
          for (int q = 0; q < 8; ++q) { const int r = r0 + q, gg = r & 3, c = (r >> 2) & 127, b = r >> 9;
              dstb[(size_t)((b * 4 + gg) * NCP + c) * 64 + lane] = (bf16_t)f2bf(c == NC ? 0.f : acc[q]); }
          __syncthreads();
        }
        GRID_BAR();
#endif
        { IDS; unsigned char* ws = WSP;
          const int bg = vcu >> 2, sub = vcu & 3, b = bg >> 2, g = bg & 3;
          for (int i = 0; i < 8; ++i) { const int qt = (i & 1) ? (8 * (i >> 1) + 7 - sub) : (8 * (i >> 1) + sub);
#ifndef NO_NSA
              att::nsa_unit(lds + RING_OFF, b, g, qt, ws, WS_BIG, WS_G, WS_KC, WS_VC, WS_O, wave, aslot);
#endif
          } }
#if REP_ATT_NSA >= 2
        GRID_BAR();
        { IDS; unsigned char* ws = WSP;
          const int bg = vcu >> 2, sub = vcu & 3, b = bg >> 2, g = bg & 3;
          for (int i = 0; i < 8; ++i) { const int qt = (i & 1) ? (8 * (i >> 1) + 7 - sub) : (8 * (i >> 1) + sub);
#ifndef NO_NSA
              att::nsa_unit(lds + RING_OFF, b, g, qt, ws, WS_BIG, WS_G, WS_KC, WS_VC, WS_O, wave, aslot);
#endif
          } }
#endif
    } else if (kind == 1) {
        { unsigned char* ws = WSP;
          pg8::Epi<pg8::EM_FOX> E{(bf16_t*)(ws + WS_BIG), FOX_LDP, nullptr, nullptr, nullptr, (float*)(ws + WS_LF), INP(10), (bf16_t*)(ws + WS_BIG + FOX_HM_OFF), FOX_HM_STRIDE};
          run_gemm<pg8::EM_FOX, 0>(lds + RING_OFF, (const bf16_t*)(ws + WS_XN), (const bf16_t*)(ws + WS_WFOX), M, FOX_NP, D, E, wave_s); }
        GRID_BAR();
#if REP_GIN >= 2
        { unsigned char* ws = WSP;
          pg8::Epi<pg8::EM_FOX> E{(bf16_t*)(ws + WS_BIG), FOX_LDP, nullptr, nullptr, nullptr, (float*)(ws + WS_LF), INP(10), (bf16_t*)(ws + WS_BIG + FOX_HM_OFF), FOX_HM_STRIDE};
          run_gemm<pg8::EM_FOX, 0>(lds + RING_OFF, (const bf16_t*)(ws + WS_XN), (const bf16_t*)(ws + WS_WFOX), M, FOX_NP, D, E, wave_s); }
        GRID_BAR();
#endif
        { IDS; unsigned char* ws = WSP; const float* LF = (const float*)(ws + WS_LF); float* CB = (float*)(ws + WS_CB);
          if (wave == 0) for (int bh = bx; bh < BATCH * NH; bh += G) {
            const int b = bh >> 4, h = bh & 15; float v[32]; float run = 0.f;
#pragma unroll
            for (int i = 0; i < 32; ++i) { run += LF[((size_t)b * T + 32 * lane + i) * 16 + h]; v[i] = run; }
            float excl = 0.f;
            for (int k = 0; k < 63; ++k) { const float t = __builtin_bit_cast(float, __builtin_amdgcn_readlane(__builtin_bit_cast(int, run), k)); if (lane > k) excl += t; }
#pragma unroll
            for (int i = 0; i < 32; ++i) CB[(size_t)bh * T + 32 * lane + i] = -(v[i] + excl) * LOG2E;
          } }
        GRID_BAR();
#if REP_SCAN >= 2
        { IDS; unsigned char* ws = WSP; const float* LF = (const float*)(ws + WS_LF); float* CB = (float*)(ws + WS_CB);
          if (wave == 0) for (int bh = bx; bh < BATCH * NH; bh += G) {
            const int b = bh >> 4, h = bh & 15; float v[32]; float run = 0.f;
#pragma unroll
            for (int i = 0; i < 32; ++i) { run += LF[((size_t)b * T + 32 * lane + i) * 16 + h]; v[i] = run; }
            float excl = 0.f;
            for (int k = 0; k < 63; ++k) { const float t = __builtin_bit_cast(float, __builtin_amdgcn_readlane(__builtin_bit_cast(int, run), k)); if (lane > k) excl += t; }
#pragma unroll
            for (int i = 0; i < 32; ++i) CB[(size_t)bh * T + 32 * lane + i] = -(v[i] + excl) * LOG2E;
          } }
        GRID_BAR();
#endif
        { IDS; unsigned char* ws = WSP;
          const int xcd = vcu >> 5, c = vcu & 31, sub = c & 3;
          for (int i = 0; i < 8; ++i) { const int bh = 32 * xcd + 8 * (i >> 1) + (c >> 2); const int qb = (i & 1) ? sub : 7 - sub;
#ifndef NO_FOX
              att::fox_unit(lds + RING_OFF, bh >> 4, bh & 15, qb, ws, WS_BIG, WS_CB, WS_O, wave, aslot);
#endif
          } }
#if REP_ATT_FOX >= 2
        GRID_BAR();
        { IDS; unsigned char* ws = WSP;
          const int xcd = vcu >> 5, c = vcu & 31, sub = c & 3;
          for (int i = 0; i < 8; ++i) { const int bh = 32 * xcd + 8 * (i >> 1) + (c >> 2); const int qb = (i & 1) ? sub : 7 - sub;
#ifndef NO_FOX
              att::fox_unit(lds + RING_OFF, bh >> 4, bh & 15, qb, ws, WS_BIG, WS_CB, WS_O, wave, aslot);
#endif
          } }
#endif
    } else {
        { unsigned char* ws = WSP;
          pg8::Epi<pg8::EM_SWA> E{(bf16_t*)(ws + WS_BIG), SWA_LDP, (const float*)(ws + WS_SWAB), (const float*)(ws + WS_ROPEC), (const float*)(ws + WS_ROPES), nullptr, nullptr, (bf16_t*)(ws + WS_BIG + SWA_HM_OFF), SWA_HM_STRIDE};
          run_gemm<pg8::EM_SWA, 0>(lds + RING_OFF, (const bf16_t*)(ws + WS_XN), (const bf16_t*)(ws + WS_WSWA), M, SWA_NP, D, E, wave_s); }
        GRID_BAR();
#if REP_GIN >= 2
        { unsigned char* ws = WSP;
          pg8::Epi<pg8::EM_SWA> E{(bf16_t*)(ws + WS_BIG), SWA_LDP, (const float*)(ws + WS_SWAB), (const float*)(ws + WS_ROPEC), (const float*)(ws + WS_ROPES), nullptr, nullptr, (bf16_t*)(ws + WS_BIG + SWA_HM_OFF), SWA_HM_STRIDE};
          run_gemm<pg8::EM_SWA, 0>(lds + RING_OFF, (const bf16_t*)(ws + WS_XN), (const bf16_t*)(ws + WS_WSWA), M, SWA_NP, D, E, wave_s); }
        GRID_BAR();
#endif
        { IDS; unsigned char* ws = WSP; const float* sinks = INP(14);
          const int bg = vcu >> 3, sub = vcu & 7;
          for (int i = 0; i < 8; ++i) {
#ifndef NO_SWA
              att::swa_unit(lds + RING_OFF, bg >> 1, bg & 1, 8 * i + sub, ws, WS_BIG, WS_O, sinks, wave, aslot);
#endif
          } }
#if REP_ATT_SWA >= 2
        GRID_BAR();
        { IDS; unsigned char* ws = WSP; const float* sinks = INP(14);
          const int bg = vcu >> 3, sub = vcu & 7;
          for (int i = 0; i < 8; ++i) {
#ifndef NO_SWA
              att::swa_unit(lds + RING_OFF, bg >> 1, bg & 1, 8 * i + sub, ws, WS_BIG, WS_O, sinks, wave, aslot);
#endif
          } }
#endif
    }
    GRID_BAR();
    { unsigned char* ws = WSP;
      pg8::Epi<pg8::EM_PLAIN> E{(bf16_t*)(ws + WS_BIG), D, kind == 2 ? INP(16) : nullptr, nullptr, nullptr, nullptr, nullptr, nullptr, 0};
      run_gemm<pg8::EM_PLAIN, 0>(lds + RING_OFF, (const bf16_t*)(ws + WS_O), (const bf16_t*)(ws + WS_WOUT) + (size_t)L * D * D, M, D, D, E, wave_s); }
    GRID_BAR();
#if REP_GOUT >= 2
    { unsigned char* ws = WSP;
      pg8::Epi<pg8::EM_PLAIN> E{(bf16_t*)(ws + WS_BIG), D, kind == 2 ? INP(16) : nullptr, nullptr, nullptr, nullptr, nullptr, nullptr, 0};
      run_gemm<pg8::EM_PLAIN, 0>(lds + RING_OFF, (const bf16_t*)(ws + WS_O), (const bf16_t*)(ws + WS_WOUT) + (size_t)L * D * D, M, D, D, E, wave_s); }
    GRID_BAR();
#endif
    { IDS; unsigned char* ws = WSP; const float* gL = INP(1) + (size_t)L * 4 * D; const float* xin = (L == 0) ? INP(0) : nullptr;
      const bf16_t* MB = (const bf16_t*)(ws + WS_BIG); bf16_t* XN = (bf16_t*)(ws + WS_XN); float* RSTD = (float*)(ws + WS_RSTD);
      for (int m = gw; m < M; m += 2 * NGW) resnorm_rows2(m, m + NGW, xin, XN, RSTD, gL, MB, gL + D, gL + 2 * D, nullptr, lane); }
    GRID_BAR();
    { unsigned char* ws = WSP;
      pg8::Epi<pg8::EM_RELU2> E{(bf16_t*)(ws + WS_BIG), FF, nullptr, nullptr, nullptr, nullptr, nullptr, nullptr, 0};
      run_gemm<pg8::EM_RELU2, 0>(lds + RING_OFF, (const bf16_t*)(ws + WS_XN), (const bf16_t*)(ws + WS_WUP) + (size_t)L * D * FF, M, FF, D, E, wave_s); }
    GRID_BAR();
#if REP_MLP >= 2
    { unsigned char* ws = WSP;
      pg8::Epi<pg8::EM_RELU2> E{(bf16_t*)(ws + WS_BIG), FF, nullptr, nullptr, nullptr, nullptr, nullptr, nullptr, 0};
      run_gemm<pg8::EM_RELU2, 0>(lds + RING_OFF, (const bf16_t*)(ws + WS_XN), (const bf16_t*)(ws + WS_WUP) + (size_t)L * D * FF, M, FF, D, E, wave_s); }
    GRID_BAR();
#endif
    { unsigned char* ws = WSP;
      pg8::Epi<pg8::EM_PLAIN> E{(bf16_t*)(ws + WS_M2), D, nullptr, nullptr, nullptr, nullptr, nullptr, nullptr, 0};
      run_gemm<pg8::EM_PLAIN, 0>(lds + RING_OFF, (const bf16_t*)(ws + WS_BIG), (const bf16_t*)(ws + WS_WDN) + (size_t)L * D * FF, M, D, FF, E, wave_s); }
    GRID_BAR();
#if REP_MLP >= 2
    { unsigned char* ws = WSP;
      pg8::Epi<pg8::EM_PLAIN> E{(bf16_t*)(ws + WS_M2), D, nullptr, nullptr, nullptr, nullptr, nullptr, nullptr, 0};
      run_gemm<pg8::EM_PLAIN, 0>(lds + RING_OFF, (const bf16_t*)(ws + WS_BIG), (const bf16_t*)(ws + WS_WDN) + (size_t)L * D * FF, M, D, FF, E, wave_s); }
    GRID_BAR();
#endif
    { IDS; unsigned char* ws = WSP; const float* gL = INP(1) + (size_t)L * 4 * D; float* xout = OUTP; bf16_t* XN = (bf16_t*)(ws + WS_XN); const bf16_t* M2 = (const bf16_t*)(ws + WS_M2); float* RSTD = (float*)(ws + WS_RSTD);
      for (int m = gw; m < M; m += 2 * NGW) resnorm_rows2(m, m + NGW, nullptr, XN, RSTD, gL + 2 * D, M2, gL + 3 * D, (L + 1 < DEPTH) ? gL + 4 * D : nullptr, (L + 1 < DEPTH) ? nullptr : xout, lane); }
    if (L + 1 < DEPTH) GRID_BAR();
#undef GRID_BAR
}

__global__ void __launch_bounds__(NWAVES * 64, 2) fwd_kernel(Args args) {
    extern __shared__ __attribute__((aligned(16))) unsigned char lds_raw[];
    LAS unsigned char* lds = (LAS unsigned char*)lds_raw;
    const int wave_s = __builtin_amdgcn_readfirstlane((int)threadIdx.x >> 6);
    for (int u = threadIdx.x; u < (LDS_BYTES - LDSCTL_OFF) / 4; u += NWAVES * 64) ((LAS unsigned*)(lds + LDSCTL_OFF))[u] = 0u;
    __syncthreads();
    if (threadIdx.x == 0) {
        LAS unsigned long long* pt = (LAS unsigned long long*)(lds + PT_OFF);
#pragma unroll
        for (int i = 0; i < 17; ++i) pt[i] = (unsigned long long)args.in[i];
        pt[17] = (unsigned long long)args.out; pt[18] = (unsigned long long)args.ws;
    }
    __syncthreads();
    volatile LAS unsigned* MISC = (volatile LAS unsigned*)(lds + MISC_OFF);
    XcdBarrier bar = xcd_barrier_post((unsigned*)(WSP + WS_CTL) + CW_BAR, MISC + 8);

    {
        IDS; unsigned char* ws = WSP;
        const float* x_in = INP(0); const float* norm_g = INP(1); const float* mlp_up = INP(2); const float* mlp_dn = INP(3);
        const float* nsa_w_in = INP(4); const float* nsa_pos = INP(5); const float* nsa_w1 = INP(6); const float* nsa_w_out = INP(8);
        const float* fox_w_in = INP(9); const float* fox_w_out = INP(11); const float* swa_w_in = INP(12); const float* swa_b_in = INP(13); const float* swa_w_out = INP(15);
        bf16_t* W_UP = (bf16_t*)(ws + WS_WUP); bf16_t* W_DN = (bf16_t*)(ws + WS_WDN); bf16_t* W_NSA = (bf16_t*)(ws + WS_WNSA); bf16_t* W_OUT = (bf16_t*)(ws + WS_WOUT);
        bf16_t* W_FOX = (bf16_t*)(ws + WS_WFOX); bf16_t* W_SWA = (bf16_t*)(ws + WS_WSWA); bf16_t* W_CMP = (bf16_t*)(ws + WS_WCMP);
        float* ROPEC = (float*)(ws + WS_ROPEC); float* ROPES = (float*)(ws + WS_ROPES); float* CMPB = (float*)(ws + WS_CMPB); float* SWAB = (float*)(ws + WS_SWAB);
        bf16_t* XN = (bf16_t*)(ws + WS_XN);
        LAS float* scr = (LAS float*)(lds + RING_OFF + wave * 16384);
        constexpr int I_UP = (D / 64) * (FF / 32), I_DN = (FF / 64) * (D / 32), I_NSA = (D / 64) * (NSA_NP / 32), I_GATE = (D / 64) * 2, I_OUT = (D / 64) * (D / 32), I_FOX = (D / 64) * ((FOX_N + 31) / 32), I_SWA = (D / 64) * (SWA_N / 32), I_CMP = (2048 / 64) * (256 / 32);
        constexpr int NITEMS = 4 * I_UP + 4 * I_DN + 2 * I_NSA + 2 * I_GATE + 4 * I_OUT + I_FOX + I_SWA + 4 * I_CMP;
        for (int it = gw; it < NITEMS; it += NGW) {
            int r = it;
            if (r < 4 * I_UP) { const int Lw = r / I_UP; conv_item(mlp_up + (size_t)Lw * D * FF, D, FF, W_UP + (size_t)Lw * D * FF, 0, r % I_UP, scr, lane); continue; } r -= 4 * I_UP;
            if (r < 4 * I_DN) { const int Lw = r / I_DN; conv_item(mlp_dn + (size_t)Lw * D * FF, FF, D, W_DN + (size_t)Lw * D * FF, 0, r % I_DN, scr, lane); continue; } r -= 4 * I_DN;
            if (r < 2 * I_NSA) { const int s = r / I_NSA; conv_item(nsa_w_in + (size_t)s * D * NSA_N, D, NSA_NP, W_NSA + (size_t)s * NSA_NP * D, 1, r % I_NSA, scr, lane, NSA_N); continue; } r -= 2 * I_NSA;
            if (r < 2 * I_GATE) { const int s = r / I_GATE; conv_item(nsa_w_in + (size_t)s * D * NSA_N + NSA_NP, D, 48, (bf16_t*)(ws + WS_WGATE) + (size_t)s * 256 * D, 0, r % I_GATE, scr, lane, NSA_N); continue; } r -= 2 * I_GATE;
            if (r < 4 * I_OUT) { const int Lw = r / I_OUT; const float* src = (Lw == 1) ? fox_w_out : (Lw == 2) ? swa_w_out : nsa_w_out + (size_t)(Lw / 3) * D * D;
                conv_item(src, D, D, W_OUT + (size_t)Lw * D * D, 0, r % I_OUT, scr, lane); continue; } r -= 4 * I_OUT;
            if (r < I_FOX) { conv_item(fox_w_in, D, FOX_N, W_FOX, 2, r, scr, lane); continue; } r -= I_FOX;
            if (r < I_SWA) { conv_item(swa_w_in, D, SWA_N, W_SWA, 3, r, scr, lane); continue; } r -= I_SWA;
            { const int sw = r / I_CMP;
                conv_item(nsa_w1 + (size_t)sw * 2048 * 256, 2048, 256, W_CMP + (size_t)sw * 256 * 2048, (sw & 1) ? 0 : 4, r % I_CMP, scr, lane); }
        }
        { constexpr int ZG = 208 * D / 8, ZF = (FOX_NP - FOX_N) * D / 8;
          for (int e = bx * 512 + tid; e < 2 * ZG + ZF; e += G * 512) {
              bf16_t* dst = e < ZG ? (bf16_t*)(ws + WS_WGATE) + (size_t)48 * D + (size_t)e * 8 : e < 2 * ZG ? (bf16_t*)(ws + WS_WGATE) + (size_t)256 * D + (size_t)48 * D + (size_t)(e - ZG) * 8 : W_FOX + (size_t)FOX_N * D + (size_t)(e - 2 * ZG) * 8;
              *(GAS u32x4*)dst = (u32x4){0u, 0u, 0u, 0u}; } }
        for (int e = bx * 512 + tid; e < T * 32; e += G * 512) { const int t = e >> 5, i = e & 31; const float inv = powf(10000.0f, -(float)(2 * i) / 64.0f); const float ang = (float)t * inv;
            ROPEC[e] = cosf(ang); ROPES[e] = sinf(ang); }
        for (int e = bx * 512 + tid; e < SWA_N; e += G * 512) SWAB[e] = swa_b_in[src_n(3, e)];
        for (int task = bx; task < 64; task += G) {
            const int sw = task >> 4, n0 = (task & 15) * 16, kq = tid >> 4, nn = tid & 15;
            const float* pos = nsa_pos + (size_t)sw * 2048; const float* w1 = nsa_w1 + (size_t)sw * 2048 * 256;
            float acc = 0.f;
#pragma unroll 8
            for (int k = kq * 64; k < kq * 64 + 64; ++k) acc += pos[k] * w1[(size_t)k * 256 + n0 + nn];
            LAS float* red = (LAS float*)(lds + RING_OFF);
            __syncthreads();
            red[kq * 16 + nn] = acc;
            __syncthreads();
            if (tid < 16) { float sm = 0.f; for (int q = 0; q < 32; ++q) sm += red[q * 16 + tid]; CMPB[sw * 256 + n0 + tid] = sm; }
            __syncthreads();
        }
        for (int m = gw; m < M; m += NGW) norm_row(x_in + (size_t)m * D, norm_g, XN + (size_t)m * D, (float*)(ws + WS_RSTD) + m, lane);
    }
#if REP_PRO >= 2
    xcd_barrier(bar);
    {
        IDS; unsigned char* ws = WSP;
        const float* x_in = INP(0); const float* norm_g = INP(1); const float* mlp_up = INP(2); const float* mlp_dn = INP(3);
        const float* nsa_w_in = INP(4); const float* nsa_pos = INP(5); const float* nsa_w1 = INP(6); const float* nsa_w_out = INP(8);
        const float* fox_w_in = INP(9); const float* fox_w_out = INP(11); const float* swa_w_in = INP(12); const float* swa_b_in = INP(13); const float* swa_w_out = INP(15);
        bf16_t* W_UP = (bf16_t*)(ws + WS_WUP); bf16_t* W_DN = (bf16_t*)(ws + WS_WDN); bf16_t* W_NSA = (bf16_t*)(ws + WS_WNSA); bf16_t* W_OUT = (bf16_t*)(ws + WS_WOUT);
        bf16_t* W_FOX = (bf16_t*)(ws + WS_WFOX); bf16_t* W_SWA = (bf16_t*)(ws + WS_WSWA); bf16_t* W_CMP = (bf16_t*)(ws + WS_WCMP);
        float* ROPEC = (float*)(ws + WS_ROPEC); float* ROPES = (float*)(ws + WS_ROPES); float* CMPB = (float*)(ws + WS_CMPB); float* SWAB = (float*)(ws + WS_SWAB);
        bf16_t* XN = (bf16_t*)(ws + WS_XN);
        LAS float* scr = (LAS float*)(lds + RING_OFF + wave * 16384);
        constexpr int I_UP = (D / 64) * (FF / 32), I_DN = (FF / 64) * (D / 32), I_NSA = (D / 64) * (NSA_NP / 32), I_GATE = (D / 64) * 2, I_OUT = (D / 64) * (D / 32), I_FOX = (D / 64) * ((FOX_N + 31) / 32), I_SWA = (D / 64) * (SWA_N / 32), I_CMP = (2048 / 64) * (256 / 32);
        constexpr int NITEMS = 4 * I_UP + 4 * I_DN + 2 * I_NSA + 2 * I_GATE + 4 * I_OUT + I_FOX + I_SWA + 4 * I_CMP;
        for (int it = gw; it < NITEMS; it += NGW) {
            int r = it;
            if (r < 4 * I_UP) { const int Lw = r / I_UP; conv_item(mlp_up + (size_t)Lw * D * FF, D, FF, W_UP + (size_t)Lw * D * FF, 0, r % I_UP, scr, lane); continue; } r -= 4 * I_UP;
            if (r < 4 * I_DN) { const int Lw = r / I_DN; conv_item(mlp_dn + (size_t)Lw * D * FF, FF, D, W_DN + (size_t)Lw * D * FF, 0, r % I_DN, scr, lane); continue; } r -= 4 * I_DN;
            if (r < 2 * I_NSA) { const int s = r / I_NSA; conv_item(nsa_w_in + (size_t)s * D * NSA_N, D, NSA_NP, W_NSA + (size_t)s * NSA_NP * D, 1, r % I_NSA, scr, lane, NSA_N); continue; } r -= 2 * I_NSA;
            if (r < 2 * I_GATE) { const int s = r / I_GATE; conv_item(nsa_w_in + (size_t)s * D * NSA_N + NSA_NP, D, 48, (bf16_t*)(ws + WS_WGATE) + (size_t)s * 256 * D, 0, r % I_GATE, scr, lane, NSA_N); continue; } r -= 2 * I_GATE;
            if (r < 4 * I_OUT) { const int Lw = r / I_OUT; const float* src = (Lw == 1) ? fox_w_out : (Lw == 2) ? swa_w_out : nsa_w_out + (size_t)(Lw / 3) * D * D;
                conv_item(src, D, D, W_OUT + (size_t)Lw * D * D, 0, r % I_OUT, scr, lane); continue; } r -= 4 * I_OUT;
            if (r < I_FOX) { conv_item(fox_w_in, D, FOX_N, W_FOX, 2, r, scr, lane); continue; } r -= I_FOX;
            if (r < I_SWA) { conv_item(swa_w_in, D, SWA_N, W_SWA, 3, r, scr, lane); continue; } r -= I_SWA;
            { const int sw = r / I_CMP;
                conv_item(nsa_w1 + (size_t)sw * 2048 * 256, 2048, 256, W_CMP + (size_t)sw * 256 * 2048, (sw & 1) ? 0 : 4, r % I_CMP, scr, lane); }
        }
        { constexpr int ZG = 208 * D / 8, ZF = (FOX_NP - FOX_N) * D / 8;
          for (int e = bx * 512 + tid; e < 2 * ZG + ZF; e += G * 512) {
              bf16_t* dst = e < ZG ? (bf16_t*)(ws + WS_WGATE) + (size_t)48 * D + (size_t)e * 8 : e < 2 * ZG ? (bf16_t*)(ws + WS_WGATE) + (size_t)256 * D + (size_t)48 * D + (size_t)(e - ZG) * 8 : W_FOX + (size_t)FOX_N * D + (size_t)(e - 2 * ZG) * 8;
              *(GAS u32x4*)dst = (u32x4){0u, 0u, 0u, 0u}; } }
        for (int e = bx * 512 + tid; e < T * 32; e += G * 512) { const int t = e >> 5, i = e & 31; const float inv = powf(10000.0f, -(float)(2 * i) / 64.0f); const float ang = (float)t * inv;
            ROPEC[e] = cosf(ang); ROPES[e] = sinf(ang); }
        for (int e = bx * 512 + tid; e < SWA_N; e += G * 512) SWAB[e] = swa_b_in[src_n(3, e)];
        for (int task = bx; task < 64; task += G) {
            const int sw = task >> 4, n0 = (task & 15) * 16, kq = tid >> 4, nn = tid & 15;
            const float* pos = nsa_pos + (size_t)sw * 2048; const float* w1 = nsa_w1 + (size_t)sw * 2048 * 256;
            float acc = 0.f;
#pragma unroll 8
            for (int k = kq * 64; k < kq * 64 + 64; ++k) acc += pos[k] * w1[(size_t)k * 256 + n0 + nn];
            LAS float* red = (LAS float*)(lds + RING_OFF);
            __syncthreads();
            red[kq * 16 + nn] = acc;
            __syncthreads();
            if (tid < 16) { float sm = 0.f; for (int q = 0; q < 32; ++q) sm += red[q * 16 + tid]; CMPB[sw * 256 + n0 + tid] = sm; }
            __syncthreads();
        }
        for (int m = gw; m < M; m += NGW) norm_row(x_in + (size_t)m * D, norm_g, XN + (size_t)m * D, (float*)(ws + WS_RSTD) + m, lane);
    }
#endif
    xcd_barrier(bar);

    int aslot = 0;
    if (L_LO <= 0 && 0 < L_HI) layer_body<0>(lds, bar, aslot, wave_s);
    if (L_LO <= 1 && 1 < L_HI) layer_body<1>(lds, bar, aslot, wave_s);
    if (L_LO <= 2 && 2 < L_HI) layer_body<2>(lds, bar, aslot, wave_s);
    if (L_LO <= 3 && 3 < L_HI) layer_body<3>(lds, bar, aslot, wave_s);
}

extern "C" void kernel_launch(void* const* d_in, const int* in_sizes, int n_in, void* d_out, int out_size, void* d_ws, size_t ws_size, hipStream_t stream) {
    static int grid = 0;
    if (grid == 0) {
        if (n_in != 17 || in_sizes[0] != M * D || out_size != M * D || ws_size < WS_END) { fprintf(stderr, "kernel_launch: unexpected problem shape (n_in %d, in0 %d, out %d, ws %zu)\n", n_in, n_in > 0 ? in_sizes[0] : -1, out_size, ws_size); grid = -1; return; }
        int dev = 0, cus = 0, per_cu = 0;
        if (hipGetDevice(&dev) != hipSuccess || hipDeviceGetAttribute(&cus, hipDeviceAttributeMultiprocessorCount, dev) != hipSuccess) { grid = -1; return; }
        if (hipFuncSetAttribute((const void*)fwd_kernel, hipFuncAttributeMaxDynamicSharedMemorySize, LDS_BYTES) != hipSuccess) { fprintf(stderr, "kernel_launch: hipFuncSetAttribute failed\n"); grid = -1; return; }
        if (hipOccupancyMaxActiveBlocksPerMultiprocessor(&per_cu, (const void*)fwd_kernel, NWAVES * 64, LDS_BYTES) != hipSuccess || per_cu < 1) { fprintf(stderr, "kernel_launch: occupancy query reports %d\n", per_cu); }
        (void)hipGetLastError();
        if (cus < 256) { fprintf(stderr, "kernel_launch: needs 256 CUs, device has %d\n", cus); grid = -1; return; }
        grid = 256;
    }
    if (grid < 0) return;
    if (hipMemsetAsync((char*)d_ws + WS_CTL, 0, CTL_ZERO_BYTES, stream) != hipSuccess) return;
    Args a{};
    for (int i = 0; i < 17; ++i) a.in[i] = (const float*)d_in[i];
    a.out = (float*)d_out; a.ws = (unsigned char*)d_ws;
    hipLaunchKernelGGL(fwd_kernel, dim3(grid), dim3(NWAVES * 64), LDS_BYTES, stream, a);
}
```

```cpp
#include <hip/hip_runtime.h>
#include <cstdio>
#include <cstdint>

#define LAS __attribute__((address_space(3)))
#define GAS __attribute__((address_space(1)))
typedef unsigned short bf16_t;
typedef short bf16x8 __attribute__((ext_vector_type(8)));
typedef short s16x4 __attribute__((ext_vector_type(4)));
typedef float f32x2 __attribute__((ext_vector_type(2)));
typedef float f32x4 __attribute__((ext_vector_type(4)));
typedef float f32x16 __attribute__((ext_vector_type(16)));
typedef unsigned u32x2 __attribute__((ext_vector_type(2)));
typedef unsigned u32x4 __attribute__((ext_vector_type(4)));

constexpr int BATCH = 16, T = 2048, D = 1024, NH = 16, HD = 64, FF = 4096, DEPTH = 4;
constexpr int M = BATCH * T;
constexpr int NSA_N = 2608, NSA_NP = 2560, NSA_LDP = 1536;
constexpr int FOX_N = 3088, FOX_NP = 3328, FOX_LDP = 1024;
constexpr int SWA_N = 1280, SWA_NP = 1280, SWA_LDP = 1024;
constexpr int CMP_LDP = NSA_LDP;
constexpr int NC = 127, NCP = 128;
constexpr int CMP_ROWS = BATCH * NCP * 4;
constexpr size_t NSA_HM_OFF = (size_t)96 << 20, NSA_HM_STRIDE = (size_t)8 << 20;
constexpr size_t FOX_HM_OFF = (size_t)64 << 20, FOX_HM_STRIDE = (size_t)32 << 20;
constexpr size_t SWA_HM_OFF = (size_t)64 << 20, SWA_HM_STRIDE = (size_t)4 << 20;
constexpr float LOG2E = 1.4426950408889634f;
constexpr float C2 = 0.125f * LOG2E;
constexpr float NORM_EPS = 1e-6f;

__device__ __forceinline__ unsigned cvt_pk_bf16(float lo, float hi) { unsigned r; asm volatile("v_cvt_pk_bf16_f32 %0, %1, %2" : "=v"(r) : "v"(lo), "v"(hi)); return r; }
__device__ __forceinline__ void store8(bf16_t* p, f32x4 a, f32x4 b) { u32x4 w; w.x = cvt_pk_bf16(a[0], a[1]); w.y = cvt_pk_bf16(a[2], a[3]); w.z = cvt_pk_bf16(b[0], b[1]); w.w = cvt_pk_bf16(b[2], b[3]); *(GAS u32x4*)p = w; }

__device__ __forceinline__ int lane_id_volatile() { int x; asm volatile("v_mbcnt_lo_u32_b32 %0, -1, 0\n\tv_mbcnt_hi_u32_b32 %0, -1, %0" : "=v"(x)); return x; }

namespace pg8 {
#define PG8_LAS __attribute__((address_space(3)))
constexpr int BM = 256, BK = 64, HALF = 128, HTB = HALF * BK * 2  , STAGE_BYTES = 8 * HTB, NXCD = 8, WGM = 8;

__host__ __device__ __forceinline__ int lds_byte(int r, int c) { const int st = (r >> 4) * 2 + (c >> 5), rr = r & 15, cc = c & 31, ob = rr * 64 + cc * 2; return st * 1024 + (ob ^ (((ob >> 9) & 1) << 5)); }
__host__ __device__ __forceinline__ void stage_rc(int b, int& R, int& C) { const int st = b / 1024, sb = b % 1024, swz = sb ^ (((sb >> 9) & 1) << 5); R = (st >> 1) * 16 + swz / 64; C = (st & 1) * 32 + (swz % 64) / 2; }
__host__ __device__ __forceinline__ int perm32(int rho) { const int n = rho >> 4, i = rho & 15; return 8 * (i >> 2) + 4 * n + (i & 3); }

struct Unit { int pm, pn; };
struct Gemm { const bf16_t* A; const bf16_t* Bt; int M, N, K; };

struct StaticOrder {
    int nM, nN, nwg, G, c;
    __host__ __device__ void init(int M_, int N_, int G_, int c_) { nM = M_ / BM; nN = N_ / BM; nwg = nM * nN; G = G_; c = c_; }
    __host__ __device__ bool next(int i, Unit& u) const {
        const long L = (long)i * G + c; if (L >= nwg) return false;
        int wgid = (int)L; { const int q = nwg / NXCD, r = nwg % NXCD, xcd = wgid % NXCD, off = wgid / NXCD; wgid = (xcd < r ? xcd * (q + 1) : r * (q + 1) + (xcd - r) * q) + off; }
        const int nig = WGM * nN, gid = wgid / nig, fm = gid * WGM, gsz = (nM - fm) < WGM ? (nM - fm) : WGM;
        u.pm = fm + ((wgid % nig) % gsz); u.pn = (wgid % nig) / gsz; return true;
    }
    __device__ __forceinline__ void a_ready(const Unit&) const {}
    __device__ __forceinline__ void done(const Unit&) const {}
};

enum EpiMode { EM_PLAIN = 0, EM_RELU2 = 1, EM_NSA = 2, EM_FOX = 3, EM_SWA = 4, EM_CMP = 5, EM_GATE = 6 };

__device__ __forceinline__ void rope4(f32x4& v, float c0, float s0, float c1, float s1) {
    const float a0 = v[0], b0 = v[1], a1 = v[2], b1 = v[3];
    v[0] = a0 * c0 - b0 * s0; v[1] = b0 * c0 + a0 * s0; v[2] = a1 * c1 - b1 * s1; v[3] = b1 * c1 + a1 * s1;
}
__device__ __forceinline__ float sigmoidf_(float x) { return 1.0f / (1.0f + __expf(-x)); }
__device__ __forceinline__ float logsigmoidf_(float x) { return fminf(x, 0.f) - log1pf(expf(-fabsf(x))); }

template <int MODE> struct Epi {
    static constexpr bool PERM = true, AFTER_DRAIN = false;
    bf16_t* O; int ldc; const float* bias; const float* rc; const float* rs; float* aux; const float* auxb;
    bf16_t* hm0; size_t hm_stride;
    __device__ __forceinline__ void operator()(const f32x4 (&acc)[2][2][4][2], const Unit& u, int wr, int wc, int fr, int fq) const {
        const int row0 = u.pm * BM + wr * 64 + fr;
        const int cw = wc * 32 + 8 * fq;
        const int colt = u.pn * BM;
        if (MODE == EM_GATE) {
            if (cw < 48) {
#pragma unroll
                for (int ai = 0; ai < 2; ++ai)
#pragma unroll
                    for (int m = 0; m < 4; ++m) { const size_t row = (size_t)(row0 + ai * HALF + m * 16); f32x4 v0 = acc[ai][0][m][0], v1 = acc[ai][0][m][1];
#pragma unroll
                        for (int j = 0; j < 4; ++j) { v0[j] = sigmoidf_(v0[j]); v1[j] = sigmoidf_(v1[j]); }
                        *(GAS f32x4*)(aux + row * 48 + cw) = v0; *(GAS f32x4*)(aux + row * 48 + cw + 4) = v1; }
            }
            return;
        }
        if (MODE == EM_FOX && u.pn == 12) {
            if (cw < 16) {
                const f32x4 b0 = *(const GAS f32x4*)(auxb + cw), b1 = *(const GAS f32x4*)(auxb + cw + 4);
#pragma unroll
                for (int ai = 0; ai < 2; ++ai)
#pragma unroll
                    for (int m = 0; m < 4; ++m) { const size_t row = (size_t)(row0 + ai * HALF + m * 16); f32x4 v0 = acc[ai][0][m][0] + b0, v1 = acc[ai][0][m][1] + b1;
#pragma unroll
                        for (int j = 0; j < 4; ++j) { v0[j] = logsigmoidf_(v0[j]); v1[j] = logsigmoidf_(v1[j]); }
                        *(GAS f32x4*)(aux + row * 16 + cw) = v0; *(GAS f32x4*)(aux + row * 16 + cw + 4) = v1; }
            }
            return;
        }
        bool rope0 = false, rope1 = false; float sc = 1.f;
        if (MODE == EM_NSA) { if (u.pn < 4) { rope0 = rope1 = true; sc = C2; } else if (!(u.pn & 1)) { rope0 = rope1 = true; } }
        if (MODE == EM_FOX) { if (u.pn < 4) sc = C2; }
        if (MODE == EM_SWA) { if (u.pn < 4) { rope0 = rope1 = true; sc = C2; } else { rope0 = true; } }
        f32x4 bv[2][2];
#pragma unroll
        for (int bj = 0; bj < 2; ++bj)
#pragma unroll
            for (int n = 0; n < 2; ++n) bv[bj][n] = bias ? *(const GAS f32x4*)(bias + colt + bj * HALF + cw + 4 * n) : (f32x4){0.f, 0.f, 0.f, 0.f};
        const int ib = 16 * (wc & 1) + 4 * fq;
        bf16_t* base = O; int colo = colt; size_t rowo = 0;
        if (MODE == EM_CMP) { colo = 0; rowo = (size_t)u.pn * CMP_ROWS; }
        bool hm = false; bf16_t* hb[2] = {nullptr, nullptr}; int hd[2] = {0, 0}; int HG = 1;
        if (MODE == EM_FOX && u.pn >= 4) { hm = true; HG = 16; hb[0] = hb[1] = hm0 + (u.pn >= 8 ? hm_stride : 0); hd[0] = ((u.pn - 4) & 3) * 4 + (wc >> 1); hd[1] = hd[0] + 2; }
        if (MODE == EM_NSA && u.pn >= 6) { hm = true; HG = 4; hb[0] = hb[1] = hm0 + (size_t)(u.pn - 6) * hm_stride; hd[0] = (wc >> 1); hd[1] = hd[0] + 2; }
        if (MODE == EM_SWA && u.pn == 4) { hm = true; HG = 2; hb[0] = hm0; hb[1] = hm0 + hm_stride; hd[0] = hd[1] = (wc >> 1); }
#pragma unroll
        for (int ai = 0; ai < 2; ++ai)
#pragma unroll
            for (int m = 0; m < 4; ++m) {
                const int row = row0 + ai * HALF + m * 16;
                f32x4 cc = {1.f, 1.f, 1.f, 1.f}, ss = {0.f, 0.f, 0.f, 0.f};
                if (MODE == EM_NSA || MODE == EM_SWA) { if (rope0) { const int t = row & (T - 1); cc = *(const GAS f32x4*)(rc + t * 32 + ib); ss = *(const GAS f32x4*)(rs + t * 32 + ib); } }
                bf16_t* rowp = base + (rowo + (size_t)row) * ldc + colo + cw;
#pragma unroll
                for (int bj = 0; bj < 2; ++bj) {
                    f32x4 v0 = acc[ai][bj][m][0] + bv[bj][0], v1 = acc[ai][bj][m][1] + bv[bj][1];
                    if (MODE == EM_NSA || MODE == EM_SWA) { if (bj == 0 ? rope0 : rope1) { rope4(v0, cc[0], ss[0], cc[1], ss[1]); rope4(v1, cc[2], ss[2], cc[3], ss[3]); } }
                    if (MODE == EM_RELU2) {
#pragma unroll
                        for (int j = 0; j < 4; ++j) { const float a = fmaxf(v0[j], 0.f), b = fmaxf(v1[j], 0.f); v0[j] = a * a; v1[j] = b * b; } }
                    if (MODE == EM_CMP) {
#pragma unroll
                        for (int j = 0; j < 4; ++j) { v0[j] = v0[j] * sigmoidf_(v0[j]); v1[j] = v1[j] * sigmoidf_(v1[j]); } }
                    if (MODE == EM_NSA || MODE == EM_FOX || MODE == EM_SWA) { v0 = v0 * sc; v1 = v1 * sc; }
                    if ((MODE == EM_FOX || MODE == EM_NSA || MODE == EM_SWA) && hm) store8(hb[bj] + (((size_t)(row >> 11) * HG + hd[bj]) * T + (row & (T - 1))) * 64 + (cw & 63), v0, v1);
                    else store8(rowp + bj * HALF, v0, v1);
                }
            }
    }
};

template <class Epi, class Sched, int AMODE, bool ALIGN_EPI = false, bool SP2 = false>
__device__ __forceinline__ void gemm_phase(PG8_LAS unsigned char* lds, const Gemm g, const Sched& S, const Epi& E, int wave_id) {
    int tid_; { int x_; asm volatile("v_mbcnt_lo_u32_b32 %0, -1, 0\n\tv_mbcnt_hi_u32_b32 %0, -1, %0" : "=v"(x_)); tid_ = wave_id * 64 + x_; }
    const int tid = tid_, wid = __builtin_amdgcn_readfirstlane(tid >> 6), lane = tid & 63, wr = wid >> 2, wc = wid & 3, fr = lane & 15, fq = lane >> 4;
    const int K = g.K, nt = K / BK;
    unsigned voffA[2], voffB[2];
#pragma unroll
    for (int i = 0; i < 2; ++i) { int R, C; stage_rc(tid * 16 + i * 8192, R, C); const int Rb = Epi::PERM ? ((R & ~31) + perm32(R & 31)) : R;
        voffA[i] = (AMODE == 1) ? (unsigned)((16 * (R >> 2)) * CMP_LDP + (R & 3) * 64 + C) * 2u : (unsigned)(R * K + C) * 2u; voffB[i] = (unsigned)(Rb * K + C) * 2u; }
    const size_t kstepB = (size_t)(BK * 2);
    const size_t hstepB = (size_t)HALF * K * 2;
    const size_t tstepB = 2 * hstepB;
    const size_t kstepA = (AMODE == 1) ? (size_t)CMP_LDP * 2 : kstepB;
    const size_t hstepA = (AMODE == 1) ? (size_t)512 * CMP_LDP * 2 : hstepB;
    const size_t tstepA = 2 * hstepA;
    const size_t pnstepA = (AMODE == 1) ? (size_t)512 : (size_t)0;
    const unsigned ldsw = (unsigned)wid * 1024u;
    const int aoff = lds_byte(wr * 64 + fr, fq * 8), boff = lds_byte(wc * 32 + fr, fq * 8);
#define PG8_SA(b, h) (((b) * 2 + (h)) * HTB)
#define PG8_SB(b, h) ((4 + (b) * 2 + (h)) * HTB)
#define PG8_STAGE(bufoff, gbase, voff) do { _Pragma("unroll") for (int _i = 0; _i < 2; ++_i) \
        __builtin_amdgcn_global_load_lds((const unsigned*)((const char*)(gbase) + (voff)[_i]), (PG8_LAS unsigned*)(lds + (bufoff) + ldsw + _i * 8192), 16, 0, 0); } while (0)
#define PG8_LDA(dst, b, h) do { _Pragma("unroll") for (int m = 0; m < 4; ++m) _Pragma("unroll") for (int k = 0; k < 2; ++k) dst[m][k] = *(const PG8_LAS bf16x8*)(lds + PG8_SA(b, h) + aoff + m * 2048 + k * 1024); } while (0)
#define PG8_LDB(dst, b, h) do { _Pragma("unroll") for (int n = 0; n < 2; ++n) _Pragma("unroll") for (int k = 0; k < 2; ++k) dst[n][k] = *(const PG8_LAS bf16x8*)(lds + PG8_SB(b, h) + boff + n * 2048 + k * 1024); } while (0)
#define PG8_MMA(ai, bj, At, Bt) do { __builtin_amdgcn_s_setprio(1); _Pragma("unroll") for (int m = 0; m < 4; ++m) _Pragma("unroll") for (int n = 0; n < 2; ++n) _Pragma("unroll") for (int k = 0; k < 2; ++k) \
        acc[ai][bj][m][n] = __builtin_amdgcn_mfma_f32_16x16x32_bf16(Bt[n][k], At[m][k], acc[ai][bj][m][n], 0, 0, 0); __builtin_amdgcn_s_setprio(0); } while (0)
#define PG8_WAIT_V(n) asm volatile("s_waitcnt vmcnt(" #n ")" ::: "memory")
#define PG8_WAIT_L(n) asm volatile("s_waitcnt lgkmcnt(" #n ")" ::: "memory")
#define PG8_BAR __builtin_amdgcn_s_barrier()
#define PG8_SCHED __builtin_amdgcn_sched_barrier(0)
    Unit cur, nxt; int ui = 0;
    if (!S.next(0, cur)) return;
    f32x4 acc[2][2][4][2];
#pragma unroll
    for (int a = 0; a < 2; ++a)
#pragma unroll
        for (int b = 0; b < 2; ++b)
#pragma unroll
            for (int m = 0; m < 4; ++m)
#pragma unroll
                for (int n = 0; n < 2; ++n) acc[a][b][m][n] = (f32x4){0.f, 0.f, 0.f, 0.f};
    bf16x8 At[4][2], B0[2][2], B1[2][2];
    const char* cA = (const char*)g.A + (size_t)cur.pm * tstepA + (size_t)cur.pn * pnstepA; const char* cB = (const char*)g.Bt + (size_t)cur.pn * tstepB;
    S.a_ready(cur);
    if constexpr (SP2) {
        PG8_STAGE(PG8_SB(0, 0), cB, voffB); PG8_STAGE(PG8_SB(0, 1), cB + hstepB, voffB); PG8_STAGE(PG8_SA(0, 0), cA, voffA); PG8_STAGE(PG8_SA(0, 1), cA + hstepA, voffA);
        if (wr == 1) PG8_BAR;
        PG8_WAIT_V(2); PG8_BAR;
        PG8_STAGE(PG8_SB(1, 0), cB + kstepB, voffB); PG8_STAGE(PG8_SA(1, 0), cA + kstepA, voffA); PG8_STAGE(PG8_SB(1, 1), cB + hstepB + kstepB, voffB);
        PG8_WAIT_V(6); PG8_BAR;
    } else {
        PG8_STAGE(PG8_SB(0, 0), cB, voffB); PG8_STAGE(PG8_SA(0, 0), cA, voffA); PG8_STAGE(PG8_SB(0, 1), cB + hstepB, voffB); PG8_STAGE(PG8_SA(0, 1), cA + hstepA, voffA);
        if (wr == 1) PG8_BAR;
        PG8_WAIT_V(4); PG8_BAR;
        PG8_STAGE(PG8_SB(1, 0), cB + kstepB, voffB); PG8_STAGE(PG8_SA(1, 0), cA + kstepA, voffA); PG8_STAGE(PG8_SB(1, 1), cB + hstepB + kstepB, voffB);
        PG8_WAIT_V(6); PG8_BAR;
    }
    for (;;) {
        const bool has_next = S.next(ui + 1, nxt);
        const char* nA = has_next ? (const char*)g.A + (size_t)nxt.pm * tstepA + (size_t)nxt.pn * pnstepA : cA; const char* nB = has_next ? (const char*)g.Bt + (size_t)nxt.pn * tstepB : cB;
        for (int t = 0; t < nt; t += 2) {
            const bool last = (t == nt - 2);
            const char* a1 = cA + (size_t)(t + 1) * kstepA;
            const char* a2 = last ? nA : cA + (size_t)(t + 2) * kstepA; const char* b2 = last ? nB : cB + (size_t)(t + 2) * kstepB;
            const char* a3 = a2 + kstepA; const char* b3 = b2 + kstepB;
            if (last && has_next) S.a_ready(nxt);
            if constexpr (SP2) {
            PG8_LDB(B0, 0, 0); PG8_LDB(B1, 0, 1); PG8_SCHED; PG8_LDA(At, 0, 0); PG8_STAGE(PG8_SA(1, 1), a1 + hstepA, voffA);
            PG8_WAIT_V(8); PG8_WAIT_L(0); PG8_BAR; PG8_MMA(0, 0, At, B0); PG8_MMA(0, 1, At, B1); PG8_BAR; PG8_SCHED;
            PG8_LDA(At, 0, 1); PG8_STAGE(PG8_SB(0, 0), b2, voffB); PG8_STAGE(PG8_SB(0, 1), b2 + hstepB, voffB); PG8_STAGE(PG8_SA(0, 0), a2, voffA);
            PG8_WAIT_V(8); PG8_WAIT_L(0); PG8_BAR; PG8_MMA(1, 0, At, B0); PG8_MMA(1, 1, At, B1); PG8_BAR; PG8_SCHED;
            PG8_LDB(B0, 1, 0); PG8_LDB(B1, 1, 1); PG8_SCHED; PG8_LDA(At, 1, 0); PG8_STAGE(PG8_SA(0, 1), a2 + hstepA, voffA);
            PG8_WAIT_V(8); PG8_WAIT_L(0); PG8_BAR; PG8_MMA(0, 0, At, B0); PG8_MMA(0, 1, At, B1); PG8_BAR; PG8_SCHED;
            PG8_LDA(At, 1, 1); PG8_STAGE(PG8_SB(1, 0), b3, voffB); PG8_STAGE(PG8_SB(1, 1), b3 + hstepB, voffB); PG8_STAGE(PG8_SA(1, 0), a3, voffA);
            PG8_WAIT_V(8); PG8_WAIT_L(0); PG8_BAR; PG8_MMA(1, 0, At, B0); PG8_MMA(1, 1, At, B1); PG8_BAR; PG8_SCHED;
            } else {
            PG8_LDB(B0, 0, 0); PG8_SCHED; PG8_LDA(At, 0, 0); PG8_STAGE(PG8_SA(1, 1), a1 + hstepA, voffA);
            PG8_WAIT_L(8); PG8_BAR; PG8_WAIT_L(0); PG8_MMA(0, 0, At, B0); PG8_BAR; PG8_SCHED;
            PG8_LDB(B1, 0, 1); PG8_STAGE(PG8_SB(0, 0), b2, voffB);
            PG8_BAR; PG8_WAIT_L(0); PG8_MMA(0, 1, At, B1); PG8_BAR;
            PG8_LDA(At, 0, 1); PG8_STAGE(PG8_SA(0, 0), a2, voffA);
            PG8_BAR; PG8_WAIT_L(0); PG8_MMA(1, 0, At, B0); PG8_BAR; PG8_SCHED;
            PG8_STAGE(PG8_SB(0, 1), b2 + hstepB, voffB);
            PG8_WAIT_V(6); PG8_BAR; PG8_MMA(1, 1, At, B1); PG8_BAR;
            PG8_LDB(B0, 1, 0); PG8_SCHED; PG8_LDA(At, 1, 0); PG8_STAGE(PG8_SA(0, 1), a2 + hstepA, voffA);
            PG8_WAIT_L(8); PG8_BAR; PG8_WAIT_L(0); PG8_MMA(0, 0, At, B0); PG8_BAR; PG8_SCHED;
            PG8_LDB(B1, 1, 1); PG8_STAGE(PG8_SB(1, 0), b3, voffB);
            PG8_BAR; PG8_WAIT_L(0); PG8_MMA(0, 1, At, B1); PG8_BAR;
            PG8_LDA(At, 1, 1); PG8_STAGE(PG8_SA(1, 0), a3, voffA);
            PG8_BAR; PG8_WAIT_L(0); PG8_MMA(1, 0, At, B0); PG8_BAR; PG8_SCHED;
            PG8_STAGE(PG8_SB(1, 1), b3 + hstepB, voffB);
            PG8_WAIT_V(6); PG8_BAR; PG8_MMA(1, 1, At, B1); PG8_BAR;
            }
        }
        if constexpr (ALIGN_EPI) { if (wr == 0) PG8_BAR; }
        if constexpr (!Epi::AFTER_DRAIN) { E(acc, cur, wr, wc, fr, fq); S.done(cur); }
        if (!has_next) break;
#pragma unroll
        for (int a = 0; a < 2; ++a)
#pragma unroll
            for (int b = 0; b < 2; ++b)
#pragma unroll
                for (int m = 0; m < 4; ++m)
#pragma unroll
                    for (int n = 0; n < 2; ++n) acc[a][b][m][n] = (f32x4){0.f, 0.f, 0.f, 0.f};
        cur = nxt; cA = nA; cB = nB; ++ui;
        if constexpr (ALIGN_EPI) { if (wr == 1) PG8_BAR; }
    }
    PG8_WAIT_V(0);
    if constexpr (!ALIGN_EPI) { if (wr == 0) PG8_BAR; }
    PG8_BAR;
    if constexpr (Epi::AFTER_DRAIN) { E.fused(acc, cur, wr, wc, fr, fq, lds, wid, lane); S.done(cur); }
#undef PG8_SA
#undef PG8_SB
#undef PG8_STAGE
#undef PG8_LDA
#undef PG8_LDB
#undef PG8_MMA
#undef PG8_WAIT_V
#undef PG8_WAIT_L
#undef PG8_BAR
#undef PG8_SCHED
}
}

namespace att {
constexpr int SLOTB = 8192;
constexpr int NSLOT = 4;
constexpr int L_K = 0, L_V = 32768, L_WS = 65536, L_OST = 67584, L_PSUM = L_OST, L_IMP = 133120, L_KB = L_IMP, L_SEL = 141312, L_END = 141568;
constexpr float PFIX = 268435456.0f;
constexpr float THR = 8.0f;

__device__ __forceinline__ int crow(int r, int hh) { return (r & 3) + 8 * (r >> 2) + 4 * hh; }
typedef float f32x2_t __attribute__((ext_vector_type(2))); typedef __bf16 bf16x2_t __attribute__((ext_vector_type(2)));
__device__ __forceinline__ unsigned cvtpk_s(float lo, float hi) { f32x2_t v = {lo, hi}; bf16x2_t b = __builtin_convertvector(v, bf16x2_t); return __builtin_bit_cast(unsigned, b); }
typedef short v4i16_t __attribute__((ext_vector_type(4)));
__device__ __forceinline__ s16x4 vtr(const LAS unsigned char* p) { return __builtin_bit_cast(s16x4, __builtin_amdgcn_ds_read_tr16_b64_v4i16((LAS v4i16_t*)p)); }
__device__ __forceinline__ float swap_sum(float v) { auto rr = __builtin_amdgcn_permlane32_swap(__float_as_uint(v), __float_as_uint(v), false, false); return __uint_as_float(rr[0]) + __uint_as_float(rr[1]); }
__device__ __forceinline__ float swap_max(float v) { auto rr = __builtin_amdgcn_permlane32_swap(__float_as_uint(v), __float_as_uint(v), false, false); return fmaxf(__uint_as_float(rr[0]), __uint_as_float(rr[1])); }
__device__ __forceinline__ bool trailing_half(int wid) { asm volatile("" : "+s"(wid)); return (wid >> 2) != 0; }
#define ATT_BAR() do { __builtin_amdgcn_s_barrier(); asm volatile("" ::: "memory"); } while (0)

__device__ __forceinline__ void dma_tile(const bf16_t* Kb, const bf16_t* Vb, int pitch, int tile, LAS unsigned char* shm, int slot, int wid, int lane) {
    const bf16_t* ks = Kb + (size_t)(tile * 64 + lane) * pitch + wid * 8;
    const bf16_t* vs = Vb + (size_t)(tile * 64 + 16 * (wid & 3) + (lane >> 2)) * pitch + (wid >> 2) * 32 + (lane & 3) * 8;
    __builtin_amdgcn_global_load_lds((const unsigned*)ks, (LAS unsigned*)(shm + L_K + slot * SLOTB + wid * 1024), 16, 0, 0);
    __builtin_amdgcn_global_load_lds((const unsigned*)vs, (LAS unsigned*)(shm + L_V + slot * SLOTB + wid * 1024), 16, 0, 0);
#ifdef PROBE_DMA2
    __builtin_amdgcn_global_load_lds((const unsigned*)ks, (LAS unsigned*)(shm + L_K + slot * SLOTB + wid * 1024), 16, 0, 0);
    __builtin_amdgcn_global_load_lds((const unsigned*)vs, (LAS unsigned*)(shm + L_V + slot * SLOTB + wid * 1024), 16, 0, 0);
#endif
}
#ifdef PROBE_DMA2
#define VMW2 "4"
#define VMW4 "8"
#else
#define VMW2 "2"
#define VMW4 "4"
#endif
__device__ __forceinline__ void qkt(f32x16& p0, f32x16& p1, const LAS unsigned char* shm, int slot, const bf16x8 (&qr)[4], const f32x16& cinit, int r32, int hh) {
    const LAS unsigned char* kb = shm + L_K + slot * SLOTB + hh * 1024 + r32 * 16;
#pragma unroll
    for (int d0 = 0; d0 < 4; ++d0) {
        const bf16x8 b0 = *(const LAS bf16x8*)(kb + d0 * 2048), b1 = *(const LAS bf16x8*)(kb + d0 * 2048 + 512);
        if (d0 == 0) { p0 = __builtin_amdgcn_mfma_f32_32x32x16_bf16(b0, qr[0], cinit, 0, 0, 0); p1 = __builtin_amdgcn_mfma_f32_32x32x16_bf16(b1, qr[0], cinit, 0, 0, 0); }
        else { p0 = __builtin_amdgcn_mfma_f32_32x32x16_bf16(b0, qr[d0], p0, 0, 0, 0); p1 = __builtin_amdgcn_mfma_f32_32x32x16_bf16(b1, qr[d0], p1, 0, 0, 0); }
        if (d0 == 1) asm volatile("" ::: "memory");
    }
}
__device__ __forceinline__ void load_k(bf16x8 (&kf)[8], const LAS unsigned char* shm, int slot, int r32, int hh) {
    const LAS unsigned char* kb = shm + L_K + slot * SLOTB + hh * 1024 + r32 * 16;
#pragma unroll
    for (int d0 = 0; d0 < 4; ++d0) { kf[2 * d0] = *(const LAS bf16x8*)(kb + d0 * 2048); kf[2 * d0 + 1] = *(const LAS bf16x8*)(kb + d0 * 2048 + 512); }
}
__device__ __forceinline__ void mma_qk(f32x16& p0, f32x16& p1, const bf16x8 (&kf)[8], const bf16x8 (&qr)[4], const f32x16& cinit) {
    p0 = __builtin_amdgcn_mfma_f32_32x32x16_bf16(kf[0], qr[0], cinit, 0, 0, 0); p1 = __builtin_amdgcn_mfma_f32_32x32x16_bf16(kf[1], qr[0], cinit, 0, 0, 0);
#pragma unroll
    for (int d0 = 1; d0 < 4; ++d0) { p0 = __builtin_amdgcn_mfma_f32_32x32x16_bf16(kf[2 * d0], qr[d0], p0, 0, 0, 0); p1 = __builtin_amdgcn_mfma_f32_32x32x16_bf16(kf[2 * d0 + 1], qr[d0], p1, 0, 0, 0); }
}
__device__ __forceinline__ void load_v(bf16x8 (&vf)[8], const LAS unsigned char* shm, int slot, int lane, int hh) {
    const LAS unsigned char* vb = shm + L_V + slot * SLOTB + ((lane >> 4) & 1) * 32 + (lane & 3) * 8 + (4 * hh + ((lane & 15) >> 2)) * 64;
#pragma unroll
    for (int ks = 0; ks < 4; ++ks)
#pragma unroll
        for (int d0 = 0; d0 < 2; ++d0) {
            const s16x4 vl = vtr(vb + d0 * 4096 + ks * 1024), vh = vtr(vb + d0 * 4096 + ks * 1024 + 512);
            vf[2 * ks + d0] = (bf16x8){vl[0], vl[1], vl[2], vl[3], vh[0], vh[1], vh[2], vh[3]};
        }
}
__device__ __forceinline__ void mma_pv(f32x16 (&o)[2], const u32x4 (&pw)[4], const bf16x8 (&vf)[8]) {
#pragma unroll
    for (int ks = 0; ks < 4; ++ks)
#pragma unroll
        for (int d0 = 0; d0 < 2; ++d0) o[d0] = __builtin_amdgcn_mfma_f32_32x32x16_bf16(__builtin_bit_cast(bf16x8, pw[ks]), vf[2 * ks + d0], o[d0], 0, 0, 0);
}
__device__ __forceinline__ void pv_seq(f32x16 (&o)[2], const u32x4 (&pw)[4], const LAS unsigned char* shm, int slot, int lane, int hh) {
    const LAS unsigned char* vb = shm + L_V + slot * SLOTB + ((lane >> 4) & 1) * 32 + (lane & 3) * 8 + (4 * hh + ((lane & 15) >> 2)) * 64;
#pragma unroll
    for (int ks = 0; ks < 4; ++ks) {
#pragma unroll
        for (int d0 = 0; d0 < 2; ++d0) {
            const s16x4 vl = vtr(vb + d0 * 4096 + ks * 1024), vh = vtr(vb + d0 * 4096 + ks * 1024 + 512);
            const bf16x8 vf = {vl[0], vl[1], vl[2], vl[3], vh[0], vh[1], vh[2], vh[3]};
            o[d0] = __builtin_amdgcn_mfma_f32_32x32x16_bf16(__builtin_bit_cast(bf16x8, pw[ks]), vf, o[d0], 0, 0, 0);
        }
        if (ks == 1) asm volatile("" ::: "memory");
    }
}
__device__ __forceinline__ void range_mask(f32x16& p0, f32x16& p1, int kb, int lo, int hi) {
#pragma unroll
    for (int r = 0; r < 16; ++r) { const int k = kb + (r & 3) + 8 * (r >> 2); if (k < lo || k > hi) p0[r] = -INFINITY; if (k + 32 < lo || k + 32 > hi) p1[r] = -INFINITY; }
}
__device__ __forceinline__ void mask_hi(f32x16& p0, f32x16& p1, int dh) {
#pragma unroll
    for (int r = 0; r < 16; ++r) { const int c = (r & 3) + 8 * (r >> 2); if (c > dh) p0[r] = -INFINITY; if (c + 32 > dh) p1[r] = -INFINITY; }
}
__device__ __forceinline__ void mask_lo(f32x16& p0, f32x16& p1, int dl) {
#pragma unroll
    for (int r = 0; r < 16; ++r) { const int c = (r & 3) + 8 * (r >> 2); if (c < dl) p0[r] = -INFINITY; if (c + 32 < dl) p1[r] = -INFINITY; }
}
__device__ __forceinline__ void rescale_o(f32x16 (&o)[2], const LAS float* wsf, int hh) {
#pragma unroll
    for (int g = 0; g < 4; ++g) { const f32x4 a4 = *(const LAS f32x4*)(wsf + 8 * g + 4 * hh);
#pragma unroll
        for (int j = 0; j < 4; ++j) { o[0][4 * g + j] *= a4[j]; o[1][4 * g + j] *= a4[j]; } }
}

#define MM(a, b, c) __builtin_amdgcn_mfma_f32_32x32x16_bf16(a, b, c, 0, 0, 0)
#define SGB(mask, n) __builtin_amdgcn_sched_group_barrier(mask, n, 0)
template <int MODE>
__device__ __forceinline__ void sweep(f32x16 (&o)[2], float cref, float& l, const bf16x8 (&qr)[4], const bf16_t* Kb, const bf16_t* Vb, int pitch, int t0, int NT, int lo, int hi,
                                      unsigned rowsel, LAS unsigned char* shm, int& ring, int wid, int lane) {
    asm volatile("" : "+v"(lane));
    const int r32 = lane & 31, hh = lane >> 5;
    const int lo_max = __builtin_amdgcn_readlane(lo, 31), hi_min = __builtin_amdgcn_readfirstlane(hi);
    const int ring0 = ring;
#define SLOT(i_) ((ring0 + (i_)) & (NSLOT - 1))
    dma_tile(Kb, Vb, pitch, t0, shm, SLOT(0), wid, lane);
    dma_tile(Kb, Vb, pitch, t0 + 1, shm, SLOT(1), wid, lane);
    f32x16 a0, a1, b0, b1, cini; u32x4 pw[4]; bf16x8 kf[8], vf[8]; float ls0 = 0.f, ls1 = 0.f;
#pragma unroll
    for (int r = 0; r < 16; ++r) cini[r] = (MODE == 1) ? -cref : 0.f;
#define SET_CINI(i_) do { if (MODE == 2) { const float c_ = ((rowsel >> (t0 + (i_))) & 1u) ? 0.f : -INFINITY; _Pragma("unroll") for (int r = 0; r < 16; ++r) cini[r] = c_; } } while (0)
#define NEEDMASK(i_) ((t0 + (i_)) * 64 < lo_max || (t0 + (i_)) * 64 + 63 > hi_min)
#define BIAS(C0, C1, i_) do { if (MODE == 1) { const LAS float* kb_ = (const LAS float*)(shm + L_KB) + (t0 + (i_)) * 64 + 4 * hh; \
            _Pragma("unroll") for (int k_ = 0; k_ < 4; ++k_) { const f32x4 x0_ = *(const LAS f32x4*)(kb_ + 8 * k_), x1_ = *(const LAS f32x4*)(kb_ + 32 + 8 * k_); \
                _Pragma("unroll") for (int e_ = 0; e_ < 4; ++e_) { C0[4 * k_ + e_] += x0_[e_]; C1[4 * k_ + e_] += x1_[e_]; } } } } while (0)
    asm volatile("s_waitcnt lgkmcnt(0)" ::: "memory");
    asm volatile("s_waitcnt vmcnt(2)" ::: "memory");
    ATT_BAR();
    dma_tile(Kb, Vb, pitch, t0 + 2, shm, SLOT(2), wid, lane);
    SET_CINI(0);
    load_k(kf, shm, SLOT(0), r32, hh);
    mma_qk(a0, a1, kf, qr, cini);
    BIAS(a0, a1, 0);
    if (NEEDMASK(0)) range_mask(a0, a1, t0 * 64 + 4 * hh, lo, hi);
#pragma unroll
    for (int r = 0; r < 16; ++r) { a0[r] = __builtin_amdgcn_exp2f(a0[r]); a1[r] = __builtin_amdgcn_exp2f(a1[r]); }
#define STEP_BODY(i_, C0, C1, P0, P1, MASK_) do { \
        SET_CINI(i_); \
        load_k(kf, shm, SLOT(i_), r32, hh); \
        __builtin_amdgcn_sched_barrier(0); \
        load_v(vf, shm, SLOT((i_) - 1), lane, hh); \
          \
        C0 = MM(kf[0], qr[0], cini); C1 = MM(kf[1], qr[0], cini); \
        _Pragma("unroll") for (int d_ = 1; d_ < 4; ++d_) { C0 = MM(kf[2 * d_], qr[d_], C0); C1 = MM(kf[2 * d_ + 1], qr[d_], C1); } \
        _Pragma("unroll") for (int r = 0; r < 16; ++r) { ls0 += P0[r]; ls1 += P1[r]; } \
        _Pragma("unroll") for (int e_ = 0; e_ < 4; ++e_) { pw[0][e_] = cvtpk_s(P0[2 * e_], P0[2 * e_ + 1]); pw[1][e_] = cvtpk_s(P0[8 + 2 * e_], P0[9 + 2 * e_]); pw[2][e_] = cvtpk_s(P1[2 * e_], P1[2 * e_ + 1]); pw[3][e_] = cvtpk_s(P1[8 + 2 * e_], P1[9 + 2 * e_]); } \
        _Pragma("unroll") for (int g_ = 0; g_ < 8; ++g_) { SGB(0x008, 1); SGB(0x100, 2); SGB(0x002, 6); } \
        asm volatile("" : "+v"(ls0), "+v"(ls1), "+v"(pw[0]), "+v"(pw[1]), "+v"(pw[2]), "+v"(pw[3]));     \
        __builtin_amdgcn_sched_barrier(0); \
        BIAS(C0, C1, i_); \
        if (NEEDMASK(i_)) range_mask(C0, C1, (t0 + (i_)) * 64 + 4 * hh, lo, hi); \
        __builtin_amdgcn_sched_barrier(0); \
          \
        dma_tile(Kb, Vb, pitch, t0 + (i_) + 2, shm, SLOT((i_) + 2), wid, lane); \
        _Pragma("unroll") for (int ks_ = 0; ks_ < 4; ++ks_) _Pragma("unroll") for (int d_ = 0; d_ < 2; ++d_) o[d_] = MM(__builtin_bit_cast(bf16x8, pw[ks_]), vf[2 * ks_ + d_], o[d_]); \
        _Pragma("unroll") for (int r = 0; r < 16; ++r) { C0[r] = __builtin_amdgcn_exp2f(C0[r]); C1[r] = __builtin_amdgcn_exp2f(C1[r]); } \
        SGB(0x008, 1); SGB(0x020, 1); SGB(0x400, 4); SGB(0x008, 1); SGB(0x020, 1); SGB(0x400, 4); \
        _Pragma("unroll") for (int g_ = 0; g_ < 6; ++g_) { SGB(0x008, 1); SGB(0x400, 4); } \
        asm volatile("" : "+v"(C0), "+v"(C1));                   \
        __builtin_amdgcn_sched_barrier(0); \
    } while (0)
#define STEP(i_, C0, C1, P0, P1) do { \
        asm volatile("s_waitcnt lgkmcnt(0)" ::: "memory"); \
        asm volatile("s_waitcnt vmcnt(2)" ::: "memory");         \
        ATT_BAR(); \
        STEP_BODY(i_, C0, C1, P0, P1, false); \
    } while (0)
    int i = 1;
    for (; i + 1 < NT; i += 2) { STEP(i, b0, b1, a0, a1); STEP(i + 1, a0, a1, b0, b1); }
    if (i < NT) {
        STEP(i, b0, b1, a0, a1);
#pragma unroll
        for (int r = 0; r < 16; ++r) { a0[r] = b0[r]; a1[r] = b1[r]; }
    }
#pragma unroll
    for (int r = 0; r < 16; ++r) { ls0 += a0[r]; ls1 += a1[r]; }
#pragma unroll
    for (int e = 0; e < 4; ++e) { pw[0][e] = cvtpk_s(a0[2 * e], a0[2 * e + 1]); pw[1][e] = cvtpk_s(a0[8 + 2 * e], a0[9 + 2 * e]); pw[2][e] = cvtpk_s(a1[2 * e], a1[2 * e + 1]); pw[3][e] = cvtpk_s(a1[8 + 2 * e], a1[9 + 2 * e]); }
    load_v(vf, shm, SLOT(NT - 1), lane, hh);
    mma_pv(o, pw, vf);
    l += ls0 + ls1;
    asm volatile("s_waitcnt lgkmcnt(0)" ::: "memory");
    ring = SLOT(NT);
#undef STEP
#undef STEP_BODY
#undef BIAS
#undef NEEDMASK
#undef SET_CINI
#undef SLOT
}
#undef MM
#undef SGB
template <bool FIRST>
__device__ __forceinline__ void merge(const f32x16 (&o)[2], float scale, LAS unsigned char* shm, int wid, int r32, int hh) {
    LAS float* wsf = (LAS float*)(shm + L_WS + wid * 256);
    LAS float* stg = (LAS float*)(shm + L_OST + wid * 8192) + r32;
    if (hh == 0) wsf[r32] = scale;
#pragma unroll
    for (int g = 0; g < 4; ++g) { const f32x4 s4 = *(const LAS f32x4*)(wsf + 8 * g + 4 * hh);
#pragma unroll
        for (int j = 0; j < 4; ++j) { LAS float* p = stg + (8 * g + 4 * hh + j) * 64;
            if (FIRST) { p[0] = o[0][4 * g + j] * s4[j]; p[32] = o[1][4 * g + j] * s4[j]; }
            else { p[0] += o[0][4 * g + j] * s4[j]; p[32] += o[1][4 * g + j] * s4[j]; } } }
}
__device__ __forceinline__ void store_o(bf16_t* Ow, LAS unsigned char* shm, int wid, int lane) {
    const LAS float* stg = (const LAS float*)(shm + L_OST + wid * 8192);
#pragma unroll
    for (int i = 0; i < 4; ++i) { const int rowl = i * 8 + (lane >> 3), ch = lane & 7; const f32x4 a = *(const LAS f32x4*)(stg + rowl * 64 + ch * 8), c = *(const LAS f32x4*)(stg + rowl * 64 + ch * 8 + 4);
        u32x4 v; v.x = cvtpk_s(a[0], a[1]); v.y = cvtpk_s(a[2], a[3]); v.z = cvtpk_s(c[0], c[1]); v.w = cvtpk_s(c[2], c[3]); *(GAS u32x4*)(Ow + (size_t)rowl * D + ch * 8) = v; }
}
__device__ __forceinline__ void zero_o(f32x16 (&o)[2]) { o[0] = (f32x16){0.f, 0.f, 0.f, 0.f, 0.f, 0.f, 0.f, 0.f, 0.f, 0.f, 0.f, 0.f, 0.f, 0.f, 0.f, 0.f}; o[1] = o[0]; }
#define ATT_LOADQ(Qrow_) bf16x8 qr[4]; _Pragma("unroll") for (int d0 = 0; d0 < 4; ++d0) qr[d0] = *(const GAS bf16x8*)((Qrow_) + d0 * 16 + hh * 8)

__device__ __forceinline__ void fox_unit(LAS unsigned char* shm, int b, int h, int qb, unsigned char* ws_, size_t off_p, size_t off_cb, size_t off_o, int wid, int& ring) {
    const int lane = lane_id_volatile();
    unsigned char* ws = ws_; asm volatile("" : "+s"(ws)); const bf16_t* P = (const bf16_t*)(ws + off_p); const float* CB = (const float*)(ws + off_cb); bf16_t* O = (bf16_t*)(ws + off_o);
    const int r32 = lane & 31, hh = lane >> 5;
    const int pos = 256 * qb + 32 * wid + r32;
    const size_t row = (size_t)b * T + pos;
    ATT_LOADQ(P + row * FOX_LDP + h * 64);
    const bf16_t* Kb = (const bf16_t*)(ws + off_p + FOX_HM_OFF) + (size_t)(b * NH + h) * T * 64; const bf16_t* Vb = Kb + FOX_HM_STRIDE;
    f32x16 o[2]; zero_o(o); float l = 0.f;
    asm volatile("s_waitcnt lgkmcnt(0)" ::: "memory"); ATT_BAR();
    const float* cb = CB + (size_t)(b * NH + h) * T;
    { LAS float* kbl = (LAS float*)(shm + L_KB);
      for (int i = wid * 64 + lane; i < 64 * (4 * qb + 4); i += 512) kbl[i] = ((const GAS float*)cb)[i]; }
    const float cref = ((const GAS float*)cb)[pos] + 8.0f;
    sweep<1>(o, cref, l, qr, Kb, Vb, 64, 0, 4 * qb + 4, 0, pos, 0u, shm, ring, wid, lane);
    const float lt = swap_sum(l); const float inv = lt > 0.f ? 1.0f / lt : 0.f;
    merge<true>(o, inv, shm, wid, r32, hh);
    store_o(O + ((size_t)b * T + 256 * qb + 32 * wid) * D + h * 64, shm, wid, lane);
}
__device__ __forceinline__ void swa_unit(LAS unsigned char* shm, int b, int g, int qt, unsigned char* ws_, size_t off_p, size_t off_o, const float* sinks, int wid, int& ring) {
    const int lane = lane_id_volatile();
    unsigned char* ws = ws_; asm volatile("" : "+s"(ws)); const bf16_t* P = (const bf16_t*)(ws + off_p); bf16_t* O = (bf16_t*)(ws + off_o);
    const int r32 = lane & 31, hh = lane >> 5;
    const int q0 = 32 * qt, pos = q0 + r32, head = 8 * g + wid;
    const size_t row = (size_t)b * T + pos;
    ATT_LOADQ(P + row * SWA_LDP + head * 64);
    const bf16_t* Kb = (const bf16_t*)(ws + off_p + SWA_HM_OFF) + (size_t)(b * 2 + g) * T * 64; const bf16_t* Vb = Kb + SWA_HM_STRIDE;
    f32x16 o[2]; zero_o(o); float l = 0.f;
    const int tlo = (q0 - 127) > 0 ? ((q0 - 127) >> 6) : 0, thi = (q0 + 31) >> 6;
    sweep<0>(o, 0.f, l, qr, Kb, Vb, 64, tlo, thi - tlo + 1, pos - 127, pos, 0u, shm, ring, wid, lane);
    const float lt = swap_sum(l) + __builtin_amdgcn_exp2f(((const GAS float*)sinks)[head] * LOG2E);
    const float inv = 1.0f / lt;
    merge<true>(o, inv, shm, wid, r32, hh);
    store_o(O + ((size_t)b * T + q0) * D + head * 64, shm, wid, lane);
}
__device__ __forceinline__ void nsa_unit(LAS unsigned char* shm, int b, int g, int qt, unsigned char* ws_, size_t off_p, size_t off_g, size_t off_kc, size_t off_vc, size_t off_o, int wid, int& ring) {
#define NSA_WS() unsigned char* ws = ws_; asm volatile("" : "+s"(ws)); const bf16_t* P = (const bf16_t*)(ws + off_p); const float* G = (const float*)(ws + off_g); const bf16_t* Hb = (const bf16_t*)(ws + off_p + NSA_HM_OFF) + (size_t)(b * 4 + g) * T * 64; (void)G; (void)Hb
    const int hq = 4 * g + (wid >> 1), ph = wid & 1, q0 = 64 * qt;
    LAS unsigned* PSUM = (LAS unsigned*)(shm + L_PSUM); LAS float* IMP = (LAS float*)(shm + L_IMP); LAS unsigned* SEL = (LAS unsigned*)(shm + L_SEL);
#define NSA_LANE() const int lane = lane_id_volatile(); const int r32 = lane & 31, hh = lane >> 5; const int pos = q0 + 32 * ph + r32; const size_t row = (size_t)b * T + pos; (void)hh; (void)row
#define NSA_QROW (P + row * NSA_LDP + hq * 64)
    asm volatile("s_waitcnt lgkmcnt(0)" ::: "memory"); ATT_BAR();
    { const int tid = wid * 64 + lane_id_volatile(); for (int i = tid; i < 8192; i += 512) PSUM[i] = 0u; }
    f32x16 ocmp[2]; float inv_cmp;
    {
        NSA_LANE(); NSA_WS();
        const bf16_t* Kb = (const bf16_t*)(ws + off_kc) + (size_t)(b * 4 + g) * NCP * 64; const bf16_t* Vb = (const bf16_t*)(ws + off_vc) + (size_t)(b * 4 + g) * NCP * 64;
        const int cm = (pos < 31) ? -1 : (((pos - 31) >> 4) < 126 ? ((pos - 31) >> 4) : 126);
        const int ntile = qt >= 16 ? 2 : 1;
        ATT_LOADQ(NSA_QROW);
        f32x16 o[2]; zero_o(o); float l = 0.f; const float m = 0.f;
        const int ring0 = ring;
        sweep<0>(o, 0.f, l, qr, Kb, Vb, 64, 0, ntile, 0, cm, 0u, shm, ring, wid, lane);
        const float lt = swap_sum(l); const float inv = lt > 0.f ? 1.0f / lt : 0.f;
        f32x16 negm;
#pragma unroll
        for (int r = 0; r < 16; ++r) negm[r] = -m;
        for (int tile = 0; tile < ntile; ++tile) {
            const int sl = (ring0 + tile) & (NSLOT - 1);
            f32x16 p0, p1; qkt(p0, p1, shm, sl, qr, negm, r32, hh);
            range_mask(p0, p1, tile * 64 + 4 * hh, 0, cm);
            LAS unsigned* pb = PSUM + (tile * 64 + 4 * hh) * 64 + 32 * ph + r32;
            asm volatile("" : "+v"(pb));
#pragma unroll
            for (int r = 0; r < 16; ++r) {
                const float a = __builtin_amdgcn_exp2f(p0[r]) * inv, c = __builtin_amdgcn_exp2f(p1[r]) * inv;
                __hip_atomic_fetch_add(pb + ((r & 3) + 8 * (r >> 2)) * 64, (unsigned)(a * PFIX + 0.5f), __ATOMIC_RELAXED, __HIP_MEMORY_SCOPE_WORKGROUP);
                __hip_atomic_fetch_add(pb + ((r & 3) + 8 * (r >> 2) + 32) * 64, (unsigned)(c * PFIX + 0.5f), __ATOMIC_RELAXED, __HIP_MEMORY_SCOPE_WORKGROUP);
            }
        }
        ocmp[0] = o[0]; ocmp[1] = o[1]; inv_cmp = inv;
    }
    asm volatile("s_waitcnt lgkmcnt(0)" ::: "memory"); ATT_BAR();
    {
        const int tid = wid * 64 + lane_id_volatile();
        const int rw = tid & 63, ng = tid >> 6;
        LAS unsigned* pb = PSUM + (16 * ng - 1) * 64 + rw;
        LAS float* ib = IMP + (4 * ng) * 64 + rw;
        asm volatile("" : "+v"(pb), "+v"(ib));
        float pc[17];
#pragma unroll
        for (int e = 0; e < 17; ++e) pc[e] = (float)pb[e * 64] * (1.0f / PFIX);
        if (ng == 0) pc[0] = 0.f;
#pragma unroll
        for (int k = 0; k < 4; ++k) ib[k * 64] = pc[4 * k + 1] + pc[4 * k + 2] + pc[4 * k + 3] + 0.5f * (pc[4 * k + 4] + pc[4 * k]);
        const unsigned init = qt < 16 ? ((2u << qt) - 1u) : (1u | (1u << qt) | (1u << (qt - 1)));
        if (tid < 64) SEL[tid] = init;
    }
    asm volatile("s_waitcnt lgkmcnt(0)" ::: "memory"); ATT_BAR();
    if (qt >= 16) {
        const int tid = wid * 64 + lane_id_volatile();
        const int rw = tid & 63, ng = tid >> 6; unsigned bits = 0u;
        LAS float* ib = IMP + rw; asm volatile("" : "+v"(ib));
        float v[4]; int cnt[4] = {0, 0, 0, 0};
#pragma unroll
        for (int k = 0; k < 4; ++k) v[k] = ib[(4 * ng + k) * 64];
        for (int n2 = 1; n2 <= qt - 2; ++n2) { const float v2 = ib[n2 * 64];
#pragma unroll
            for (int k = 0; k < 4; ++k) cnt[k] += (v2 > v[k] || (v2 == v[k] && n2 < 4 * ng + k)) ? 1 : 0; }
#pragma unroll
        for (int k = 0; k < 4; ++k) { const int n = 4 * ng + k; if (n >= 1 && n <= qt - 2 && cnt[k] < 13) bits |= 1u << n; }
        if (bits) __hip_atomic_fetch_or(SEL + rw, bits, __ATOMIC_RELAXED, __HIP_MEMORY_SCOPE_WORKGROUP);
    }
    asm volatile("s_waitcnt lgkmcnt(0)" ::: "memory"); ATT_BAR();
    { NSA_LANE(); NSA_WS(); merge<true>(ocmp, ((const GAS float*)G)[row * 48 + hq * 3 + 0] * inv_cmp, shm, wid, r32, hh); }
    {
        NSA_LANE(); NSA_WS();
        const unsigned rowsel = SEL[32 * ph + r32];
        ATT_LOADQ(NSA_QROW);
        f32x16 o[2]; zero_o(o); float l = 0.f;
        sweep<2>(o, 0.f, l, qr, Hb, Hb + NSA_HM_STRIDE, 64, 0, qt + 1, 0, pos, rowsel, shm, ring, wid, lane);
        const float lt = swap_sum(l); const float inv = lt > 0.f ? 1.0f / lt : 0.f;
        merge<false>(o, ((const GAS float*)G)[row * 48 + hq * 3 + 1] * inv, shm, wid, r32, hh);
    }
    {
        NSA_LANE(); NSA_WS();
        ATT_LOADQ(NSA_QROW);
        f32x16 o[2]; zero_o(o); float l = 0.f;
        const int tlo = qt > 8 ? qt - 8 : 0;
        sweep<0>(o, 0.f, l, qr, Hb + 2 * NSA_HM_STRIDE, Hb + 3 * NSA_HM_STRIDE, 64, tlo, qt - tlo + 1, pos - 511, pos, 0u, shm, ring, wid, lane);
        const float lt = swap_sum(l); const float inv = lt > 0.f ? 1.0f / lt : 0.f;
        merge<false>(o, ((const GAS float*)G)[row * 48 + hq * 3 + 2] * inv, shm, wid, r32, hh);
    }
    { unsigned char* ws = ws_; asm volatile("" : "+s"(ws)); store_o((bf16_t*)(ws + off_o) + ((size_t)b * T + q0 + 32 * ph) * D + hq * 64, shm, wid, lane_id_volatile()); }
#undef NSA_WS
#undef NSA_LANE
#undef NSA_QROW
}
#undef ATT_LOADQ
#undef ATT_BAR
}

constexpr size_t MiB = 1u << 20;
constexpr size_t WS_CTL = 0, CTL_ZERO_BYTES = 1 * MiB;
constexpr size_t WS_WUP = 1 * MiB, WS_WDN = 33 * MiB;
constexpr size_t WS_WNSA = 65 * MiB, WNSA_STRIDE = (size_t)NSA_NP * D * 2;
constexpr size_t WS_WOUT = 76 * MiB;
constexpr size_t WS_WFOX = 84 * MiB;
constexpr size_t WS_WSWA = 84 * MiB + 6656 * 1024;
constexpr size_t WS_WCMP = 93 * MiB;
constexpr size_t WS_ROPEC = 97 * MiB, WS_ROPES = WS_ROPEC + 256 * 1024;
constexpr size_t WS_CMPB = WS_ROPES + 256 * 1024;
constexpr size_t WS_SWAB = WS_CMPB + 64 * 1024;
constexpr size_t WS_WGATE = 99 * MiB;
constexpr size_t WS_RSTD = 98 * MiB;
constexpr size_t WS_XN = 100 * MiB;
constexpr size_t WS_BIG = 164 * MiB;
constexpr size_t WS_O = WS_BIG + 192 * MiB;
constexpr size_t WS_G = 420 * MiB, WS_LF = 426 * MiB, WS_CB = 428 * MiB, WS_KC = 430 * MiB, WS_VC = 431 * MiB, WS_HID = 432 * MiB, WS_M2 = 440 * MiB, WS_END = 504 * MiB;
static_assert(WS_WSWA + (size_t)SWA_NP * D * 2 <= WS_WCMP && WS_WFOX + (size_t)FOX_NP * D * 2 <= WS_WSWA && WS_WNSA + 2 * WNSA_STRIDE <= WS_WOUT && WS_SWAB + 8192 <= WS_XN, "d_ws map");
static_assert((size_t)M * FF * 2 == 256 * MiB && WS_O + (size_t)M * D * 2 == WS_G && (size_t)M * 3072 * 2 == 192 * MiB, "d_ws map");
constexpr int CW_TMO = 0, CW_BAR = 4096;

constexpr int RING_OFF = 0, RING_BYTES = 142336;
constexpr int LDSCTL_OFF = RING_BYTES, MISC_OFF = LDSCTL_OFF + 320;
constexpr int LDS_BYTES = 147456;
static_assert(att::L_END <= RING_BYTES && MISC_OFF + 128 <= LDS_BYTES, "LDS map");
constexpr int NWAVES = 8;
#ifndef L_LO
#define L_LO 0
#endif
#ifndef L_HI
#define L_HI DEPTH
#endif

typedef GAS unsigned gu32;
typedef GAS unsigned long long gu64;
#define RLX_AGENT __ATOMIC_RELAXED, __HIP_MEMORY_SCOPE_AGENT
#define LDS_WAIT() asm volatile("s_waitcnt lgkmcnt(0)" ::: "memory")
#define VM_WAIT() asm volatile("s_waitcnt vmcnt(0)" ::: "memory")
__device__ __forceinline__ unsigned long long rt() { return __builtin_amdgcn_s_memrealtime(); }
__device__ __forceinline__ unsigned f2bf(float f) { unsigned u = __builtin_bit_cast(unsigned, f); return (u + 0x7fffu + ((u >> 16) & 1u)) >> 16; }
__device__ __forceinline__ unsigned pk2(float lo, float hi) { return f2bf(lo) | (f2bf(hi) << 16); }

#define XB_TMO      128
#define XB_XCNT(j)  (256  + 64 * (j))
#define XB_XSUB(j)  (1280 + 64 * (j))
#define XB_XGEN(j)  (2304 + 64 * (j))
#define XB_TOP      3328
#define XB_TOPGEN   3392
#define XCD_BAR_WORDS 3456
#define XB_SPIN_CAP (1u << 18)

__device__ __forceinline__ unsigned xb_ld(unsigned* p)              { return __hip_atomic_load(p, __ATOMIC_RELAXED, __HIP_MEMORY_SCOPE_AGENT); }
__device__ __forceinline__ unsigned xb_add(unsigned* p, unsigned v) { return __hip_atomic_fetch_add(p, v, __ATOMIC_RELAXED, __HIP_MEMORY_SCOPE_AGENT); }
__device__ __forceinline__ unsigned xb_xcc_id() { return (unsigned)__builtin_amdgcn_s_getreg((3 << 11) | 20) & 0xFu; }
#define XB_SPIN(cond, bar) do { unsigned _sp = 0; while (cond) { __builtin_amdgcn_s_sleep(1); \
    if ((++_sp & 255u) == 0u) { if (xb_ld(&(bar)[XB_TMO])) break; if (_sp > XB_SPIN_CAP) { atomicAdd(&(bar)[XB_TMO], 1u); break; } } } } while (0)

struct XcdBarrier {
    unsigned* bar; unsigned x;
    volatile LAS unsigned* st;
};

__device__ __forceinline__ XcdBarrier xcd_barrier_post(unsigned* bar, volatile LAS unsigned* st) {
    XcdBarrier b; b.bar = bar; b.x = xb_xcc_id(); b.st = st;
    if (threadIdx.x == 0) (void)xb_add(&bar[XB_XCNT(b.x)], 1u);
    return b;
}
__device__ __forceinline__ void xcd_barrier_complete(unsigned* bar, unsigned x, unsigned& nloc, unsigned& nx) {
    const unsigned G = gridDim.x * gridDim.y * gridDim.z;
    unsigned sum, cnt, mine, sp = 0u;
    for (;;) {
        sum = 0u; cnt = 0u; mine = 0u;
#pragma unroll
        for (unsigned j = 0; j < 16; ++j) { const unsigned c = xb_ld(&bar[XB_XCNT(j)]); sum += c; cnt += (c > 0u) ? 1u : 0u; mine = (j == x) ? c : mine; }
        if (sum == G) break;
        __builtin_amdgcn_s_sleep(1);
        if ((++sp & 255u) == 0u) { if (xb_ld(&bar[XB_TMO])) break; if (sp > XB_SPIN_CAP) { atomicAdd(&bar[XB_TMO], 1u); break; } }
    }
    nloc = mine > 0u ? mine : 1u; nx = cnt > 0u ? cnt : 1u;
}

__device__ __forceinline__ void xcd_barrier(const XcdBarrier& b) {
    asm volatile("s_waitcnt vmcnt(0)" ::: "memory");
    __syncthreads();
    if (threadIdx.x == 0) {
        unsigned* bar = b.bar;
        __builtin_amdgcn_s_waitcnt(0);
        unsigned nloc = b.st[0], nx = b.st[1];
        if (nloc == 0u) { xcd_barrier_complete(bar, b.x, nloc, nx); b.st[0] = nloc; b.st[1] = nx; }
        const unsigned old = xb_add(&bar[XB_XSUB(b.x)], 1u);
        const unsigned gen = old / nloc;
        if (old + 1u == (gen + 1u) * nloc) {
            __builtin_amdgcn_fence(__ATOMIC_RELEASE, "agent");
            asm volatile("s_waitcnt vmcnt(0)" ::: "memory");
            const unsigned og = xb_add(&bar[XB_TOP], 1u);
            const unsigned tg = og / nx;
            if (og + 1u == (tg + 1u) * nx) xb_add(&bar[XB_TOPGEN], 1u);
            else XB_SPIN(xb_ld(&bar[XB_TOPGEN]) == tg, bar);
            __builtin_amdgcn_fence(__ATOMIC_ACQUIRE, "agent");
            xb_add(&bar[XB_XGEN(b.x)], 1u);
            asm volatile("s_waitcnt vmcnt(0)" ::: "memory");
        } else {
            XB_SPIN(xb_ld(&bar[XB_XGEN(b.x)]) == gen, bar);
            __builtin_amdgcn_fence(__ATOMIC_ACQUIRE, "agent");
            asm volatile("s_waitcnt vmcnt(0)" ::: "memory");
        }
    }
    __syncthreads();
}

__device__ __forceinline__ float wave_sum(float v) {
    v += __builtin_bit_cast(float, __builtin_amdgcn_update_dpp(0, __builtin_bit_cast(int, v), 0xB1, 0xF, 0xF, true));
    v += __builtin_bit_cast(float, __builtin_amdgcn_update_dpp(0, __builtin_bit_cast(int, v), 0x4E, 0xF, 0xF, true));
    v += __builtin_bit_cast(float, __builtin_amdgcn_update_dpp(0, __builtin_bit_cast(int, v), 0x141, 0xF, 0xF, true));
    v += __builtin_bit_cast(float, __builtin_amdgcn_update_dpp(0, __builtin_bit_cast(int, v), 0x140, 0xF, 0xF, true));
    v += __builtin_bit_cast(float, __builtin_amdgcn_ds_swizzle(__builtin_bit_cast(int, v), 0x401F));
    { auto rr = __builtin_amdgcn_permlane32_swap(__float_as_uint(v), __float_as_uint(v), false, false); v = __uint_as_float(rr[0]) + __uint_as_float(rr[1]); }
    return v;
}

__device__ __forceinline__ int il64(int c) { return (c >> 1) + 32 * (c & 1); }
__device__ __forceinline__ int li64(int d) { return 2 * (d & 31) + (d >> 5); }
__device__ __forceinline__ int src_n(int mode, int n) { return (mode == 3 && n < 1152) ? (n & ~63) + il64(n & 63) : n; }
__device__ __forceinline__ int dst_n(int mode, int n) {
    if (mode == 1) { const int reg = n >> 8; const bool rope = reg < 4 || reg == 4 || reg == 6 || reg == 8; return rope ? (n & ~63) + li64(n & 63) : n; }
    if (mode == 3) return n < 1152 ? (n & ~63) + li64(n & 63) : n;
    return n;
}
__device__ __forceinline__ void conv_item(const float* W, int K, int N, bf16_t* WT, int mode, int item, LAS float* scr, int lane, int ld = 0) {
    if (ld == 0) ld = N;
    const int nblk = (N + 31) / 32, kb = item / nblk, nb = item % nblk, k0 = 64 * kb, n0 = 32 * nb;
    const int c4 = (lane & 7) * 4; const bool cin = (n0 + c4) < N;
#pragma unroll
    for (int i = 0; i < 8; ++i) { const int kk = (lane >> 3) + 8 * i; const int kd = (mode == 4) ? li64(kk) : kk;
        const f32x4 v = cin ? *(const GAS f32x4*)(W + (size_t)(k0 + kk) * ld + n0 + c4) : (f32x4){0.f, 0.f, 0.f, 0.f};
        scr[kd * 33 + c4] = v[0]; scr[kd * 33 + c4 + 1] = v[1]; scr[kd * 33 + c4 + 2] = v[2]; scr[kd * 33 + c4 + 3] = v[3]; }
    LDS_WAIT(); asm volatile("" ::: "memory");
    const int c = lane & 7;
#pragma unroll
    for (int j = 0; j < 4; ++j) { const int n = (lane >> 3) + 8 * j; const LAS float* s = scr + (8 * c) * 33 + n;
        u32x4 o; o.x = pk2(s[0 * 33], s[1 * 33]); o.y = pk2(s[2 * 33], s[3 * 33]); o.z = pk2(s[4 * 33], s[5 * 33]); o.w = pk2(s[6 * 33], s[7 * 33]);
        if (n0 + n < N) *(GAS u32x4*)(WT + (size_t)dst_n(mode, n0 + n) * K + k0 + 8 * c) = o; }
    LDS_WAIT(); asm volatile("" ::: "memory");
}
__device__ __forceinline__ void norm_row(const float* xrow, const float* g, bf16_t* orow, float* rstd_out, int lane) {
    f32x4 v[4]; float s = 0.f;
#pragma unroll
    for (int j = 0; j < 4; ++j) { v[j] = ((const GAS f32x4*)xrow)[lane + 64 * j]; s += (v[j][0] * v[j][0] + v[j][1] * v[j][1]) + (v[j][2] * v[j][2] + v[j][3] * v[j][3]); }
    const float rstd = 1.0f / sqrtf(wave_sum(s) * (1.0f / D) + NORM_EPS);
#pragma unroll
    for (int j = 0; j < 4; ++j) { const f32x4 gg = ((const GAS f32x4*)g)[lane + 64 * j]; u32x2 w; w.x = pk2(v[j][0] * rstd * gg[0], v[j][1] * rstd * gg[1]); w.y = pk2(v[j][2] * rstd * gg[2], v[j][3] * rstd * gg[3]);
        ((GAS u32x2*)orow)[lane + 64 * j] = w; }
    if (lane == 0) *rstd_out = rstd;
}
__device__ __forceinline__ void unpack4(u32x2 w, f32x4& o) { o[0] = __uint_as_float(w.x << 16); o[1] = __uint_as_float(w.x & 0xffff0000u); o[2] = __uint_as_float(w.y << 16); o[3] = __uint_as_float(w.y & 0xffff0000u); }
struct RowIn { f32x4 xv[4]; u32x2 mw[4]; float inv_rstd; };
__device__ __forceinline__ void resnorm_load(RowIn& R, const float* xin_f32, const bf16_t* xn, const float* rstd_io, const bf16_t* mrow, int lane) {
    if (xin_f32) {
#pragma unroll
        for (int j = 0; j < 4; ++j) R.xv[j] = ((const GAS f32x4*)xin_f32)[lane + 64 * j];
        R.inv_rstd = 1.f;
    } else {
#pragma unroll
        for (int j = 0; j < 4; ++j) { const u32x2 w = ((const GAS u32x2*)xn)[lane + 64 * j]; R.xv[j][0] = __uint_as_float(w.x); R.xv[j][1] = __uint_as_float(w.y); }
        R.inv_rstd = 1.0f / *(const GAS float*)rstd_io;
    }
#pragma unroll
    for (int j = 0; j < 4; ++j) R.mw[j] = ((const GAS u32x2*)mrow)[lane + 64 * j];
}
__device__ __forceinline__ void resnorm_finish(RowIn& R, bool from_f32, bf16_t* xn, float* rstd_io, const float* gcur, const float* gpost, const float* gnext, float* xout_f32, int lane) {
    f32x4 xv[4], mv[4]; float s = 0.f;
    if (from_f32) {
#pragma unroll
        for (int j = 0; j < 4; ++j) xv[j] = R.xv[j];
    } else {
#pragma unroll
        for (int j = 0; j < 4; ++j) { u32x2 w; w.x = __float_as_uint(R.xv[j][0]); w.y = __float_as_uint(R.xv[j][1]); unpack4(w, xv[j]); const f32x4 gg = ((const GAS f32x4*)gcur)[lane + 64 * j];
#pragma unroll
            for (int e = 0; e < 4; ++e) xv[j][e] = xv[j][e] * R.inv_rstd / gg[e]; }
    }
#pragma unroll
    for (int j = 0; j < 4; ++j) { unpack4(R.mw[j], mv[j]); s += (mv[j][0] * mv[j][0] + mv[j][1] * mv[j][1]) + (mv[j][2] * mv[j][2] + mv[j][3] * mv[j][3]); }
    const float rstd = 1.0f / sqrtf(wave_sum(s) * (1.0f / D) + NORM_EPS);
    float s2 = 0.f;
#pragma unroll
    for (int j = 0; j < 4; ++j) { const f32x4 gg = ((const GAS f32x4*)gpost)[lane + 64 * j];
#pragma unroll
        for (int e = 0; e < 4; ++e) { xv[j][e] += mv[j][e] * rstd * gg[e]; s2 += xv[j][e] * xv[j][e]; } }
    if (gnext) {
        const float rstd2 = 1.0f / sqrtf(wave_sum(s2) * (1.0f / D) + NORM_EPS);
#pragma unroll
        for (int j = 0; j < 4; ++j) { const f32x4 gg = ((const GAS f32x4*)gnext)[lane + 64 * j]; u32x2 w; w.x = pk2(xv[j][0] * rstd2 * gg[0], xv[j][1] * rstd2 * gg[1]); w.y = pk2(xv[j][2] * rstd2 * gg[2], xv[j][3] * rstd2 * gg[3]);
            ((GAS u32x2*)xn)[lane + 64 * j] = w; }
        if (lane == 0) *rstd_io = rstd2;
    } else {
#pragma unroll
        for (int j = 0; j < 4; ++j) ((GAS f32x4*)xout_f32)[lane + 64 * j] = xv[j];
    }
}
__device__ __forceinline__ void resnorm_rows2(int m0, int m1, const float* xin_f32, bf16_t* XN, float* RSTD, const float* gcur, const bf16_t* MB, const float* gpost, const float* gnext, float* xout_f32, int lane) {
    RowIn A, B;
    resnorm_load(A, xin_f32 ? xin_f32 + (size_t)m0 * D : nullptr, XN + (size_t)m0 * D, RSTD + m0, MB + (size_t)m0 * D, lane);
    resnorm_load(B, xin_f32 ? xin_f32 + (size_t)m1 * D : nullptr, XN + (size_t)m1 * D, RSTD + m1, MB + (size_t)m1 * D, lane);
    resnorm_finish(A, xin_f32 != nullptr, XN + (size_t)m0 * D, RSTD + m0, gcur, gpost, gnext, xout_f32 ? xout_f32 + (size_t)m0 * D : nullptr, lane);
    resnorm_finish(B, xin_f32 != nullptr, XN + (size_t)m1 * D, RSTD + m1, gcur, gpost, gnext, xout_f32 ? xout_f32 + (size_t)m1 * D : nullptr, lane);
}

struct Args { const float* in[17]; float* out; unsigned char* ws; };
constexpr int PT_OFF = LDSCTL_OFF;
__device__ __forceinline__ unsigned char* ldptr(LAS unsigned char* lds, int idx) {
    const volatile LAS unsigned* p = (const volatile LAS unsigned*)(lds + PT_OFF + idx * 8);
    const unsigned lo = (unsigned)__builtin_amdgcn_readfirstlane((int)p[0]), hi = (unsigned)__builtin_amdgcn_readfirstlane((int)p[1]);
    return (unsigned char*)(((unsigned long long)hi << 32) | lo);
}
#define INP(i) ((const float*)ldptr(lds, (i)))
#define OUTP ((float*)ldptr(lds, 17))
#define WSP (ldptr(lds, 18))
#define IDS int tid_ = wave_s * 64 + lane_id_volatile(); const int tid = tid_, lane = tid & 63, wave = wave_s; const int G = gridDim.x, bx = blockIdx.x; \
    const int vcu = (G % 8 == 0) ? (bx % 8) * (G / 8) + bx / 8 : bx; const int gw = vcu * NWAVES + wave, NGW = G * NWAVES; (void)lane; (void)gw; (void)NGW; (void)vcu; (void)bx; (void)tid; (void)wave
template <int MODE, int AMODE>
__device__ __forceinline__ void run_gemm(LAS unsigned char* lds, const bf16_t* A, const bf16_t* Bt, int Mr, int N, int K, const pg8::Epi<MODE>& E, int wave_s, int ord_g = 0, int ord_c = 0) {
    pg8::Gemm g{A, Bt, Mr, N, K}; pg8::StaticOrder S; if (ord_g) S.init(Mr, N, ord_g, ord_c); else S.init(Mr, N, (int)gridDim.x, (int)blockIdx.x);
#ifndef NO_GEMM
#ifdef ONLY_MODE
    if (MODE == ONLY_MODE)
#endif
    pg8::gemm_phase<pg8::Epi<MODE>, pg8::StaticOrder, AMODE, true, true>(lds, g, S, E, wave_s);
#endif
}

#ifndef REP_GIN
#define REP_GIN 1
#endif
#ifndef REP_CMP
#define REP_CMP 1
#endif
#ifndef REP_SCAN
#define REP_SCAN 1
#endif
#ifndef REP_ATT_NSA
#define REP_ATT_NSA 1
#endif
#ifndef REP_ATT_FOX
#define REP_ATT_FOX 1
#endif
#ifndef REP_ATT_SWA
#define REP_ATT_SWA 1
#endif
#ifndef REP_GOUT
#define REP_GOUT 1
#endif
#ifndef REP_MLP
#define REP_MLP 1
#endif
#ifndef REP_PRO
#define REP_PRO 1
#endif
template <int L>
__device__ __forceinline__ void layer_body(LAS unsigned char* lds, const XcdBarrier& bar, int& aslot, const int wave_s) {
#define GRID_BAR() xcd_barrier(bar)
    constexpr int kind = L % 3, sl = L / 3;
    if (kind == 0) {
        { unsigned char* ws = WSP;
          pg8::Epi<pg8::EM_NSA> E{(bf16_t*)(ws + WS_BIG), NSA_LDP, nullptr, (const float*)(ws + WS_ROPEC), (const float*)(ws + WS_ROPES), (float*)(ws + WS_G), nullptr, (bf16_t*)(ws + WS_BIG + NSA_HM_OFF), NSA_HM_STRIDE};
          run_gemm<pg8::EM_NSA, 0>(lds + RING_OFF, (const bf16_t*)(ws + WS_XN), (const bf16_t*)(ws + WS_WNSA) + (size_t)sl * NSA_NP * D, M, NSA_NP, D, E, wave_s); }
        GRID_BAR();
#if REP_GIN >= 2
        { unsigned char* ws = WSP;
          pg8::Epi<pg8::EM_NSA> E{(bf16_t*)(ws + WS_BIG), NSA_LDP, nullptr, (const float*)(ws + WS_ROPEC), (const float*)(ws + WS_ROPES), (float*)(ws + WS_G), nullptr, (bf16_t*)(ws + WS_BIG + NSA_HM_OFF), NSA_HM_STRIDE};
          run_gemm<pg8::EM_NSA, 0>(lds + RING_OFF, (const bf16_t*)(ws + WS_XN), (const bf16_t*)(ws + WS_WNSA) + (size_t)sl * NSA_NP * D, M, NSA_NP, D, E, wave_s); }
        GRID_BAR();
#endif
        if ((int)blockIdx.x < 64) { unsigned char* ws = WSP;
          pg8::Epi<pg8::EM_CMP> E{(bf16_t*)(ws + WS_HID), 256, (const float*)(ws + WS_CMPB) + sl * 512, nullptr, nullptr, nullptr, nullptr, nullptr, 0};
          run_gemm<pg8::EM_CMP, 1>(lds + RING_OFF, (const bf16_t*)(ws + WS_BIG) + 1024, (const bf16_t*)(ws + WS_WCMP) + (size_t)sl * 2 * 256 * 2048, CMP_ROWS, 512, 2048, E, wave_s); }
        else { unsigned char* ws = WSP;
          pg8::Epi<pg8::EM_GATE> E{nullptr, 0, nullptr, nullptr, nullptr, (float*)(ws + WS_G), nullptr, nullptr, 0};
          run_gemm<pg8::EM_GATE, 0>(lds + RING_OFF, (const bf16_t*)(ws + WS_XN), (const bf16_t*)(ws + WS_WGATE) + (size_t)sl * 256 * D, M, 256, D, E, wave_s, 192, (int)blockIdx.x - 64); }
        GRID_BAR();
#if REP_CMP >= 2
        if ((int)blockIdx.x < 64) { unsigned char* ws = WSP;
          pg8::Epi<pg8::EM_CMP> E{(bf16_t*)(ws + WS_HID), 256, (const float*)(ws + WS_CMPB) + sl * 512, nullptr, nullptr, nullptr, nullptr, nullptr, 0};
          run_gemm<pg8::EM_CMP, 1>(lds + RING_OFF, (const bf16_t*)(ws + WS_BIG) + 1024, (const bf16_t*)(ws + WS_WCMP) + (size_t)sl * 2 * 256 * 2048, CMP_ROWS, 512, 2048, E, wave_s); }
        else { unsigned char* ws = WSP;
          pg8::Epi<pg8::EM_GATE> E{nullptr, 0, nullptr, nullptr, nullptr, (float*)(ws + WS_G), nullptr, nullptr, 0};
          run_gemm<pg8::EM_GATE, 0>(lds + RING_OFF, (const bf16_t*)(ws + WS_XN), (const bf16_t*)(ws + WS_WGATE) + (size_t)sl * 256 * D, M, 256, D, E, wave_s, 192, (int)blockIdx.x - 64); }
        GRID_BAR();
#endif
        { IDS; unsigned char* ws = WSP; const bf16_t* HID = (const bf16_t*)(ws + WS_HID); const float* nsa_w2 = INP(7);
          const int which = bx >> 7, wl = bx & 127;
          LAS float* w2s = (LAS float*)(lds + RING_OFF);
          { const GAS f32x4* w2g = (const GAS f32x4*)(nsa_w2 + (size_t)(sl * 2 + which) * 256 * 64); for (int i = tid; i < 4096; i += 512) ((LAS f32x4*)w2s)[i] = w2g[i]; }
          __syncthreads();
          const int r0 = (wl * 8 + wave) * 8;
          float f[8][4], acc[8];
#pragma unroll
          for (int q = 0; q < 8; ++q) { const u32x2 hw = *(const GAS u32x2*)(HID + ((size_t)which * CMP_ROWS + r0 + q) * 256 + 4 * lane);
              f[q][0] = __uint_as_float(hw.x << 16); f[q][1] = __uint_as_float(hw.x & 0xffff0000u); f[q][2] = __uint_as_float(hw.y << 16); f[q][3] = __uint_as_float(hw.y & 0xffff0000u); acc[q] = 0.f; }
          const LAS float* wcol = w2s + (which ? lane : il64(lane));
          for (int jj = 0; jj < 64; ++jj) {
#pragma unroll
              for (int s = 0; s < 4; ++s) { const float w = wcol[(4 * jj + s) * 64];
#pragma unroll
                  for (int q = 0; q < 8; ++q) acc[q] += __builtin_bit_cast(float, __builtin_amdgcn_readlane(__builtin_bit_cast(int, f[q][s]), jj)) * w; }
          }
          bf16_t* dstb = (bf16_t*)(ws + (which ? WS_VC : WS_KC));
#pragma unroll
          for (int q = 0; q < 8; ++q) { const int r = r0 + q, gg = r & 3, c = (r >> 2) & 127, b = r >> 9;
              dstb[(size_t)((b * 4 + gg) * NCP + c) * 64 + lane] = (bf16_t)f2bf(c == NC ? 0.f : acc[q]); }
          __syncthreads();
        }
        GRID_BAR();
#if REP_CMP >= 2
        { IDS; unsigned char* ws = WSP; const bf16_t* HID = (const bf16_t*)(ws + WS_HID); const float* nsa_w2 = INP(7);
          const int which = bx >> 7, wl = bx & 127;
          LAS float* w2s = (LAS float*)(lds + RING_OFF);
          { const GAS f32x4* w2g = (const GAS f32x4*)(nsa_w2 + (size_t)(sl * 2 + which) * 256 * 64); for (int i = tid; i < 4096; i += 512) ((LAS f32x4*)w2s)[i] = w2g[i]; }
          __syncthreads();
          const int r0 = (wl * 8 + wave) * 8;
          float f[8][4], acc[8];
#pragma unroll
          for (int q = 0; q < 8; ++q) { const u32x2 hw = *(const GAS u32x2*)(HID + ((size_t)which * CMP_ROWS + r0 + q) * 256 + 4 * lane);
              f[q][0] = __uint_as_float(hw.x << 16); f[q][1] = __uint_as_float(hw.x & 0xffff0000u); f[q][2] = __uint_as_float(hw.y << 16); f[q][3] = __uint_as_float(hw.y & 0xffff0000u); acc[q] = 0.f; }
          const LAS float* wcol = w2s + (which ? lane : il64(lane));
          for (int jj = 0; jj < 64; ++jj) {
#pragma unroll
              for (int s = 0; s < 4; ++s) { const float w = wcol[(4 * jj + s) * 64];
#pragma unroll
                  for (int q = 0; q < 8; ++q) acc[q] += __builtin_bit_cast(float, __builtin_amdgcn_readlane(__builtin_bit_cast(int, f[q][s]), jj)) * w; }
          }
          bf16_t* dstb = (bf16_t*)(ws + (which ? WS_VC : WS_KC));
#pragma unroll
          for (int q = 0; q < 8; ++q) { const int r = r0 + q, gg = r & 3, c = (r >> 2) & 127, b = r >> 9;
              dstb[(size_t)((b * 4 + gg) * NCP + c) * 64 + lane] = (bf16_t)f2bf(c == NC ? 0.f : acc[q]); }
          __syncthreads();
        }
        GRID_BAR();
#endif
        { IDS; unsigned char* ws = WSP;
          const int bg = vcu >> 2, sub = vcu & 3, b = bg >> 2, g = bg & 3;
          for (int i = 0; i < 8; ++i) { const int qt = (i & 1) ? (8 * (i >> 1) + 7 - sub) : (8 * (i >> 1) + sub);
#ifndef NO_NSA
              att::nsa_unit(lds + RING_OFF, b, g, qt, ws, WS_BIG, WS_G, WS_KC, WS_VC, WS_O, wave, aslot);
#endif
          } }
#if REP_ATT_NSA >= 2
        GRID_BAR();
        { IDS; unsigned char* ws = WSP;
          const int bg = vcu >> 2, sub = vcu & 3, b = bg >> 2, g = bg & 3;
          for (int i = 0; i < 8; ++i) { const int qt = (i & 1) ? (8 * (i >> 1) + 7 - sub) : (8 * (i >> 1) + sub);
#ifndef NO_NSA
              att::nsa_unit(lds + RING_OFF, b, g, qt, ws, WS_BIG, WS_G, WS_KC, WS_VC, WS_O, wave, aslot);
#endif
          } }
#endif
    } else if (kind == 1) {
        { unsigned char* ws = WSP;
          pg8::Epi<pg8::EM_FOX> E{(bf16_t*)(ws + WS_BIG), FOX_LDP, nullptr, nullptr, nullptr, (float*)(ws + WS_LF), INP(10), (bf16_t*)(ws + WS_BIG + FOX_HM_OFF), FOX_HM_STRIDE};
          run_gemm<pg8::EM_FOX, 0>(lds + RING_OFF, (const bf16_t*)(ws + WS_XN), (const bf16_t*)(ws + WS_WFOX), M, FOX_NP, D, E, wave_s); }
        GRID_BAR();
#if REP_GIN >= 2
        { unsigned char* ws = WSP;
          pg8::Epi<pg8::EM_FOX> E{(bf16_t*)(ws + WS_BIG), FOX_LDP, nullptr, nullptr, nullptr, (float*)(ws + WS_LF), INP(10), (bf16_t*)(ws + WS_BIG + FOX_HM_OFF), FOX_HM_STRIDE};
          run_gemm<pg8::EM_FOX, 0>(lds + RING_OFF, (const bf16_t*)(ws + WS_XN), (const bf16_t*)(ws + WS_WFOX), M, FOX_NP, D, E, wave_s); }
        GRID_BAR();
#endif
        { IDS; unsigned char* ws = WSP; const float* LF = (const float*)(ws + WS_LF); float* CB = (float*)(ws + WS_CB);
          if (wave == 0) for (int bh = bx; bh < BATCH * NH; bh += G) {
            const int b = bh >> 4, h = bh & 15; float v[32]; float run = 0.f;
#pragma unroll
            for (int i = 0; i < 32; ++i) { run += LF[((size_t)b * T + 32 * lane + i) * 16 + h]; v[i] = run; }
            float excl = 0.f;
            for (int k = 0; k < 63; ++k) { const float t = __builtin_bit_cast(float, __builtin_amdgcn_readlane(__builtin_bit_cast(int, run), k)); if (lane > k) excl += t; }
#pragma unroll
            for (int i = 0; i < 32; ++i) CB[(size_t)bh * T + 32 * lane + i] = -(v[i] + excl) * LOG2E;
          } }
        GRID_BAR();
#if REP_SCAN >= 2
        { IDS; unsigned char* ws = WSP; const float* LF = (const float*)(ws + WS_LF); float* CB = (float*)(ws + WS_CB);
          if (wave == 0) for (int bh = bx; bh < BATCH * NH; bh += G) {
            const int b = bh >> 4, h = bh & 15; float v[32]; float run = 0.f;
#pragma unroll
            for (int i = 0; i < 32; ++i) { run += LF[((size_t)b * T + 32 * lane + i) * 16 + h]; v[i] = run; }
            float excl = 0.f;
            for (int k = 0; k < 63; ++k) { const float t = __builtin_bit_cast(float, __builtin_amdgcn_readlane(__builtin_bit_cast(int, run), k)); if (lane > k) excl += t; }
#pragma unroll
            for (int i = 0; i < 32; ++i) CB[(size_t)bh * T + 32 * lane + i] = -(v[i] + excl) * LOG2E;
          } }
        GRID_BAR();
#endif
        { IDS; unsigned char* ws = WSP;
          const int xcd = vcu >> 5, c = vcu & 31, sub = c & 3;
          for (int i = 0; i < 8; ++i) { const int bh = 32 * xcd + 8 * (i >> 1) + (c >> 2); const int qb = (i & 1) ? sub : 7 - sub;
#ifndef NO_FOX
              att::fox_unit(lds + RING_OFF, bh >> 4, bh & 15, qb, ws, WS_BIG, WS_CB, WS_O, wave, aslot);
#endif
          } }
#if REP_ATT_FOX >= 2
        GRID_BAR();
        { IDS; unsigned char* ws = WSP;
          const int xcd = vcu >> 5, c = vcu & 31, sub = c & 3;
          for (int i = 0; i < 8; ++i) { const int bh = 32 * xcd + 8 * (i >> 1) + (c >> 2); const int qb = (i & 1) ? sub : 7 - sub;
#ifndef NO_FOX
              att::fox_unit(lds + RING_OFF, bh >> 4, bh & 15, qb, ws, WS_BIG, WS_CB, WS_O, wave, aslot);
#endif
          } }
#endif
    } else {
        { unsigned char* ws = WSP;
          pg8::Epi<pg8::EM_SWA> E{(bf16_t*)(ws + WS_BIG), SWA_LDP, (const float*)(ws + WS_SWAB), (const float*)(ws + WS_ROPEC), (const float*)(ws + WS_ROPES), nullptr, nullptr, (bf16_t*)(ws + WS_BIG + SWA_HM_OFF), SWA_HM_STRIDE};
          run_gemm<pg8::EM_SWA, 0>(lds + RING_OFF, (const bf16_t*)(ws + WS_XN), (const bf16_t*)(ws + WS_WSWA), M, SWA_NP, D, E, wave_s); }
        GRID_BAR();
#if REP_GIN >= 2
        { unsigned char* ws = WSP;
          pg8::Epi<pg8::EM_SWA> E{(bf16_t*)(ws + WS_BIG), SWA_LDP, (const float*)(ws + WS_SWAB), (const float*)(ws + WS_ROPEC), (const float*)(ws + WS_ROPES), nullptr, nullptr, (bf16_t*)(ws + WS_BIG + SWA_HM_OFF), SWA_HM_STRIDE};
          run_gemm<pg8::EM_SWA, 0>(lds + RING_OFF, (const bf16_t*)(ws + WS_XN), (const bf16_t*)(ws + WS_WSWA), M, SWA_NP, D, E, wave_s); }
        GRID_BAR();
#endif
        { IDS; unsigned char* ws = WSP; const float* sinks = INP(14);
          const int bg = vcu >> 3, sub = vcu & 7;
          for (int i = 0; i < 8; ++i) {
#ifndef NO_SWA
              att::swa_unit(lds + RING_OFF, bg >> 1, bg & 1, 8 * i + sub, ws, WS_BIG, WS_O, sinks, wave, aslot);
#endif
          } }
#if REP_ATT_SWA >= 2
        GRID_BAR();
        { IDS; unsigned char* ws = WSP; const float* sinks = INP(14);
          const int bg = vcu >> 3, sub = vcu & 7;
          for (int i = 0; i < 8; ++i) {
#ifndef NO_SWA
              att::swa_unit(lds + RING_OFF, bg >> 1, bg & 1, 8 * i + sub, ws, WS_BIG, WS_O, sinks, wave, aslot);
#endif
          } }
#endif
    }
    GRID_BAR();
    { unsigned char* ws = WSP;
      pg8::Epi<pg8::EM_PLAIN> E{(bf16_t*)(ws + WS_BIG), D, kind == 2 ? INP(16) : nullptr, nullptr, nullptr, nullptr, nullptr, nullptr, 0};
      run_gemm<pg8::EM_PLAIN, 0>(lds + RING_OFF, (const bf16_t*)(ws + WS_O), (const bf16_t*)(ws + WS_WOUT) + (size_t)L * D * D, M, D, D, E, wave_s); }
    GRID_BAR();
#if REP_GOUT >= 2
    { unsigned char* ws = WSP;
      pg8::Epi<pg8::EM_PLAIN> E{(bf16_t*)(ws + WS_BIG), D, kind == 2 ? INP(16) : nullptr, nullptr, nullptr, nullptr, nullptr, nullptr, 0};
      run_gemm<pg8::EM_PLAIN, 0>(lds + RING_OFF, (const bf16_t*)(ws + WS_O), (const bf16_t*)(ws + WS_WOUT) + (size_t)L * D * D, M, D, D, E, wave_s); }
    GRID_BAR();
#endif
    { IDS; unsigned char* ws = WSP; const float* gL = INP(1) + (size_t)L * 4 * D; const float* xin = (L == 0) ? INP(0) : nullptr;
      const bf16_t* MB = (const bf16_t*)(ws + WS_BIG); bf16_t* XN = (bf16_t*)(ws + WS_XN); float* RSTD = (float*)(ws + WS_RSTD);
      for (int m = gw; m < M; m += 2 * NGW) resnorm_rows2(m, m + NGW, xin, XN, RSTD, gL, MB, gL + D, gL + 2 * D, nullptr, lane); }
    GRID_BAR();
    { unsigned char* ws = WSP;
      pg8::Epi<pg8::EM_RELU2> E{(bf16_t*)(ws + WS_BIG), FF, nullptr, nullptr, nullptr, nullptr, nullptr, nullptr, 0};
      run_gemm<pg8::EM_RELU2, 0>(lds + RING_OFF, (const bf16_t*)(ws + WS_XN), (const bf16_t*)(ws + WS_WUP) + (size_t)L * D * FF, M, FF, D, E, wave_s); }
    GRID_BAR();
#if REP_MLP >= 2
    { unsigned char* ws = WSP;
      pg8::Epi<pg8::EM_RELU2> E{(bf16_t*)(ws + WS_BIG), FF, nullptr, nullptr, nullptr, nullptr, nullptr, nullptr, 0};
      run_gemm<pg8::EM_RELU2, 0>(lds + RING_OFF, (const bf16_t*)(ws + WS_XN), (const bf16_t*)(ws + WS_WUP) + (size_t)L * D * FF, M, FF, D, E, wave_s); }
    GRID_BAR();
#endif
    { unsigned char* ws = WSP;
      pg8::Epi<pg8::EM_PLAIN> E{(bf16_t*)(ws + WS_M2), D, nullptr, nullptr, nullptr, nullptr, nullptr, nullptr, 0};
      run_gemm<pg8::EM_PLAIN, 0>(lds + RING_OFF, (const bf16_t*)(ws + WS_BIG), (const bf16_t*)(ws + WS_WDN) + (size_t)L * D * FF, M, D, FF, E, wave_s); }
    GRID_BAR();
#if REP_MLP >= 2
    { unsigned char* ws = WSP;
      pg8::Epi<pg8::EM_PLAIN> E{(bf16_t*)(ws + WS_M2), D, nullptr, nullptr, nullptr, nullptr, nullptr, nullptr, 0};
      run_gemm<pg8::EM_PLAIN, 0>(lds + RING_OFF, (const bf16_t*)(ws + WS_BIG), (const bf16_t*)(ws + WS_WDN) + (size_t)L * D * FF, M, D, FF, E, wave_s); }
    GRID_BAR();
#endif
    { IDS; unsigned char* ws = WSP; const float* gL = INP(1) + (size_t)L * 4 * D; float* xout = OUTP; bf16_t* XN = (bf16_t*)(ws + WS_XN); const bf16_t* M2 = (const bf16_t*)(ws + WS_M2); float* RSTD = (float*)(ws + WS_RSTD);
      for (int m = gw; m < M; m += 2 * NGW) resnorm_rows2(m, m + NGW, nullptr, XN, RSTD, gL + 2 * D, M2, gL + 3 * D, (L + 1 < DEPTH) ? gL + 4 * D : nullptr, (L + 1 < DEPTH) ? nullptr : xout, lane); }
    if (L + 1 < DEPTH) GRID_BAR();
#undef GRID_BAR
}

__global__ void __launch_bounds__(NWAVES * 64, 2) fwd_kernel(Args args) {
    extern __shared__ __attribute__((aligned(16))) unsigned char lds_raw[];
    LAS unsigned char* lds = (LAS unsigned char*)lds_raw;
    const int wave_s = __builtin_amdgcn_readfirstlane((int)threadIdx.x >> 6);
    for (int u = threadIdx.x; u < (LDS_BYTES - LDSCTL_OFF) / 4; u += NWAVES * 64) ((LAS unsigned*)(lds + LDSCTL_OFF))[u] = 0u;
    __syncthreads();
    if (threadIdx.x == 0) {
        LAS unsigned long long* pt = (LAS unsigned long long*)(lds + PT_OFF);
#pragma unroll
        for (int i = 0; i < 17; ++i) pt[i] = (unsigned long long)args.in[i];
        pt[17] = (unsigned long long)args.out; pt[18] = (unsigned long long)args.ws;
    }
    __syncthreads();
    volatile LAS unsigned* MISC = (volatile LAS unsigned*)(lds + MISC_OFF);
    XcdBarrier bar = xcd_barrier_post((unsigned*)(WSP + WS_CTL) + CW_BAR, MISC + 8);

    {
        IDS; unsigned char* ws = WSP;
        const float* x_in = INP(0); const float* norm_g = INP(1); const float* mlp_up = INP(2); const float* mlp_dn = INP(3);
        const float* nsa_w_in = INP(4); const float* nsa_pos = INP(5); const float* nsa_w1 = INP(6); const float* nsa_w_out = INP(8);
        const float* fox_w_in = INP(9); const float* fox_w_out = INP(11); const float* swa_w_in = INP(12); const float* swa_b_in = INP(13); const float* swa_w_out = INP(15);
        bf16_t* W_UP = (bf16_t*)(ws + WS_WUP); bf16_t* W_DN = (bf16_t*)(ws + WS_WDN); bf16_t* W_NSA = (bf16_t*)(ws + WS_WNSA); bf16_t* W_OUT = (bf16_t*)(ws + WS_WOUT);
        bf16_t* W_FOX = (bf16_t*)(ws + WS_WFOX); bf16_t* W_SWA = (bf16_t*)(ws + WS_WSWA); bf16_t* W_CMP = (bf16_t*)(ws + WS_WCMP);
        float* ROPEC = (float*)(ws + WS_ROPEC); float* ROPES = (float*)(ws + WS_ROPES); float* CMPB = (float*)(ws + WS_CMPB); float* SWAB = (float*)(ws + WS_SWAB);
        bf16_t* XN = (bf16_t*)(ws + WS_XN);
        LAS float* scr = (LAS float*)(lds + RING_OFF + wave * 16384);
        constexpr int I_UP = (D / 64) * (FF / 32), I_DN = (FF / 64) * (D / 32), I_NSA = (D / 64) * (NSA_NP / 32), I_GATE = (D / 64) * 2, I_OUT = (D / 64) * (D / 32), I_FOX = (D / 64) * ((FOX_N + 31) / 32), I_SWA = (D / 64) * (SWA_N / 32), I_CMP = (2048 / 64) * (256 / 32);
        constexpr int NITEMS = 4 * I_UP + 4 * I_DN + 2 * I_NSA + 2 * I_GATE + 4 * I_OUT + I_FOX + I_SWA + 4 * I_CMP;
        for (int it = gw; it < NITEMS; it += NGW) {
            int r = it;
            if (r < 4 * I_UP) { const int Lw = r / I_UP; conv_item(mlp_up + (size_t)Lw * D * FF, D, FF, W_UP + (size_t)Lw * D * FF, 0, r % I_UP, scr, lane); continue; } r -= 4 * I_UP;
            if (r < 4 * I_DN) { const int Lw = r / I_DN; conv_item(mlp_dn + (size_t)Lw * D * FF, FF, D, W_DN + (size_t)Lw * D * FF, 0, r % I_DN, scr, lane); continue; } r -= 4 * I_DN;
            if (r < 2 * I_NSA) { const int s = r / I_NSA; conv_item(nsa_w_in + (size_t)s * D * NSA_N, D, NSA_NP, W_NSA + (size_t)s * NSA_NP * D, 1, r % I_NSA, scr, lane, NSA_N); continue; } r -= 2 * I_NSA;
            if (r < 2 * I_GATE) { const int s = r / I_GATE; conv_item(nsa_w_in + (size_t)s * D * NSA_N + NSA_NP, D, 48, (bf16_t*)(ws + WS_WGATE) + (size_t)s * 256 * D, 0, r % I_GATE, scr, lane, NSA_N); continue; } r -= 2 * I_GATE;
            if (r < 4 * I_OUT) { const int Lw = r / I_OUT; const float* src = (Lw == 1) ? fox_w_out : (Lw == 2) ? swa_w_out : nsa_w_out + (size_t)(Lw / 3) * D * D;
                conv_item(src, D, D, W_OUT + (size_t)Lw * D * D, 0, r % I_OUT, scr, lane); continue; } r -= 4 * I_OUT;
            if (r < I_FOX) { conv_item(fox_w_in, D, FOX_N, W_FOX, 2, r, scr, lane); continue; } r -= I_FOX;
            if (r < I_SWA) { conv_item(swa_w_in, D, SWA_N, W_SWA, 3, r, scr, lane); continue; } r -= I_SWA;
            { const int sw = r / I_CMP;
                conv_item(nsa_w1 + (size_t)sw * 2048 * 256, 2048, 256, W_CMP + (size_t)sw * 256 * 2048, (sw & 1) ? 0 : 4, r % I_CMP, scr, lane); }
        }
        { constexpr int ZG = 208 * D / 8, ZF = (FOX_NP - FOX_N) * D / 8;
          for (int e = bx * 512 + tid; e < 2 * ZG + ZF; e += G * 512) {
              bf16_t* dst = e < ZG ? (bf16_t*)(ws + WS_WGATE) + (size_t)48 * D + (size_t)e * 8 : e < 2 * ZG ? (bf16_t*)(ws + WS_WGATE) + (size_t)256 * D + (size_t)48 * D + (size_t)(e - ZG) * 8 : W_FOX + (size_t)FOX_N * D + (size_t)(e - 2 * ZG) * 8;
              *(GAS u32x4*)dst = (u32x4){0u, 0u, 0u, 0u}; } }
        for (int e = bx * 512 + tid; e < T * 32; e += G * 512) { const int t = e >> 5, i = e & 31; const float inv = powf(10000.0f, -(float)(2 * i) / 64.0f); const float ang = (float)t * inv;
            ROPEC[e] = cosf(ang); ROPES[e] = sinf(ang); }
        for (int e = bx * 512 + tid; e < SWA_N; e += G * 512) SWAB[e] = swa_b_in[src_n(3, e)];
        for (int task = bx; task < 64; task += G) {
            const int sw = task >> 4, n0 = (task & 15) * 16, kq = tid >> 4, nn = tid & 15;
            const float* pos = nsa_pos + (size_t)sw * 2048; const float* w1 = nsa_w1 + (size_t)sw * 2048 * 256;
            float acc = 0.f;
#pragma unroll 8
            for (int k = kq * 64; k < kq * 64 + 64; ++k) acc += pos[k] * w1[(size_t)k * 256 + n0 + nn];
            LAS float* red = (LAS float*)(lds + RING_OFF);
            __syncthreads();
            red[kq * 16 + nn] = acc;
            __syncthreads();
            if (tid < 16) { float sm = 0.f; for (int q = 0; q < 32; ++q) sm += red[q * 16 + tid]; CMPB[sw * 256 + n0 + tid] = sm; }
            __syncthreads();
        }
        for (int m = gw; m < M; m += NGW) norm_row(x_in + (size_t)m * D, norm_g, XN + (size_t)m * D, (float*)(ws + WS_RSTD) + m, lane);
    }
#if REP_PRO >= 2
    xcd_barrier(bar);
    {
        IDS; unsigned char* ws = WSP;
        const float* x_in = INP(0); const float* norm_g = INP(1); const float* mlp_up = INP(2); const float* mlp_dn = INP(3);
        const float* nsa_w_in = INP(4); const float* nsa_pos = INP(5); const float* nsa_w1 = INP(6); const float* nsa_w_out = INP(8);
        const float* fox_w_in = INP(9); const float* fox_w_out = INP(11); const float* swa_w_in = INP(12); const float* swa_b_in = INP(13); const float* swa_w_out = INP(15);
        bf16_t* W_UP = (bf16_t*)(ws + WS_WUP); bf16_t* W_DN = (bf16_t*)(ws + WS_WDN); bf16_t* W_NSA = (bf16_t*)(ws + WS_WNSA); bf16_t* W_OUT = (bf16_t*)(ws + WS_WOUT);
        bf16_t* W_FOX = (bf16_t*)(ws + WS_WFOX); bf16_t* W_SWA = (bf16_t*)(ws + WS_WSWA); bf16_t* W_CMP = (bf16_t*)(ws + WS_WCMP);
        float* ROPEC = (float*)(ws + WS_ROPEC); float* ROPES = (float*)(ws + WS_ROPES); float* CMPB = (float*)(ws + WS_CMPB); float* SWAB = (float*)(ws + WS_SWAB);
        bf16_t* XN = (bf16_t*)(ws + WS_XN);
        LAS float* scr = (LAS float*)(lds + RING_OFF + wave * 16384);
        constexpr int I_UP = (D / 64) * (FF / 32), I_DN = (FF / 64) * (D / 32), I_NSA = (D / 64) * (NSA_NP / 32), I_GATE = (D / 64) * 2, I_OUT = (D / 64) * (D / 32), I_FOX = (D / 64) * ((FOX_N + 31) / 32), I_SWA = (D / 64) * (SWA_N / 32), I_CMP = (2048 / 64) * (256 / 32);
        constexpr int NITEMS = 4 * I_UP + 4 * I_DN + 2 * I_NSA + 2 * I_GATE + 4 * I_OUT + I_FOX + I_SWA + 4 * I_CMP;
        for (int it = gw; it < NITEMS; it += NGW) {
            int r = it;
            if (r < 4 * I_UP) { const int Lw = r / I_UP; conv_item(mlp_up + (size_t)Lw * D * FF, D, FF, W_UP + (size_t)Lw * D * FF, 0, r % I_UP, scr, lane); continue; } r -= 4 * I_UP;
            if (r < 4 * I_DN) { const int Lw = r / I_DN; conv_item(mlp_dn + (size_t)Lw * D * FF, FF, D, W_DN + (size_t)Lw * D * FF, 0, r % I_DN, scr, lane); continue; } r -= 4 * I_DN;
            if (r < 2 * I_NSA) { const int s = r / I_NSA; conv_item(nsa_w_in + (size_t)s * D * NSA_N, D, NSA_NP, W_NSA + (size_t)s * NSA_NP * D, 1, r % I_NSA, scr, lane, NSA_N); continue; } r -= 2 * I_NSA;
            if (r < 2 * I_GATE) { const int s = r / I_GATE; conv_item(nsa_w_in + (size_t)s * D * NSA_N + NSA_NP, D, 48, (bf16_t*)(ws + WS_WGATE) + (size_t)s * 256 * D, 0, r % I_GATE, scr, lane, NSA_N); continue; } r -= 2 * I_GATE;
            if (r < 4 * I_OUT) { const int Lw = r / I_OUT; const float* src = (Lw == 1) ? fox_w_out : (Lw == 2) ? swa_w_out : nsa_w_out + (size_t)(Lw / 3) * D * D;
                conv_item(src, D, D, W_OUT + (size_t)Lw * D * D, 0, r % I_OUT, scr, lane); continue; } r -= 4 * I_OUT;
            if (r < I_FOX) { conv_item(fox_w_in, D, FOX_N, W_FOX, 2, r, scr, lane); continue; } r -= I_FOX;
            if (r < I_SWA) { conv_item(swa_w_in, D, SWA_N, W_SWA, 3, r, scr, lane); continue; } r -= I_SWA;
            { const int sw = r / I_CMP;
                conv_item(nsa_w1 + (size_t)sw * 2048 * 256, 2048, 256, W_CMP + (size_t)sw * 256 * 2048, (sw & 1) ? 0 : 4, r % I_CMP, scr, lane); }
        }
        { constexpr int ZG = 208 * D / 8, ZF = (FOX_NP - FOX_N) * D / 8;
          for (int e = bx * 512 + tid; e < 2 * ZG + ZF; e += G * 512) {
              bf16_t* dst = e < ZG ? (bf16_t*)(ws + WS_WGATE) + (size_t)48 * D + (size_t)e * 8 : e < 2 * ZG ? (bf16_t*)(ws + WS_WGATE) + (size_t)256 * D + (size_t)48 * D + (size_t)(e - ZG) * 8 : W_FOX + (size_t)FOX_N * D + (size_t)(e - 2 * ZG) * 8;
              *(GAS u32x4*)dst = (u32x4){0u, 0u, 0u, 0u}; } }
        for (int e = bx * 512 + tid; e < T * 32; e += G * 512) { const int t = e >> 5, i = e & 31; const float inv = powf(10000.0f, -(float)(2 * i) / 64.0f); const float ang = (float)t * inv;
            ROPEC[e] = cosf(ang); ROPES[e] = sinf(ang); }
        for (int e = bx * 512 + tid; e < SWA_N; e += G * 512) SWAB[e] = swa_b_in[src_n(3, e)];
        for (int task = bx; task < 64; task += G) {
            const int sw = task >> 4, n0 = (task & 15) * 16, kq = tid >> 4, nn = tid & 15;
            const float* pos = nsa_pos + (size_t)sw * 2048; const float* w1 = nsa_w1 + (size_t)sw * 2048 * 256;
            float acc = 0.f;
#pragma unroll 8
            for (int k = kq * 64; k < kq * 64 + 64; ++k) acc += pos[k] * w1[(size_t)k * 256 + n0 + nn];
            LAS float* red = (LAS float*)(lds + RING_OFF);
            __syncthreads();
            red[kq * 16 + nn] = acc;
            __syncthreads();
            if (tid < 16) { float sm = 0.f; for (int q = 0; q < 32; ++q) sm += red[q * 16 + tid]; CMPB[sw * 256 + n0 + tid] = sm; }
            __syncthreads();
        }
        for (int m = gw; m < M; m += NGW) norm_row(x_in + (size_t)m * D, norm_g, XN + (size_t)m * D, (float*)(ws + WS_RSTD) + m, lane);
    }
#endif
    xcd_barrier(bar);

    int aslot = 0;
    if (L_LO <= 0 && 0 < L_HI) layer_body<0>(lds, bar, aslot, wave_s);
    if (L_LO <= 1 && 1 < L_HI) layer_body<1>(lds, bar, aslot, wave_s);
    if (L_LO <= 2 && 2 < L_HI) layer_body<2>(lds, bar, aslot, wave_s);
    if (L_LO <= 3 && 3 < L_HI) layer_body<3>(lds, bar, aslot, wave_s);
}

extern "C" void kernel_launch(void* const* d_in, const int* in_sizes, int n_in, void* d_out, int out_size, void* d_ws, size_t ws_size, hipStream_t stream) {
    static int grid = 0;
    if (grid == 0) {
        if (n_in != 17 || in_sizes[0] != M * D || out_size != M * D || ws_size < WS_END) { fprintf(stderr, "kernel_launch: unexpected problem shape (n_in %d, in0 %d, out %d, ws %zu)\n", n_in, n_in > 0 ? in_sizes[0] : -1, out_size, ws_size); grid = -1; return; }
        int dev = 0, cus = 0, per_cu = 0;
        if (hipGetDevice(&dev) != hipSuccess || hipDeviceGetAttribute(&cus, hipDeviceAttributeMultiprocessorCount, dev) != hipSuccess) { grid = -1; return; }
        if (hipFuncSetAttribute((const void*)fwd_kernel, hipFuncAttributeMaxDynamicSharedMemorySize, LDS_BYTES) != hipSuccess) { fprintf(stderr, "kernel_launch: hipFuncSetAttribute failed\n"); grid = -1; return; }
        if (hipOccupancyMaxActiveBlocksPerMultiprocessor(&per_cu, (const void*)fwd_kernel, NWAVES * 64, LDS_BYTES) != hipSuccess || per_cu < 1) { fprintf(stderr, "kernel_launch: occupancy query reports %d\n", per_cu); }
        (void)hipGetLastError();
        if (cus < 256) { fprintf(stderr, "kernel_launch: needs 256 CUs, device has %d\n", cus); grid = -1; return; }
        grid = 256;
    }
    if (grid < 0) return;
    if (hipMemsetAsync((char*)d_ws + WS_CTL, 0, CTL_ZERO_BYTES, stream) != hipSuccess) return;
    Args a{};
    for (int i = 0; i < 17; ++i) a.in[i] = (const float*)d_in[i];
    a.out = (float*)d_out; a.ws = (unsigned char*)d_ws;
    hipLaunchKernelGGL(fwd_kernel, dim3(grid), dim3(NWAVES * 64), LDS_BYTES, stream, a);
}
```
